# Optimizing an MI355X kernel written in HIP

```python
import jax, jax.numpy as jnp
from jax import lax
import numpy as np

D_MODEL = 4096
BATCH = 2
SEQ = 4096
DEPTH = 2

N_A_LAYERS = DEPTH // 2
N_B_LAYERS = DEPTH - N_A_LAYERS
D_FF = 4 * D_MODEL
EPS = 1e-6
NEG_BIG = -1e30

M_HEADS = 8
M_DV = D_MODEL // M_HEADS
M_DK = M_DV // 2
M_CHUNK = 64
GATE_CAP = 15.0
M_QK = M_HEADS * M_DK
M_SPLITS = (M_QK, 2 * M_QK, 2 * M_QK + D_MODEL, 2 * M_QK + 2 * D_MODEL)
M_IN = 2 * M_QK + 2 * D_MODEL + 2 * M_HEADS

N_HEADS = 32
HEAD_DIM = D_MODEL // N_HEADS
N_KV = 4
HPG = N_HEADS // N_KV
KV_DIM = N_KV * HEAD_DIM
N_BRANCH = 3
CMP_BLOCK = 32
CMP_STRIDE = 16
CMP_HIDDEN = 4 * HEAD_DIM
SEL_BLOCK = 64
N_SEL = 16
WINDOW = 512
Q_BLOCK = 64

kernel_name = "hybrid_mlstm_nsa_yoco"


def rms_norm(x, g):
    xf = x.astype(jnp.float32)
    y = xf * lax.rsqrt(jnp.mean(xf * xf, axis=-1, keepdims=True) + EPS)
    return (y * g.astype(jnp.float32)).astype(x.dtype)


def masked_softmax(s, mask):
    s = jnp.where(mask, s.astype(jnp.float32), NEG_BIG)
    return jax.nn.softmax(s, axis=-1) * mask


def soft_cap(x, cap):
    return cap * jnp.tanh(x / cap)


def squared_relu_mlp(xn, w_up, w_down):
    h = jax.nn.relu(xn @ w_up)
    return (h * h) @ w_down


def mlstm_chunkwise(q, k, v, log_i, log_f):
    B, H, S, DK = q.shape
    DV = v.shape[-1]
    L = M_CHUNK
    NC = S // L

    def to_chunks(a):
        a = a.astype(jnp.float32).reshape(B, H, NC, L, *a.shape[3:])
        return jnp.moveaxis(a, 2, 0)

    xs = (to_chunks(q), to_chunks(k), to_chunks(v), to_chunks(log_i), to_chunks(log_f))
    causal = jnp.tril(jnp.ones((L, L), dtype=bool))

    def step(carry, inp):
        C, n, m = carry
        qc, kc, vc, li, lf = inp
        b = jnp.cumsum(lf, axis=-1)
        log_d = jnp.where(causal, b[..., :, None] - b[..., None, :] + li[..., None, :], -jnp.inf)
        log_inter = b + m[..., None]
        m_t = jnp.maximum(log_inter, jnp.max(log_d, axis=-1))
        w_intra = jnp.exp(log_d - m_t[..., None])
        w_inter = jnp.exp(log_inter - m_t)
        s = jnp.einsum("bhtd,bhsd->bhts", qc, kc) * w_intra
        num = w_inter[..., None] * jnp.einsum("bhtd,bhde->bhte", qc, C) + jnp.einsum("bhts,bhse->bhte", s, vc)
        den = w_inter * jnp.einsum("bhtd,bhd->bht", qc, n) + jnp.sum(s, axis=-1)
        h = num / jnp.maximum(jnp.abs(den), jnp.exp(-m_t))[..., None]
        b_last = b[..., -1]
        log_w = b_last[..., None] - b + li
        m_new = jnp.maximum(b_last + m, jnp.max(log_w, axis=-1))
        wk = jnp.exp(log_w - m_new[..., None])[..., None] * kc
        decay = jnp.exp(b_last + m - m_new)
        C = decay[..., None, None] * C + jnp.einsum("bhsd,bhse->bhde", wk, vc)
        n = decay[..., None] * n + jnp.sum(wk, axis=2)
        return (C, n, m_new), h

    init = (jnp.zeros((B, H, DK, DV), jnp.float32),
            jnp.zeros((B, H, DK), jnp.float32),
            jnp.zeros((B, H), jnp.float32))
    _, h = lax.scan(step, init, xs)
    return jnp.moveaxis(h, 0, 2).reshape(B, H, S, DV)


def mlstm_mixer(xn, w_in, b_gate, head_g, w_out):
    B, S, _ = xn.shape
    proj = xn @ w_in
    q, k, v, o, g = jnp.split(proj, M_SPLITS, axis=-1)
    q = q.reshape(B, S, M_HEADS, M_DK).transpose(0, 2, 1, 3)
    k = k.reshape(B, S, M_HEADS, M_DK).transpose(0, 2, 1, 3) * (M_DK ** -0.5)
    v = v.reshape(B, S, M_HEADS, M_DV).transpose(0, 2, 1, 3)
    g = soft_cap(g.astype(jnp.float32) + b_gate.astype(jnp.float32), GATE_CAP)
    log_i = g[..., :M_HEADS].transpose(0, 2, 1)
    log_f = jax.nn.log_sigmoid(g[..., M_HEADS:]).transpose(0, 2, 1)
    h = mlstm_chunkwise(q, k, v, log_i, log_f)
    h = rms_norm(h, head_g.reshape(M_HEADS, 1, M_DV))
    h = h.transpose(0, 2, 1, 3).reshape(B, S, D_MODEL).astype(xn.dtype)
    return (jax.nn.sigmoid(o) * h) @ w_out


def nsa_shared_kv(xs, w_kv, k_norm_g, cmp_pos, cmp_w1, cmp_w2):
    B, S, _ = xs.shape
    kv = (xs @ w_kv).reshape(B, S, 2 * N_BRANCH, N_KV, HEAD_DIM)
    n_cmp = (S - CMP_BLOCK) // CMP_STRIDE + 1
    idx = np.arange(n_cmp)[:, None] * CMP_STRIDE + np.arange(CMP_BLOCK)[None, :]

    def compress(a, j):
        blk = a[:, idx] + cmp_pos[j][None, None, :, None, :]
        blk = blk.transpose(0, 3, 1, 2, 4).reshape(B, N_KV, n_cmp, CMP_BLOCK * HEAD_DIM)
        return jax.nn.gelu(blk @ cmp_w1[j]) @ cmp_w2[j]

    def to_bgsd(a):
        return a.transpose(0, 2, 1, 3)

    k_cmp = rms_norm(compress(kv[:, :, 0], 0), k_norm_g[0])
    v_cmp = compress(kv[:, :, 1], 1)
    k_sel = rms_norm(to_bgsd(kv[:, :, 2]), k_norm_g[1])
    v_sel = to_bgsd(kv[:, :, 3])
    k_win = rms_norm(to_bgsd(kv[:, :, 4]), k_norm_g[2])
    v_win = to_bgsd(kv[:, :, 5])
    return k_cmp, v_cmp, k_sel, v_sel, k_win, v_win


def cmp_to_sel_matrix(n_cmp, n_sb):
    c0 = np.arange(n_cmp)[:, None] * CMP_STRIDE
    s0 = np.arange(n_sb)[None, :] * SEL_BLOCK
    ov = np.minimum(c0 + CMP_BLOCK, s0 + SEL_BLOCK) - np.maximum(c0, s0)
    return jnp.asarray(np.maximum(ov, 0) / CMP_BLOCK, dtype=jnp.float32)


def nsa_mixer(xn, kv, w_qg, q_norm_g, w_out):
    k_cmp, v_cmp, k_sel, v_sel, k_win, v_win = kv
    B, S, _ = xn.shape
    n_cmp = k_cmp.shape[2]
    n_sb = S // SEL_BLOCK
    n_qb = S // Q_BLOCK
    top = min(N_SEL, n_sb)
    scale = HEAD_DIM ** -0.5
    t = jnp.arange(S)

    proj = xn @ w_qg
    q = proj[..., :D_MODEL].reshape(B, S, N_KV, HPG, HEAD_DIM).transpose(0, 2, 3, 1, 4)
    gates = jax.nn.sigmoid(proj[..., D_MODEL:].astype(jnp.float32))
    gates = gates.reshape(B, S, N_BRANCH, N_KV, HPG).transpose(2, 0, 3, 4, 1)[..., None]
    q_cmp = rms_norm(q, q_norm_g[0])
    q_sel = rms_norm(q, q_norm_g[1])
    q_win = rms_norm(q, q_norm_g[2])

    s = jnp.einsum("bghtd,bgcd->bghtc", q_cmp, k_cmp) * scale
    cmp_valid = (jnp.arange(n_cmp) * CMP_STRIDE + CMP_BLOCK - 1)[None, :] <= t[:, None]
    p_cmp = masked_softmax(s, cmp_valid)
    o_cmp = jnp.einsum("bghtc,bgcd->bghtd", p_cmp.astype(v_cmp.dtype), v_cmp)

    p_blk = jnp.einsum("bghtc,cj->bgtj", p_cmp, cmp_to_sel_matrix(n_cmp, n_sb))
    blk = jnp.arange(n_sb)[None, :]
    cur = (t // SEL_BLOCK)[:, None]
    forced = (blk == cur) | (blk == 0)
    p_blk = jnp.where(forced, jnp.inf, jnp.where(blk <= cur, p_blk, -jnp.inf))
    _, sel_idx = lax.top_k(p_blk, top)

    k_blocks = k_sel.reshape(B, N_KV, n_sb, SEL_BLOCK, HEAD_DIM)
    v_blocks = v_sel.reshape(B, N_KV, n_sb, SEL_BLOCK, HEAD_DIM)
    k_pad = jnp.pad(k_win, ((0, 0), (0, 0), (WINDOW, 0), (0, 0)))
    v_pad = jnp.pad(v_win, ((0, 0), (0, 0), (WINDOW, 0), (0, 0)))
    gather = jax.vmap(jax.vmap(lambda blocks, ix: blocks[ix].reshape(ix.shape[0], -1, HEAD_DIM)))

    def split_q(a):
        return jnp.moveaxis(a.reshape(B, N_KV, HPG, n_qb, Q_BLOCK, HEAD_DIM), 3, 0)

    xs = (split_q(q_sel), split_q(q_win),
          jnp.moveaxis(sel_idx.reshape(B, N_KV, n_qb, Q_BLOCK, top), 2, 0),
          jnp.arange(n_qb) * Q_BLOCK)

    def block_fn(inp):
        qs, qw, ix, start = inp
        tq = start + jnp.arange(Q_BLOCK)
        ks = gather(k_blocks, ix)
        vs = gather(v_blocks, ix)
        kpos = (ix[..., None] * SEL_BLOCK + jnp.arange(SEL_BLOCK)).reshape(B, N_KV, Q_BLOCK, -1)
        s_sel = jnp.einsum("bghqd,bgqkd->bghqk", qs, ks) * scale
        p_sel = masked_softmax(s_sel, (kpos <= tq[:, None])[:, :, None])
        o_sel = jnp.einsum("bghqk,bgqkd->bghqd", p_sel.astype(vs.dtype), vs)
        kw = lax.dynamic_slice_in_dim(k_pad, start, WINDOW + Q_BLOCK, axis=2)
        vw = lax.dynamic_slice_in_dim(v_pad, start, WINDOW + Q_BLOCK, axis=2)
        wpos = start - WINDOW + jnp.arange(WINDOW + Q_BLOCK)
        diff = tq[:, None] - wpos[None, :]
        wmask = (diff >= 0) & (diff < WINDOW) & (wpos[None, :] >= 0)
        s_win = jnp.einsum("bghqd,bgkd->bghqk", qw, kw) * scale
        p_win = masked_softmax(s_win, wmask)
        o_win = jnp.einsum("bghqk,bgkd->bghqd", p_win.astype(vw.dtype), vw)
        return o_sel, o_win

    o_sel, o_win = lax.map(block_fn, xs)

    def merge(o):
        return jnp.moveaxis(o, 0, 3).reshape(B, N_KV, HPG, S, HEAD_DIM)

    o = gates[0] * o_cmp + gates[1] * merge(o_sel) + gates[2] * merge(o_win)
    o = o.transpose(0, 3, 1, 2, 4).reshape(B, S, D_MODEL).astype(xn.dtype)
    return o @ w_out


def setup_inputs(seed: int = 0) -> dict:
    key = jax.random.key(seed)
    ks = jax.random.split(key, 24)
    f32 = jnp.float32

    def dense(k, shape, fan_in):
        return jax.random.normal(k, shape, f32) * (fan_in ** -0.5)

    def gain(k, shape):
        return 1.0 + 0.02 * jax.random.normal(k, shape, f32)

    gate_base = jnp.concatenate([jnp.full((M_HEADS,), -2.0, f32), jnp.full((M_HEADS,), 3.0, f32)])
    m_b_gate = gate_base[None, :] + 0.1 * jax.random.normal(ks[4], (N_A_LAYERS, 2 * M_HEADS), f32)
    return {
        "x": jax.random.normal(ks[0], (BATCH, SEQ, D_MODEL), f32),
        "attn_norm_g": gain(ks[1], (DEPTH, D_MODEL)),
        "mlp_norm_g": gain(ks[2], (DEPTH, D_MODEL)),
        "m_w_in": dense(ks[3], (N_A_LAYERS, D_MODEL, M_IN), D_MODEL),
        "m_b_gate": m_b_gate,
        "m_head_g": gain(ks[5], (N_A_LAYERS, D_MODEL)),
        "m_w_out": dense(ks[6], (N_A_LAYERS, D_MODEL, D_MODEL), D_MODEL),
        "kv_norm_g": gain(ks[7], (D_MODEL,)),
        "w_kv": dense(ks[8], (D_MODEL, 2 * N_BRANCH * KV_DIM), D_MODEL),
        "k_norm_g": gain(ks[9], (N_BRANCH, HEAD_DIM)),
        "cmp_pos": 0.1 * jax.random.normal(ks[10], (2, CMP_BLOCK, HEAD_DIM), f32),
        "cmp_w1": dense(ks[11], (2, CMP_BLOCK * HEAD_DIM, CMP_HIDDEN), CMP_BLOCK * HEAD_DIM),
        "cmp_w2": dense(ks[12], (2, CMP_HIDDEN, HEAD_DIM), CMP_HIDDEN),
        "n_w_qg": dense(ks[13], (N_B_LAYERS, D_MODEL, D_MODEL + N_BRANCH * N_HEADS), D_MODEL),
        "q_norm_g": gain(ks[14], (N_B_LAYERS, N_BRANCH, HEAD_DIM)),
        "n_w_out": dense(ks[15], (N_B_LAYERS, D_MODEL, D_MODEL), D_MODEL),
        "mlp_w_up": dense(ks[16], (DEPTH, D_MODEL, D_FF), D_MODEL),
        "mlp_w_down": dense(ks[17], (DEPTH, D_FF, D_MODEL), D_FF),
    }


def reference(x, attn_norm_g, mlp_norm_g, m_w_in, m_b_gate, m_head_g, m_w_out, kv_norm_g, w_kv,
              k_norm_g, cmp_pos, cmp_w1, cmp_w2, n_w_qg, q_norm_g, n_w_out, mlp_w_up, mlp_w_down):
    shared_kv = None
    for layer in range(DEPTH):
        h = rms_norm(x, attn_norm_g[layer])
        if layer < N_A_LAYERS:
            a = layer
            x = x + mlstm_mixer(h, m_w_in[a], m_b_gate[a], m_head_g[a], m_w_out[a])
        else:
            if shared_kv is None:
                shared_kv = nsa_shared_kv(rms_norm(x, kv_norm_g), w_kv, k_norm_g, cmp_pos, cmp_w1, cmp_w2)
            b = layer - N_A_LAYERS
            x = x + nsa_mixer(h, shared_kv, n_w_qg[b], q_norm_g[b], n_w_out[b])
        x = x + squared_relu_mlp(rms_norm(x, mlp_norm_g[layer]), mlp_w_up[layer], mlp_w_down[layer])
    return x
```

```cpp
#include <hip/hip_runtime.h>
#include <hip/hip_bf16.h>
#include <cstdio>
#include <cstdint>
#include <cmath>
namespace pg8 {
#define PG8_LAS __attribute__((address_space(3)))
typedef unsigned short bf16_t;
typedef short bf16x8 __attribute__((ext_vector_type(8)));
typedef float f32x4 __attribute__((ext_vector_type(4)));
typedef unsigned u32x4 __attribute__((ext_vector_type(4)));
constexpr int BM = 256, BK = 64, HALF = 128, HTB = HALF * BK * 2  , STAGE_BYTES = 8 * HTB, NXCD = 8, WGM = 8;

__host__ __device__ __forceinline__ int lds_byte(int r, int c) { const int st = (r >> 4) * 2 + (c >> 5), rr = r & 15, cc = c & 31, ob = rr * 64 + cc * 2; return st * 1024 + (ob ^ (((ob >> 9) & 1) << 5)); }
__host__ __device__ __forceinline__ void stage_rc(int b, int& R, int& C) { const int st = b / 1024, sb = b % 1024, swz = sb ^ (((sb >> 9) & 1) << 5); R = (st >> 1) * 16 + swz / 64; C = (st & 1) * 32 + (swz % 64) / 2; }
__host__ __device__ __forceinline__ int perm32(int rho) { const int n = rho >> 4, i = rho & 15; return 8 * (i >> 2) + 4 * n + (i & 3); }

struct Unit { int pm, pn; };
struct Gemm { const bf16_t* A; const bf16_t* Bt; int M, N, K; };

struct StaticOrder {
    int nM, nN, nwg, G, c;
    __host__ __device__ void init(int M, int N, int G_, int c_) { nM = M / BM; nN = N / BM; nwg = nM * nN; G = G_; c = c_; }
    __host__ __device__ bool next(int i, Unit& u) const {
        const long L = (long)i * G + c; if (L >= nwg) return false;
        int wgid = (int)L; { const int q = nwg / NXCD, r = nwg % NXCD, xcd = wgid % NXCD, off = wgid / NXCD; wgid = (xcd < r ? xcd * (q + 1) : r * (q + 1) + (xcd - r) * q) + off; }
        const int nig = WGM * nN, gid = wgid / nig, fm = gid * WGM, gsz = (nM - fm) < WGM ? (nM - fm) : WGM;
        u.pm = fm + ((wgid % nig) % gsz); u.pn = (wgid % nig) / gsz; return true;
    }
    __device__ __forceinline__ void a_ready(const Unit&) const {}
    __device__ __forceinline__ void done(const Unit&) const {}
};

typedef float f32x2c __attribute__((ext_vector_type(2))); typedef __bf16 bf16x2c __attribute__((ext_vector_type(2)));
__device__ __forceinline__ unsigned cvt_pk_bf16(float lo, float hi) { f32x2c v = {lo, hi}; bf16x2c b = __builtin_convertvector(v, bf16x2c); return __builtin_bit_cast(unsigned, b); }
template <int ACT  > struct EpiBf16 {
    static constexpr bool PERM = true, AFTER_DRAIN = false;
    bf16_t* O; int ldc;
    __device__ __forceinline__ void operator()(const f32x4 (&acc)[2][2][4][2], const Unit& u, int wr, int wc, int fr, int fq) const {
        const int row0 = u.pm * BM + wr * 64 + fr, col0 = u.pn * BM + wc * 32 + 8 * fq;
#pragma unroll
        for (int ai = 0; ai < 2; ++ai)
#pragma unroll
            for (int m = 0; m < 4; ++m) { bf16_t* rowp = O + (size_t)(row0 + ai * HALF + m * 16) * ldc + col0;
#pragma unroll
                for (int bj = 0; bj < 2; ++bj) { f32x4 v0 = acc[ai][bj][m][0], v1 = acc[ai][bj][m][1];
                    if (ACT == 2) {
#pragma unroll
                        for (int e = 0; e < 4; ++e) { const float a = fmaxf(v0[e], 0.f), b = fmaxf(v1[e], 0.f); v0[e] = a * a; v1[e] = b * b; } }
                    u32x4 w; w.x = cvt_pk_bf16(v0[0], v0[1]); w.y = cvt_pk_bf16(v0[2], v0[3]); w.z = cvt_pk_bf16(v1[0], v1[1]); w.w = cvt_pk_bf16(v1[2], v1[3]);
                    *(u32x4*)(rowp + bj * HALF) = w; } }
    }
};
struct EpiResF32 {
    static constexpr bool PERM = false, AFTER_DRAIN = false;
    const float* base; float* out; int ldc;
    __device__ __forceinline__ void operator()(const f32x4 (&acc)[2][2][4][2], const Unit& u, int wr, int wc, int fr, int fq) const {
        const int col0 = u.pn * BM + wc * 32 + 4 * fq;
#pragma unroll
        for (int ai = 0; ai < 2; ++ai)
#pragma unroll
            for (int m = 0; m < 4; ++m) { const size_t off = (size_t)(u.pm * BM + ai * HALF + wr * 64 + m * 16 + fr) * ldc + col0;
#pragma unroll
                for (int bj = 0; bj < 2; ++bj)
#pragma unroll
                    for (int n = 0; n < 2; ++n) { const f32x4 bs = *(const f32x4*)(base + off + bj * HALF + n * 16); *(f32x4*)(out + off + bj * HALF + n * 16) = bs + acc[ai][bj][m][n]; } }
    }
};

template <class Epi, class Sched, bool ALIGN_EPI = false, bool SP2 = false>
__device__ __forceinline__ void gemm_phase(PG8_LAS unsigned char* lds, const Gemm g, const Sched& S, const Epi& E) {
    const int tid = threadIdx.x, wid = __builtin_amdgcn_readfirstlane(tid >> 6), lane = tid & 63, wr = wid >> 2, wc = wid & 3, fr = lane & 15, fq = lane >> 4;
    const int K = g.K, nt = K / BK;
    unsigned voffA[2], voffB[2];
#pragma unroll
    for (int i = 0; i < 2; ++i) { int R, C; stage_rc(tid * 16 + i * 8192, R, C); const int Rb = Epi::PERM ? ((R & ~31) + perm32(R & 31)) : R;
        voffA[i] = (unsigned)(R * K + C) * 2u; voffB[i] = (unsigned)(Rb * K + C) * 2u; }
    const size_t kstep = (size_t)(BK * 2);
    const size_t hstep = (size_t)HALF * K * 2;
    const size_t tstep = 2 * hstep;
    const unsigned ldsw = (unsigned)wid * 1024u;
    const int aoff = lds_byte(wr * 64 + fr, fq * 8), boff = lds_byte(wc * 32 + fr, fq * 8);
#define PG8_SA(b, h) (((b) * 2 + (h)) * HTB)
#define PG8_SB(b, h) ((4 + (b) * 2 + (h)) * HTB)
#define PG8_STAGE(bufoff, gbase, voff) do { _Pragma("unroll") for (int _i = 0; _i < 2; ++_i) \
        __builtin_amdgcn_global_load_lds((const unsigned*)((const char*)(gbase) + (voff)[_i]), (PG8_LAS unsigned*)(lds + (bufoff) + ldsw + _i * 8192), 16, 0, 0); } while (0)
#define PG8_LDA(dst, b, h) do { _Pragma("unroll") for (int m = 0; m < 4; ++m) _Pragma("unroll") for (int k = 0; k < 2; ++k) dst[m][k] = *(const PG8_LAS bf16x8*)(lds + PG8_SA(b, h) + aoff + m * 2048 + k * 1024); } while (0)
#define PG8_LDB(dst, b, h) do { _Pragma("unroll") for (int n = 0; n < 2; ++n) _Pragma("unroll") for (int k = 0; k < 2; ++k) dst[n][k] = *(const PG8_LAS bf16x8*)(lds + PG8_SB(b, h) + boff + n * 2048 + k * 1024); } while (0)
#define PG8_MMA(ai, bj, At, Bt) do { __builtin_amdgcn_s_setprio(1); _Pragma("unroll") for (int m = 0; m < 4; ++m) _Pragma("unroll") for (int n = 0; n < 2; ++n) _Pragma("unroll") for (int k = 0; k < 2; ++k) \
        acc[ai][bj][m][n] = __builtin_amdgcn_mfma_f32_16x16x32_bf16(Bt[n][k], At[m][k], acc[ai][bj][m][n], 0, 0, 0); __builtin_amdgcn_s_setprio(0); } while (0)
#define PG8_WAIT_V(n) asm volatile("s_waitcnt vmcnt(" #n ")" ::: "memory")
#define PG8_WAIT_L(n) asm volatile("s_waitcnt lgkmcnt(" #n ")" ::: "memory")
#define PG8_BAR __builtin_amdgcn_s_barrier()
#define PG8_SCHED __builtin_amdgcn_sched_barrier(0)
    Unit cur, nxt; int ui = 0;
    if (!S.next(0, cur)) return;
    f32x4 acc[2][2][4][2];
#pragma unroll
    for (int a = 0; a < 2; ++a)
#pragma unroll
        for (int b = 0; b < 2; ++b)
#pragma unroll
            for (int m = 0; m < 4; ++m)
#pragma unroll
                for (int n = 0; n < 2; ++n) acc[a][b][m][n] = (f32x4){0.f, 0.f, 0.f, 0.f};
    bf16x8 At[4][2], B0[2][2], B1[2][2];
    const char* cA = (const char*)g.A + (size_t)cur.pm * tstep; const char* cB = (const char*)g.Bt + (size_t)cur.pn * tstep;
    S.a_ready(cur);
    if constexpr (SP2) {
        PG8_STAGE(PG8_SB(0, 0), cB, voffB); PG8_STAGE(PG8_SB(0, 1), cB + hstep, voffB); PG8_STAGE(PG8_SA(0, 0), cA, voffA); PG8_STAGE(PG8_SA(0, 1), cA + hstep, voffA);
        if (wr == 1) PG8_BAR;
        PG8_WAIT_V(2); PG8_BAR;
        PG8_STAGE(PG8_SB(1, 0), cB + kstep, voffB); PG8_STAGE(PG8_SA(1, 0), cA + kstep, voffA); PG8_STAGE(PG8_SB(1, 1), cB + hstep + kstep, voffB);
        PG8_WAIT_V(6); PG8_BAR;
    } else {
        PG8_STAGE(PG8_SB(0, 0), cB, voffB); PG8_STAGE(PG8_SA(0, 0), cA, voffA); PG8_STAGE(PG8_SB(0, 1), cB + hstep, voffB); PG8_STAGE(PG8_SA(0, 1), cA + hstep, voffA);
        if (wr == 1) PG8_BAR;
        PG8_WAIT_V(4); PG8_BAR;
        PG8_STAGE(PG8_SB(1, 0), cB + kstep, voffB); PG8_STAGE(PG8_SA(1, 0), cA + kstep, voffA); PG8_STAGE(PG8_SB(1, 1), cB + hstep + kstep, voffB);
        PG8_WAIT_V(6); PG8_BAR;
    }
    for (;;) {
        const bool has_next = S.next(ui + 1, nxt);
        const char* nA = has_next ? (const char*)g.A + (size_t)nxt.pm * tstep : cA; const char* nB = has_next ? (const char*)g.Bt + (size_t)nxt.pn * tstep : cB;
        for (int t = 0; t < nt; t += 2) {
            const bool last = (t == nt - 2);
            const char* a1 = cA + (size_t)(t + 1) * kstep;
            const char* a2 = last ? nA : cA + (size_t)(t + 2) * kstep; const char* b2 = last ? nB : cB + (size_t)(t + 2) * kstep;
            const char* a3 = a2 + kstep; const char* b3 = b2 + kstep;
            if (last && has_next) S.a_ready(nxt);
            if constexpr (SP2) {
            PG8_LDB(B0, 0, 0); PG8_LDB(B1, 0, 1); PG8_SCHED; PG8_LDA(At, 0, 0); PG8_STAGE(PG8_SA(1, 1), a1 + hstep, voffA);
            PG8_WAIT_V(8); PG8_WAIT_L(0); PG8_BAR; PG8_MMA(0, 0, At, B0); PG8_MMA(0, 1, At, B1); PG8_BAR; PG8_SCHED;
            PG8_LDA(At, 0, 1); PG8_STAGE(PG8_SB(0, 0), b2, voffB); PG8_STAGE(PG8_SB(0, 1), b2 + hstep, voffB); PG8_STAGE(PG8_SA(0, 0), a2, voffA);
            PG8_WAIT_V(8); PG8_WAIT_L(0); PG8_BAR; PG8_MMA(1, 0, At, B0); PG8_MMA(1, 1, At, B1); PG8_BAR; PG8_SCHED;
            PG8_LDB(B0, 1, 0); PG8_LDB(B1, 1, 1); PG8_SCHED; PG8_LDA(At, 1, 0); PG8_STAGE(PG8_SA(0, 1), a2 + hstep, voffA);
            PG8_WAIT_V(8); PG8_WAIT_L(0); PG8_BAR; PG8_MMA(0, 0, At, B0); PG8_MMA(0, 1, At, B1); PG8_BAR; PG8_SCHED;
            PG8_LDA(At, 1, 1); PG8_STAGE(PG8_SB(1, 0), b3, voffB); PG8_STAGE(PG8_SB(1, 1), b3 + hstep, voffB); PG8_STAGE(PG8_SA(1, 0), a3, voffA);
            PG8_WAIT_V(8); PG8_WAIT_L(0); PG8_BAR; PG8_MMA(1, 0, At, B0); PG8_MMA(1, 1, At, B1); PG8_BAR; PG8_SCHED;
            } else {
            PG8_LDB(B0, 0, 0); PG8_SCHED; PG8_LDA(At, 0, 0); PG8_STAGE(PG8_SA(1, 1), a1 + hstep, voffA);
            PG8_WAIT_L(8); PG8_BAR; PG8_WAIT_L(0); PG8_MMA(0, 0, At, B0); PG8_BAR; PG8_SCHED;
            PG8_LDB(B1, 0, 1); PG8_STAGE(PG8_SB(0, 0), b2, voffB);
            PG8_BAR; PG8_WAIT_L(0); PG8_MMA(0, 1, At, B1); PG8_BAR;
            PG8_LDA(At, 0, 1); PG8_STAGE(PG8_SA(0, 0), a2, voffA);
            PG8_BAR; PG8_WAIT_L(0); PG8_MMA(1, 0, At, B0); PG8_BAR; PG8_SCHED;
            PG8_STAGE(PG8_SB(0, 1), b2 + hstep, voffB);
            PG8_WAIT_V(6); PG8_BAR; PG8_MMA(1, 1, At, B1); PG8_BAR;
            PG8_LDB(B0, 1, 0); PG8_SCHED; PG8_LDA(At, 1, 0); PG8_STAGE(PG8_SA(0, 1), a2 + hstep, voffA);
            PG8_WAIT_L(8); PG8_BAR; PG8_WAIT_L(0); PG8_MMA(0, 0, At, B0); PG8_BAR; PG8_SCHED;
            PG8_LDB(B1, 1, 1); PG8_STAGE(PG8_SB(1, 0), b3, voffB);
            PG8_BAR; PG8_WAIT_L(0); PG8_MMA(0, 1, At, B1); PG8_BAR;
            PG8_LDA(At, 1, 1); PG8_STAGE(PG8_SA(1, 0), a3, voffA);
            PG8_BAR; PG8_WAIT_L(0); PG8_MMA(1, 0, At, B0); PG8_BAR; PG8_SCHED;
            PG8_STAGE(PG8_SB(1, 1), b3 + hstep, voffB);
            PG8_WAIT_V(6); PG8_BAR; PG8_MMA(1, 1, At, B1); PG8_BAR;
            }
        }
        if constexpr (ALIGN_EPI) { if (wr == 0) PG8_BAR; }
        if constexpr (!Epi::AFTER_DRAIN) { E(acc, cur, wr, wc, fr, fq); S.done(cur); }
        if (!has_next) break;
#pragma unroll
        for (int a = 0; a < 2; ++a)
#pragma unroll
            for (int b = 0; b < 2; ++b)
#pragma unroll
                for (int m = 0; m < 4; ++m)
#pragma unroll
                    for (int n = 0; n < 2; ++n) acc[a][b][m][n] = (f32x4){0.f, 0.f, 0.f, 0.f};
        cur = nxt; cA = nA; cB = nB; ++ui;
        if constexpr (ALIGN_EPI) { if (wr == 1) PG8_BAR; }
    }
    PG8_WAIT_V(0);
    if constexpr (!ALIGN_EPI) { if (wr == 0) PG8_BAR; }
    PG8_BAR;
    if constexpr (Epi::AFTER_DRAIN) { E.fused(acc, cur, wr, wc, fr, fq, lds, wid, lane); S.done(cur); }
#undef PG8_SA
#undef PG8_SB
#undef PG8_STAGE
#undef PG8_LDA
#undef PG8_LDB
#undef PG8_MMA
#undef PG8_WAIT_V
#undef PG8_WAIT_L
#undef PG8_BAR
#undef PG8_SCHED
}
}
#define GAS __attribute__((address_space(1)))
#define LAS __attribute__((address_space(3)))
typedef unsigned short bf16;
typedef unsigned v4u __attribute__((ext_vector_type(4)));
typedef float f32x4 __attribute__((ext_vector_type(4)));
typedef short bf16x8 __attribute__((ext_vector_type(8)));
typedef GAS unsigned gu32;
typedef GAS unsigned long long gu64;
#define RLX_AGENT __ATOMIC_RELAXED, __HIP_MEMORY_SCOPE_AGENT
#define LDS_WAIT() asm volatile("s_waitcnt lgkmcnt(0)" ::: "memory")
#define VM_WAIT() asm volatile("s_waitcnt vmcnt(0)" ::: "memory")
__device__ __forceinline__ unsigned long long rt() { return __builtin_amdgcn_s_memrealtime(); }

#define XB_TMO      128
#define XB_XCNT(j)  (256  + 64 * (j))
#define XB_XSUB(j)  (1280 + 64 * (j))
#define XB_XGEN(j)  (2304 + 64 * (j))
#define XB_TOP      3328
#define XB_TOPGEN   3392
#define XCD_BAR_WORDS 3456
#define XB_SPIN_CAP (1u << 18)

__device__ __forceinline__ unsigned xb_ld(unsigned* p)              { return __hip_atomic_load(p, __ATOMIC_RELAXED, __HIP_MEMORY_SCOPE_AGENT); }
__device__ __forceinline__ unsigned xb_add(unsigned* p, unsigned v) { return __hip_atomic_fetch_add(p, v, __ATOMIC_RELAXED, __HIP_MEMORY_SCOPE_AGENT); }
__device__ __forceinline__ unsigned xb_xcc_id() { return (unsigned)__builtin_amdgcn_s_getreg((3 << 11) | 20) & 0xFu; }
#define XB_SPIN(cond, bar) do { unsigned _sp = 0; while (cond) { __builtin_amdgcn_s_sleep(1); \
    if ((++_sp & 255u) == 0u) { if (xb_ld(&(bar)[XB_TMO])) break; if (_sp > XB_SPIN_CAP) { atomicAdd(&(bar)[XB_TMO], 1u); break; } } } } while (0)

struct XcdBarrier {
    unsigned* bar; unsigned x;
    volatile LAS unsigned* st;
};

__device__ __forceinline__ XcdBarrier xcd_barrier_post(unsigned* bar, volatile LAS unsigned* st) {
    XcdBarrier b; b.bar = bar; b.x = xb_xcc_id(); b.st = st;
    if (threadIdx.x == 0) (void)xb_add(&bar[XB_XCNT(b.x)], 1u);
    return b;
}
__device__ __forceinline__ void xcd_barrier_complete(unsigned* bar, unsigned x, unsigned& nloc, unsigned& nx) {
    const unsigned G = gridDim.x * gridDim.y * gridDim.z;
    unsigned sum, cnt, mine, sp = 0u;
    for (;;) {
        sum = 0u; cnt = 0u; mine = 0u;
#pragma unroll
        for (unsigned j = 0; j < 16; ++j) { const unsigned c = xb_ld(&bar[XB_XCNT(j)]); sum += c; cnt += (c > 0u) ? 1u : 0u; mine = (j == x) ? c : mine; }
        if (sum == G) break;
        __builtin_amdgcn_s_sleep(1);
        if ((++sp & 255u) == 0u) { if (xb_ld(&bar[XB_TMO])) break; if (sp > XB_SPIN_CAP) { atomicAdd(&bar[XB_TMO], 1u); break; } }
    }
    nloc = mine > 0u ? mine : 1u; nx = cnt > 0u ? cnt : 1u;
}

__device__ __forceinline__ void xcd_barrier(const XcdBarrier& b) {
    asm volatile("s_waitcnt vmcnt(0)" ::: "memory");
    __syncthreads();
    if (threadIdx.x == 0) {
        unsigned* bar = b.bar;
        __builtin_amdgcn_s_waitcnt(0);
        unsigned nloc = b.st[0], nx = b.st[1];
        if (nloc == 0u) { xcd_barrier_complete(bar, b.x, nloc, nx); b.st[0] = nloc; b.st[1] = nx; }
        const unsigned old = xb_add(&bar[XB_XSUB(b.x)], 1u);
        const unsigned gen = old / nloc;
        if (old + 1u == (gen + 1u) * nloc) {
            __builtin_amdgcn_fence(__ATOMIC_RELEASE, "agent");
            asm volatile("s_waitcnt vmcnt(0)" ::: "memory");
            const unsigned og = xb_add(&bar[XB_TOP], 1u);
            const unsigned tg = og / nx;
            if (og + 1u == (tg + 1u) * nx) xb_add(&bar[XB_TOPGEN], 1u);
            else XB_SPIN(xb_ld(&bar[XB_TOPGEN]) == tg, bar);
            __builtin_amdgcn_fence(__ATOMIC_ACQUIRE, "agent");
            xb_add(&bar[XB_XGEN(b.x)], 1u);
            asm volatile("s_waitcnt vmcnt(0)" ::: "memory");
        } else {
            XB_SPIN(xb_ld(&bar[XB_XGEN(b.x)]) == gen, bar);
            __builtin_amdgcn_fence(__ATOMIC_ACQUIRE, "agent");
            asm volatile("s_waitcnt vmcnt(0)" ::: "memory");
        }
    }
    __syncthreads();
}

constexpr int NWAVES = 8;
#ifndef MK_PER_PHASE
#define MK_PER_PHASE 1
#endif
constexpr int N_PHASES = 17;
constexpr int BATCH = 2, SEQ = 4096, DM = 4096, MTOK = BATCH * SEQ, DFF = 16384;
constexpr int MH = 8, MDK = 256, MDV = 512, M_MAIN = 12288, M_IN = 12304;
constexpr int NKVQ = 7168, NQG = 4192, KVW = 3072;
constexpr float EPS = 1e-6f;
constexpr float ATT_SCALE = 0.08838834764831845f;

constexpr size_t MiB = 1u << 20;
constexpr size_t WS_CTL = 0, CTL_ZERO_BYTES = 1 * MiB;
constexpr size_t WS_WG1 = 1 * MiB, WS_WG2 = 2 * MiB, WS_W2C = 3 * MiB, WS_POSB = 3 * MiB + 512 * 1024;
constexpr size_t WS_LI = 4 * MiB, WS_LF = 4 * MiB + 512 * 1024, WS_GT = 5 * MiB, WS_HC = 8 * MiB, WS_KC = 12 * MiB, WS_VC = 12 * MiB + 512 * 1024, WS_SELM = 13 * MiB;
constexpr size_t WS_WIN = 16 * MiB, WS_WMO = 112 * MiB, WS_WUP0 = 144 * MiB, WS_WDN0 = 272 * MiB, WS_WKVQ = 400 * MiB, WS_W1C = 456 * MiB, WS_WNO = 464 * MiB, WS_WUP1 = 496 * MiB, WS_WDN1 = 624 * MiB;
constexpr size_t WS_XB = 752 * MiB, WS_A3 = 816 * MiB, WS_HR = 880 * MiB, WS_XA = 944 * MiB, WS_XBF = 1072 * MiB, WS_BIG = 1200 * MiB, WS_AOF = 1328 * MiB, WS_END = 1456 * MiB;
constexpr int CW_BAR = 4096;

constexpr int RING_OFF = 0, RING_BYTES = 131072;
constexpr int LDSCTL_OFF = RING_BYTES, MISC_OFF = LDSCTL_OFF + 320;
constexpr int LDS_BYTES = 147456;
static_assert(MISC_OFF + 128 <= LDS_BYTES, "LDS map");

typedef float f32x16 __attribute__((ext_vector_type(16)));
typedef short s16x4 __attribute__((ext_vector_type(4)));
typedef float f32x2v __attribute__((ext_vector_type(2)));

struct Frame {
    LAS unsigned char* lds;
    volatile LAS unsigned* MISC;
    gu32* ctl;
    int tid, lane, wave, G;
    const float* in[18]; float* out; unsigned char* ws;
};

__device__ __forceinline__ float wave_sum(float v) {
#pragma unroll
    for (int o = 1; o < 64; o <<= 1) v += __shfl_xor(v, o);
    return v;
}
typedef float f32x2_t __attribute__((ext_vector_type(2))); typedef __bf16 bf16x2_t __attribute__((ext_vector_type(2)));
__device__ __forceinline__ unsigned pk2(float lo, float hi) { f32x2_t v = {lo, hi}; bf16x2_t b = __builtin_convertvector(v, bf16x2_t); return __builtin_bit_cast(unsigned, b); }
__device__ __forceinline__ float bf_lo(unsigned w) { return __uint_as_float(w << 16); }
__device__ __forceinline__ float bf_hi(unsigned w) { return __uint_as_float(w & 0xffff0000u); }
__device__ __forceinline__ float bf1(unsigned short h) { return __uint_as_float(((unsigned)h) << 16); }
__device__ __forceinline__ unsigned short f2bf1(float f) { return (unsigned short)(pk2(f, 0.f) & 0xffffu); }
__device__ __forceinline__ f32x4 mfma16(bf16x8 a, bf16x8 b, f32x4 c) { return __builtin_amdgcn_mfma_f32_16x16x32_bf16(a, b, c, 0, 0, 0); }
typedef short v4i16_t __attribute__((ext_vector_type(4)));
__device__ __forceinline__ s16x4 tr16(const LAS unsigned char* p) { return __builtin_bit_cast(s16x4, __builtin_amdgcn_ds_read_tr16_b64_v4i16((LAS v4i16_t*)p)); }
__device__ __forceinline__ bf16x8 cat8(s16x4 lo, s16x4 hi) { return (bf16x8){lo[0], lo[1], lo[2], lo[3], hi[0], hi[1], hi[2], hi[3]}; }

__device__ __forceinline__ void tr_item(const float* W, int K, int ldw, int col0, int ncols, const float* gain, float cscale, int cs_lo, int cs_hi, bf16* WT, int row_off, LAS float* scr, int item, int lane) {
    const int nblk = (ncols + 31) / 32, kb = item / nblk, nb = item % nblk, k0 = 64 * kb, n0 = 32 * nb;
    const int nn = n0 + (lane & 31); const bool nok = nn < ncols; const float cs = (nn >= cs_lo && nn < cs_hi) ? cscale : 1.f;
#pragma unroll 8
    for (int i = 0; i < 32; ++i) { const int kk = 2 * i + (lane >> 5);
        float v = nok ? W[(size_t)(k0 + kk) * ldw + col0 + nn] : 0.f;
        if (gain) v *= gain[k0 + kk];
        scr[kk * 33 + (lane & 31)] = v * cs; }
    LDS_WAIT(); asm volatile("" ::: "memory");
    const int c = lane & 7;
#pragma unroll
    for (int j = 0; j < 4; ++j) { const int n = (lane >> 3) + 8 * j; const LAS float* s = scr + (8 * c) * 33 + n;
        v4u o; o.x = pk2(s[0 * 33], s[1 * 33]); o.y = pk2(s[2 * 33], s[3 * 33]); o.z = pk2(s[4 * 33], s[5 * 33]); o.w = pk2(s[6 * 33], s[7 * 33]);
        if (n0 + n < ncols) *(GAS v4u*)(WT + (size_t)(row_off + n0 + n) * K + k0 + 8 * c) = o; }
    LDS_WAIT(); asm volatile("" ::: "memory");
}
__device__ __forceinline__ void rownorm_row(const float* xrow, bf16* orow, int lane) {
    const GAS f32x4* xr = (const GAS f32x4*)xrow + lane;
    f32x4 v[16]; float s = 0.f;
#pragma unroll
    for (int j = 0; j < 16; ++j) { v[j] = xr[64 * j]; s += (v[j].x * v[j].x + v[j].y * v[j].y) + (v[j].z * v[j].z + v[j].w * v[j].w); }
    const float rstd = 1.f / sqrtf(wave_sum(s) * (1.f / DM) + EPS);
    GAS unsigned long long* o8 = (GAS unsigned long long*)orow + lane;
#pragma unroll
    for (int j = 0; j < 16; ++j) o8[64 * j] = (unsigned long long)pk2(v[j].x * rstd, v[j].y * rstd) | ((unsigned long long)pk2(v[j].z * rstd, v[j].w * rstd) << 32);
}
__device__ __forceinline__ void rownorm_phase(Frame& F, const float* src, bf16* dst) {
    const int gw = blockIdx.x * NWAVES + F.wave, NGW = F.G * NWAVES;
    for (int m = gw; m < MTOK; m += NGW) rownorm_row(src + (size_t)m * DM, dst + (size_t)m * DM, F.lane);
}

__device__ __forceinline__ void p0_prologue(Frame& F) {
    LAS float* scr = (LAS float*)(F.lds + RING_OFF + F.wave * 16384);
    const int gw = blockIdx.x * NWAVES + F.wave, NGW = F.G * NWAVES;
    unsigned char* ws = F.ws;
    { const int gt = blockIdx.x * (NWAVES * 64) + F.tid;
      if (gt < 1024) { const int j = gt >> 9, n = gt & 511; const float* pos = F.in[10] + (size_t)j * 4096; const float* w1 = F.in[11] + (size_t)j * 4096 * 512 + n;
          float a0 = 0.f, a1 = 0.f, a2 = 0.f, a3 = 0.f;
          for (int kk = 0; kk < 4096; kk += 4) { a0 += pos[kk] * w1[(size_t)kk * 512]; a1 += pos[kk + 1] * w1[(size_t)(kk + 1) * 512]; a2 += pos[kk + 2] * w1[(size_t)(kk + 2) * 512]; a3 += pos[kk + 3] * w1[(size_t)(kk + 3) * 512]; }
          ((float*)(ws + WS_POSB))[gt] = (a0 + a1) + (a2 + a3); } }
    constexpr int I0 = 64 * 384, I1 = 64, I2 = 64 * 128, I3 = 64 * 512, I4 = 256 * 128, I5 = 64 * 96, I6 = 64 * 128, I7 = 64 * 3, I8 = 64 * 16, I9 = 64 * 16, I10 = 32, I11 = 32, I12 = 64 * 128, I13 = 64 * 512, I14 = 256 * 128;
    constexpr int NITEMS = I0 + I1 + I2 + I3 + I4 + I5 + I6 + I7 + I8 + I9 + I10 + I11 + I12 + I13 + I14;
    for (int it = gw; it < NITEMS; it += NGW) {
        int r = it; const float* W; int K, ldw, col0, ncols, row_off = 0, cs_lo = 0, cs_hi = 0; const float* gain = nullptr; float cscale = 1.f; bf16* WT;
        if (r < I0) { W = F.in[3]; K = 4096; ldw = M_IN; col0 = 0; ncols = M_MAIN; gain = F.in[1]; cscale = 0.0625f; cs_lo = 2048; cs_hi = 4096; WT = (bf16*)(ws + WS_WIN); }
        else if ((r -= I0) < I1) { W = F.in[3]; K = 4096; ldw = M_IN; col0 = M_MAIN; ncols = 16; gain = F.in[1]; WT = (bf16*)(ws + WS_WG1); }
        else if ((r -= I1) < I2) { W = F.in[6]; K = 4096; ldw = 4096; col0 = 0; ncols = 4096; gain = F.in[5]; WT = (bf16*)(ws + WS_WMO); }
        else if ((r -= I2) < I3) { W = F.in[16]; K = 4096; ldw = DFF; col0 = 0; ncols = DFF; gain = F.in[2]; WT = (bf16*)(ws + WS_WUP0); }
        else if ((r -= I3) < I4) { W = F.in[17]; K = DFF; ldw = 4096; col0 = 0; ncols = 4096; WT = (bf16*)(ws + WS_WDN0); }
        else if ((r -= I4) < I5) { W = F.in[8]; K = 4096; ldw = KVW; col0 = 0; ncols = KVW; gain = F.in[7]; WT = (bf16*)(ws + WS_WKVQ); }
        else if ((r -= I5) < I6) { W = F.in[13]; K = 4096; ldw = NQG; col0 = 0; ncols = 4096; gain = F.in[1] + 4096; WT = (bf16*)(ws + WS_WKVQ); row_off = KVW; }
        else if ((r -= I6) < I7) { W = F.in[13]; K = 4096; ldw = NQG; col0 = 4096; ncols = 96; gain = F.in[1] + 4096; WT = (bf16*)(ws + WS_WG2); }
        else if ((r -= I7) < I8) { W = F.in[11]; K = 4096; ldw = 512; col0 = 0; ncols = 512; WT = (bf16*)(ws + WS_W1C); }
        else if ((r -= I8) < I9) { W = F.in[11] + (size_t)4096 * 512; K = 4096; ldw = 512; col0 = 0; ncols = 512; WT = (bf16*)(ws + WS_W1C) + (size_t)512 * 4096; }
        else if ((r -= I9) < I10) { W = F.in[12]; K = 512; ldw = 128; col0 = 0; ncols = 128; WT = (bf16*)(ws + WS_W2C); }
        else if ((r -= I10) < I11) { W = F.in[12] + (size_t)512 * 128; K = 512; ldw = 128; col0 = 0; ncols = 128; WT = (bf16*)(ws + WS_W2C) + (size_t)128 * 512; }
        else if ((r -= I11) < I12) { W = F.in[15]; K = 4096; ldw = 4096; col0 = 0; ncols = 4096; WT = (bf16*)(ws + WS_WNO); }
        else if ((r -= I12) < I13) { W = F.in[16] + (size_t)4096 * DFF; K = 4096; ldw = DFF; col0 = 0; ncols = DFF; gain = F.in[2] + 4096; WT = (bf16*)(ws + WS_WUP1); }
        else { r -= I13; W = F.in[17] + (size_t)DFF * 4096; K = DFF; ldw = 4096; col0 = 0; ncols = 4096; WT = (bf16*)(ws + WS_WDN1); }
        tr_item(W, K, ldw, col0, ncols, gain, cscale, cs_lo, cs_hi, WT, row_off, scr, r, F.lane);
    }
    rownorm_phase(F, F.in[0], (bf16*)(ws + WS_XB));
}

template <int NT, class AP>
__device__ __forceinline__ void mini_gemm16(f32x4 (&acc)[NT], const AP& ap, const bf16* Bt, int ldb, int K, int lane) {
    const int r16 = lane & 15, kq = lane >> 4;
#pragma unroll
    for (int n = 0; n < NT; ++n) acc[n] = (f32x4){0.f, 0.f, 0.f, 0.f};
    const bf16* brow = Bt + (size_t)r16 * ldb + kq * 8;
#pragma unroll 2
    for (int k0 = 0; k0 < K; k0 += 32) {
        const bf16x8 a = *(const bf16x8*)ap(r16, k0 + kq * 8);
#pragma unroll
        for (int n = 0; n < NT; ++n) { const bf16x8 b = *(const bf16x8*)(brow + (size_t)n * 16 * ldb + k0); acc[n] = mfma16(a, b, acc[n]); }
    }
}
struct RowMajorA { const bf16* A; int lda; __device__ __forceinline__ const bf16* operator()(int r16, int k) const { return A + (size_t)r16 * lda + k; } };

__device__ __forceinline__ void gates1_phase(Frame& F) {
    const int gw = blockIdx.x * NWAVES + F.wave, NGW = F.G * NWAVES; const int r16 = F.lane & 15, kq = F.lane >> 4;
    const bf16* XB = (const bf16*)(F.ws + WS_XB); const bf16* Wg = (const bf16*)(F.ws + WS_WG1);
    float* LI = (float*)(F.ws + WS_LI); float* LF = (float*)(F.ws + WS_LF);
    const float bias = F.in[4][r16];
    for (int rt = gw; rt < MTOK / 16; rt += NGW) {
        f32x4 acc[1]; RowMajorA ap{XB + (size_t)rt * 16 * DM, DM};
        mini_gemm16<1>(acc, ap, Wg, DM, DM, F.lane);
#pragma unroll
        for (int i = 0; i < 4; ++i) { const int row = rt * 16 + 4 * kq + i, b = row >> 12, t = row & 4095;
            float g = acc[0][i] + bias; g = 15.f * tanhf(g * (1.f / 15.f));
            if (r16 < 8) LI[(size_t)(b * 8 + r16) * SEQ + t] = g;
            else LF[(size_t)(b * 8 + (r16 - 8)) * SEQ + t] = fminf(g, 0.f) - log1pf(__expf(-fabsf(g))); }
    }
}
__device__ __forceinline__ void gates2_phase(Frame& F) {
    const int gw = blockIdx.x * NWAVES + F.wave, NGW = F.G * NWAVES; const int r16 = F.lane & 15, kq = F.lane >> 4;
    const bf16* XB = (const bf16*)(F.ws + WS_XB); const bf16* Wg = (const bf16*)(F.ws + WS_WG2); float* GT = (float*)(F.ws + WS_GT);
    for (int rt = gw; rt < MTOK / 16; rt += NGW) {
        f32x4 acc[6]; RowMajorA ap{XB + (size_t)rt * 16 * DM, DM};
        mini_gemm16<6>(acc, ap, Wg, DM, DM, F.lane);
#pragma unroll
        for (int n = 0; n < 6; ++n)
#pragma unroll
            for (int i = 0; i < 4; ++i) { const int row = rt * 16 + 4 * kq + i; GT[(size_t)row * 96 + n * 16 + r16] = 1.f / (1.f + __expf(-acc[n][i])); }
    }
}

constexpr int ML_QS = 528, ML_VS = 80, ML_PS = 144;
constexpr int ML_Q = 0, ML_K = ML_Q + 64 * ML_QS, ML_V = ML_K + 64 * ML_QS, ML_VW = ML_V + 64 * ML_VS, ML_P = ML_VW + 64 * ML_VS, ML_CT = ML_P + 64 * ML_PS, ML_SC = ML_CT + 32 * ML_QS;
static_assert(ML_SC + 4096 <= RING_BYTES, "mlstm LDS");
__device__ __forceinline__ void mlstm_phase(Frame& F) {
    LAS unsigned char* L = F.lds + RING_OFF;
    LAS float* sc_a = (LAS float*)(L + ML_SC); LAS float* sc_M = sc_a + 64; LAS float* sc_b = sc_a + 128; LAS float* sc_w = sc_a + 192;
    LAS float* sc_rs = sc_a + 256; LAS float* sc_qn = sc_a + 512; LAS float* sc_nv = sc_a + 576;
    const int tid = F.tid, lane = F.lane, wid = F.wave, r16 = lane & 15, kq = lane >> 4;
    const int tt = wid >> 1, sp = wid & 1, et = wid & 1;
    const bf16* QKVO = (const bf16*)(F.ws + WS_BIG); bf16* HR = (bf16*)(F.ws + WS_HR);
    const float* LI = (const float*)(F.ws + WS_LI); const float* LF = (const float*)(F.ws + WS_LF);
    for (int unit = blockIdx.x; unit < 256; unit += F.G) {
        const int bh = unit >> 4, sl = unit & 15, b = bh >> 3, hd = bh & 7, e0 = sl * 32;
        f32x4 CT[4];
#pragma unroll
        for (int j = 0; j < 4; ++j) CT[j] = (f32x4){0.f, 0.f, 0.f, 0.f};
        float m_state = 0.f;
        if (tid < 256) sc_nv[tid] = 0.f;
        for (int i = tid; i < 32 * ML_QS / 4; i += NWAVES * 64) ((LAS unsigned*)(L + ML_CT))[i] = 0u;
        bf16x8 pq[4], pk[4], pv = {}; float pli, plf;
        const size_t rowb = (size_t)b * SEQ;
        const int qr_ = tid >> 3, qc_ = tid & 7, vr_ = tid >> 2, vc_ = tid & 3;
#define ML_LOAD(c) do { const bf16* base = QKVO + (rowb + (size_t)(c) * 64) * M_MAIN; \
            _Pragma("unroll") for (int i = 0; i < 4; ++i) { pq[i] = *(const bf16x8*)(base + (size_t)qr_ * M_MAIN + hd * 256 + (qc_ + 8 * i) * 8); \
                                                            pk[i] = *(const bf16x8*)(base + (size_t)qr_ * M_MAIN + 2048 + hd * 256 + (qc_ + 8 * i) * 8); } \
            if (tid < 256) pv = *(const bf16x8*)(base + (size_t)vr_ * M_MAIN + 4096 + hd * 512 + e0 + vc_ * 8); \
            pli = LI[(size_t)bh * SEQ + (c) * 64 + lane]; plf = LF[(size_t)bh * SEQ + (c) * 64 + lane]; } while (0)
        ML_LOAD(0);
        __syncthreads();
        for (int c = 0; c < 64; ++c) {
            float bsum = plf;
#pragma unroll
            for (int o = 1; o < 64; o <<= 1) { const float t_ = __shfl_up(bsum, o); if (lane >= o) bsum += t_; }
            const float a_s = pli - bsum;
            float pm = a_s;
#pragma unroll
            for (int o = 1; o < 64; o <<= 1) { const float t_ = __shfl_up(pm, o); if (lane >= o) pm = fmaxf(pm, t_); }
            const float Mt = fmaxf(m_state, pm);
            const float M63 = __shfl(Mt, 63), b63 = __shfl(bsum, 63);
            const float w_s = __expf(a_s - M63), decay = __expf(m_state - M63);
            if (wid == 0) { sc_a[lane] = a_s; sc_M[lane] = Mt; sc_b[lane] = bsum; sc_w[lane] = w_s; }
#pragma unroll
            for (int i = 0; i < 4; ++i) { *(LAS bf16x8*)(L + ML_Q + qr_ * ML_QS + (qc_ + 8 * i) * 16) = pq[i]; *(LAS bf16x8*)(L + ML_K + qr_ * ML_QS + (qc_ + 8 * i) * 16) = pk[i]; }
            if (tid < 256) { *(LAS bf16x8*)(L + ML_V + vr_ * ML_VS + vc_ * 16) = pv;
                const float wv = __shfl(w_s, 16 * wid + (lane >> 2)); const v4u raw = __builtin_bit_cast(v4u, pv); v4u o;
                o.x = pk2(bf_lo(raw.x) * wv, bf_hi(raw.x) * wv); o.y = pk2(bf_lo(raw.y) * wv, bf_hi(raw.y) * wv); o.z = pk2(bf_lo(raw.z) * wv, bf_hi(raw.z) * wv); o.w = pk2(bf_lo(raw.w) * wv, bf_hi(raw.w) * wv);
                *(LAS v4u*)(L + ML_VW + vr_ * ML_VS + vc_ * 16) = o; }
            if (c + 1 < 64) ML_LOAD(c + 1);
            __syncthreads();
            f32x4 sacc0 = {0.f, 0.f, 0.f, 0.f}, sacc1 = sacc0, iacc = sacc0;
            { const LAS unsigned char* qrow = L + ML_Q + (tt * 16 + r16) * ML_QS + kq * 16;
              const LAS unsigned char* krow = L + ML_K + (sp * 32 + r16) * ML_QS + kq * 16;
              const LAS unsigned char* crow_ = L + ML_CT + (et * 16 + r16) * ML_QS + kq * 16;
#pragma unroll
              for (int k0 = 0; k0 < 8; ++k0) { const bf16x8 a = *(const LAS bf16x8*)(qrow + k0 * 64);
                  const bf16x8 b0 = *(const LAS bf16x8*)(krow + k0 * 64), b1 = *(const LAS bf16x8*)(krow + 16 * ML_QS + k0 * 64), bc = *(const LAS bf16x8*)(crow_ + k0 * 64);
                  sacc0 = mfma16(a, b0, sacc0); sacc1 = mfma16(a, b1, sacc1); iacc = mfma16(a, bc, iacc); } }
#pragma unroll
            for (int st2 = 0; st2 < 2; ++st2) { const int s = (2 * sp + st2) * 16 + r16; const float as_ = sc_a[s];
#pragma unroll
                for (int i = 0; i < 4; ++i) { const int t = tt * 16 + 4 * kq + i; const float sv = st2 ? sacc1[i] : sacc0[i];
                    const float val = (s <= t) ? sv * __expf(as_ - sc_M[t]) : 0.f;
                    float rsum = val; rsum += __shfl_xor(rsum, 1); rsum += __shfl_xor(rsum, 2); rsum += __shfl_xor(rsum, 4); rsum += __shfl_xor(rsum, 8);
                    if (r16 == 0) sc_rs[(2 * sp + st2) * 64 + t] = rsum;
                    *(LAS unsigned short*)(L + ML_P + t * ML_PS + s * 2) = f2bf1(val); } }
            { const int t = tid >> 3, part = tid & 7; float qn = 0.f;
              const LAS unsigned* qp = (const LAS unsigned*)(L + ML_Q + t * ML_QS + part * 64);
#pragma unroll
              for (int j = 0; j < 16; ++j) { const unsigned w = qp[j]; qn += bf_lo(w) * sc_nv[part * 32 + 2 * j] + bf_hi(w) * sc_nv[part * 32 + 2 * j + 1]; }
              qn += __shfl_xor(qn, 1); qn += __shfl_xor(qn, 2); qn += __shfl_xor(qn, 4);
              if (part == 0) sc_qn[t] = qn; }
            __syncthreads();
            { f32x4 xacc = {0.f, 0.f, 0.f, 0.f}; const int j = r16 >> 2, q = r16 & 3;
#pragma unroll
              for (int ks = 0; ks < 2; ++ks) { const bf16x8 a = *(const LAS bf16x8*)(L + ML_P + (tt * 16 + r16) * ML_PS + (ks * 32 + kq * 8) * 2);
                  const LAS unsigned char* va = L + ML_V + (ks * 32 + 8 * kq + j) * ML_VS + (et * 16 + 4 * q) * 2;
                  const bf16x8 bb = cat8(tr16(va), tr16(va + 4 * ML_VS));
                  xacc = mfma16(a, bb, xacc); }
#pragma unroll
              for (int i = 0; i < 4; ++i) { const int t = tt * 16 + 4 * kq + i; const float Mt_t = sc_M[t], bb_t = sc_b[t];
                  const float winter = __expf(m_state - Mt_t);
                  const float den = winter * sc_qn[t] + ((sc_rs[t] + sc_rs[64 + t]) + (sc_rs[128 + t] + sc_rs[192 + t]));
                  const float num = winter * iacc[i] + xacc[i];
                  const float dd = fmaxf(fabsf(den), __expf(-(bb_t + Mt_t)));
                  HR[(rowb + (size_t)c * 64 + t) * DM + hd * 512 + e0 + et * 16 + r16] = f2bf1(num / dd); } }
            { const int j = r16 >> 2, q = r16 & 3; bf16x8 af[2];
#pragma unroll
              for (int ks = 0; ks < 2; ++ks) { const LAS unsigned char* va = L + ML_VW + (ks * 32 + 8 * kq + j) * ML_VS + (et * 16 + 4 * q) * 2; af[ks] = cat8(tr16(va), tr16(va + 4 * ML_VS)); }
#pragma unroll
              for (int jt = 0; jt < 4; ++jt) { const int dt = 4 * (wid >> 1) + jt; f32x4 acc = CT[jt] * decay;
#pragma unroll
                  for (int ks = 0; ks < 2; ++ks) { const LAS unsigned char* ka = L + ML_K + (ks * 32 + 8 * kq + j) * ML_QS + (dt * 16 + 4 * q) * 2;
                      acc = mfma16(af[ks], cat8(tr16(ka), tr16(ka + 4 * ML_QS)), acc); }
                  CT[jt] = acc;
#pragma unroll
                  for (int i = 0; i < 4; ++i) *(LAS unsigned short*)(L + ML_CT + (et * 16 + 4 * kq + i) * ML_QS + (dt * 16 + r16) * 2) = f2bf1(acc[i]); } }
            if (tid < 256) { float nv = sc_nv[tid] * decay;
#pragma unroll 8
                for (int s = 0; s < 64; ++s) nv += sc_w[s] * bf1(*(const LAS unsigned short*)(L + ML_K + s * ML_QS + tid * 2));
                sc_nv[tid] = nv; }
            m_state = b63 + M63;
            __syncthreads();
        }
#undef ML_LOAD
    }
}

__device__ __forceinline__ void gating_phase(Frame& F) {
    const int gw = blockIdx.x * NWAVES + F.wave, NGW = F.G * NWAVES, lane = F.lane;
    const bf16* HR = (const bf16*)(F.ws + WS_HR); const bf16* QKVO = (const bf16*)(F.ws + WS_BIG); bf16* A3 = (bf16*)(F.ws + WS_A3);
    for (int row = gw; row < MTOK; row += NGW) {
#pragma unroll 2
        for (int hd = 0; hd < 8; ++hd) {
            const v4u hv = *(const v4u*)(HR + (size_t)row * DM + hd * 512 + lane * 8);
            const v4u ov = *(const v4u*)(QKVO + (size_t)row * M_MAIN + 8192 + hd * 512 + lane * 8);
            float h[8] = {bf_lo(hv.x), bf_hi(hv.x), bf_lo(hv.y), bf_hi(hv.y), bf_lo(hv.z), bf_hi(hv.z), bf_lo(hv.w), bf_hi(hv.w)};
            float o[8] = {bf_lo(ov.x), bf_hi(ov.x), bf_lo(ov.y), bf_hi(ov.y), bf_lo(ov.z), bf_hi(ov.z), bf_lo(ov.w), bf_hi(ov.w)};
            float ss = 0.f;
#pragma unroll
            for (int e = 0; e < 8; ++e) ss += h[e] * h[e];
            const float rstd = 1.f / sqrtf(wave_sum(ss) * (1.f / 512.f) + EPS);
            float r[8];
#pragma unroll
            for (int e = 0; e < 8; ++e) r[e] = h[e] * rstd / (1.f + __expf(-o[e]));
            v4u w; w.x = pk2(r[0], r[1]); w.y = pk2(r[2], r[3]); w.z = pk2(r[4], r[5]); w.w = pk2(r[6], r[7]);
            *(v4u*)(A3 + (size_t)row * DM + hd * 512 + lane * 8) = w;
        }
    }
}

__device__ __forceinline__ float gelu_tanh(float v) { const float u = 0.7978845608028654f * (v + 0.044715f * v * v * v); return 0.5f * v * (1.f + tanhf(u)); }
struct CmpA { const bf16* KVQ; int j, rt; __device__ __forceinline__ const bf16* operator()(int r16, int k) const {
    const int row = rt * 16 + r16, bg = row >> 8; int c = row & 255; c = c > 254 ? 254 : c; const int b = bg >> 2, g = bg & 3;
    return KVQ + ((size_t)b * SEQ + 16 * c + (k >> 7)) * NKVQ + j * 512 + g * 128 + (k & 127); } };
__device__ __forceinline__ void nsa_prep_phase(Frame& F) {
    const int gw = blockIdx.x * NWAVES + F.wave, NGW = F.G * NWAVES, lane = F.lane, r16 = lane & 15, kq = lane >> 4;
    bf16* KVQ = (bf16*)(F.ws + WS_BIG);
    { const int v = lane >> 3, br = v >> 2, g = v & 3, d0 = (lane & 7) * 16;
      float gn[16];
#pragma unroll
      for (int e = 0; e < 16; ++e) gn[e] = F.in[9][(br + 1) * 128 + d0 + e] * F.in[14][(br + 1) * 128 + d0 + e] * ATT_SCALE;
      for (int row = gw; row < MTOK; row += NGW) {
          bf16* p = KVQ + (size_t)row * NKVQ + (2 + 2 * br) * 512 + g * 128 + d0;
          const v4u a = *(const v4u*)p, c = *(const v4u*)(p + 8);
          float x[16] = {bf_lo(a.x), bf_hi(a.x), bf_lo(a.y), bf_hi(a.y), bf_lo(a.z), bf_hi(a.z), bf_lo(a.w), bf_hi(a.w), bf_lo(c.x), bf_hi(c.x), bf_lo(c.y), bf_hi(c.y), bf_lo(c.z), bf_hi(c.z), bf_lo(c.w), bf_hi(c.w)};
          float ss = 0.f;
#pragma unroll
          for (int e = 0; e < 16; ++e) ss += x[e] * x[e];
          ss += __shfl_xor(ss, 1); ss += __shfl_xor(ss, 2); ss += __shfl_xor(ss, 4);
          const float rstd = 1.f / sqrtf(ss * (1.f / 128.f) + EPS);
#pragma unroll
          for (int e = 0; e < 16; ++e) x[e] *= rstd * gn[e];
          v4u o0, o1; o0.x = pk2(x[0], x[1]); o0.y = pk2(x[2], x[3]); o0.z = pk2(x[4], x[5]); o0.w = pk2(x[6], x[7]); o1.x = pk2(x[8], x[9]); o1.y = pk2(x[10], x[11]); o1.z = pk2(x[12], x[13]); o1.w = pk2(x[14], x[15]);
          *(v4u*)p = o0; *(v4u*)(p + 8) = o1; } }
    { const bf16* W1C = (const bf16*)(F.ws + WS_W1C); const float* posb = (const float*)(F.ws + WS_POSB); bf16* HC = (bf16*)(F.ws + WS_HC);
      for (int task = gw; task < 2048; task += NGW) { const int j = task >> 10, rt = (task & 1023) >> 3, cg = task & 7;
          f32x4 acc[4]; CmpA ap{KVQ, j, rt};
          mini_gemm16<4>(acc, ap, W1C + ((size_t)j * 512 + cg * 64) * 4096, 4096, 4096, lane);
#pragma unroll
          for (int n = 0; n < 4; ++n) { const int col = cg * 64 + n * 16 + r16; const float pb = posb[j * 512 + col];
#pragma unroll
              for (int i = 0; i < 4; ++i) { const int row = rt * 16 + 4 * kq + i; HC[((size_t)j * 2048 + row) * 512 + col] = f2bf1(gelu_tanh(acc[n][i] + pb)); } } } }
}
__device__ __forceinline__ void nsa_cmp2_phase(Frame& F) {
    const int gw = blockIdx.x * NWAVES + F.wave, NGW = F.G * NWAVES, lane = F.lane, r16 = lane & 15, kq = lane >> 4;
    const bf16* HC = (const bf16*)(F.ws + WS_HC); const bf16* W2C = (const bf16*)(F.ws + WS_W2C); bf16* KC = (bf16*)(F.ws + WS_KC); bf16* VC = (bf16*)(F.ws + WS_VC);
    for (int task = gw; task < 256; task += NGW) { const int j = task >> 7, rt = task & 127;
        f32x4 acc[8]; RowMajorA ap{HC + ((size_t)j * 2048 + rt * 16) * 512, 512};
        mini_gemm16<8>(acc, ap, W2C + (size_t)j * 128 * 512, 512, 512, lane);
#pragma unroll
        for (int i = 0; i < 4; ++i) { const int row = rt * 16 + 4 * kq + i; const bool pad = (row & 255) == 255;
            float sc = 1.f;
            if (j == 0) { float ss = 0.f;
#pragma unroll
                for (int n = 0; n < 8; ++n) ss += acc[n][i] * acc[n][i];
                ss += __shfl_xor(ss, 1); ss += __shfl_xor(ss, 2); ss += __shfl_xor(ss, 4); ss += __shfl_xor(ss, 8);
                sc = ATT_SCALE / sqrtf(ss * (1.f / 128.f) + EPS); }
#pragma unroll
            for (int n = 0; n < 8; ++n) { const int col = n * 16 + r16; float v = acc[n][i] * sc;
                if (j == 0) v *= F.in[9][col] * F.in[14][col];
                if (pad) v = 0.f;
                (j == 0 ? KC : VC)[(size_t)row * 128 + col] = f2bf1(v); } } }
}

namespace nsa {
constexpr int D = 128, KVBLK = 64, SHM_K = 16384, SHM_V = 16384;
constexpr int O_V = 0, O_K = SHM_V, O_WS = O_K + SHM_K, O_PB = O_WS + NWAVES * 64 * 4, O_SELM = O_PB + 32 * 65 * 4, O_END = O_SELM + 32 * 8;
constexpr float THR2 = 11.0f;
#define KSWZ(row, colB) ((row) * 256 + ((colB) ^ (((row) & 7) << 4)))
#define SBAR() __builtin_amdgcn_sched_barrier(0)
__device__ __forceinline__ int v_st(int k, int c) { const int kk = (k & ~0xC) | ((k & 4) << 1) | ((k & 8) >> 1); return ((kk >> 3) * 4 + (c >> 5)) * 512 + ((kk & 7) * 32 + (c & 31)) * 2; }
__device__ __forceinline__ int v_rd_base(int lane) { return ((lane & 3) << 3) | (((lane >> 2) & 3) << 6) | (((lane >> 4) & 1) << 5) | (((lane >> 5) & 1) << 8); }
constexpr int v_rd_off(int d0, int ks, int half) { return d0 * 512 + ks * 4096 + half * 2048; }
__device__ __forceinline__ int crow(int r, int hi) { return (r & 3) + 8 * (r >> 2) + 4 * hi; }
__device__ __forceinline__ void mask_tile(f32x16& p0, f32x16& p1, int dq, unsigned W) {
    const float NEG = -__builtin_inff();
#pragma unroll
    for (int r = 0; r < 16; ++r) { const int c = (r & 3) + 8 * (r >> 2);
        if ((unsigned)(dq - c) >= W) p0[r] = NEG;
        if ((unsigned)(dq - c - 32) >= W) p1[r] = NEG; }
}
__device__ __forceinline__ float rowmax32(const f32x16& p0, const f32x16& p1) {
    float pmax = p0[0];
#pragma unroll
    for (int r = 1; r < 16; ++r) pmax = fmaxf(pmax, p0[r]);
#pragma unroll
    for (int r = 0; r < 16; ++r) pmax = fmaxf(pmax, p1[r]);
    auto rr = __builtin_amdgcn_permlane32_swap(__float_as_uint(pmax), __float_as_uint(pmax), false, false);
    return fmaxf(__uint_as_float(rr[0]), __uint_as_float(rr[1]));
}
__device__ __forceinline__ float rowsum32(const f32x16& p0, const f32x16& p1) {
    float ps = 0.f;
#pragma unroll
    for (int r = 0; r < 16; ++r) ps += p0[r];
#pragma unroll
    for (int r = 0; r < 16; ++r) ps += p1[r];
    auto rr = __builtin_amdgcn_permlane32_swap(__float_as_uint(ps), __float_as_uint(ps), false, false);
    return __uint_as_float(rr[0]) + __uint_as_float(rr[1]);
}
__device__ __forceinline__ void partialSM(f32x16& p0, f32x16& p1, float& m_reg, float& alpha, float c2) {
    const float pmax = rowmax32(p0, p1); float mn;
    if (__builtin_expect(__all((pmax - m_reg) * c2 <= THR2), 1)) { mn = m_reg; alpha = 1.f; }
    else { mn = fmaxf(m_reg, pmax); alpha = __builtin_amdgcn_exp2f((m_reg - mn) * c2); m_reg = mn; }
    const float mnL = -mn * c2;
#pragma unroll
    for (int r = 0; r < 16; ++r) p0[r] = fmaf(p0[r], c2, mnL);
#pragma unroll
    for (int r = 0; r < 16; ++r) p1[r] = fmaf(p1[r], c2, mnL);
#pragma unroll
    for (int r = 0; r < 16; ++r) p0[r] = __builtin_amdgcn_exp2f(p0[r]);
}
__device__ __forceinline__ void packP(const f32x16& p0, const f32x16& p1, bf16x8& pa0, bf16x8& pa1, bf16x8& pa2, bf16x8& pa3) {
#define PK4(P, B_, OUT) do { unsigned a0 = pk2(P[B_+0], P[B_+1]), a1 = pk2(P[B_+2], P[B_+3]);                          \
        unsigned b0 = pk2(P[B_+4], P[B_+5]), b1 = pk2(P[B_+6], P[B_+7]);                                             \
        auto r0 = __builtin_amdgcn_permlane32_swap(a0, b0, false, false); auto r1 = __builtin_amdgcn_permlane32_swap(a1, b1, false, false); \
        u32x4_t w = {r0[0], r1[0], r0[1], r1[1]}; OUT = __builtin_bit_cast(bf16x8, w); } while (0)
    typedef unsigned u32x4_t __attribute__((ext_vector_type(4)));
    PK4(p0, 0, pa0); PK4(p0, 8, pa1); PK4(p1, 0, pa2); PK4(p1, 8, pa3);
#undef PK4
}
__device__ __forceinline__ void finishSM(f32x16& p0, f32x16& p1, float alpha, float& l_reg, bf16x8& pa0, bf16x8& pa1, bf16x8& pa2, bf16x8& pa3) {
#pragma unroll
    for (int r = 0; r < 16; ++r) p1[r] = __builtin_amdgcn_exp2f(p1[r]);
    l_reg = l_reg * alpha + rowsum32(p0, p1);
    packP(p0, p1, pa0, pa1, pa2, pa3);
}
__device__ __forceinline__ void qkt(f32x16& p0, f32x16& p1, const char* K_lds, int r32, int hi, const bf16x8* qr, float cinit) {
#pragma unroll
    for (int r = 0; r < 16; ++r) { p0[r] = cinit; p1[r] = cinit; }
    const char* kb[4];
#pragma unroll
    for (int dd = 0; dd < 4; ++dd) kb[dd] = K_lds + KSWZ(r32, (dd * 16 + hi * 8) * 2);
#pragma unroll
    for (int d0 = 0; d0 < 8; ++d0) { const char* a = kb[d0 & 3] + (d0 >> 2) * 128;
        const bf16x8 b0 = *reinterpret_cast<const bf16x8*>(a);
        const bf16x8 b1 = *reinterpret_cast<const bf16x8*>(a + 32 * 256);
        p0 = __builtin_amdgcn_mfma_f32_32x32x16_bf16(b0, qr[d0], p0, 0, 0, 0);
        p1 = __builtin_amdgcn_mfma_f32_32x32x16_bf16(b1, qr[d0], p1, 0, 0, 0); }
}
__device__ __forceinline__ void pv_tile(f32x16* o, int vb0, bf16x8 pa0, bf16x8 pa1, bf16x8 pa2, bf16x8 pa3) {
#define TRRD(dst, off) asm volatile("ds_read_b64_tr_b16 %0, %1 offset:%2" : "=&v"(dst) : "v"(vb0), "i"(off) : "memory")
#define PV_D0(d0) do { s16x4 l0, l1, l2, l3, h0, h1, h2, h3; constexpr int b_ = v_rd_off(d0, 0, 0); \
        TRRD(l0, b_); TRRD(h0, b_ + 2048); TRRD(l1, b_ + 4096); TRRD(h1, b_ + 6144); TRRD(l2, b_ + 8192); TRRD(h2, b_ + 10240); TRRD(l3, b_ + 12288); TRRD(h3, b_ + 14336); \
        asm volatile("s_waitcnt lgkmcnt(0)" ::: "memory"); SBAR();   \
        o[d0] = __builtin_amdgcn_mfma_f32_32x32x16_bf16(pa0, (bf16x8){l0[0], l0[1], l0[2], l0[3], h0[0], h0[1], h0[2], h0[3]}, o[d0], 0, 0, 0);   \
        o[d0] = __builtin_amdgcn_mfma_f32_32x32x16_bf16(pa1, (bf16x8){l1[0], l1[1], l1[2], l1[3], h1[0], h1[1], h1[2], h1[3]}, o[d0], 0, 0, 0);   \
        o[d0] = __builtin_amdgcn_mfma_f32_32x32x16_bf16(pa2, (bf16x8){l2[0], l2[1], l2[2], l2[3], h2[0], h2[1], h2[2], h2[3]}, o[d0], 0, 0, 0);   \
        o[d0] = __builtin_amdgcn_mfma_f32_32x32x16_bf16(pa3, (bf16x8){l3[0], l3[1], l3[2], l3[3], h3[0], h3[1], h3[2], h3[3]}, o[d0], 0, 0, 0); } while (0)
    PV_D0(0); PV_D0(1); PV_D0(2); PV_D0(3);
#undef PV_D0
#undef TRRD
}
struct Stage { bf16x8 k0, k1, v0, v1; };
__device__ __forceinline__ void stage_load(Stage& S, const bf16* Kp, const bf16* Vp, int ld, int kb, int sr, int sc, bool withV) {
    const bf16* kt = Kp + (size_t)kb * ld; const bf16* vt = Vp + (size_t)kb * ld;
    const unsigned voff = (unsigned)(sr * ld + sc);
    S.k0 = *(const bf16x8*)(kt + voff); S.k1 = *(const bf16x8*)(kt + (size_t)32 * ld + voff);
    if (withV) { S.v0 = *(const bf16x8*)(vt + voff); S.v1 = *(const bf16x8*)(vt + (size_t)32 * ld + voff); }
}
__device__ __forceinline__ void stage_write(const Stage& S, char* lds, int sr, int sc, bool withV) {
    const int kws = KSWZ(sr, sc * 2);
    *(bf16x8*)(lds + O_K + kws) = S.k0; *(bf16x8*)(lds + O_K + kws + 32 * 256) = S.k1;
    if (withV) { *(bf16x8*)(lds + O_V + v_st(sr, sc)) = S.v0; *(bf16x8*)(lds + O_V + v_st(32 + sr, sc)) = S.v1; }
}
template <int ACC>
__device__ __forceinline__ void emit(const f32x16* o, const float* fl, float* AOFw, bf16* AOw, int r32, int hi) {
    int r32o = r32, hio = hi; asm volatile("" : "+v"(r32o), "+v"(hio));
    const unsigned lane_off = (unsigned)(4 * hio * DM + r32o);
#pragma unroll
    for (int r = 0; r < 16; ++r) { const float f = fl[(r & 3) + 8 * (r >> 2) + 4 * hio]; const unsigned off = lane_off + (unsigned)(((r & 3) + 8 * (r >> 2)) * DM);
#pragma unroll
        for (int d0 = 0; d0 < 4; ++d0) { float v = o[d0][r] * f;
            if (ACC >= 1) v += AOFw[off + d0 * 32];
            if (ACC < 2) AOFw[off + d0 * 32] = v;
            else { const float vn = __shfl_xor(v, 1); if ((r32o & 1) == 0) *(unsigned*)(AOw + off + d0 * 32) = pk2(v, vn); } } }
}
template <int MODE, int ACC>
__device__ __forceinline__ void flash_pass(char* lds, const bf16* Kp, const bf16* Vp, int ld, unsigned long long tiles, int t, int qb, unsigned long long mymask, const bf16x8* qr, float c2, float gate, float* AOFw, bf16* AOw,
                                           int tid, int wid, int lane) {
    const int r32 = lane & 31, hi = lane >> 5, sr = tid >> 4, sc = (tid & 15) * 8;
    float* ws = (float*)(lds + O_WS) + wid * 64; float* li_l = ws; float* al_l = ws + 32;
    const int vb0 = (int)(uintptr_t)(lds + O_V) + v_rd_base(lane);
    f32x16 o[4] = {}; float m_reg = -1e30f, l_reg = 0.f;
    Stage S; unsigned long long rem = tiles;
    int j = __builtin_ctzll(rem); rem &= rem - 1;
    stage_load(S, Kp, Vp, ld, j * KVBLK, sr, sc, true);
    for (;;) {
        __syncthreads();
        stage_write(S, lds, sr, sc, true);
        __syncthreads();
        const int jn = rem ? __builtin_ctzll(rem) : -1;
        if (jn >= 0) { rem &= rem - 1; stage_load(S, Kp, Vp, ld, jn * KVBLK, sr, sc, true); }
        f32x16 p0, p1; float alpha; bf16x8 pa0, pa1, pa2, pa3;
        float cinit = 0.f;
        if (MODE == 1) cinit = ((mymask >> j) & 1ull) ? 0.f : -__builtin_inff();
        qkt(p0, p1, lds + O_K, r32, hi, qr, cinit);
        if (MODE == 0) mask_tile(p0, p1, t - j * KVBLK - 4 * hi, 512u);
        else if (j == qb) mask_tile(p0, p1, t - j * KVBLK - 4 * hi, 0x7fffffffu);
        partialSM(p0, p1, m_reg, alpha, c2);
        finishSM(p0, p1, alpha, l_reg, pa0, pa1, pa2, pa3);
        if (__any(alpha < 1.f)) { if (hi == 0) al_l[r32] = alpha; asm volatile("s_waitcnt lgkmcnt(0)" ::: "memory");
#pragma unroll
            for (int d_ = 0; d_ < 4; ++d_)
#pragma unroll
                for (int r = 0; r < 16; ++r) o[d_][r] *= al_l[crow(r, hi)]; }
        pv_tile(o, vb0, pa0, pa1, pa2, pa3);
        if (jn < 0) break;
        j = jn;
    }
    if (hi == 0) li_l[r32] = gate / l_reg; asm volatile("s_waitcnt lgkmcnt(0)" ::: "memory");
    emit<ACC>(o, li_l, AOFw, AOw, r32, hi);
}

__device__ __forceinline__ void unit(Frame& F, char* lds, int b, int g, int tg) {
    const int tid = F.tid, lane = F.lane, wid = F.wave, r32 = lane & 31, hi = lane >> 5, sr = tid >> 4, sc = (tid & 15) * 8;
    const int head = g * 8 + wid, tok0 = tg * 32, t = tok0 + r32, qb = tg >> 1, bg = b * 4 + g;
    const bf16* KVQ = (const bf16*)(F.ws + WS_BIG); const float* GT = (const float*)(F.ws + WS_GT);
    const bf16* KC = (const bf16*)(F.ws + WS_KC) + (size_t)bg * 256 * 128; const bf16* VC = (const bf16*)(F.ws + WS_VC) + (size_t)bg * 256 * 128;
    const size_t rowq = (size_t)b * SEQ + t;
    float* ws = (float*)(lds + O_WS) + wid * 64; float* li_l = ws;
    unsigned* pb = (unsigned*)(lds + O_PB); unsigned* selm = (unsigned*)(lds + O_SELM);
    const int vb0 = (int)(uintptr_t)(lds + O_V) + v_rd_base(lane);
    bf16x8 qr[8]; float ss = 0.f;
#pragma unroll
    for (int d0 = 0; d0 < 8; ++d0) { qr[d0] = *(const bf16x8*)(KVQ + rowq * NKVQ + KVW + head * 128 + d0 * 16 + hi * 8);
        const v4u w = __builtin_bit_cast(v4u, qr[d0]);
        ss += (bf_lo(w.x) * bf_lo(w.x) + bf_hi(w.x) * bf_hi(w.x)) + (bf_lo(w.y) * bf_lo(w.y) + bf_hi(w.y) * bf_hi(w.y)) + (bf_lo(w.z) * bf_lo(w.z) + bf_hi(w.z) * bf_hi(w.z)) + (bf_lo(w.w) * bf_lo(w.w) + bf_hi(w.w) * bf_hi(w.w)); }
    { auto rr = __builtin_amdgcn_permlane32_swap(__float_as_uint(ss), __float_as_uint(ss), false, false); ss = __uint_as_float(rr[0]) + __uint_as_float(rr[1]); }
    const float c2 = 1.4426950408889634f / sqrtf(ss * (1.f / 128.f) + EPS);
    const float g_cmp = GT[rowq * 96 + head], g_sel = GT[rowq * 96 + 32 + head], g_win = GT[rowq * 96 + 64 + head];
    for (int i = tid; i < 32 * 65; i += NWAVES * 64) pb[i] = 0u;
    float* AOFw = (float*)(F.ws + WS_AOF) + ((size_t)b * SEQ + tok0) * DM + head * 128;
    bf16* AOw = (bf16*)(F.ws + WS_A3) + ((size_t)b * SEQ + tok0) * DM + head * 128;
    const int nct = (tg >> 5) + 1; const int cmax = (t - 31) >> 4;
    float m_c = -1e30f, l_c = 0.f;
    { Stage S;
      for (int kt = 0; kt < nct; ++kt) {
          stage_load(S, KC, VC, 128, kt * 64, sr, sc, false);
          __syncthreads(); stage_write(S, lds, sr, sc, false); __syncthreads();
          f32x16 p0, p1; qkt(p0, p1, lds + O_K, r32, hi, qr, 0.f);
          mask_tile(p0, p1, cmax - kt * 64 - 4 * hi, 0x7fffffffu);
          const float pmax = rowmax32(p0, p1), mn = fmaxf(m_c, pmax), al = __builtin_amdgcn_exp2f((m_c - mn) * c2), mnL = -mn * c2;
#pragma unroll
          for (int r = 0; r < 16; ++r) { p0[r] = __builtin_amdgcn_exp2f(fmaf(p0[r], c2, mnL)); p1[r] = __builtin_amdgcn_exp2f(fmaf(p1[r], c2, mnL)); }
          l_c = l_c * al + rowsum32(p0, p1); m_c = mn; }
      const float inv_l = l_c > 0.f ? 1.f / l_c : 0.f; const float mnL = -m_c * c2;
      f32x16 o[4] = {};
      for (int kt = 0; kt < nct; ++kt) {
          stage_load(S, KC, VC, 128, kt * 64, sr, sc, true);
          __syncthreads(); stage_write(S, lds, sr, sc, true); __syncthreads();
          f32x16 p0, p1; qkt(p0, p1, lds + O_K, r32, hi, qr, 0.f);
          mask_tile(p0, p1, cmax - kt * 64 - 4 * hi, 0x7fffffffu);
#pragma unroll
          for (int r = 0; r < 16; ++r) { p0[r] = __builtin_amdgcn_exp2f(fmaf(p0[r], c2, mnL)) * inv_l; p1[r] = __builtin_amdgcn_exp2f(fmaf(p1[r], c2, mnL)) * inv_l; }
#pragma unroll
          for (int rg = 0; rg < 4; ++rg) { const int j0 = 16 * kt + 2 * rg + hi;
              const float a0 = (p0[4 * rg] + p0[4 * rg + 1]) + (p0[4 * rg + 2] + 0.5f * p0[4 * rg + 3]), b0 = 0.5f * p0[4 * rg + 3];
              const float a1 = (p1[4 * rg] + p1[4 * rg + 1]) + (p1[4 * rg + 2] + 0.5f * p1[4 * rg + 3]), b1 = 0.5f * p1[4 * rg + 3];
              atomicAdd(&pb[r32 * 65 + j0], (unsigned)(a0 * 67108864.f + 0.5f)); atomicAdd(&pb[r32 * 65 + j0 + 1], (unsigned)(b0 * 67108864.f + 0.5f));
              atomicAdd(&pb[r32 * 65 + j0 + 8], (unsigned)(a1 * 67108864.f + 0.5f)); atomicAdd(&pb[r32 * 65 + j0 + 9], (unsigned)(b1 * 67108864.f + 0.5f)); }
          bf16x8 pa0, pa1, pa2, pa3; packP(p0, p1, pa0, pa1, pa2, pa3);
          pv_tile(o, vb0, pa0, pa1, pa2, pa3); }
      if (hi == 0) li_l[r32] = g_cmp; asm volatile("s_waitcnt lgkmcnt(0)" ::: "memory");
      emit<0>(o, li_l, AOFw, AOw, r32, hi); }
    __syncthreads();
#pragma unroll 1
    for (int tt = 0; tt < 4; ++tt) { const int tok = 4 * wid + tt; const bool valid = lane <= qb; const bool forced = lane == 0 || lane == qb;
        const unsigned key = forced ? 0xFFFFFFFFu : pb[tok * 65 + lane]; int rank = 0;
        for (int i = 0; i <= qb; ++i) { const unsigned ki = (unsigned)__builtin_amdgcn_readlane((int)key, i); rank += (ki > key || (ki == key && i < lane)) ? 1 : 0; }
        const unsigned long long mk = __ballot(valid && rank < 16);
        if (lane == 0) { selm[2 * tok] = (unsigned)mk; selm[2 * tok + 1] = (unsigned)(mk >> 32); } }
    __syncthreads();
    const unsigned long long mymask = (unsigned long long)selm[2 * r32] | ((unsigned long long)selm[2 * r32 + 1] << 32);
    unsigned ulo = (unsigned)mymask, uhi = (unsigned)(mymask >> 32);
#pragma unroll
    for (int o_ = 1; o_ < 32; o_ <<= 1) { ulo |= __shfl_xor(ulo, o_); uhi |= __shfl_xor(uhi, o_); }
    const unsigned long long uni = (unsigned long long)(unsigned)__builtin_amdgcn_readfirstlane((int)ulo) | ((unsigned long long)(unsigned)__builtin_amdgcn_readfirstlane((int)uhi) << 32);
    { const int lowk = tok0 - 511, j_lo = lowk > 0 ? lowk >> 6 : 0, j_hi = ((tok0 + 31) >> 6) + 1;
      const unsigned long long tiles = ((j_hi >= 64) ? ~0ull : ((1ull << j_hi) - 1ull)) & ~((1ull << j_lo) - 1ull);
      const bf16* Kw = KVQ + (size_t)b * SEQ * NKVQ + 4 * 512 + g * 128; const bf16* Vw = KVQ + (size_t)b * SEQ * NKVQ + 5 * 512 + g * 128;
      flash_pass<0, 1>(lds, Kw, Vw, NKVQ, tiles, t, qb, 0ull, qr, c2, g_win, AOFw, AOw, tid, wid, lane); }
    { const bf16* Ks = KVQ + (size_t)b * SEQ * NKVQ + 2 * 512 + g * 128; const bf16* Vs = KVQ + (size_t)b * SEQ * NKVQ + 3 * 512 + g * 128;
      flash_pass<1, 2>(lds, Ks, Vs, NKVQ, uni, t, qb, mymask, qr, c2, g_sel, AOFw, AOw, tid, wid, lane); }
    __syncthreads();
}
#undef KSWZ
#undef SBAR
}
__device__ __forceinline__ void nsa_attn_phase(Frame& F) {
    for (int ui = blockIdx.x; ui < 1024; ui += F.G) { const int vw = ui & 255, rnd = ui >> 8, bg = vw & 7, s = vw >> 3;
        const int tg = rnd == 0 ? s : rnd == 1 ? 63 - s : rnd == 2 ? 64 + s : 127 - s;
        nsa::unit(F, (char*)(F.lds + RING_OFF), bg >> 2, bg & 3, tg); }
}

struct Args { const float* in[18]; float* out; unsigned char* ws; int ph_lo, ph_hi; };
__global__ void __launch_bounds__(NWAVES * 64, 2) skel_fwd(Args args) {
    extern __shared__ __attribute__((aligned(16))) unsigned char lds[];
    Frame F;
    F.lds = (LAS unsigned char*)lds;
    F.MISC = (volatile LAS unsigned*)(F.lds + MISC_OFF);
    F.tid = threadIdx.x; F.lane = F.tid & 63; F.wave = __builtin_amdgcn_readfirstlane(F.tid >> 6);
    F.G = gridDim.x;
    unsigned char* ws = args.ws; F.ws = ws; F.out = args.out;
#pragma unroll
    for (int i = 0; i < 18; ++i) F.in[i] = args.in[i];
    F.ctl = (gu32*)(ws + WS_CTL);
    for (int u = F.tid; u < (LDS_BYTES - LDSCTL_OFF) / 4; u += NWAVES * 64) ((LAS unsigned*)(F.lds + LDSCTL_OFF))[u] = 0u;
    __syncthreads();
    XcdBarrier bar; bar.bar = (unsigned*)(F.ctl + CW_BAR); bar.x = 0; bar.st = nullptr;
    if (!MK_PER_PHASE) bar = xcd_barrier_post((unsigned*)(F.ctl + CW_BAR), F.MISC + 8);
    const int lo = args.ph_lo, hi = args.ph_hi;
#ifndef PHASE_MASK
#define PHASE_MASK 0x1ffff
#endif
#define IN(k) (((PHASE_MASK >> (k)) & 1) && lo <= (k) && (k) < hi)
#define SEAM(k) do { if (IN(k) && IN((k) + 1)) xcd_barrier(bar); } while (0)
    bf16* XB = (bf16*)(ws + WS_XB); bf16* A3 = (bf16*)(ws + WS_A3); bf16* BIG = (bf16*)(ws + WS_BIG);
    float* XA = (float*)(ws + WS_XA); float* XBF = (float*)(ws + WS_XBF);

    if (IN(0)) { p0_prologue(F); } SEAM(0);
    if (IN(1)) {
        pg8::Gemm g{XB, (const bf16*)(ws + WS_WIN), MTOK, M_MAIN, DM}; pg8::StaticOrder S; S.init(MTOK, M_MAIN, F.G, (int)blockIdx.x);
        pg8::EpiBf16<0> E{BIG, M_MAIN};
        pg8::gemm_phase<pg8::EpiBf16<0>, pg8::StaticOrder, true, true>(F.lds + RING_OFF, g, S, E);
        gates1_phase(F);
    } SEAM(1);
    if (IN(2)) { mlstm_phase(F); } SEAM(2);
    if (IN(3)) { gating_phase(F); } SEAM(3);
    if (IN(4)) {
        pg8::Gemm g{A3, (const bf16*)(ws + WS_WMO), MTOK, DM, DM}; pg8::StaticOrder S; S.init(MTOK, DM, F.G, (int)blockIdx.x);
        pg8::EpiResF32 E{F.in[0], XA, DM};
        pg8::gemm_phase<pg8::EpiResF32, pg8::StaticOrder, true, true>(F.lds + RING_OFF, g, S, E);
    } SEAM(4);
    if (IN(5)) { rownorm_phase(F, XA, XB); } SEAM(5);
    if (IN(6)) {
        pg8::Gemm g{XB, (const bf16*)(ws + WS_WUP0), MTOK, DFF, DM}; pg8::StaticOrder S; S.init(MTOK, DFF, F.G, (int)blockIdx.x);
        pg8::EpiBf16<2> E{BIG, DFF};
        pg8::gemm_phase<pg8::EpiBf16<2>, pg8::StaticOrder, true, true>(F.lds + RING_OFF, g, S, E);
    } SEAM(6);
    if (IN(7)) {
        pg8::Gemm g{BIG, (const bf16*)(ws + WS_WDN0), MTOK, DM, DFF}; pg8::StaticOrder S; S.init(MTOK, DM, F.G, (int)blockIdx.x);
        pg8::EpiResF32 E{XA, XBF, DM};
        pg8::gemm_phase<pg8::EpiResF32, pg8::StaticOrder, true, true>(F.lds + RING_OFF, g, S, E);
    } SEAM(7);
    if (IN(8)) { rownorm_phase(F, XBF, XB); } SEAM(8);
    if (IN(9)) {
        pg8::Gemm g{XB, (const bf16*)(ws + WS_WKVQ), MTOK, NKVQ, DM}; pg8::StaticOrder S; S.init(MTOK, NKVQ, F.G, (int)blockIdx.x);
        pg8::EpiBf16<0> E{BIG, NKVQ};
        pg8::gemm_phase<pg8::EpiBf16<0>, pg8::StaticOrder, true, true>(F.lds + RING_OFF, g, S, E);
        gates2_phase(F);
    } SEAM(9);
    if (IN(10)) { nsa_prep_phase(F); } SEAM(10);
    if (IN(11)) { nsa_cmp2_phase(F); } SEAM(11);
    if (IN(12)) { nsa_attn_phase(F); } SEAM(12);
    if (IN(13)) {
        pg8::Gemm g{A3, (const bf16*)(ws + WS_WNO), MTOK, DM, DM}; pg8::StaticOrder S; S.init(MTOK, DM, F.G, (int)blockIdx.x);
        pg8::EpiResF32 E{XBF, XA, DM};
        pg8::gemm_phase<pg8::EpiResF32, pg8::StaticOrder, true, true>(F.lds + RING_OFF, g, S, E);
    } SEAM(13);
    if (IN(14)) { rownorm_phase(F, XA, XB); } SEAM(14);
    if (IN(15)) {
        pg8::Gemm g{XB, (const bf16*)(ws + WS_WUP1), MTOK, DFF, DM}; pg8::StaticOrder S; S.init(MTOK, DFF, F.G, (int)blockIdx.x);
        pg8::EpiBf16<2> E{BIG, DFF};
        pg8::gemm_phase<pg8::EpiBf16<2>, pg8::StaticOrder, true, true>(F.lds + RING_OFF, g, S, E);
    } SEAM(15);
    if (IN(16)) {
        pg8::Gemm g{BIG, (const bf16*)(ws + WS_WDN1), MTOK, DM, DFF}; pg8::StaticOrder S; S.init(MTOK, DM, F.G, (int)blockIdx.x);
        pg8::EpiResF32 E{XA, F.out, DM};
        pg8::gemm_phase<pg8::EpiResF32, pg8::StaticOrder, true, true>(F.lds + RING_OFF, g, S, E);
    }
#undef IN
#undef SEAM
}

extern "C" void kernel_launch(void* const* d_in, const int* in_sizes, int n_in, void* d_out, int out_size, void* d_ws, size_t ws_size, hipStream_t stream) {
    static int grid = 0;
    if (grid == 0) {
        if (n_in != 18 || in_sizes[0] != MTOK * DM || out_size != MTOK * DM || ws_size < WS_END) { fprintf(stderr, "kernel_launch: unexpected shapes (n_in %d, in0 %d, out %d, ws %zu); nothing launched\n", n_in, n_in > 0 ? in_sizes[0] : -1, out_size, ws_size); grid = -1; return; }
        int dev = 0, cus = 0, per_cu = 0;
        if (hipGetDevice(&dev) != hipSuccess || hipDeviceGetAttribute(&cus, hipDeviceAttributeMultiprocessorCount, dev) != hipSuccess) { grid = -1; return; }
        if (hipFuncSetAttribute((const void*)skel_fwd, hipFuncAttributeMaxDynamicSharedMemorySize, LDS_BYTES) != hipSuccess) { fprintf(stderr, "kernel_launch: hipFuncSetAttribute failed\n"); grid = -1; return; }
        if (hipOccupancyMaxActiveBlocksPerMultiprocessor(&per_cu, (const void*)skel_fwd, NWAVES * 64, LDS_BYTES) != hipSuccess || per_cu < 1) fprintf(stderr, "kernel_launch: occupancy query reports %d\n", per_cu);
        (void)hipGetLastError();
        grid = cus;
    }
    if (grid < 0) return;
    if (hipMemsetAsync((char*)d_ws + WS_CTL, 0, CTL_ZERO_BYTES, stream) != hipSuccess) return;
    Args a{};
    for (int i = 0; i < 18; ++i) a.in[i] = (const float*)d_in[i];
    a.out = (float*)d_out; a.ws = (unsigned char*)d_ws;
#if MK_PER_PHASE
    for (int p = 0; p < N_PHASES; ++p) { a.ph_lo = p; a.ph_hi = p + 1; hipLaunchKernelGGL(skel_fwd, dim3(grid), dim3(NWAVES * 64), LDS_BYTES, stream, a); }
#else
    a.ph_lo = 0; a.ph_hi = N_PHASES; hipLaunchKernelGGL(skel_fwd, dim3(grid), dim3(NWAVES * 64), LDS_BYTES, stream, a);
#endif
}
```

```cpp
#include <hip/hip_runtime.h>
#include <hip/hip_bf16.h>
#include <cstdio>
#include <cstdint>
#include <cmath>
namespace pg8 {
#define PG8_LAS __attribute__((address_space(3)))
typedef unsigned short bf16_t;
typedef short bf16x8 __attribute__((ext_vector_type(8)));
typedef float f32x4 __attribute__((ext_vector_type(4)));
typedef unsigned u32x4 __attribute__((ext_vector_type(4)));
typedef int v8i32_t __attribute__((ext_vector_type(8)));
typedef int v4i32_t __attribute__((ext_vector_type(4)));
constexpr int BM = 256, BK = 64, HALF = 128, HTB = HALF * BK * 2  , STAGE_BYTES = 8 * HTB, NXCD = 8, WGM = 8;

__host__ __device__ __forceinline__ int lds_byte(int r, int c) { const int st = (r >> 4) * 2 + (c >> 5), rr = r & 15, cc = c & 31, ob = rr * 64 + cc * 2; return st * 1024 + (ob ^ (((ob >> 9) & 1) << 5)); }
__host__ __device__ __forceinline__ void stage_rc(int b, int& R, int& C) { const int st = b / 1024, sb = b % 1024, swz = sb ^ (((sb >> 9) & 1) << 5); R = (st >> 1) * 16 + swz / 64; C = (st & 1) * 32 + (swz % 64) / 2; }
__host__ __device__ __forceinline__ int perm32(int rho) { const int n = rho >> 4, i = rho & 15; return 8 * (i >> 2) + 4 * n + (i & 3); }

struct Unit { int pm, pn; };
struct Gemm { const bf16_t* A; const bf16_t* Bt; int M, N, K; };

struct StaticOrder {
    int nM, nN, nwg, G, c;
    __host__ __device__ void init(int M, int N, int G_, int c_) { nM = M / BM; nN = N / BM; nwg = nM * nN; G = G_; c = c_; }
    __host__ __device__ bool next(int i, Unit& u) const {
        const long L = (long)i * G + c; if (L >= nwg) return false;
        int wgid = (int)L; { const int q = nwg / NXCD, r = nwg % NXCD, xcd = wgid % NXCD, off = wgid / NXCD; wgid = (xcd < r ? xcd * (q + 1) : r * (q + 1) + (xcd - r) * q) + off; }
        const int nig = WGM * nN, gid = wgid / nig, fm = gid * WGM, gsz = (nM - fm) < WGM ? (nM - fm) : WGM;
        u.pm = fm + ((wgid % nig) % gsz); u.pn = (wgid % nig) / gsz; return true;
    }
    __device__ __forceinline__ void a_ready(const Unit&) const {}
    __device__ __forceinline__ void done(const Unit&) const {}
};

typedef float f32x2c __attribute__((ext_vector_type(2))); typedef __bf16 bf16x2c __attribute__((ext_vector_type(2)));
__device__ __forceinline__ unsigned cvt_pk_bf16(float lo, float hi) { f32x2c v = {lo, hi}; bf16x2c b = __builtin_convertvector(v, bf16x2c); return __builtin_bit_cast(unsigned, b); }
template <int ACT  , bool SCALED = false> struct EpiBf16 {
    static constexpr bool PERM = true, AFTER_DRAIN = false;
    bf16_t* O; int ldc; const float* rstd; float osc = 1.f;
    __device__ __forceinline__ void operator()(const f32x4 (&acc)[2][2][4][2], const Unit& u, int wr, int wc, int fr, int fq) const {
        const int row0 = u.pm * BM + wr * 64 + fr, col0 = u.pn * BM + wc * 32 + 8 * fq;
#pragma unroll
        for (int ai = 0; ai < 2; ++ai)
#pragma unroll
            for (int m = 0; m < 4; ++m) { const int row = row0 + ai * HALF + m * 16; bf16_t* rowp = O + (size_t)row * ldc + col0;
                const float rs = (SCALED ? rstd[row] : 1.f) * osc;
#pragma unroll
                for (int bj = 0; bj < 2; ++bj) { f32x4 v0 = acc[ai][bj][m][0], v1 = acc[ai][bj][m][1];
                    v0 = v0 * rs; v1 = v1 * rs;
                    if (ACT == 2) {
#pragma unroll
                        for (int e = 0; e < 4; ++e) { const float a = fmaxf(v0[e], 0.f), b = fmaxf(v1[e], 0.f); v0[e] = a * a; v1[e] = b * b; } }
                    u32x4 w; w.x = cvt_pk_bf16(v0[0], v0[1]); w.y = cvt_pk_bf16(v0[2], v0[3]); w.z = cvt_pk_bf16(v1[0], v1[1]); w.w = cvt_pk_bf16(v1[2], v1[3]);
                    *(u32x4*)(rowp + bj * HALF) = w; } }
    }
};
template <bool BASE_BF16, bool OUT_BF16, bool Q8 = false> struct EpiRes {
    static constexpr bool PERM = true, AFTER_DRAIN = false;
    const void* base; void* out; float* part; int ldc; float osc = 1.f; unsigned char* o8 = nullptr; const float* ra = nullptr; const float* cmax = nullptr;
    __device__ __forceinline__ void operator()(const f32x4 (&acc)[2][2][4][2], const Unit& u, int wr, int wc, int fr, int fq) const {
        const int col0 = u.pn * BM + wc * 32 + 8 * fq;
        f32x4 cs[2][2];
        if (Q8) {
#pragma unroll
            for (int bj = 0; bj < 2; ++bj) { cs[bj][0] = *(const f32x4*)(cmax + col0 + bj * HALF) * (1.f / 127.f); cs[bj][1] = *(const f32x4*)(cmax + col0 + bj * HALF + 4) * (1.f / 127.f); } }
#pragma unroll
        for (int ai = 0; ai < 2; ++ai)
#pragma unroll
            for (int m = 0; m < 4; ++m) { const int row = u.pm * BM + ai * HALF + wr * 64 + m * 16 + fr; const size_t off = (size_t)row * ldc + col0; float s = 0.f; float rr = 0.f; if (Q8) rr = ra[row];
#pragma unroll
                for (int bj = 0; bj < 2; ++bj) { f32x4 b0, b1;
                    if (BASE_BF16) { const u32x4 w = *(const u32x4*)((const bf16_t*)base + off + bj * HALF);
                        b0 = (f32x4){__uint_as_float(w.x << 16), __uint_as_float(w.x & 0xffff0000u), __uint_as_float(w.y << 16), __uint_as_float(w.y & 0xffff0000u)};
                        b1 = (f32x4){__uint_as_float(w.z << 16), __uint_as_float(w.z & 0xffff0000u), __uint_as_float(w.w << 16), __uint_as_float(w.w & 0xffff0000u)}; }
                    else { b0 = *(const f32x4*)((const float*)base + off + bj * HALF); b1 = *(const f32x4*)((const float*)base + off + bj * HALF + 4); }
                    f32x4 o0, o1;
                    if (Q8) { const v4i32_t i0 = __builtin_bit_cast(v4i32_t, acc[ai][bj][m][0]), i1 = __builtin_bit_cast(v4i32_t, acc[ai][bj][m][1]);
#pragma unroll
                        for (int e = 0; e < 4; ++e) { o0[e] = b0[e] + (float)i0[e] * rr * cs[bj][0][e]; o1[e] = b1[e] + (float)i1[e] * rr * cs[bj][1][e]; } }
                    else { o0 = b0 + acc[ai][bj][m][0] * osc; o1 = b1 + acc[ai][bj][m][1] * osc; }
                    if (o8) { typedef int i32x2 __attribute__((ext_vector_type(2))); i32x2 q; q.x = __builtin_amdgcn_cvt_pk_fp8_f32(o0[0], o0[1], 0, false); q.x = __builtin_amdgcn_cvt_pk_fp8_f32(o0[2], o0[3], q.x, true);
                        q.y = __builtin_amdgcn_cvt_pk_fp8_f32(o1[0], o1[1], 0, false); q.y = __builtin_amdgcn_cvt_pk_fp8_f32(o1[2], o1[3], q.y, true); *(i32x2*)(o8 + off + bj * HALF) = q; }
                    s += ((o0[0] * o0[0] + o0[1] * o0[1]) + (o0[2] * o0[2] + o0[3] * o0[3])) + ((o1[0] * o1[0] + o1[1] * o1[1]) + (o1[2] * o1[2] + o1[3] * o1[3]));
                    if (OUT_BF16) { u32x4 w; w.x = cvt_pk_bf16(o0[0], o0[1]); w.y = cvt_pk_bf16(o0[2], o0[3]); w.z = cvt_pk_bf16(o1[0], o1[1]); w.w = cvt_pk_bf16(o1[2], o1[3]); *(u32x4*)((bf16_t*)out + off + bj * HALF) = w; }
                    else { *(f32x4*)((float*)out + off + bj * HALF) = o0; *(f32x4*)((float*)out + off + bj * HALF + 4) = o1; } }
                if (part) { s += __shfl_xor(s, 16); s += __shfl_xor(s, 32); if (fq == 0) part[(size_t)row * 64 + u.pn * 4 + wc] = s; } }
    }
};
template <int ACT> struct EpiQ8 {
    static constexpr bool PERM = true, AFTER_DRAIN = false;
    bf16_t* O; int ldc; const float* cmax; const float* ra;
    __device__ __forceinline__ void operator()(const f32x4 (&acc)[2][2][4][2], const Unit& u, int wr, int wc, int fr, int fq) const {
        const int row0 = u.pm * BM + wr * 64 + fr, col0 = u.pn * BM + wc * 32 + 8 * fq;
        f32x4 cs[2][2];
#pragma unroll
        for (int bj = 0; bj < 2; ++bj) { cs[bj][0] = *(const f32x4*)(cmax + col0 + bj * HALF) * (1.f / 127.f); cs[bj][1] = *(const f32x4*)(cmax + col0 + bj * HALF + 4) * (1.f / 127.f); }
#pragma unroll
        for (int ai = 0; ai < 2; ++ai)
#pragma unroll
            for (int m = 0; m < 4; ++m) { const int row = row0 + ai * HALF + m * 16; bf16_t* rowp = O + (size_t)row * ldc + col0; const float rr = ra[row];
#pragma unroll
                for (int bj = 0; bj < 2; ++bj) { const v4i32_t i0 = __builtin_bit_cast(v4i32_t, acc[ai][bj][m][0]), i1 = __builtin_bit_cast(v4i32_t, acc[ai][bj][m][1]); f32x4 v0, v1;
#pragma unroll
                    for (int e = 0; e < 4; ++e) { float a = (float)i0[e] * rr * cs[bj][0][e], b = (float)i1[e] * rr * cs[bj][1][e]; if (ACT == 2) { a = fmaxf(a, 0.f); b = fmaxf(b, 0.f); a *= a; b *= b; } v0[e] = a; v1[e] = b; }
                    u32x4 w; w.x = cvt_pk_bf16(v0[0], v0[1]); w.y = cvt_pk_bf16(v0[2], v0[3]); w.z = cvt_pk_bf16(v1[0], v1[1]); w.w = cvt_pk_bf16(v1[2], v1[3]);
                    *(u32x4*)(rowp + bj * HALF) = w; } }
    }
};
template <class Epi, class Sched, bool ALIGN_EPI = false, bool SP2 = false, int QM = 0>
__device__ __forceinline__ void gemm_phase(PG8_LAS unsigned char* lds, const Gemm g, const Sched& S, const Epi& E) {
    const int tid = threadIdx.x, wid = __builtin_amdgcn_readfirstlane(tid >> 6), lane = tid & 63, wr = wid >> 2, wc = wid & 3, fr = lane & 15, fq = lane >> 4;
    constexpr bool F8 = QM == 1, I8 = QM == 2;
    constexpr int ES = QM ? 1 : 2;
    const int K = g.K, nt = K / (QM ? 2 * BK : BK);
    unsigned voffA[2], voffB[2];
#pragma unroll
    for (int i = 0; i < 2; ++i) { int R, C; stage_rc(tid * 16 + i * 8192, R, C); const int Rb = Epi::PERM ? ((R & ~31) + perm32(R & 31)) : R;
        voffA[i] = (unsigned)(R * K * ES + C * 2); voffB[i] = (unsigned)(Rb * K * ES + C * 2); }
    const size_t kstep = (size_t)(BK * 2);
    const size_t hstep = (size_t)HALF * K * ES;
    const size_t tstep = 2 * hstep;
    const unsigned ldsw = (unsigned)wid * 1024u;
    const int aoff = lds_byte(wr * 64 + fr, F8 ? fq * 16 : fq * 8), boff = lds_byte(wc * 32 + fr, F8 ? fq * 16 : fq * 8);
#define PG8_SA(b, h) (((b) * 2 + (h)) * HTB)
#define PG8_SB(b, h) ((4 + (b) * 2 + (h)) * HTB)
#define PG8_STAGE(bufoff, gbase, voff) do { _Pragma("unroll") for (int _i = 0; _i < 2; ++_i) \
        __builtin_amdgcn_global_load_lds((const unsigned*)((const char*)(gbase) + (voff)[_i]), (PG8_LAS unsigned*)(lds + (bufoff) + ldsw + _i * 8192), 16, 0, 0); } while (0)
#define PG8_LDA(dst, b, h) do { if constexpr (F8) { _Pragma("unroll") for (int m = 0; m < 4; ++m) dst##8[m] = *(const PG8_LAS v8i32_t*)(lds + PG8_SA(b, h) + aoff + m * 2048); } \
        else { _Pragma("unroll") for (int m = 0; m < 4; ++m) _Pragma("unroll") for (int k = 0; k < 2; ++k) dst[m][k] = *(const PG8_LAS bf16x8*)(lds + PG8_SA(b, h) + aoff + m * 2048 + k * 1024); } } while (0)
#define PG8_LDB(dst, b, h) do { if constexpr (F8) { _Pragma("unroll") for (int n = 0; n < 2; ++n) dst##8[n] = *(const PG8_LAS v8i32_t*)(lds + PG8_SB(b, h) + boff + n * 2048); } \
        else { _Pragma("unroll") for (int n = 0; n < 2; ++n) _Pragma("unroll") for (int k = 0; k < 2; ++k) dst[n][k] = *(const PG8_LAS bf16x8*)(lds + PG8_SB(b, h) + boff + n * 2048 + k * 1024); } } while (0)
#define PG8_MMA(ai, bj, At, Bt) do { __builtin_amdgcn_s_setprio(1); _Pragma("unroll") for (int m = 0; m < 4; ++m) _Pragma("unroll") for (int n = 0; n < 2; ++n) { \
        if constexpr (F8) asm volatile("v_mfma_scale_f32_16x16x128_f8f6f4 %0, %1, %2, %0, %3, %3 op_sel_hi:[0,0,0]" : "+v"(acc[ai][bj][m][n]) : "v"(Bt##8[n]), "v"(At##8[m]), "v"(scl8));   \
        else if constexpr (I8) { _Pragma("unroll") for (int k = 0; k < 2; ++k) acc[ai][bj][m][n] = __builtin_bit_cast(f32x4, __builtin_amdgcn_mfma_i32_16x16x64_i8(__builtin_bit_cast(v4i32_t, Bt[n][k]), __builtin_bit_cast(v4i32_t, At[m][k]), __builtin_bit_cast(v4i32_t, acc[ai][bj][m][n]), 0, 0, 0)); } \
        else { _Pragma("unroll") for (int k = 0; k < 2; ++k) acc[ai][bj][m][n] = __builtin_amdgcn_mfma_f32_16x16x32_bf16(Bt[n][k], At[m][k], acc[ai][bj][m][n], 0, 0, 0); } } \
        __builtin_amdgcn_s_setprio(0); } while (0)
#define PG8_WAIT_V(n) asm volatile("s_waitcnt vmcnt(" #n ")" ::: "memory")
#define PG8_WAIT_L(n) asm volatile("s_waitcnt lgkmcnt(" #n ")" ::: "memory")
#define PG8_BAR __builtin_amdgcn_s_barrier()
#define PG8_SCHED __builtin_amdgcn_sched_barrier(0)
    Unit cur, nxt; int ui = 0;
    if (!S.next(0, cur)) return;
    f32x4 acc[2][2][4][2];
#pragma unroll
    for (int a = 0; a < 2; ++a)
#pragma unroll
        for (int b = 0; b < 2; ++b)
#pragma unroll
            for (int m = 0; m < 4; ++m)
#pragma unroll
                for (int n = 0; n < 2; ++n) acc[a][b][m][n] = (f32x4){0.f, 0.f, 0.f, 0.f};
    bf16x8 At[4][2], B0[2][2], B1[2][2]; v8i32_t At8[4], B08[2], B18[2];
    int scl8 = 0x7F7F7F7F; asm volatile("" : "+v"(scl8));
    const char* cA = (const char*)g.A + (size_t)cur.pm * tstep; const char* cB = (const char*)g.Bt + (size_t)cur.pn * tstep;
    S.a_ready(cur);
    if constexpr (SP2) {
        PG8_STAGE(PG8_SB(0, 0), cB, voffB); PG8_STAGE(PG8_SB(0, 1), cB + hstep, voffB); PG8_STAGE(PG8_SA(0, 0), cA, voffA); PG8_STAGE(PG8_SA(0, 1), cA + hstep, voffA);
        if (wr == 1) PG8_BAR;
        PG8_WAIT_V(2); PG8_BAR;
        PG8_STAGE(PG8_SB(1, 0), cB + kstep, voffB); PG8_STAGE(PG8_SA(1, 0), cA + kstep, voffA); PG8_STAGE(PG8_SB(1, 1), cB + hstep + kstep, voffB);
        PG8_WAIT_V(6); PG8_BAR;
    } else {
        PG8_STAGE(PG8_SB(0, 0), cB, voffB); PG8_STAGE(PG8_SA(0, 0), cA, voffA); PG8_STAGE(PG8_SB(0, 1), cB + hstep, voffB); PG8_STAGE(PG8_SA(0, 1), cA + hstep, voffA);
        if (wr == 1) PG8_BAR;
        PG8_WAIT_V(4); PG8_BAR;
        PG8_STAGE(PG8_SB(1, 0), cB + kstep, voffB); PG8_STAGE(PG8_SA(1, 0), cA + kstep, voffA); PG8_STAGE(PG8_SB(1, 1), cB + hstep + kstep, voffB);
        PG8_WAIT_V(6); PG8_BAR;
    }
    for (;;) {
        const bool has_next = S.next(ui + 1, nxt);
        const char* nA = has_next ? (const char*)g.A + (size_t)nxt.pm * tstep : cA; const char* nB = has_next ? (const char*)g.Bt + (size_t)nxt.pn * tstep : cB;
        for (int t = 0; t < nt; t += 2) {
            const bool last = (t == nt - 2);
            const char* a1 = cA + (size_t)(t + 1) * kstep;
            const char* a2 = last ? nA : cA + (size_t)(t + 2) * kstep; const char* b2 = last ? nB : cB + (size_t)(t + 2) * kstep;
            const char* a3 = a2 + kstep; const char* b3 = b2 + kstep;
            if (last && has_next) S.a_ready(nxt);
            if constexpr (SP2) {
            PG8_LDB(B0, 0, 0); PG8_LDB(B1, 0, 1); PG8_SCHED; PG8_LDA(At, 0, 0); PG8_STAGE(PG8_SA(1, 1), a1 + hstep, voffA);
            PG8_WAIT_V(8); PG8_WAIT_L(0); PG8_BAR; PG8_MMA(0, 0, At, B0); PG8_MMA(0, 1, At, B1); PG8_BAR; PG8_SCHED;
            PG8_LDA(At, 0, 1); PG8_STAGE(PG8_SB(0, 0), b2, voffB); PG8_STAGE(PG8_SB(0, 1), b2 + hstep, voffB); PG8_STAGE(PG8_SA(0, 0), a2, voffA);
            PG8_WAIT_V(8); PG8_WAIT_L(0); PG8_BAR; PG8_MMA(1, 0, At, B0); PG8_MMA(1, 1, At, B1); PG8_BAR; PG8_SCHED;
            PG8_LDB(B0, 1, 0); PG8_LDB(B1, 1, 1); PG8_SCHED; PG8_LDA(At, 1, 0); PG8_STAGE(PG8_SA(0, 1), a2 + hstep, voffA);
            PG8_WAIT_V(8); PG8_WAIT_L(0); PG8_BAR; PG8_MMA(0, 0, At, B0); PG8_MMA(0, 1, At, B1); PG8_BAR; PG8_SCHED;
            PG8_LDA(At, 1, 1); PG8_STAGE(PG8_SB(1, 0), b3, voffB); PG8_STAGE(PG8_SB(1, 1), b3 + hstep, voffB); PG8_STAGE(PG8_SA(1, 0), a3, voffA);
            PG8_WAIT_V(8); PG8_WAIT_L(0); PG8_BAR; PG8_MMA(1, 0, At, B0); PG8_MMA(1, 1, At, B1); PG8_BAR; PG8_SCHED;
            } else {
            PG8_LDB(B0, 0, 0); PG8_SCHED; PG8_LDA(At, 0, 0); PG8_STAGE(PG8_SA(1, 1), a1 + hstep, voffA);
            PG8_WAIT_L(8); PG8_BAR; PG8_WAIT_L(0); PG8_MMA(0, 0, At, B0); PG8_BAR; PG8_SCHED;
            PG8_LDB(B1, 0, 1); PG8_STAGE(PG8_SB(0, 0), b2, voffB);
            PG8_BAR; PG8_WAIT_L(0); PG8_MMA(0, 1, At, B1); PG8_BAR;
            PG8_LDA(At, 0, 1); PG8_STAGE(PG8_SA(0, 0), a2, voffA);
            PG8_BAR; PG8_WAIT_L(0); PG8_MMA(1, 0, At, B0); PG8_BAR; PG8_SCHED;
            PG8_STAGE(PG8_SB(0, 1), b2 + hstep, voffB);
            PG8_WAIT_V(6); PG8_BAR; PG8_MMA(1, 1, At, B1); PG8_BAR;
            PG8_LDB(B0, 1, 0); PG8_SCHED; PG8_LDA(At, 1, 0); PG8_STAGE(PG8_SA(0, 1), a2 + hstep, voffA);
            PG8_WAIT_L(8); PG8_BAR; PG8_WAIT_L(0); PG8_MMA(0, 0, At, B0); PG8_BAR; PG8_SCHED;
            PG8_LDB(B1, 1, 1); PG8_STAGE(PG8_SB(1, 0), b3, voffB);
            PG8_BAR; PG8_WAIT_L(0); PG8_MMA(0, 1, At, B1); PG8_BAR;
            PG8_LDA(At, 1, 1); PG8_STAGE(PG8_SA(1, 0), a3, voffA);
            PG8_BAR; PG8_WAIT_L(0); PG8_MMA(1, 0, At, B0); PG8_BAR; PG8_SCHED;
            PG8_STAGE(PG8_SB(1, 1), b3 + hstep, voffB);
            PG8_WAIT_V(6); PG8_BAR; PG8_MMA(1, 1, At, B1); PG8_BAR;
            }
        }
        if constexpr (F8) { asm volatile("s_nop 15\n\ts_nop 15" ::: "memory"); PG8_SCHED; }
        if constexpr (ALIGN_EPI) { if (wr == 0) PG8_BAR; }
        if constexpr (!Epi::AFTER_DRAIN) { E(acc, cur, wr, wc, fr, fq); S.done(cur); }
        if (!has_next) break;
#pragma unroll
        for (int a = 0; a < 2; ++a)
#pragma unroll
            for (int b = 0; b < 2; ++b)
#pragma unroll
                for (int m = 0; m < 4; ++m)
#pragma unroll
                    for (int n = 0; n < 2; ++n) acc[a][b][m][n] = (f32x4){0.f, 0.f, 0.f, 0.f};
        cur = nxt; cA = nA; cB = nB; ++ui;
        if constexpr (ALIGN_EPI) { if (wr == 1) PG8_BAR; }
    }
    PG8_WAIT_V(0);
    if constexpr (!ALIGN_EPI) { if (wr == 0) PG8_BAR; }
    PG8_BAR;
    if constexpr (Epi::AFTER_DRAIN) { E.fused(acc, cur, wr, wc, fr, fq, lds, wid, lane); S.done(cur); }
#undef PG8_SA
#undef PG8_SB
#undef PG8_STAGE
#undef PG8_LDA
#undef PG8_LDB
#undef PG8_MMA
#undef PG8_WAIT_V
#undef PG8_WAIT_L
#undef PG8_BAR
#undef PG8_SCHED
}
}
#define GAS __attribute__((address_space(1)))
#define LAS __attribute__((address_space(3)))
typedef unsigned short bf16;
typedef unsigned v4u __attribute__((ext_vector_type(4)));
typedef float f32x4 __attribute__((ext_vector_type(4)));
typedef short bf16x8 __attribute__((ext_vector_type(8)));
typedef GAS unsigned gu32;
typedef GAS unsigned long long gu64;
#define RLX_AGENT __ATOMIC_RELAXED, __HIP_MEMORY_SCOPE_AGENT
#define LDS_WAIT() asm volatile("s_waitcnt lgkmcnt(0)" ::: "memory")
#define VM_WAIT() asm volatile("s_waitcnt vmcnt(0)" ::: "memory")
__device__ __forceinline__ unsigned long long rt() { return __builtin_amdgcn_s_memrealtime(); }

#define XB_TMO      128
#define XB_XCNT(j)  (256  + 64 * (j))
#define XB_XSUB(j)  (1280 + 64 * (j))
#define XB_XGEN(j)  (2304 + 64 * (j))
#define XB_TOP      3328
#define XB_TOPGEN   3392
#define XCD_BAR_WORDS 3456
#define XB_SPIN_CAP (1u << 18)

__device__ __forceinline__ unsigned xb_ld(unsigned* p)              { return __hip_atomic_load(p, __ATOMIC_RELAXED, __HIP_MEMORY_SCOPE_AGENT); }
__device__ __forceinline__ unsigned xb_add(unsigned* p, unsigned v) { return __hip_atomic_fetch_add(p, v, __ATOMIC_RELAXED, __HIP_MEMORY_SCOPE_AGENT); }
__device__ __forceinline__ unsigned xb_xcc_id() { return (unsigned)__builtin_amdgcn_s_getreg((3 << 11) | 20) & 0xFu; }
#define XB_SPIN(cond, bar) do { unsigned _sp = 0; while (cond) { __builtin_amdgcn_s_sleep(1); \
    if ((++_sp & 255u) == 0u) { if (xb_ld(&(bar)[XB_TMO])) break; if (_sp > XB_SPIN_CAP) { atomicAdd(&(bar)[XB_TMO], 1u); break; } } } } while (0)

struct XcdBarrier {
    unsigned* bar; unsigned x;
    volatile LAS unsigned* st;
};

__device__ __forceinline__ XcdBarrier xcd_barrier_post(unsigned* bar, volatile LAS unsigned* st) {
    XcdBarrier b; b.bar = bar; b.x = xb_xcc_id(); b.st = st;
    if (threadIdx.x == 0) (void)xb_add(&bar[XB_XCNT(b.x)], 1u);
    return b;
}
__device__ __forceinline__ void xcd_barrier_complete(unsigned* bar, unsigned x, unsigned& nloc, unsigned& nx) {
    const unsigned G = gridDim.x * gridDim.y * gridDim.z;
    unsigned sum, cnt, mine, sp = 0u;
    for (;;) {
        sum = 0u; cnt = 0u; mine = 0u;
#pragma unroll
        for (unsigned j = 0; j < 16; ++j) { const unsigned c = xb_ld(&bar[XB_XCNT(j)]); sum += c; cnt += (c > 0u) ? 1u : 0u; mine = (j == x) ? c : mine; }
        if (sum == G) break;
        __builtin_amdgcn_s_sleep(1);
        if ((++sp & 255u) == 0u) { if (xb_ld(&bar[XB_TMO])) break; if (sp > XB_SPIN_CAP) { atomicAdd(&bar[XB_TMO], 1u); break; } }
    }
    nloc = mine > 0u ? mine : 1u; nx = cnt > 0u ? cnt : 1u;
}

__device__ __forceinline__ void xcd_barrier(const XcdBarrier& b) {
    asm volatile("s_waitcnt vmcnt(0)" ::: "memory");
    __syncthreads();
    if (threadIdx.x == 0) {
        unsigned* bar = b.bar;
        __builtin_amdgcn_s_waitcnt(0);
        unsigned nloc = b.st[0], nx = b.st[1];
        if (nloc == 0u) { xcd_barrier_complete(bar, b.x, nloc, nx); b.st[0] = nloc; b.st[1] = nx; }
        const unsigned old = xb_add(&bar[XB_XSUB(b.x)], 1u);
        const unsigned gen = old / nloc;
        if (old + 1u == (gen + 1u) * nloc) {
            __builtin_amdgcn_fence(__ATOMIC_RELEASE, "agent");
            asm volatile("s_waitcnt vmcnt(0)" ::: "memory");
            const unsigned og = xb_add(&bar[XB_TOP], 1u);
            const unsigned tg = og / nx;
            if (og + 1u == (tg + 1u) * nx) xb_add(&bar[XB_TOPGEN], 1u);
            else XB_SPIN(xb_ld(&bar[XB_TOPGEN]) == tg, bar);
            __builtin_amdgcn_fence(__ATOMIC_ACQUIRE, "agent");
            xb_add(&bar[XB_XGEN(b.x)], 1u);
            asm volatile("s_waitcnt vmcnt(0)" ::: "memory");
        } else {
            XB_SPIN(xb_ld(&bar[XB_XGEN(b.x)]) == gen, bar);
            __builtin_amdgcn_fence(__ATOMIC_ACQUIRE, "agent");
            asm volatile("s_waitcnt vmcnt(0)" ::: "memory");
        }
    }
    __syncthreads();
}

constexpr int NWAVES = 8;
#ifndef MK_PER_PHASE
#define MK_PER_PHASE 0
#endif
constexpr int N_PHASES = 17;
constexpr int BATCH = 2, SEQ = 4096, DM = 4096, MTOK = BATCH * SEQ, DFF = 16384;
constexpr int MH = 8, MDK = 256, MDV = 512, M_MAIN = 12288, M_IN = 12304;
constexpr int NKVQ = 7168, NQG = 4192, KVW = 3072;
constexpr float EPS = 1e-6f;
#ifndef Q8_UP_MASK
#define Q8_STRIPS 1
#define Q8_KVQ 1
#define Q8_WMO 1
#define Q8_UP_MASK 3
#endif
constexpr float ATT_SCALE = 0.08838834764831845f;

constexpr size_t MiB = 1u << 20;
constexpr size_t WS_CTL = 0, CTL_CMAX = 65536  , CTL_ZERO_BYTES = 65536 + 4 * 16384 * 4;
constexpr size_t WS_WG1 = 1 * MiB, WS_WG2 = 2 * MiB, WS_W2C = 3 * MiB, WS_POSB = 3 * MiB + 512 * 1024, WS_POSP = 3 * MiB + 640 * 1024;
constexpr size_t WS_LI = 4 * MiB, WS_LF = 4 * MiB + 512 * 1024, WS_GT = 5 * MiB, WS_HC = 8 * MiB, WS_KC = 12 * MiB, WS_VC = 12 * MiB + 512 * 1024, WS_SELM = 13 * MiB;
constexpr size_t WS_WIN = 16 * MiB, WS_WMO = 112 * MiB, WS_WUP0 = 144 * MiB, WS_WDN0 = 272 * MiB, WS_WKVQ = 400 * MiB, WS_W1C = 456 * MiB, WS_WNO = 464 * MiB, WS_WUP1 = 496 * MiB, WS_WDN1 = 624 * MiB;
constexpr size_t WS_XB = 752 * MiB, WS_A3 = 816 * MiB, WS_HR = 880 * MiB, WS_X1 = 944 * MiB, WS_X2 = 1008 * MiB, WS_BIG = 1200 * MiB, WS_AOF = 1328 * MiB, WS_WUPQ0 = 1456 * MiB, WS_WUPQ1 = 1520 * MiB  , WS_XQ = 1584 * MiB  , WS_WKVQ8 = 1616 * MiB  , WS_WMOQ = 1644 * MiB  , WS_END = 1660 * MiB;
constexpr int CW_BAR = 4096;
constexpr int CW_QHEAD = 16384;
constexpr size_t WS_PART = 13 * MiB, WS_RS = 15 * MiB;

constexpr int RING_OFF = 0, RING_BYTES = 147456;
constexpr int LDSCTL_OFF = RING_BYTES, MISC_OFF = LDSCTL_OFF + 320;
constexpr int LDS_BYTES = 159744;
static_assert(MISC_OFF + 128 <= LDS_BYTES, "LDS map");

typedef float f32x16 __attribute__((ext_vector_type(16)));
typedef short s16x4 __attribute__((ext_vector_type(4)));
typedef float f32x2v __attribute__((ext_vector_type(2)));

struct Frame {
    LAS unsigned char* lds;
    volatile LAS unsigned* MISC;
    gu32* ctl;
    int tid, lane, wave, G;
    const float* in[18]; float* out; unsigned char* ws;
};

__device__ __forceinline__ float wave_sum(float v) {
#pragma unroll
    for (int o = 1; o < 64; o <<= 1) v += __shfl_xor(v, o);
    return v;
}
typedef float f32x2_t __attribute__((ext_vector_type(2))); typedef __bf16 bf16x2_t __attribute__((ext_vector_type(2)));
__device__ __forceinline__ unsigned pk2(float lo, float hi) { f32x2_t v = {lo, hi}; bf16x2_t b = __builtin_convertvector(v, bf16x2_t); return __builtin_bit_cast(unsigned, b); }
__device__ __forceinline__ float bf_lo(unsigned w) { return __uint_as_float(w << 16); }
__device__ __forceinline__ float bf_hi(unsigned w) { return __uint_as_float(w & 0xffff0000u); }
__device__ __forceinline__ float bf1(unsigned short h) { return __uint_as_float(((unsigned)h) << 16); }
__device__ __forceinline__ unsigned short f2bf1(float f) { return (unsigned short)(pk2(f, 0.f) & 0xffffu); }
__device__ __forceinline__ f32x4 mfma16(bf16x8 a, bf16x8 b, f32x4 c) { return __builtin_amdgcn_mfma_f32_16x16x32_bf16(a, b, c, 0, 0, 0); }
typedef short v4i16_t __attribute__((ext_vector_type(4)));
__device__ __forceinline__ s16x4 tr16(const LAS unsigned char* p) { return __builtin_bit_cast(s16x4, __builtin_amdgcn_ds_read_tr16_b64_v4i16((LAS v4i16_t*)p)); }
__device__ __forceinline__ bf16x8 cat8(s16x4 lo, s16x4 hi) { return (bf16x8){lo[0], lo[1], lo[2], lo[3], hi[0], hi[1], hi[2], hi[3]}; }

__device__ __forceinline__ void tr_item(const float* W, int K, int ldw, int col0, int ncols, const float* gain, float cscale, int cs_lo, int cs_hi, bf16* WT, int row_off, LAS float* scr, int item, int lane) {
    const int nblk = (ncols + 31) / 32, kb = item / nblk, nb = item % nblk, k0 = 64 * kb, n0 = 32 * nb;
    const int nn = n0 + (lane & 31); const bool nok = nn < ncols; const float cs = (nn >= cs_lo && nn < cs_hi) ? cscale : 1.f;
#pragma unroll 8
    for (int i = 0; i < 32; ++i) { const int kk = 2 * i + (lane >> 5);
        float v = nok ? W[(size_t)(k0 + kk) * ldw + col0 + nn] : 0.f;
        if (gain) v *= gain[k0 + kk];
        scr[kk * 33 + (lane & 31)] = v * cs; }
    LDS_WAIT(); asm volatile("" ::: "memory");
    const int c = lane & 7;
#pragma unroll
    for (int j = 0; j < 4; ++j) { const int n = (lane >> 3) + 8 * j; const LAS float* s = scr + (8 * c) * 33 + n;
        v4u o; o.x = pk2(s[0 * 33], s[1 * 33]); o.y = pk2(s[2 * 33], s[3 * 33]); o.z = pk2(s[4 * 33], s[5 * 33]); o.w = pk2(s[6 * 33], s[7 * 33]);
        if (n0 + n < ncols) *(GAS v4u*)(WT + (size_t)(row_off + n0 + n) * K + k0 + 8 * c) = o; }
    LDS_WAIT(); asm volatile("" ::: "memory");
}
struct CvJob { const float* W; const float* gain; bf16* WT; int K, ldw, col0, ncols, row_off, cs_lo, cs_hi, r, f8; float cscale, osc; unsigned* cmax; };
__device__ __forceinline__ void cv_load(const CvJob& J, f32x4 (&v)[16], float (&gk)[16], int lane) {
    const int nblk = J.ncols >> 6, kb = J.r / nblk, nb = J.r - kb * nblk, k0 = 64 * kb, n0 = 64 * nb;
    const float* src = J.W + (size_t)(k0 + (lane >> 4)) * J.ldw + J.col0 + n0 + 4 * (lane & 15);
    const float* gp = J.gain ? J.gain : J.W;
    const float gmul = J.gain ? 1.f : 0.f, gadd = J.gain ? 0.f : 1.f;
#pragma unroll
    for (int i = 0; i < 16; ++i) { const float g = gp[k0 + 4 * i + (lane >> 4)]; gk[i] = fmaf(g, gmul, gadd); }
#pragma unroll
    for (int i = 0; i < 16; ++i) v[i] = __builtin_nontemporal_load((const GAS f32x4*)(src + (size_t)(4 * i) * J.ldw));
}
__device__ __forceinline__ void cv_store(const CvJob& J, f32x4 (&v)[16], const float (&gkv)[16], LAS unsigned char* scr, int lane) {
    const int nblk = J.ncols >> 6, kb = J.r / nblk, nb = J.r - kb * nblk, k0 = 64 * kb, n0 = 64 * nb;
    const int c = lane & 15, kr = lane >> 4;
    const float cs = ((n0 >= J.cs_lo && n0 < J.cs_hi) ? J.cscale : 1.f) * J.osc;
    f32x4 cm = {0.f, 0.f, 0.f, 0.f};
#pragma unroll
    for (int i = 0; i < 16; ++i) { const float gk = gkv[i] * cs; const f32x4 x = v[i] * gk; cm = __builtin_elementwise_max(cm, __builtin_elementwise_abs(x));
        typedef unsigned u32x2_t __attribute__((ext_vector_type(2)));
        u32x2_t w; w.x = pk2(x.x, x.y); w.y = pk2(x.z, x.w);
        *(LAS u32x2_t*)(scr + (4 * i + kr) * 136 + c * 8) = w; }
    if (J.cmax) {
#pragma unroll
        for (int e = 0; e < 4; ++e) { float m_ = cm[e]; m_ = fmaxf(m_, __shfl_xor(m_, 16)); m_ = fmaxf(m_, __shfl_xor(m_, 32)); if (kr == 0) atomicMax(J.cmax + n0 + 4 * c + e, __float_as_uint(m_)); } }
    LDS_WAIT(); asm volatile("" ::: "memory");
    const int g = lane >> 4, i16 = lane & 15, j = i16 >> 2, q = i16 & 3;
#pragma unroll
    for (int it = 0; it < 8; ++it) { const int nbk = it >> 1, kb8 = (it & 1) * 4 + g;
        const LAS unsigned char* a = scr + (kb8 * 8 + j) * 136 + (nbk * 16 + 4 * q) * 2;
        const bf16x8 o = cat8(tr16(a), tr16(a + 4 * 136));
        if (J.f8) { const v4u w = __builtin_bit_cast(v4u, o); typedef int i32x2 __attribute__((ext_vector_type(2))); i32x2 q;
            q.x = __builtin_amdgcn_cvt_pk_fp8_f32(bf_lo(w.x), bf_hi(w.x), 0, false); q.x = __builtin_amdgcn_cvt_pk_fp8_f32(bf_lo(w.y), bf_hi(w.y), q.x, true);
            q.y = __builtin_amdgcn_cvt_pk_fp8_f32(bf_lo(w.z), bf_hi(w.z), 0, false); q.y = __builtin_amdgcn_cvt_pk_fp8_f32(bf_lo(w.w), bf_hi(w.w), q.y, true);
            *(GAS i32x2*)((unsigned char*)J.WT + (size_t)(J.row_off + n0 + nbk * 16 + i16) * J.K + k0 + kb8 * 8) = q; }
        else __builtin_nontemporal_store(o, (GAS bf16x8*)(J.WT + (size_t)(J.row_off + n0 + nbk * 16 + i16) * J.K + k0 + kb8 * 8)); }
    LDS_WAIT(); asm volatile("" ::: "memory");
}
__device__ __forceinline__ void rownorm_row(const float* xrow, bf16* orow, int lane) {
    const GAS f32x4* xr = (const GAS f32x4*)xrow + lane;
    f32x4 v[16]; float s = 0.f;
#pragma unroll
    for (int j = 0; j < 16; ++j) { v[j] = xr[64 * j]; s += (v[j].x * v[j].x + v[j].y * v[j].y) + (v[j].z * v[j].z + v[j].w * v[j].w); }
    const float rstd = 1.f / sqrtf(wave_sum(s) * (1.f / DM) + EPS);
    GAS unsigned long long* o8 = (GAS unsigned long long*)orow + lane;
#pragma unroll
    for (int j = 0; j < 16; ++j) o8[64 * j] = (unsigned long long)pk2(v[j].x * rstd, v[j].y * rstd) | ((unsigned long long)pk2(v[j].z * rstd, v[j].w * rstd) << 32);
}
__device__ __forceinline__ void rownorm_phase(Frame& F, const float* src, bf16* dst) {
    const int gw = blockIdx.x * NWAVES + F.wave, NGW = F.G * NWAVES;
    for (int m = gw; m < MTOK; m += NGW) rownorm_row(src + (size_t)m * DM, dst + (size_t)m * DM, F.lane);
}

constexpr int CW_0 = 64 * 192, CW_2 = Q8_STRIPS ? 0 : 64 * 64, CW_3 = Q8_STRIPS ? 0 : 64 * 256, CW_4 = 256 * 64, CW_5 = Q8_STRIPS ? 0 : 64 * 48, CW_6 = Q8_STRIPS ? 0 : 64 * 64, CW_8 = 64 * 8, CW_9 = 64 * 8, CW_10 = 16, CW_11 = 16, CW_12 = 64 * 64, CW_13 = Q8_STRIPS ? 0 : 64 * 256, CW_14 = 256 * 64;
constexpr int CW_EARLY = CW_0, CW_TOTAL = CW_0 + CW_2 + CW_3 + CW_4 + CW_5 + CW_6 + CW_8 + CW_9 + CW_10 + CW_11 + CW_12 + CW_13 + CW_14;
__device__ __forceinline__ CvJob cv_decode(Frame& F, int it) {
    unsigned char* ws = F.ws; CvJob J; J.gain = nullptr; J.row_off = 0; J.cs_lo = 0; J.cs_hi = 0; J.cscale = 1.f; J.col0 = 0; J.f8 = 0; J.osc = 1.f; J.cmax = nullptr; int r = it;
    if (r < CW_0) { J.W = F.in[3]; J.K = 4096; J.ldw = M_IN; J.ncols = M_MAIN; J.gain = F.in[1]; J.cscale = 0.0625f; J.cs_lo = 2048; J.cs_hi = 4096; J.WT = (bf16*)(ws + WS_WIN); }
    else if ((r -= CW_0) < CW_2) { J.W = F.in[6]; J.K = 4096; J.ldw = 4096; J.ncols = 4096; J.gain = F.in[5]; J.WT = (bf16*)(ws + WS_WMO); if (Q8_WMO) J.cmax = (unsigned*)(ws + CTL_CMAX) + 49152; }
    else if ((r -= CW_2) < CW_3) { J.W = F.in[16]; J.K = 4096; J.ldw = DFF; J.ncols = DFF; J.gain = F.in[2]; J.WT = (bf16*)(ws + WS_WUP0); if (Q8_UP_MASK & 1) J.cmax = (unsigned*)(ws + CTL_CMAX); }
    else if ((r -= CW_3) < CW_4) { J.W = F.in[17]; J.K = DFF; J.ldw = 4096; J.ncols = 4096; J.WT = (bf16*)(ws + WS_WDN0); }
    else if ((r -= CW_4) < CW_5) { J.W = F.in[8]; J.K = 4096; J.ldw = KVW; J.ncols = KVW; J.gain = F.in[7]; J.WT = (bf16*)(ws + WS_WKVQ); if (Q8_KVQ) J.cmax = (unsigned*)(ws + CTL_CMAX) + 32768; else { J.f8 = 1; J.osc = 256.f; } }
    else if ((r -= CW_5) < CW_6) { J.W = F.in[13]; J.K = 4096; J.ldw = NQG; J.ncols = 4096; J.gain = F.in[1] + 4096; J.WT = (bf16*)(ws + WS_WKVQ); J.row_off = KVW; if (Q8_KVQ) J.cmax = (unsigned*)(ws + CTL_CMAX) + 32768 + KVW; else { J.f8 = 1; J.osc = 256.f; } }
    else if ((r -= CW_6) < CW_8) { J.W = F.in[11]; J.K = 4096; J.ldw = 512; J.ncols = 512; J.WT = (bf16*)(ws + WS_W1C); }
    else if ((r -= CW_8) < CW_9) { J.W = F.in[11] + (size_t)4096 * 512; J.K = 4096; J.ldw = 512; J.ncols = 512; J.WT = (bf16*)(ws + WS_W1C) + (size_t)512 * 4096; }
    else if ((r -= CW_9) < CW_10) { J.W = F.in[12]; J.K = 512; J.ldw = 128; J.ncols = 128; J.WT = (bf16*)(ws + WS_W2C); }
    else if ((r -= CW_10) < CW_11) { J.W = F.in[12] + (size_t)512 * 128; J.K = 512; J.ldw = 128; J.ncols = 128; J.WT = (bf16*)(ws + WS_W2C) + (size_t)128 * 512; }
    else if ((r -= CW_11) < CW_12) { J.W = F.in[15]; J.K = 4096; J.ldw = 4096; J.ncols = 4096; J.WT = (bf16*)(ws + WS_WNO); J.f8 = 1; J.osc = 256.f; }
    else if ((r -= CW_12) < CW_13) { J.W = F.in[16] + (size_t)4096 * DFF; J.K = 4096; J.ldw = DFF; J.ncols = DFF; J.gain = F.in[2] + 4096; J.WT = (bf16*)(ws + WS_WUP1); if (Q8_UP_MASK & 2) J.cmax = (unsigned*)(ws + CTL_CMAX) + 16384; }
    else { r -= CW_13; J.W = F.in[17] + (size_t)DFF * 4096; J.K = DFF; J.ldw = 4096; J.ncols = 4096; J.WT = (bf16*)(ws + WS_WDN1); }
    J.r = r; return J;
}
__device__ __forceinline__ void convert_wide(Frame& F, int lo, int hi, int worker, int nworkers) {
    LAS unsigned char* scr = F.lds + RING_OFF + F.wave * 16384;
    int it = lo + worker; if (it >= hi) return;
    f32x4 va[16], vb[16]; float ga[16], gb[16]; CvJob ja = cv_decode(F, it), jb = ja;
    cv_load(ja, va, ga, F.lane);
    for (;;) {
        const int itb = it + nworkers; const bool hb = itb < hi;
        if (hb) { jb = cv_decode(F, itb); cv_load(jb, vb, gb, F.lane); }
        cv_store(ja, va, ga, scr, F.lane);
        if (!hb) break;
        const int ita = itb + nworkers; const bool ha = ita < hi;
        if (ha) { ja = cv_decode(F, ita); cv_load(ja, va, ga, F.lane); }
        cv_store(jb, vb, gb, scr, F.lane);
        if (!ha) break;
        it = ita;
    }
}
struct CvQ { gu32* head; int lo, hi, cur, end; };
__device__ __forceinline__ int cvq_next(CvQ& Q, int lane) {
    if (Q.cur == Q.end) { unsigned v = 0u; if (lane == 0) v = __hip_atomic_fetch_add(Q.head, 8u, RLX_AGENT);
        Q.cur = Q.lo + __builtin_amdgcn_readfirstlane((int)v); Q.end = Q.cur + 8 < Q.hi ? Q.cur + 8 : Q.hi; if (Q.cur >= Q.hi) { Q.cur = Q.end = Q.hi; return Q.hi; } }
    return Q.cur++;
}
__device__ __forceinline__ void convert_queue(Frame& F, int lo, int hi, gu32* head) {
    LAS unsigned char* scr = F.lds + RING_OFF + F.wave * 16384;
    CvQ Q{head, lo, hi, 0, 0};
    int it = cvq_next(Q, F.lane); if (it >= hi) return;
    f32x4 va[16], vb[16]; float ga[16], gb[16]; CvJob ja = cv_decode(F, it), jb = ja;
    cv_load(ja, va, ga, F.lane);
    for (;;) {
        const int itb = cvq_next(Q, F.lane); const bool hb = itb < hi;
        if (hb) { jb = cv_decode(F, itb); cv_load(jb, vb, gb, F.lane); }
        cv_store(ja, va, ga, scr, F.lane);
        if (!hb) break;
        const int ita = cvq_next(Q, F.lane); const bool ha = ita < hi;
        if (ha) { ja = cv_decode(F, ita); cv_load(ja, va, ga, F.lane); }
        cv_store(jb, vb, gb, scr, F.lane);
        if (!ha) break;
    }
}
__device__ __forceinline__ void convert_narrow(Frame& F, int lo, int hi, int worker, int nworkers) {
    LAS float* scr = (LAS float*)(F.lds + RING_OFF + F.wave * 16384);
    for (int it = lo + worker; it < hi; it += nworkers) {
        if (it < 64) tr_item(F.in[3], 4096, M_IN, M_MAIN, 16, F.in[1], 1.f, 0, 0, (bf16*)(F.ws + WS_WG1), 0, scr, it, F.lane);
        else tr_item(F.in[13], 4096, NQG, 4096, 96, F.in[1] + 4096, 1.f, 0, 0, (bf16*)(F.ws + WS_WG2), 0, scr, it - 64, F.lane);
    }
}
__device__ __forceinline__ void p0_prologue(Frame& F) {
    const int gw = blockIdx.x * NWAVES + F.wave, NGW = F.G * NWAVES;
    unsigned char* ws = F.ws;
    { float* pp = (float*)(ws + WS_POSP);
      for (int task = gw; task < 512; task += NGW) { const int j = task >> 8, nbk = (task >> 5) & 7, ch = task & 31, n = nbk * 64 + F.lane;
          const float* pos = F.in[10] + (size_t)j * 4096 + ch * 128; const float* w1 = F.in[11] + ((size_t)j * 4096 + ch * 128) * 512 + n;
          float a0 = 0.f, a1 = 0.f, a2 = 0.f, a3 = 0.f;
#pragma unroll 4
          for (int kk = 0; kk < 128; kk += 4) { a0 += pos[kk] * w1[(size_t)kk * 512]; a1 += pos[kk + 1] * w1[(size_t)(kk + 1) * 512]; a2 += pos[kk + 2] * w1[(size_t)(kk + 2) * 512]; a3 += pos[kk + 3] * w1[(size_t)(kk + 3) * 512]; }
          pp[ch * 1024 + j * 512 + n] = (a0 + a1) + (a2 + a3); } }
    convert_wide(F, 0, CW_EARLY, gw, NGW); convert_narrow(F, 0, 64, gw, NGW);
    rownorm_phase(F, F.in[0], (bf16*)(ws + WS_XB));
}

__device__ __forceinline__ unsigned q8_pack4(float a, float b, float c, float d, float sc) {
    const float M = 12582912.f;
    const unsigned ya = __float_as_uint(fmaf(a, sc, M)), yb = __float_as_uint(fmaf(b, sc, M)), yc = __float_as_uint(fmaf(c, sc, M)), yd = __float_as_uint(fmaf(d, sc, M));
    return __builtin_amdgcn_perm(yb, ya, 0x0c0c0400u) | __builtin_amdgcn_perm(yd, yc, 0x04000c0cu);
}
__device__ __forceinline__ float quant_row(const bf16* src, unsigned char* dst, float sc, int lane) {
    v4u w[8]; float am = 0.f;
#pragma unroll
    for (int i = 0; i < 8; ++i) { w[i] = *(const v4u*)(src + (i * 64 + lane) * 8);
        am = fmaxf(fmaxf(fmaxf(am, fmaxf(fabsf(bf_lo(w[i].x)), fabsf(bf_hi(w[i].x)))), fmaxf(fabsf(bf_lo(w[i].y)), fabsf(bf_hi(w[i].y)))), fmaxf(fmaxf(fabsf(bf_lo(w[i].z)), fabsf(bf_hi(w[i].z))), fmaxf(fabsf(bf_lo(w[i].w)), fabsf(bf_hi(w[i].w))))); }
    float step = 0.f;
    if (sc <= 0.f) {
#pragma unroll
        for (int o = 1; o < 64; o <<= 1) am = fmaxf(am, __shfl_xor(am, o));
        sc = am > 0.f ? 127.f / am : 0.f; step = am * (1.f / 127.f); }
#pragma unroll
    for (int i = 0; i < 8; ++i) { typedef unsigned u32x2_t __attribute__((ext_vector_type(2))); u32x2_t o;
        o.x = q8_pack4(bf_lo(w[i].x), bf_hi(w[i].x), bf_lo(w[i].y), bf_hi(w[i].y), sc); o.y = q8_pack4(bf_lo(w[i].z), bf_hi(w[i].z), bf_lo(w[i].w), bf_hi(w[i].w), sc);
        *(u32x2_t*)(dst + (i * 64 + lane) * 8) = o; }
    return step;
}
__device__ __forceinline__ void wquant_phase(Frame& F, const bf16* W, const float* cmax, unsigned char* WQ, int N) {
    const int gw = blockIdx.x * NWAVES + F.wave, NGW = F.G * NWAVES;
    for (int n = gw; n < N; n += NGW) { const float m_ = cmax[n]; (void)quant_row(W + (size_t)n * DM, WQ + (size_t)n * DM, m_ > 0.f ? 127.f / m_ : 1e-30f, F.lane); }
}
__device__ __forceinline__ void rstd_phase(Frame& F, float* rs, const bf16* X = nullptr, unsigned char* XQ = nullptr, float* ra = nullptr) {
    const int gw = blockIdx.x * NWAVES + F.wave, NGW = F.G * NWAVES; const float* part = (const float*)(F.ws + WS_PART);
    for (int row = gw; row < MTOK; row += NGW) { const float t = wave_sum(part[(size_t)row * 64 + F.lane]); const float r_ = 1.f / sqrtf(t * (1.f / DM) + EPS); if (F.lane == 0) rs[row] = r_;
        if (X) { const float st = quant_row(X + (size_t)row * DM, XQ + (size_t)row * DM, 0.f, F.lane); if (F.lane == 0) ra[row] = st * r_; } }
}
template <int NT, class AP>
__device__ __forceinline__ void mini_gemm16(f32x4 (&acc)[NT], const AP& ap, const bf16* Bt, int ldb, int K, int lane) {
    const int r16 = lane & 15, kq = lane >> 4;
#pragma unroll
    for (int n = 0; n < NT; ++n) acc[n] = (f32x4){0.f, 0.f, 0.f, 0.f};
    const bf16* brow = Bt + (size_t)r16 * ldb + kq * 8;
#pragma unroll 8
    for (int k0 = 0; k0 < K; k0 += 32) {
        const bf16x8 a = *(const bf16x8*)ap(r16, k0 + kq * 8);
#pragma unroll
        for (int n = 0; n < NT; ++n) { const bf16x8 b = *(const bf16x8*)(brow + (size_t)n * 16 * ldb + k0); acc[n] = mfma16(a, b, acc[n]); }
    }
}
struct RowMajorA { const bf16* A; int lda; __device__ __forceinline__ const bf16* operator()(int r16, int k) const { return A + (size_t)r16 * lda + k; } };

template <int NT, class AP>
__device__ __forceinline__ void mini_gemm16_splitk(f32x4& out, const AP& ap, const bf16* Bt, int ldb, int K, LAS float* red, int wid, int lane) {
    const int r16 = lane & 15, kq = lane >> 4, kc = K >> 3;
    f32x4 acc[NT];
#pragma unroll
    for (int n = 0; n < NT; ++n) acc[n] = (f32x4){0.f, 0.f, 0.f, 0.f};
    const bf16* brow = Bt + (size_t)r16 * ldb + kq * 8;
#pragma unroll 4
    for (int k0 = wid * kc; k0 < (wid + 1) * kc; k0 += 32) {
        const bf16x8 a = *(const bf16x8*)ap(r16, k0 + kq * 8);
#pragma unroll
        for (int n = 0; n < NT; ++n) { const bf16x8 b = *(const bf16x8*)(brow + (size_t)n * 16 * ldb + k0); acc[n] = mfma16(a, b, acc[n]); }
    }
#pragma unroll
    for (int n = 0; n < NT; ++n) *(LAS f32x4*)(red + ((wid * NT + n) * 64 + lane) * 4) = acc[n];
    __syncthreads();
    out = (f32x4){0.f, 0.f, 0.f, 0.f};
    if (wid < NT) {
#pragma unroll
        for (int w = 0; w < 8; ++w) out = out + *(const LAS f32x4*)(red + ((w * NT + wid) * 64 + lane) * 4); }
    __syncthreads();
}
__device__ __forceinline__ void gates1_phase(Frame& F) {
    const int r16 = F.lane & 15, kq = F.lane >> 4;
    const bf16* XB = (const bf16*)(F.ws + WS_XB); const bf16* Wg = (const bf16*)(F.ws + WS_WG1);
    float* LI = (float*)(F.ws + WS_LI); float* LF = (float*)(F.ws + WS_LF);
    const float bias = F.in[4][r16];
    for (int rt = blockIdx.x; rt < MTOK / 16; rt += F.G) {
        f32x4 acc; RowMajorA ap{XB + (size_t)rt * 16 * DM, DM};
        mini_gemm16_splitk<1>(acc, ap, Wg, DM, DM, (LAS float*)(F.lds + RING_OFF), F.wave, F.lane);
        if (F.wave == 0) {
#pragma unroll
            for (int i = 0; i < 4; ++i) { const int row = rt * 16 + 4 * kq + i, b = row >> 12, t = row & 4095;
                float g = acc[i] + bias; g = 15.f * tanhf(g * (1.f / 15.f));
                if (r16 < 8) LI[(size_t)(b * 8 + r16) * SEQ + t] = g;
                else LF[(size_t)(b * 8 + (r16 - 8)) * SEQ + t] = fminf(g, 0.f) - log1pf(__expf(-fabsf(g))); } }
    }
}
__device__ __forceinline__ void gates2_phase(Frame& F) {
    const int r16 = F.lane & 15, kq = F.lane >> 4;
    const bf16* XB = (const bf16*)(F.ws + WS_X2); const bf16* Wg = (const bf16*)(F.ws + WS_WG2); float* GT = (float*)(F.ws + WS_GT);
    for (int rt = blockIdx.x; rt < MTOK / 16; rt += F.G) {
        f32x4 acc; RowMajorA ap{XB + (size_t)rt * 16 * DM, DM};
        mini_gemm16_splitk<6>(acc, ap, Wg, DM, DM, (LAS float*)(F.lds + RING_OFF), F.wave, F.lane);
        if (F.wave < 6) {
#pragma unroll
            for (int i = 0; i < 4; ++i) { const int row = rt * 16 + 4 * kq + i; const float rs = ((const float*)(F.ws + WS_RS))[8192 + row];
                GT[(size_t)row * 96 + F.wave * 16 + r16] = 1.f / (1.f + __expf(-acc[i] * rs)); } }
    }
}

#define QS_BAR() do { asm volatile("s_waitcnt lgkmcnt(0)" ::: "memory"); __builtin_amdgcn_s_barrier(); asm volatile("" ::: "memory"); } while (0)
#define QS_SB() __builtin_amdgcn_sched_barrier(0)
constexpr int QS_RS = 4112, QS_NSTRIPS = 512 + 512 + 96 + 128 + 128;
struct QsJob { const float* W; const float* gain; unsigned char* WQ; float* cmax; int ldw, n0; };
__device__ __forceinline__ QsJob qs_decode(Frame& F, int s_) {
    unsigned char* ws = F.ws; QsJob J; float* cm = (float*)(ws + CTL_CMAX); int s = s_;
    if (s < 512) { J.W = F.in[16]; J.ldw = DFF; J.gain = F.in[2]; J.WQ = ws + WS_WUPQ0; J.cmax = cm; }
    else if ((s -= 512) < 512) { J.W = F.in[16] + (size_t)4096 * DFF; J.ldw = DFF; J.gain = F.in[2] + 4096; J.WQ = ws + WS_WUPQ1; J.cmax = cm + 16384; }
    else if ((s -= 512) < 96) { J.W = F.in[8]; J.ldw = KVW; J.gain = F.in[7]; J.WQ = ws + WS_WKVQ8; J.cmax = cm + 32768; }
    else if ((s -= 96) < 128) { J.W = F.in[13]; J.ldw = NQG; J.gain = F.in[1] + 4096; J.WQ = ws + WS_WKVQ8 + (size_t)KVW * 4096; J.cmax = cm + 32768 + KVW; }
    else { s -= 128; J.W = F.in[6]; J.ldw = 4096; J.gain = F.in[5]; J.WQ = ws + WS_WMOQ; J.cmax = cm + 49152; }
    J.n0 = 32 * s; return J;
}
__device__ __forceinline__ void qs_load(const QsJob& J, int q, f32x4 (&v)[8], f32x2_t (&g)[4], int tid) {
    const int seg = tid & 7, kp = tid >> 3;
    unsigned off_w = (unsigned)(2 * kp * J.ldw + 4 * seg) * 4u, off_g = (unsigned)kp * 8u;
    asm volatile("" : "+v"(off_w), "+v"(off_g));
    const char* wb = (const char*)(J.W + J.n0); const char* gb = (const char*)J.gain;
#pragma unroll
    for (int i = 0; i < 4; ++i) g[i] = *(const f32x2_t*)(gb + (size_t)((q * 4 + i) * 128) * 4 + off_g);
#pragma unroll
    for (int i = 0; i < 4; ++i) { const char* p = wb + (size_t)((q * 4 + i) * 128) * (size_t)J.ldw * 4;
        v[2 * i] = __builtin_nontemporal_load((const GAS f32x4*)(p + off_w)); v[2 * i + 1] = __builtin_nontemporal_load((const GAS f32x4*)(p + (size_t)J.ldw * 4 + off_w)); }
}
__device__ __forceinline__ void qs_put(const f32x4 (&v)[8], const f32x2_t (&g)[4], int q, f32x4& cm, LAS unsigned char* lds, int tid) {
    const int seg = tid & 7, kp = tid >> 3;
    unsigned lb = (unsigned)((4 * seg) * QS_RS + 4 * kp); asm volatile("" : "+v"(lb));
#pragma unroll
    for (int i = 0; i < 4; ++i) { const f32x4 x0 = v[2 * i] * g[i].x, x1 = v[2 * i + 1] * g[i].y;
        cm = __builtin_elementwise_max(cm, __builtin_elementwise_max(__builtin_elementwise_abs(x0), __builtin_elementwise_abs(x1)));
        LAS unsigned char* b = lds + lb + (q * 4 + i) * 256;
        *(LAS unsigned*)(b) = pk2(x0.x, x1.x); *(LAS unsigned*)(b + QS_RS) = pk2(x0.y, x1.y); *(LAS unsigned*)(b + 2 * QS_RS) = pk2(x0.z, x1.z); *(LAS unsigned*)(b + 3 * QS_RS) = pk2(x0.w, x1.w); }
}
__device__ __forceinline__ void qs_park(const f32x4 (&v)[8], const f32x2_t (&g)[4], int q, f32x4& cm, unsigned (&park)[16][4]) {
#pragma unroll
    for (int i = 0; i < 4; ++i) { const f32x4 x0 = v[2 * i] * g[i].x, x1 = v[2 * i + 1] * g[i].y;
        cm = __builtin_elementwise_max(cm, __builtin_elementwise_max(__builtin_elementwise_abs(x0), __builtin_elementwise_abs(x1)));
        unsigned p0 = pk2(x0.x, x1.x), p1 = pk2(x0.y, x1.y), p2 = pk2(x0.z, x1.z), p3 = pk2(x0.w, x1.w);
        asm volatile("" : "+v"(p0), "+v"(p1), "+v"(p2), "+v"(p3));
        park[(q - 4) * 4 + i][0] = p0; park[(q - 4) * 4 + i][1] = p1; park[(q - 4) * 4 + i][2] = p2; park[(q - 4) * 4 + i][3] = p3; }
}
__device__ __forceinline__ void qs_flush(const QsJob& J, LAS unsigned char* lds, const float (&sc4)[4], int half, int wave, unsigned l16, unsigned l8) {
#pragma unroll
    for (int rr = 0; rr < 4; ++rr) { const int n = wave + 8 * rr; unsigned char* dst = J.WQ + (size_t)(J.n0 + n) * 4096 + half * 2048;
#pragma unroll
        for (int i = 0; i < 4; ++i) { const v4u w = *(const LAS v4u*)(lds + n * QS_RS + l16 + i * 1024);
            typedef unsigned u32x2_t __attribute__((ext_vector_type(2))); u32x2_t o;
            o.x = q8_pack4(bf_lo(w.x), bf_hi(w.x), bf_lo(w.y), bf_hi(w.y), sc4[rr]); o.y = q8_pack4(bf_lo(w.z), bf_hi(w.z), bf_lo(w.w), bf_hi(w.w), sc4[rr]);
            *(u32x2_t*)(dst + l8 + i * 512) = o; } }
}
__device__ __forceinline__ void convert_strips(Frame& F, int cw, int ncw) {
    LAS unsigned char* lds = F.lds + RING_OFF; LAS float* wm = (LAS float*)(lds + 32 * QS_RS);
    const int tid = F.tid, lane = F.lane, wave = F.wave;
    QS_BAR();
    int s = cw; if (s >= QS_NSTRIPS) return;
    f32x4 A[8], B[8]; f32x2_t gA[4], gB[4];
    unsigned l16 = (unsigned)lane * 16u, l8 = (unsigned)lane * 8u; asm volatile("" : "+v"(l16), "+v"(l8));
    QsJob J = qs_decode(F, s); qs_load(J, 0, A, gA, tid); qs_load(J, 1, B, gB, tid);
    for (;;) {
        f32x4 cm = {0.f, 0.f, 0.f, 0.f}; unsigned park[16][4];
#pragma unroll 1
        for (int qq = 0; qq < 2; ++qq) {
            qs_put(A, gA, 2 * qq, cm, lds, tid); QS_SB(); qs_load(J, 2 * qq + 2, A, gA, tid); QS_SB();
            qs_put(B, gB, 2 * qq + 1, cm, lds, tid); QS_SB(); qs_load(J, 2 * qq + 3, B, gB, tid); QS_SB(); }
        qs_park(A, gA, 4, cm, park); QS_SB(); qs_load(J, 6, A, gA, tid); QS_SB();
        qs_park(B, gB, 5, cm, park); QS_SB(); qs_load(J, 7, B, gB, tid); QS_SB();
        const int sn = s + ncw; const bool more = sn < QS_NSTRIPS; QsJob Jn = J; if (more) Jn = qs_decode(F, sn);
        qs_park(A, gA, 6, cm, park); QS_SB(); if (more) qs_load(Jn, 0, A, gA, tid); QS_SB();
        qs_park(B, gB, 7, cm, park); QS_SB();
#pragma unroll
        for (int e = 0; e < 4; ++e) { float m_ = cm[e]; m_ = fmaxf(m_, __shfl_xor(m_, 8)); m_ = fmaxf(m_, __shfl_xor(m_, 16)); m_ = fmaxf(m_, __shfl_xor(m_, 32)); cm[e] = m_; }
        if (lane < 8) *(LAS f32x4*)(wm + wave * 32 + 4 * lane) = cm;
        QS_BAR();
        float sc4[4];
#pragma unroll
        for (int rr = 0; rr < 4; ++rr) { const int n = wave + 8 * rr; float m_ = 0.f;
#pragma unroll
            for (int w8 = 0; w8 < 8; ++w8) m_ = fmaxf(m_, wm[w8 * 32 + n]);
            sc4[rr] = m_ > 0.f ? 127.f / m_ : 0.f;
            if (lane == 0) J.cmax[J.n0 + n] = m_; }
        qs_flush(J, lds, sc4, 0, wave, l16, l8);
        QS_BAR();
        { const int seg = tid & 7, kp = tid >> 3; unsigned lb = (unsigned)((4 * seg) * QS_RS + 4 * kp); asm volatile("" : "+v"(lb));
#pragma unroll
          for (int d = 0; d < 16; ++d) { LAS unsigned char* b = lds + lb + d * 256;
              *(LAS unsigned*)(b) = park[d][0]; *(LAS unsigned*)(b + QS_RS) = park[d][1]; *(LAS unsigned*)(b + 2 * QS_RS) = park[d][2]; *(LAS unsigned*)(b + 3 * QS_RS) = park[d][3]; } }
        QS_SB(); if (more) qs_load(Jn, 1, B, gB, tid); QS_SB();
        QS_BAR();
        qs_flush(J, lds, sc4, 1, wave, l16, l8);
        QS_BAR();
        if (!more) break;
        s = sn; J = Jn;
    }
}

#define ML_BAR() do { asm volatile("s_waitcnt lgkmcnt(0)" ::: "memory"); __builtin_amdgcn_s_barrier(); asm volatile("" ::: "memory"); } while (0)
constexpr int ML_QS = 528, ML_VS = 144, ML_PS = 144;
constexpr int ML_Q = 0, ML_K = ML_Q + 64 * ML_QS, ML_V = ML_K + 64 * ML_QS, ML_VW = ML_V + 64 * ML_VS, ML_P = ML_VW + 64 * ML_VS, ML_CT = ML_P + 64 * ML_PS, ML_SC = ML_CT + 64 * ML_QS, ML_H = ML_SC + 4096;
static_assert(ML_H + 64 * ML_VS <= RING_BYTES, "mlstm LDS");
struct MlPref { bf16x8 q[4], k[4], v; float li, lf; };
struct MlK { LAS unsigned char* L; const bf16* QKVO; bf16* HR; const float* LI; const float* LF; size_t rowb; int bh, hd, e0, tid, lane, wid; };
__device__ __forceinline__ void ml_load(MlPref& P, const MlK& K, int c) {
    const int qr_ = K.tid >> 3, qc_ = K.tid & 7;
    const bf16* base = K.QKVO + (K.rowb + (size_t)c * 64 + qr_) * M_MAIN;
#pragma unroll
    for (int i = 0; i < 4; ++i) { P.q[i] = *(const bf16x8*)(base + K.hd * 256 + (qc_ + 8 * i) * 8); P.k[i] = *(const bf16x8*)(base + 2048 + K.hd * 256 + (qc_ + 8 * i) * 8); }
    P.v = *(const bf16x8*)(base + 4096 + K.hd * 512 + K.e0 + qc_ * 8);
    P.li = K.LI[(size_t)K.bh * SEQ + c * 64 + K.lane]; P.lf = K.LF[(size_t)K.bh * SEQ + c * 64 + K.lane];
}
__device__ __forceinline__ void ml_chunk(MlPref& P, f32x4 (&CT)[2][4], float& m_state, const MlK& K, int c) {
    LAS unsigned char* L = K.L;
    LAS float* sc_a = (LAS float*)(L + ML_SC); LAS float* sc_M = sc_a + 64; LAS float* sc_b = sc_a + 128; LAS float* sc_w = sc_a + 192;
    LAS float* sc_rs = sc_a + 256; LAS float* sc_qn = sc_a + 512; LAS float* sc_nv = sc_a + 576;
    const int tid = K.tid, lane = K.lane, wid = K.wid, r16 = lane & 15, kq = lane >> 4;
    const int tt = wid >> 1, sp = wid & 1, ep = wid & 1, qr_ = tid >> 3, qc_ = tid & 7;
    float bsum = P.lf;
#pragma unroll
    for (int o = 1; o < 64; o <<= 1) { const float t_ = __shfl_up(bsum, o); if (lane >= o) bsum += t_; }
    const float a_s = P.li - bsum;
    float pm = a_s;
#pragma unroll
    for (int o = 1; o < 64; o <<= 1) { const float t_ = __shfl_up(pm, o); if (lane >= o) pm = fmaxf(pm, t_); }
    const float Mt = fmaxf(m_state, pm);
    const float M63 = __uint_as_float(__builtin_amdgcn_readlane(__float_as_uint(Mt), 63)), b63 = __uint_as_float(__builtin_amdgcn_readlane(__float_as_uint(bsum), 63));
    const float w_s = __expf(a_s - M63), decay = __expf(m_state - M63);
    if (wid == 0) { sc_a[lane] = a_s; sc_M[lane] = Mt; sc_b[lane] = bsum; sc_w[lane] = w_s; }
#pragma unroll
    for (int i = 0; i < 4; ++i) { *(LAS bf16x8*)(L + ML_Q + qr_ * ML_QS + (qc_ + 8 * i) * 16) = P.q[i]; *(LAS bf16x8*)(L + ML_K + qr_ * ML_QS + (qc_ + 8 * i) * 16) = P.k[i]; }
    { *(LAS bf16x8*)(L + ML_V + qr_ * ML_VS + qc_ * 16) = P.v;
        const float wv = __shfl(w_s, 8 * wid + (lane >> 3)); const v4u raw = __builtin_bit_cast(v4u, P.v); v4u o;
        o.x = pk2(bf_lo(raw.x) * wv, bf_hi(raw.x) * wv); o.y = pk2(bf_lo(raw.y) * wv, bf_hi(raw.y) * wv); o.z = pk2(bf_lo(raw.z) * wv, bf_hi(raw.z) * wv); o.w = pk2(bf_lo(raw.w) * wv, bf_hi(raw.w) * wv);
        *(LAS v4u*)(L + ML_VW + qr_ * ML_VS + qc_ * 16) = o; }
    ml_load(P, K, c + 2 < 64 ? c + 2 : 63);
    ML_BAR();
    f32x4 sacc0 = {0.f, 0.f, 0.f, 0.f}, sacc1 = sacc0, iacc0 = sacc0, iacc1 = sacc0;
    { const LAS unsigned char* qrow = L + ML_Q + (tt * 16 + r16) * ML_QS + kq * 16;
      const LAS unsigned char* krow = L + ML_K + (sp * 32 + r16) * ML_QS + kq * 16;
      const LAS unsigned char* crow_ = L + ML_CT + (ep * 32 + r16) * ML_QS + kq * 16;
#pragma unroll 2
      for (int k0 = 0; k0 < 8; ++k0) { const bf16x8 a = *(const LAS bf16x8*)(qrow + k0 * 64);
          const bf16x8 b0 = *(const LAS bf16x8*)(krow + k0 * 64), b1 = *(const LAS bf16x8*)(krow + 16 * ML_QS + k0 * 64);
          const bf16x8 bc0 = *(const LAS bf16x8*)(crow_ + k0 * 64), bc1 = *(const LAS bf16x8*)(crow_ + 16 * ML_QS + k0 * 64);
          sacc0 = mfma16(b0, a, sacc0); sacc1 = mfma16(b1, a, sacc1); iacc0 = mfma16(bc0, a, iacc0); iacc1 = mfma16(bc1, a, iacc1); } }
    const int tl = tt * 16 + r16;
    const float Mt_t = sc_M[tl];
#pragma unroll
    for (int st2 = 0; st2 < 2; ++st2) { const int s0 = (2 * sp + st2) * 16 + 4 * kq; const f32x4 a4 = *(const LAS f32x4*)(sc_a + s0); const f32x4 sv = st2 ? sacc1 : sacc0;
        float pv4[4]; float rsum = 0.f;
#pragma unroll
        for (int i = 0; i < 4; ++i) { pv4[i] = (s0 + i <= tl) ? sv[i] * __expf(a4[i] - Mt_t) : 0.f; rsum += pv4[i]; }
        rsum += __shfl_xor(rsum, 16); rsum += __shfl_xor(rsum, 32);
        if (kq == 0) sc_rs[(2 * sp + st2) * 64 + tl] = rsum;
        typedef unsigned u32x2_t __attribute__((ext_vector_type(2)));
        u32x2_t w; w.x = pk2(pv4[0], pv4[1]); w.y = pk2(pv4[2], pv4[3]);
        *(LAS u32x2_t*)(L + ML_P + tl * ML_PS + s0 * 2) = w; }
    { const int t = tid >> 3, part = tid & 7; float qn = 0.f;
      const LAS v4u* qp = (const LAS v4u*)(L + ML_Q + t * ML_QS + part * 64); const LAS f32x4* np_ = (const LAS f32x4*)(sc_nv + part * 32);
#pragma unroll
      for (int j = 0; j < 4; ++j) { const v4u w = qp[j]; const f32x4 n0 = np_[2 * j], n1 = np_[2 * j + 1];
          qn += (bf_lo(w.x) * n0[0] + bf_hi(w.x) * n0[1]) + (bf_lo(w.y) * n0[2] + bf_hi(w.y) * n0[3]) + (bf_lo(w.z) * n1[0] + bf_hi(w.z) * n1[1]) + (bf_lo(w.w) * n1[2] + bf_hi(w.w) * n1[3]); }
      qn += __shfl_xor(qn, 1); qn += __shfl_xor(qn, 2); qn += __shfl_xor(qn, 4);
      if (part == 0) sc_qn[t] = qn; }
    ML_BAR();
    { f32x4 xacc[2] = {{0.f, 0.f, 0.f, 0.f}, {0.f, 0.f, 0.f, 0.f}}; const int j = r16 >> 2, q = r16 & 3;
#pragma unroll
      for (int ks = 0; ks < 2; ++ks) { const bf16x8 pf = *(const LAS bf16x8*)(L + ML_P + tl * ML_PS + (ks * 32 + kq * 8) * 2);
#pragma unroll
          for (int e2 = 0; e2 < 2; ++e2) { const LAS unsigned char* va = L + ML_V + (ks * 32 + 8 * kq + j) * ML_VS + ((2 * ep + e2) * 16 + 4 * q) * 2;
              xacc[e2] = mfma16(cat8(tr16(va), tr16(va + 4 * ML_VS)), pf, xacc[e2]); } }
      const float bb_t = sc_b[tl], winter = __expf(m_state - Mt_t);
      const float den = winter * sc_qn[tl] + ((sc_rs[tl] + sc_rs[64 + tl]) + (sc_rs[128 + tl] + sc_rs[192 + tl]));
      const float rdd = 1.f / fmaxf(fabsf(den), __expf(-(bb_t + Mt_t)));
#pragma unroll
      for (int e2 = 0; e2 < 2; ++e2) { const f32x4 ia = e2 ? iacc1 : iacc0; float hv[4];
#pragma unroll
          for (int i = 0; i < 4; ++i) hv[i] = (winter * ia[i] + xacc[e2][i]) * rdd;
          typedef unsigned u32x2_t __attribute__((ext_vector_type(2)));
          u32x2_t w; w.x = pk2(hv[0], hv[1]); w.y = pk2(hv[2], hv[3]);
          *(LAS u32x2_t*)(L + ML_H + tl * ML_VS + ((2 * ep + e2) * 16 + 4 * kq) * 2) = w; } }
    { const int j = r16 >> 2, q = r16 & 3; bf16x8 af[2][2];
#pragma unroll
      for (int e2 = 0; e2 < 2; ++e2)
#pragma unroll
          for (int ks = 0; ks < 2; ++ks) { const LAS unsigned char* va = L + ML_VW + (ks * 32 + 8 * kq + j) * ML_VS + ((2 * ep + e2) * 16 + 4 * q) * 2; af[e2][ks] = cat8(tr16(va), tr16(va + 4 * ML_VS)); }
#pragma unroll
      for (int jt = 0; jt < 4; ++jt) { const int dt = 4 * (wid >> 1) + jt; bf16x8 bfr[2];
#pragma unroll
          for (int ks = 0; ks < 2; ++ks) { const LAS unsigned char* ka = L + ML_K + (ks * 32 + 8 * kq + j) * ML_QS + (dt * 16 + 4 * q) * 2; bfr[ks] = cat8(tr16(ka), tr16(ka + 4 * ML_QS)); }
#pragma unroll
          for (int e2 = 0; e2 < 2; ++e2) { f32x4 acc = CT[e2][jt] * decay;
              acc = mfma16(bfr[0], af[e2][0], acc); acc = mfma16(bfr[1], af[e2][1], acc);
              CT[e2][jt] = acc;
              typedef unsigned u32x2_t __attribute__((ext_vector_type(2)));
              u32x2_t w; w.x = pk2(acc[0], acc[1]); w.y = pk2(acc[2], acc[3]);
              *(LAS u32x2_t*)(L + ML_CT + ((2 * ep + e2) * 16 + r16) * ML_QS + (dt * 16 + 4 * kq) * 2) = w; } } }
    if (tid < 256) { float nv = sc_nv[tid] * decay;
#pragma unroll
        for (int s = 0; s < 64; ++s) nv += __uint_as_float(__builtin_amdgcn_readlane(__float_as_uint(w_s), s)) * bf1(*(const LAS unsigned short*)(L + ML_K + s * ML_QS + tid * 2));
        sc_nv[tid] = nv; }
    m_state = b63 + M63;
    ML_BAR();
    *(bf16x8*)(K.HR + (K.rowb + (size_t)c * 64 + qr_) * DM + K.hd * 512 + K.e0 + qc_ * 8) = *(const LAS bf16x8*)(L + ML_H + qr_ * ML_VS + qc_ * 16);
}
__device__ __forceinline__ void mlstm_phase(Frame& F, int worker, int nworkers) {
    LAS unsigned char* L = F.lds + RING_OFF;
    LAS float* sc_nv = (LAS float*)(L + ML_SC) + 576;
    for (int unit = worker; unit < 128; unit += nworkers) {
        const int bh = unit >> 3, sl = unit & 7, b = bh >> 3;
        MlK K; K.L = L; K.QKVO = (const bf16*)(F.ws + WS_BIG); K.HR = (bf16*)(F.ws + WS_HR); K.LI = (const float*)(F.ws + WS_LI); K.LF = (const float*)(F.ws + WS_LF);
        K.rowb = (size_t)b * SEQ; K.bh = bh; K.hd = bh & 7; K.e0 = sl * 64; K.tid = F.tid; K.lane = F.lane; K.wid = F.wave;
        f32x4 CT[2][4];
#pragma unroll
        for (int a = 0; a < 2; ++a)
#pragma unroll
            for (int j = 0; j < 4; ++j) CT[a][j] = (f32x4){0.f, 0.f, 0.f, 0.f};
        float m_state = 0.f;
        if (F.tid < 256) sc_nv[F.tid] = 0.f;
        for (int i = F.tid; i < 64 * ML_QS / 4; i += NWAVES * 64) ((LAS unsigned*)(L + ML_CT))[i] = 0u;
        MlPref P0, P1;
        ml_load(P0, K, 0); ml_load(P1, K, 1);
        __syncthreads();
        for (int c = 0; c < 64; c += 2) { ml_chunk(P0, CT, m_state, K, c); ml_chunk(P1, CT, m_state, K, c + 1); }
    }
}

__device__ __forceinline__ void gating_phase(Frame& F) {
    const int gw = blockIdx.x * NWAVES + F.wave, NGW = F.G * NWAVES, lane = F.lane;
    const bf16* HR = (const bf16*)(F.ws + WS_HR); const bf16* QKVO = (const bf16*)(F.ws + WS_BIG); bf16* A3 = (bf16*)(F.ws + WS_A3);
    float* ra = (float*)(F.ws + WS_RS) + 24576;
    for (int row = gw; row < MTOK; row += NGW) {
        unsigned pk[8][4]; float am = 0.f;
#pragma unroll
        for (int hd = 0; hd < 8; ++hd) {
            const v4u hv = *(const v4u*)(HR + (size_t)row * DM + hd * 512 + lane * 8);
            const v4u ov = *(const v4u*)(QKVO + (size_t)row * M_MAIN + 8192 + hd * 512 + lane * 8);
            float h[8] = {bf_lo(hv.x), bf_hi(hv.x), bf_lo(hv.y), bf_hi(hv.y), bf_lo(hv.z), bf_hi(hv.z), bf_lo(hv.w), bf_hi(hv.w)};
            float o[8] = {bf_lo(ov.x), bf_hi(ov.x), bf_lo(ov.y), bf_hi(ov.y), bf_lo(ov.z), bf_hi(ov.z), bf_lo(ov.w), bf_hi(ov.w)};
            float ss = 0.f;
#pragma unroll
            for (int e = 0; e < 8; ++e) ss += h[e] * h[e];
            const float rstd = 1.f / sqrtf(wave_sum(ss) * (1.f / 512.f) + EPS);
            float r[8];
#pragma unroll
            for (int e = 0; e < 8; ++e) { r[e] = h[e] * rstd / (1.f + __expf(-o[e])); am = fmaxf(am, fabsf(r[e])); }
#pragma unroll
            for (int j = 0; j < 4; ++j) pk[hd][j] = pk2(r[2 * j], r[2 * j + 1]);
            if (!Q8_WMO) { v4u w; w.x = pk[hd][0]; w.y = pk[hd][1]; w.z = pk[hd][2]; w.w = pk[hd][3]; *(v4u*)(A3 + (size_t)row * DM + hd * 512 + lane * 8) = w; }
        }
        if (Q8_WMO) {
#pragma unroll
            for (int o = 1; o < 64; o <<= 1) am = fmaxf(am, __shfl_xor(am, o));
            const float sc = am > 0.f ? 127.f / am : 0.f;
#pragma unroll
            for (int hd = 0; hd < 8; ++hd) { typedef unsigned u32x2_t __attribute__((ext_vector_type(2))); u32x2_t o;
                o.x = q8_pack4(bf_lo(pk[hd][0]), bf_hi(pk[hd][0]), bf_lo(pk[hd][1]), bf_hi(pk[hd][1]), sc); o.y = q8_pack4(bf_lo(pk[hd][2]), bf_hi(pk[hd][2]), bf_lo(pk[hd][3]), bf_hi(pk[hd][3]), sc);
                *(u32x2_t*)((unsigned char*)A3 + (size_t)row * DM + hd * 512 + lane * 8) = o; }
            if (lane == 0) ra[row] = am * (1.f / 127.f); }
    }
}

__device__ __forceinline__ float gelu_tanh(float v) { const float u = 0.7978845608028654f * (v + 0.044715f * v * v * v); return 0.5f * v * (1.f + tanhf(u)); }
struct CmpA { const bf16* KVQ; int j, rt; __device__ __forceinline__ const bf16* operator()(int r16, int k) const {
    const int row = rt * 16 + r16, bg = row >> 8; int c = row & 255; c = c > 254 ? 254 : c; const int b = bg >> 2, g = bg & 3;
    return KVQ + ((size_t)b * SEQ + 16 * c + (k >> 7)) * NKVQ + j * 512 + g * 128 + (k & 127); } };
__device__ __forceinline__ void nsa_prep_phase(Frame& F) {
    const int gw = blockIdx.x * NWAVES + F.wave, NGW = F.G * NWAVES, lane = F.lane, r16 = lane & 15, kq = lane >> 4;
    bf16* KVQ = (bf16*)(F.ws + WS_BIG);
    { const int v = lane >> 3, br = v >> 2, g = v & 3, d0 = (lane & 7) * 16;
      float gn[16];
#pragma unroll
      for (int e = 0; e < 16; ++e) gn[e] = F.in[9][(br + 1) * 128 + d0 + e] * F.in[14][(br + 1) * 128 + d0 + e] * ATT_SCALE;
      for (int row = gw; row < MTOK; row += NGW) {
          bf16* p = KVQ + (size_t)row * NKVQ + (2 + 2 * br) * 512 + g * 128 + d0;
          const v4u a = *(const v4u*)p, c = *(const v4u*)(p + 8);
          float x[16] = {bf_lo(a.x), bf_hi(a.x), bf_lo(a.y), bf_hi(a.y), bf_lo(a.z), bf_hi(a.z), bf_lo(a.w), bf_hi(a.w), bf_lo(c.x), bf_hi(c.x), bf_lo(c.y), bf_hi(c.y), bf_lo(c.z), bf_hi(c.z), bf_lo(c.w), bf_hi(c.w)};
          float ss = 0.f;
#pragma unroll
          for (int e = 0; e < 16; ++e) ss += x[e] * x[e];
          ss += __shfl_xor(ss, 1); ss += __shfl_xor(ss, 2); ss += __shfl_xor(ss, 4);
          const float rstd = 1.f / sqrtf(ss * (1.f / 128.f) + EPS);
#pragma unroll
          for (int e = 0; e < 16; ++e) x[e] *= rstd * gn[e];
          v4u o0, o1; o0.x = pk2(x[0], x[1]); o0.y = pk2(x[2], x[3]); o0.z = pk2(x[4], x[5]); o0.w = pk2(x[6], x[7]); o1.x = pk2(x[8], x[9]); o1.y = pk2(x[10], x[11]); o1.z = pk2(x[12], x[13]); o1.w = pk2(x[14], x[15]);
          *(v4u*)p = o0; *(v4u*)(p + 8) = o1; } }
    { const bf16* W1C = (const bf16*)(F.ws + WS_W1C); const bf16* W2C = (const bf16*)(F.ws + WS_W2C); const float* posb = (const float*)(F.ws + WS_POSB);
      bf16* KC = (bf16*)(F.ws + WS_KC); bf16* VC = (bf16*)(F.ws + WS_VC);
      LAS unsigned char* Hs = F.lds + RING_OFF; LAS float* ps = (LAS float*)(F.lds + RING_OFF + 16 * 1040);
      const int wid = F.wave;
      for (int task = blockIdx.x; task < 256; task += F.G) { const int j = task >> 7, rt = task & 127;
          { f32x4 acc[4]; CmpA ap{KVQ, j, rt};
            mini_gemm16<4>(acc, ap, W1C + ((size_t)j * 512 + wid * 64) * 4096, 4096, 4096, lane);
#pragma unroll
            for (int n = 0; n < 4; ++n) { const int col = wid * 64 + n * 16 + r16; const float pb = posb[j * 512 + col];
#pragma unroll
                for (int i = 0; i < 4; ++i) *(LAS unsigned short*)(Hs + (4 * kq + i) * 1040 + col * 2) = f2bf1(gelu_tanh(acc[n][i] + pb)); } }
          __syncthreads();
          f32x4 o = {0.f, 0.f, 0.f, 0.f};
          { const bf16* brow = W2C + ((size_t)j * 128 + wid * 16 + r16) * 512 + kq * 8;
#pragma unroll 4
            for (int k0 = 0; k0 < 512; k0 += 32) o = mfma16(*(const LAS bf16x8*)(Hs + r16 * 1040 + (k0 + kq * 8) * 2), *(const bf16x8*)(brow + k0), o); }
          const int col = wid * 16 + r16;
          if (j == 0) {
#pragma unroll
              for (int i = 0; i < 4; ++i) { float ss = o[i] * o[i]; ss += __shfl_xor(ss, 1); ss += __shfl_xor(ss, 2); ss += __shfl_xor(ss, 4); ss += __shfl_xor(ss, 8);
                  if (r16 == 0) ps[wid * 16 + 4 * kq + i] = ss; } }
          __syncthreads();
          const float gsc = (j == 0) ? F.in[9][col] * F.in[14][col] * ATT_SCALE : 1.f;
#pragma unroll
          for (int i = 0; i < 4; ++i) { const int row = rt * 16 + 4 * kq + i; float v = o[i];
              if (j == 0) { float ss = 0.f;
#pragma unroll
                  for (int w = 0; w < 8; ++w) ss += ps[w * 16 + 4 * kq + i];
                  v *= gsc / sqrtf(ss * (1.f / 128.f) + EPS); }
              if ((row & 255) == 255) v = 0.f;
              (j == 0 ? KC : VC)[(size_t)row * 128 + col] = f2bf1(v); }
          __syncthreads(); } }
}
__device__ __forceinline__ void nsa_cmp2_phase(Frame& F) {
    const int gw = blockIdx.x * NWAVES + F.wave, NGW = F.G * NWAVES, lane = F.lane, r16 = lane & 15, kq = lane >> 4;
    const bf16* HC = (const bf16*)(F.ws + WS_HC); const bf16* W2C = (const bf16*)(F.ws + WS_W2C); bf16* KC = (bf16*)(F.ws + WS_KC); bf16* VC = (bf16*)(F.ws + WS_VC);
    for (int task = gw; task < 256; task += NGW) { const int j = task >> 7, rt = task & 127;
        f32x4 acc[8]; RowMajorA ap{HC + ((size_t)j * 2048 + rt * 16) * 512, 512};
        mini_gemm16<8>(acc, ap, W2C + (size_t)j * 128 * 512, 512, 512, lane);
#pragma unroll
        for (int i = 0; i < 4; ++i) { const int row = rt * 16 + 4 * kq + i; const bool pad = (row & 255) == 255;
            float sc = 1.f;
            if (j == 0) { float ss = 0.f;
#pragma unroll
                for (int n = 0; n < 8; ++n) ss += acc[n][i] * acc[n][i];
                ss += __shfl_xor(ss, 1); ss += __shfl_xor(ss, 2); ss += __shfl_xor(ss, 4); ss += __shfl_xor(ss, 8);
                sc = ATT_SCALE / sqrtf(ss * (1.f / 128.f) + EPS); }
#pragma unroll
            for (int n = 0; n < 8; ++n) { const int col = n * 16 + r16; float v = acc[n][i] * sc;
                if (j == 0) v *= F.in[9][col] * F.in[14][col];
                if (pad) v = 0.f;
                (j == 0 ? KC : VC)[(size_t)row * 128 + col] = f2bf1(v); } } }
}

namespace nsa {
constexpr int D = 128, KVBLK = 64, SHM_K = 16384, SHM_V = 16384;
constexpr int O_V = 0, O_K = SHM_V, BUF1 = SHM_V + SHM_K  , O_WS = 2 * BUF1, O_PB = O_WS + NWAVES * 64 * 4, O_SELM = O_PB + 32 * 65 * 4, O_OT = ((O_SELM + 32 * 8 + 1023) / 1024) * 1024  , O_END = O_OT + 32 * 2048;
static_assert(O_END <= RING_BYTES, "nsa LDS");
constexpr float THR2 = 11.0f;
#define KSWZ(row, colB) ((row) * 256 + ((colB) ^ (((row) & 7) << 4)))
#define SBAR() __builtin_amdgcn_sched_barrier(0)
__device__ __forceinline__ int v_st(int k, int c) { const int kk = (k & ~0xC) | ((k & 4) << 1) | ((k & 8) >> 1); return ((kk >> 3) * 4 + (c >> 5)) * 512 + ((kk & 7) * 32 + (c & 31)) * 2; }
__device__ __forceinline__ int v_rd_base(int lane) { return ((lane & 3) << 3) | (((lane >> 2) & 3) << 6) | (((lane >> 4) & 1) << 5) | (((lane >> 5) & 1) << 8); }
constexpr int v_rd_off(int d0, int ks, int half) { return d0 * 512 + ks * 4096 + half * 2048; }
__device__ __forceinline__ int crow(int r, int hi) { return (r & 3) + 8 * (r >> 2) + 4 * hi; }
__device__ __forceinline__ void mask_tile(f32x16& p0, f32x16& p1, int dq, unsigned W) {
    const float NEG = -__builtin_inff();
#pragma unroll
    for (int r = 0; r < 16; ++r) { const int c = (r & 3) + 8 * (r >> 2);
        if ((unsigned)(dq - c) >= W) p0[r] = NEG;
        if ((unsigned)(dq - c - 32) >= W) p1[r] = NEG; }
}
__device__ __forceinline__ float rowmax32(const f32x16& p0, const f32x16& p1) {
    float pmax = p0[0];
#pragma unroll
    for (int r = 1; r < 16; ++r) pmax = fmaxf(pmax, p0[r]);
#pragma unroll
    for (int r = 0; r < 16; ++r) pmax = fmaxf(pmax, p1[r]);
    auto rr = __builtin_amdgcn_permlane32_swap(__float_as_uint(pmax), __float_as_uint(pmax), false, false);
    return fmaxf(__uint_as_float(rr[0]), __uint_as_float(rr[1]));
}
__device__ __forceinline__ float rowsum32(const f32x16& p0, const f32x16& p1) {
    float ps = 0.f;
#pragma unroll
    for (int r = 0; r < 16; ++r) ps += p0[r];
#pragma unroll
    for (int r = 0; r < 16; ++r) ps += p1[r];
    auto rr = __builtin_amdgcn_permlane32_swap(__float_as_uint(ps), __float_as_uint(ps), false, false);
    return __uint_as_float(rr[0]) + __uint_as_float(rr[1]);
}
__device__ __forceinline__ void partialSM(f32x16& p0, f32x16& p1, float& m_reg, float& alpha, float c2) {
    const float pmax = rowmax32(p0, p1); float mn;
    if (__builtin_expect(__all((pmax - m_reg) * c2 <= THR2), 1)) { mn = m_reg; alpha = 1.f; }
    else { mn = fmaxf(m_reg, pmax); alpha = __builtin_amdgcn_exp2f((m_reg - mn) * c2); m_reg = mn; }
    const float mnL = -mn * c2;
#pragma unroll
    for (int r = 0; r < 16; ++r) p0[r] = fmaf(p0[r], c2, mnL);
#pragma unroll
    for (int r = 0; r < 16; ++r) p1[r] = fmaf(p1[r], c2, mnL);
#pragma unroll
    for (int r = 0; r < 16; ++r) p0[r] = __builtin_amdgcn_exp2f(p0[r]);
}
__device__ __forceinline__ void packP(const f32x16& p0, const f32x16& p1, bf16x8& pa0, bf16x8& pa1, bf16x8& pa2, bf16x8& pa3) {
#define PK4(P, B_, OUT) do { unsigned a0 = pk2(P[B_+0], P[B_+1]), a1 = pk2(P[B_+2], P[B_+3]);                          \
        unsigned b0 = pk2(P[B_+4], P[B_+5]), b1 = pk2(P[B_+6], P[B_+7]);                                             \
        auto r0 = __builtin_amdgcn_permlane32_swap(a0, b0, false, false); auto r1 = __builtin_amdgcn_permlane32_swap(a1, b1, false, false); \
        u32x4_t w = {r0[0], r1[0], r0[1], r1[1]}; OUT = __builtin_bit_cast(bf16x8, w); } while (0)
    typedef unsigned u32x4_t __attribute__((ext_vector_type(4)));
    PK4(p0, 0, pa0); PK4(p0, 8, pa1); PK4(p1, 0, pa2); PK4(p1, 8, pa3);
#undef PK4
}
__device__ __forceinline__ void finishSM(f32x16& p0, f32x16& p1, float alpha, float& l_reg, bf16x8& pa0, bf16x8& pa1, bf16x8& pa2, bf16x8& pa3) {
#pragma unroll
    for (int r = 0; r < 16; ++r) p1[r] = __builtin_amdgcn_exp2f(p1[r]);
    l_reg = l_reg * alpha + rowsum32(p0, p1);
    packP(p0, p1, pa0, pa1, pa2, pa3);
}
__device__ __forceinline__ void qkt(f32x16& p0, f32x16& p1, const char* K_lds, int r32, int hi, const bf16x8* qr, float cinit) {
#pragma unroll
    for (int r = 0; r < 16; ++r) { p0[r] = cinit; p1[r] = cinit; }
    const char* kb[4];
#pragma unroll
    for (int dd = 0; dd < 4; ++dd) kb[dd] = K_lds + KSWZ(r32, (dd * 16 + hi * 8) * 2);
#pragma unroll
    for (int d0 = 0; d0 < 8; ++d0) { const char* a = kb[d0 & 3] + (d0 >> 2) * 128;
        const bf16x8 b0 = *reinterpret_cast<const bf16x8*>(a);
        const bf16x8 b1 = *reinterpret_cast<const bf16x8*>(a + 32 * 256);
        p0 = __builtin_amdgcn_mfma_f32_32x32x16_bf16(b0, qr[d0], p0, 0, 0, 0);
        p1 = __builtin_amdgcn_mfma_f32_32x32x16_bf16(b1, qr[d0], p1, 0, 0, 0); }
}
__device__ __forceinline__ void pv_tile(f32x16* o, int vb0, bf16x8 pa0, bf16x8 pa1, bf16x8 pa2, bf16x8 pa3) {
#define TRRD(dst, off) asm volatile("ds_read_b64_tr_b16 %0, %1 offset:%2" : "=&v"(dst) : "v"(vb0), "i"(off) : "memory")
#define PV_D0(d0) do { s16x4 l0, l1, l2, l3, h0, h1, h2, h3; constexpr int b_ = v_rd_off(d0, 0, 0); \
        TRRD(l0, b_); TRRD(h0, b_ + 2048); TRRD(l1, b_ + 4096); TRRD(h1, b_ + 6144); TRRD(l2, b_ + 8192); TRRD(h2, b_ + 10240); TRRD(l3, b_ + 12288); TRRD(h3, b_ + 14336); \
        asm volatile("s_waitcnt lgkmcnt(0)" ::: "memory"); SBAR();   \
        o[d0] = __builtin_amdgcn_mfma_f32_32x32x16_bf16(pa0, (bf16x8){l0[0], l0[1], l0[2], l0[3], h0[0], h0[1], h0[2], h0[3]}, o[d0], 0, 0, 0);   \
        o[d0] = __builtin_amdgcn_mfma_f32_32x32x16_bf16(pa1, (bf16x8){l1[0], l1[1], l1[2], l1[3], h1[0], h1[1], h1[2], h1[3]}, o[d0], 0, 0, 0);   \
        o[d0] = __builtin_amdgcn_mfma_f32_32x32x16_bf16(pa2, (bf16x8){l2[0], l2[1], l2[2], l2[3], h2[0], h2[1], h2[2], h2[3]}, o[d0], 0, 0, 0);   \
        o[d0] = __builtin_amdgcn_mfma_f32_32x32x16_bf16(pa3, (bf16x8){l3[0], l3[1], l3[2], l3[3], h3[0], h3[1], h3[2], h3[3]}, o[d0], 0, 0, 0); } while (0)
    PV_D0(0); PV_D0(1); PV_D0(2); PV_D0(3);
#undef PV_D0
#undef TRRD
}
struct Stage { bf16x8 k0, k1, v0, v1; };
__device__ __forceinline__ void stage_load(Stage& S, const bf16* Kp, const bf16* Vp, int ld, int kb, int sr, int sc, bool withV) {
    const bf16* kt = Kp + (size_t)kb * ld; const bf16* vt = Vp + (size_t)kb * ld;
    const unsigned voff = (unsigned)(sr * ld + sc);
    S.k0 = *(const bf16x8*)(kt + voff); S.k1 = *(const bf16x8*)(kt + (size_t)32 * ld + voff);
    if (withV) { S.v0 = *(const bf16x8*)(vt + voff); S.v1 = *(const bf16x8*)(vt + (size_t)32 * ld + voff); }
}
__device__ __forceinline__ void stage_write(const Stage& S, char* lds, int sr, int sc, bool withV) {
    const int kws = KSWZ(sr, sc * 2);
    *(bf16x8*)(lds + O_K + kws) = S.k0; *(bf16x8*)(lds + O_K + kws + 32 * 256) = S.k1;
    if (withV) { *(bf16x8*)(lds + O_V + v_st(sr, sc)) = S.v0; *(bf16x8*)(lds + O_V + v_st(32 + sr, sc)) = S.v1; }
}
template <int ACC>
__device__ __forceinline__ void emit(const f32x16* o, const float* fl, char* OTw, int r32, int hi) {
    int r32o = r32, hio = hi; asm volatile("" : "+v"(r32o), "+v"(hio));
    char* base = OTw + 4 * hio * 2048 + r32o * 2;
#pragma unroll
    for (int r = 0; r < 16; ++r) { const float f = fl[(r & 3) + 8 * (r >> 2) + 4 * hio]; unsigned short* p = (unsigned short*)(base + ((r & 3) + 8 * (r >> 2)) * 2048);
#pragma unroll
        for (int d0 = 0; d0 < 4; ++d0) { float v = o[d0][r] * f;
            if (ACC >= 1) v += bf1(p[d0 * 32]);
            p[d0 * 32] = f2bf1(v); } }
}
template <int MODE, int ACC>
__device__ __forceinline__ void flash_pass(char* lds, const bf16* Kp, const bf16* Vp, int ld, unsigned long long tiles, int t, int qb, unsigned long long mymask, const bf16x8* qr, float c2, float gate, char* OTw,
                                           Stage& S, const bf16* Kn, const bf16* Vn, Stage* Sn, int tid, int wid, int lane) {
    const int r32 = lane & 31, hi = lane >> 5, sr = tid >> 4, sc = (tid & 15) * 8;
    float* ws = (float*)(lds + O_WS) + wid * 64; float* li_l = ws; float* al_l = ws + 32;
    const int vb0 = (int)(uintptr_t)(lds + O_V) + v_rd_base(lane);
    f32x16 o[4] = {}; float m_reg = -1e30f, l_reg = 0.f;
    unsigned long long rem = tiles;
    int j = __builtin_ctzll(rem); rem &= rem - 1;
    __syncthreads();
    stage_write(S, lds, sr, sc, true);
    int jn = rem ? __builtin_ctzll(rem) : -1;
    if (jn >= 0) { rem &= rem - 1; stage_load(S, Kp, Vp, ld, jn * KVBLK, sr, sc, true); }
    int cur = 0;
    for (;;) {
        __syncthreads();
        int jnn = -1;
        if (jn >= 0) { stage_write(S, lds + (cur ^ 1) * BUF1, sr, sc, true); jnn = rem ? __builtin_ctzll(rem) : -1;
            if (jnn >= 0) { rem &= rem - 1; stage_load(S, Kp, Vp, ld, jnn * KVBLK, sr, sc, true); } }
        f32x16 p0, p1; float alpha; bf16x8 pa0, pa1, pa2, pa3;
        float cinit = 0.f;
        if (MODE == 1) cinit = ((mymask >> j) & 1ull) ? 0.f : -__builtin_inff();
        qkt(p0, p1, lds + cur * BUF1 + O_K, r32, hi, qr, cinit);
        if (MODE == 0) { const int tok0_ = t - r32; if (!(j * KVBLK + 63 <= tok0_ && j * KVBLK >= tok0_ - 480)) mask_tile(p0, p1, t - j * KVBLK - 4 * hi, 512u); }
        else if (j == qb) mask_tile(p0, p1, t - j * KVBLK - 4 * hi, 0x7fffffffu);
        partialSM(p0, p1, m_reg, alpha, c2);
        finishSM(p0, p1, alpha, l_reg, pa0, pa1, pa2, pa3);
        if (__any(alpha < 1.f)) { if (hi == 0) al_l[r32] = alpha; asm volatile("s_waitcnt lgkmcnt(0)" ::: "memory");
#pragma unroll
            for (int d_ = 0; d_ < 4; ++d_)
#pragma unroll
                for (int r = 0; r < 16; ++r) o[d_][r] *= al_l[crow(r, hi)]; }
        pv_tile(o, vb0 + cur * BUF1, pa0, pa1, pa2, pa3);
        if (jn < 0) break;
        j = jn; jn = jnn; cur ^= 1;
    }
    if (Sn) stage_load(*Sn, Kn, Vn, ld, 0, sr, sc, true);
    if (hi == 0) li_l[r32] = gate / l_reg; asm volatile("s_waitcnt lgkmcnt(0)" ::: "memory");
    emit<ACC>(o, li_l, OTw, r32, hi);
}

__device__ __forceinline__ void unit(Frame& F, char* lds, int b, int g, int tg) {
    const int tid = F.tid, lane = F.lane, wid = F.wave, r32 = lane & 31, hi = lane >> 5, sr = tid >> 4, sc = (tid & 15) * 8;
    const int head = g * 8 + wid, tok0 = tg * 32, t = tok0 + r32, qb = tg >> 1, bg = b * 4 + g;
    const bf16* KVQ = (const bf16*)(F.ws + WS_BIG); const float* GT = (const float*)(F.ws + WS_GT);
    const bf16* KC = (const bf16*)(F.ws + WS_KC) + (size_t)bg * 256 * 128; const bf16* VC = (const bf16*)(F.ws + WS_VC) + (size_t)bg * 256 * 128;
    const size_t rowq = (size_t)b * SEQ + t;
    float* ws = (float*)(lds + O_WS) + wid * 64; float* li_l = ws;
    unsigned* pb = (unsigned*)(lds + O_PB); unsigned* selm = (unsigned*)(lds + O_SELM);
    const int vb0 = (int)(uintptr_t)(lds + O_V) + v_rd_base(lane);
    bf16x8 qr[8]; float ss = 0.f;
#pragma unroll
    for (int d0 = 0; d0 < 8; ++d0) { qr[d0] = *(const bf16x8*)(KVQ + rowq * NKVQ + KVW + head * 128 + d0 * 16 + hi * 8);
        const v4u w = __builtin_bit_cast(v4u, qr[d0]);
        ss += (bf_lo(w.x) * bf_lo(w.x) + bf_hi(w.x) * bf_hi(w.x)) + (bf_lo(w.y) * bf_lo(w.y) + bf_hi(w.y) * bf_hi(w.y)) + (bf_lo(w.z) * bf_lo(w.z) + bf_hi(w.z) * bf_hi(w.z)) + (bf_lo(w.w) * bf_lo(w.w) + bf_hi(w.w) * bf_hi(w.w)); }
    { auto rr = __builtin_amdgcn_permlane32_swap(__float_as_uint(ss), __float_as_uint(ss), false, false); ss = __uint_as_float(rr[0]) + __uint_as_float(rr[1]); }
    const float c2 = 1.4426950408889634f / sqrtf(ss * (1.f / 128.f) + EPS);
    const float g_cmp = GT[rowq * 96 + head], g_sel = GT[rowq * 96 + 32 + head], g_win = GT[rowq * 96 + 64 + head];
    for (int i = tid; i < 32 * 65; i += NWAVES * 64) pb[i] = 0u;
    char* OTw = lds + O_OT + wid * 256;
    const int nct = (tg >> 5) + 1; const int cmax = (t - 31) >> 4;
    float m_c = -1e30f, l_c = 0.f;
    { Stage S;
      for (int kt = 0; kt < nct; ++kt) {
          stage_load(S, KC, VC, 128, kt * 64, sr, sc, false);
          __syncthreads(); stage_write(S, lds, sr, sc, false); __syncthreads();
          f32x16 p0, p1; qkt(p0, p1, lds + O_K, r32, hi, qr, 0.f);
          mask_tile(p0, p1, cmax - kt * 64 - 4 * hi, 0x7fffffffu);
          const float pmax = rowmax32(p0, p1), mn = fmaxf(m_c, pmax), al = __builtin_amdgcn_exp2f((m_c - mn) * c2), mnL = -mn * c2;
#pragma unroll
          for (int r = 0; r < 16; ++r) { p0[r] = __builtin_amdgcn_exp2f(fmaf(p0[r], c2, mnL)); p1[r] = __builtin_amdgcn_exp2f(fmaf(p1[r], c2, mnL)); }
          l_c = l_c * al + rowsum32(p0, p1); m_c = mn; }
      const float inv_l = l_c > 0.f ? 1.f / l_c : 0.f; const float mnL = -m_c * c2;
      f32x16 o[4] = {};
      for (int kt = 0; kt < nct; ++kt) {
          stage_load(S, KC, VC, 128, kt * 64, sr, sc, true);
          __syncthreads(); stage_write(S, lds, sr, sc, true); __syncthreads();
          f32x16 p0, p1; qkt(p0, p1, lds + O_K, r32, hi, qr, 0.f);
          mask_tile(p0, p1, cmax - kt * 64 - 4 * hi, 0x7fffffffu);
#pragma unroll
          for (int r = 0; r < 16; ++r) { p0[r] = __builtin_amdgcn_exp2f(fmaf(p0[r], c2, mnL)) * inv_l; p1[r] = __builtin_amdgcn_exp2f(fmaf(p1[r], c2, mnL)) * inv_l; }
#pragma unroll
          for (int rg = 0; rg < 4; ++rg) { const int j0 = 16 * kt + 2 * rg + hi;
              const float a0 = (p0[4 * rg] + p0[4 * rg + 1]) + (p0[4 * rg + 2] + 0.5f * p0[4 * rg + 3]), b0 = 0.5f * p0[4 * rg + 3];
              const float a1 = (p1[4 * rg] + p1[4 * rg + 1]) + (p1[4 * rg + 2] + 0.5f * p1[4 * rg + 3]), b1 = 0.5f * p1[4 * rg + 3];
              atomicAdd(&pb[r32 * 65 + j0], (unsigned)(a0 * 67108864.f + 0.5f)); atomicAdd(&pb[r32 * 65 + j0 + 1], (unsigned)(b0 * 67108864.f + 0.5f));
              atomicAdd(&pb[r32 * 65 + j0 + 8], (unsigned)(a1 * 67108864.f + 0.5f)); atomicAdd(&pb[r32 * 65 + j0 + 9], (unsigned)(b1 * 67108864.f + 0.5f)); }
          bf16x8 pa0, pa1, pa2, pa3; packP(p0, p1, pa0, pa1, pa2, pa3);
          pv_tile(o, vb0, pa0, pa1, pa2, pa3); }
      if (hi == 0) li_l[r32] = g_cmp; asm volatile("s_waitcnt lgkmcnt(0)" ::: "memory");
      emit<0>(o, li_l, OTw, r32, hi); }
    const int lowk_ = tok0 - 511, wj_lo = lowk_ > 0 ? lowk_ >> 6 : 0, wj_hi = ((tok0 + 31) >> 6) + 1;
    const unsigned long long wtiles = ((wj_hi >= 64) ? ~0ull : ((1ull << wj_hi) - 1ull)) & ~((1ull << wj_lo) - 1ull);
    const bf16* Kw = KVQ + (size_t)b * SEQ * NKVQ + 4 * 512 + g * 128; const bf16* Vw = KVQ + (size_t)b * SEQ * NKVQ + 5 * 512 + g * 128;
    Stage SW; stage_load(SW, Kw, Vw, NKVQ, wj_lo * KVBLK, sr, sc, true);
    __syncthreads();
#pragma unroll 1
    for (int tt = 0; tt < 4; ++tt) { const int tok = 4 * wid + tt; const bool valid = lane <= qb; const bool forced = lane == 0 || lane == qb;
        const unsigned key = forced ? 0xFFFFFFFFu : pb[tok * 65 + lane]; int rank = 0;
        for (int i = 0; i <= qb; ++i) { const unsigned ki = (unsigned)__builtin_amdgcn_readlane((int)key, i); rank += (ki > key || (ki == key && i < lane)) ? 1 : 0; }
        const unsigned long long mk = __ballot(valid && rank < 16);
        if (lane == 0) { selm[2 * tok] = (unsigned)mk; selm[2 * tok + 1] = (unsigned)(mk >> 32); } }
    __syncthreads();
    const unsigned long long mymask = (unsigned long long)selm[2 * r32] | ((unsigned long long)selm[2 * r32 + 1] << 32);
    unsigned ulo = (unsigned)mymask, uhi = (unsigned)(mymask >> 32);
#pragma unroll
    for (int o_ = 1; o_ < 32; o_ <<= 1) { ulo |= __shfl_xor(ulo, o_); uhi |= __shfl_xor(uhi, o_); }
    const unsigned long long uni = (unsigned long long)(unsigned)__builtin_amdgcn_readfirstlane((int)ulo) | ((unsigned long long)(unsigned)__builtin_amdgcn_readfirstlane((int)uhi) << 32);
    { const bf16* Ks = KVQ + (size_t)b * SEQ * NKVQ + 2 * 512 + g * 128; const bf16* Vs = KVQ + (size_t)b * SEQ * NKVQ + 3 * 512 + g * 128;
      Stage SS;
      flash_pass<0, 1>(lds, Kw, Vw, NKVQ, wtiles, t, qb, 0ull, qr, c2, g_win, OTw, SW, Ks, Vs, &SS, tid, wid, lane);
      flash_pass<1, 2>(lds, Ks, Vs, NKVQ, uni, t, qb, mymask, qr, c2, g_sel, OTw, SS, nullptr, nullptr, nullptr, tid, wid, lane); }
    __syncthreads();
    { const int tok = tid >> 4, ch = tid & 15;
      const char* src = lds + O_OT + tok * 2048 + ch * 128; unsigned char* dst = (unsigned char*)(F.ws + WS_A3) + ((size_t)b * SEQ + tok0 + tok) * DM + g * 1024 + ch * 64;
#pragma unroll
      for (int i = 0; i < 4; ++i) { const v4u w0 = *(const v4u*)(src + i * 32), w1 = *(const v4u*)(src + i * 32 + 16); v4u q; const unsigned ws_[8] = {w0.x, w0.y, w0.z, w0.w, w1.x, w1.y, w1.z, w1.w}; int qq[4];
#pragma unroll
          for (int e = 0; e < 4; ++e) { int t_ = __builtin_amdgcn_cvt_pk_fp8_f32(bf_lo(ws_[2 * e]) * 64.f, bf_hi(ws_[2 * e]) * 64.f, 0, false); qq[e] = __builtin_amdgcn_cvt_pk_fp8_f32(bf_lo(ws_[2 * e + 1]) * 64.f, bf_hi(ws_[2 * e + 1]) * 64.f, t_, true); }
          q.x = (unsigned)qq[0]; q.y = (unsigned)qq[1]; q.z = (unsigned)qq[2]; q.w = (unsigned)qq[3]; *(v4u*)(dst + i * 16) = q; } }
    __syncthreads();
}
#undef KSWZ
#undef SBAR
}
__device__ __forceinline__ void nsa_attn_phase(Frame& F) {
    for (int ui = blockIdx.x; ui < 1024; ui += F.G) { const int vw = ui & 255, rnd = ui >> 8, bg = vw & 7, s = vw >> 3;
        const int tg = rnd == 0 ? s : rnd == 1 ? 63 - s : rnd == 2 ? 64 + s : 127 - s;
        nsa::unit(F, (char*)(F.lds + RING_OFF), bg >> 2, bg & 3, tg); }
}

struct Args { const float* in[18]; float* out; unsigned char* ws; int ph_lo, ph_hi; };
__global__ void __launch_bounds__(NWAVES * 64, 2) skel_fwd(Args args) {
    extern __shared__ __attribute__((aligned(16))) unsigned char lds[];
    Frame F;
    F.lds = (LAS unsigned char*)lds;
    F.MISC = (volatile LAS unsigned*)(F.lds + MISC_OFF);
    F.tid = threadIdx.x; F.lane = F.tid & 63; F.wave = __builtin_amdgcn_readfirstlane(F.tid >> 6);
    F.G = gridDim.x;
    unsigned char* ws = args.ws; F.ws = ws; F.out = args.out;
#pragma unroll
    for (int i = 0; i < 18; ++i) F.in[i] = args.in[i];
    F.ctl = (gu32*)(ws + WS_CTL);
    for (int u = F.tid; u < (LDS_BYTES - LDSCTL_OFF) / 4; u += NWAVES * 64) ((LAS unsigned*)(F.lds + LDSCTL_OFF))[u] = 0u;
    __syncthreads();
    XcdBarrier bar; bar.bar = (unsigned*)(F.ctl + CW_BAR); bar.x = 0; bar.st = nullptr;
    if (!MK_PER_PHASE) bar = xcd_barrier_post((unsigned*)(F.ctl + CW_BAR), F.MISC + 8);
    const int lo = args.ph_lo, hi = args.ph_hi;
#ifndef PHASE_MASK
#define PHASE_MASK 0x1ffff
#endif
#define IN(k) (((PHASE_MASK >> (k)) & 1) && lo <= (k) && (k) < hi)
#ifndef DUP_MASK
#define DUP_MASK 0
#endif
#ifndef PROBE_ML
#define PROBE_ML 0
#endif
#ifndef PROBE2
#define PROBE2 0
#endif
#ifndef CW_TAIL
#define CW_TAIL 10240
#endif
#ifndef TS_ON
#define TS_ON 0
#define TS_LO 0
#define TS_HI 0
#endif
#define REP(k) for (int rep_ = 0, nrep_ = 1 + ((DUP_MASK >> (k)) & 1); rep_ < nrep_; ++rep_, (rep_ < nrep_ ? xcd_barrier(bar) : (void)0))
#define SEAM(k) do { if (IN(k) && (hi > (k) + 1)) xcd_barrier(bar); if (TS_ON && (k) == TS_HI) ts1 = __builtin_amdgcn_s_memrealtime(); } while (0)
    unsigned long long ts0 = 0, ts1 = 0;
    bf16* XB = (bf16*)(ws + WS_XB); bf16* A3 = (bf16*)(ws + WS_A3); bf16* BIG = (bf16*)(ws + WS_BIG);
    bf16* X1 = (bf16*)(ws + WS_X1); bf16* X2 = (bf16*)(ws + WS_X2); bf16* X3 = X1;

    if (TS_ON && 0 == TS_LO) ts0 = __builtin_amdgcn_s_memrealtime(); if (IN(0)) REP(0) { p0_prologue(F); } SEAM(0);
    if (TS_ON && 1 == TS_LO) ts0 = __builtin_amdgcn_s_memrealtime(); if (IN(1)) REP(1) {
        pg8::Gemm g{XB, (const bf16*)(ws + WS_WIN), MTOK, M_MAIN, DM}; pg8::StaticOrder S; S.init(MTOK, M_MAIN, F.G, (int)blockIdx.x);
        pg8::EpiBf16<0> E{BIG, M_MAIN, nullptr};
        pg8::gemm_phase<pg8::EpiBf16<0>, pg8::StaticOrder, true, true>(F.lds + RING_OFF, g, S, E);
        gates1_phase(F);
    } SEAM(1);
    if (TS_ON && 2 == TS_LO) ts0 = __builtin_amdgcn_s_memrealtime(); if (IN(2)) REP(2) {
        const int bid = (int)blockIdx.x;
        if (F.G == 256) {
            const int x = bid & 7, y = bid >> 3;
            if (x < 4) mlstm_phase(F, (x * 4 + (y >> 3)) * 8 + (y & 7), 128);
            else if (!(PROBE_ML && rep_)) { const int wk = (y * 4 + (x - 4)) * NWAVES + F.wave; convert_narrow(F, 64, 256, wk, 128 * NWAVES); if (Q8_STRIPS) convert_strips(F, (x - 4) * 32 + y, 128); convert_wide(F, CW_EARLY, CW_TOTAL, wk, 128 * NWAVES); }
        } else {
            mlstm_phase(F, bid, F.G); if (Q8_STRIPS) convert_strips(F, bid, F.G); convert_wide(F, CW_EARLY, CW_TOTAL, bid * NWAVES + F.wave, F.G * NWAVES); convert_narrow(F, 64, 256, bid * NWAVES + F.wave, F.G * NWAVES);
        }
    } SEAM(2);
#if PROBE2 == 1
    { xcd_barrier(bar); const int bid = (int)blockIdx.x, x = bid & 7, y = bid >> 3; if (x < 4) mlstm_phase(F, (x * 4 + (y >> 3)) * 8 + (y & 7), 128); xcd_barrier(bar); }
#elif PROBE2 == 2
    { xcd_barrier(bar); const int bid = (int)blockIdx.x, x = bid & 7, y = bid >> 3; if (x >= 4) { const int wk = (y * 4 + (x - 4)) * NWAVES + F.wave; convert_wide(F, CW_EARLY, CW_TOTAL, wk, 128 * NWAVES); } xcd_barrier(bar); }
#elif PROBE2 == 4
    { xcd_barrier(bar); const int bid = (int)blockIdx.x, x = bid & 7, y = bid >> 3;
      if (x < 4) mlstm_phase(F, (x * 4 + (y >> 3)) * 8 + (y & 7), 128);
      else { const int wk = (y * 4 + (x - 4)) * NWAVES + F.wave; convert_wide(F, CW_EARLY, CW_TOTAL, wk, 128 * NWAVES); }
      xcd_barrier(bar); }
#elif PROBE2 == 3
    { xcd_barrier(bar); convert_wide(F, CW_EARLY, CW_TOTAL, blockIdx.x * NWAVES + F.wave, F.G * NWAVES); xcd_barrier(bar); }
#endif
    if (TS_ON && 3 == TS_LO) ts0 = __builtin_amdgcn_s_memrealtime(); if (IN(3)) REP(3) { gating_phase(F);
        if (Q8_WMO && !Q8_STRIPS) wquant_phase(F, (const bf16*)(ws + WS_WMO), (const float*)(ws + CTL_CMAX) + 49152, (unsigned char*)(ws + WS_WMOQ), DM);
        if ((Q8_UP_MASK & 1) && !Q8_STRIPS) wquant_phase(F, (const bf16*)(ws + WS_WUP0), (const float*)(ws + CTL_CMAX), (unsigned char*)(ws + WS_WUPQ0), DFF);
        if ((Q8_UP_MASK & 2) && !Q8_STRIPS) wquant_phase(F, (const bf16*)(ws + WS_WUP1), (const float*)(ws + CTL_CMAX) + 16384, (unsigned char*)(ws + WS_WUPQ1), DFF);
        if (Q8_KVQ && !Q8_STRIPS) wquant_phase(F, (const bf16*)(ws + WS_WKVQ), (const float*)(ws + CTL_CMAX) + 32768, (unsigned char*)(ws + WS_WKVQ8), NKVQ);
        if (blockIdx.x == 0) { const float* pp = (const float*)(ws + WS_POSP); float* posb = (float*)(ws + WS_POSB);
            for (int i = F.tid; i < 1024; i += NWAVES * 64) { float a = 0.f;
#pragma unroll 8
                for (int ch = 0; ch < 32; ++ch) a += pp[ch * 1024 + i];
                posb[i] = a; } }
    } SEAM(3);
    if (TS_ON && 4 == TS_LO) ts0 = __builtin_amdgcn_s_memrealtime(); if (IN(4)) REP(4) {
        pg8::StaticOrder S; S.init(MTOK, DM, F.G, (int)blockIdx.x);
        if (Q8_WMO) { pg8::Gemm g{A3, (const bf16*)(ws + WS_WMOQ), MTOK, DM, DM};
            pg8::EpiRes<false, true, true> E{F.in[0], X1, (float*)(ws + WS_PART), DM, 1.f, nullptr, (const float*)(ws + WS_RS) + 24576, (const float*)(ws + CTL_CMAX) + 49152};
            pg8::gemm_phase<pg8::EpiRes<false, true, true>, pg8::StaticOrder, true, true, 2>(F.lds + RING_OFF, g, S, E); }
        else { pg8::Gemm g{A3, (const bf16*)(ws + WS_WMO), MTOK, DM, DM};
            pg8::EpiRes<false, true> E{F.in[0], X1, (float*)(ws + WS_PART), DM};
            pg8::gemm_phase<pg8::EpiRes<false, true>, pg8::StaticOrder, true, true>(F.lds + RING_OFF, g, S, E); }
    } SEAM(4);
    if (TS_ON && 5 == TS_LO) ts0 = __builtin_amdgcn_s_memrealtime(); if (IN(5)) REP(5) { if (Q8_UP_MASK & 1) rstd_phase(F, (float*)(ws + WS_RS), X1, (unsigned char*)(ws + WS_XQ), (float*)(ws + WS_RS) + 24576); else rstd_phase(F, (float*)(ws + WS_RS)); } SEAM(5);
    if (TS_ON && 6 == TS_LO) ts0 = __builtin_amdgcn_s_memrealtime(); if (IN(6)) REP(6) {
        pg8::StaticOrder S; S.init(MTOK, DFF, F.G, (int)blockIdx.x);
        if (Q8_UP_MASK & 1) { pg8::Gemm g{(const bf16*)(ws + WS_XQ), (const bf16*)(ws + WS_WUPQ0), MTOK, DFF, DM};
            pg8::EpiQ8<2> E{BIG, DFF, (const float*)(ws + CTL_CMAX), (const float*)(ws + WS_RS) + 24576};
            pg8::gemm_phase<pg8::EpiQ8<2>, pg8::StaticOrder, true, true, 2>(F.lds + RING_OFF, g, S, E); }
        else { pg8::Gemm g{X1, (const bf16*)(ws + WS_WUP0), MTOK, DFF, DM};
            pg8::EpiBf16<2, true> E{BIG, DFF, (const float*)(ws + WS_RS)};
            pg8::gemm_phase<pg8::EpiBf16<2, true>, pg8::StaticOrder, true, true>(F.lds + RING_OFF, g, S, E); }
    } SEAM(6);
    if (TS_ON && 7 == TS_LO) ts0 = __builtin_amdgcn_s_memrealtime(); if (IN(7)) REP(7) {
        pg8::Gemm g{BIG, (const bf16*)(ws + WS_WDN0), MTOK, DM, DFF}; pg8::StaticOrder S; S.init(MTOK, DM, F.G, (int)blockIdx.x);
        pg8::EpiRes<true, true> E{X1, X2, (float*)(ws + WS_PART), DM, 1.f, Q8_KVQ ? nullptr : (unsigned char*)(ws + WS_HR)};
        pg8::gemm_phase<pg8::EpiRes<true, true>, pg8::StaticOrder, true, true>(F.lds + RING_OFF, g, S, E);
    } SEAM(7);
    if (TS_ON && 8 == TS_LO) ts0 = __builtin_amdgcn_s_memrealtime(); if (IN(8)) REP(8) { if (Q8_KVQ) rstd_phase(F, (float*)(ws + WS_RS) + 8192, X2, (unsigned char*)(ws + WS_XQ), (float*)(ws + WS_RS) + 24576); else rstd_phase(F, (float*)(ws + WS_RS) + 8192); } SEAM(8);
    if (TS_ON && 9 == TS_LO) ts0 = __builtin_amdgcn_s_memrealtime(); if (IN(9)) REP(9) {
        pg8::StaticOrder S; S.init(MTOK, NKVQ, F.G, (int)blockIdx.x);
        if (Q8_KVQ) { pg8::Gemm g{(const bf16*)(ws + WS_XQ), (const bf16*)(ws + WS_WKVQ8), MTOK, NKVQ, DM};
            pg8::EpiQ8<0> E{BIG, NKVQ, (const float*)(ws + CTL_CMAX) + 32768, (const float*)(ws + WS_RS) + 24576};
            pg8::gemm_phase<pg8::EpiQ8<0>, pg8::StaticOrder, true, true, 2>(F.lds + RING_OFF, g, S, E); }
        else { pg8::Gemm g{(const bf16*)(ws + WS_HR), (const bf16*)(ws + WS_WKVQ), MTOK, NKVQ, DM};
            pg8::EpiBf16<0, true> E{BIG, NKVQ, (const float*)(ws + WS_RS) + 8192, 1.f / 256.f};
            pg8::gemm_phase<pg8::EpiBf16<0, true>, pg8::StaticOrder, true, true, 1>(F.lds + RING_OFF, g, S, E); }
        gates2_phase(F);
    } SEAM(9);
    if (TS_ON && 10 == TS_LO) ts0 = __builtin_amdgcn_s_memrealtime(); if (IN(10)) REP(10) { nsa_prep_phase(F); } SEAM(10);
    if (TS_ON && 11 == TS_LO) ts0 = __builtin_amdgcn_s_memrealtime();
    if (TS_ON && 12 == TS_LO) ts0 = __builtin_amdgcn_s_memrealtime(); if (IN(12)) REP(12) { nsa_attn_phase(F); } SEAM(12);
    if (TS_ON && 13 == TS_LO) ts0 = __builtin_amdgcn_s_memrealtime(); if (IN(13)) REP(13) {
        pg8::Gemm g{A3, (const bf16*)(ws + WS_WNO), MTOK, DM, DM}; pg8::StaticOrder S; S.init(MTOK, DM, F.G, (int)blockIdx.x);
        pg8::EpiRes<true, true> E{X2, X3, (float*)(ws + WS_PART), DM, 1.f / 16384.f};
        pg8::gemm_phase<pg8::EpiRes<true, true>, pg8::StaticOrder, true, true, 1>(F.lds + RING_OFF, g, S, E);
    } SEAM(13);
    if (TS_ON && 14 == TS_LO) ts0 = __builtin_amdgcn_s_memrealtime(); if (IN(14)) REP(14) { if (Q8_UP_MASK & 2) rstd_phase(F, (float*)(ws + WS_RS) + 16384, X3, (unsigned char*)(ws + WS_XQ), (float*)(ws + WS_RS) + 24576); else rstd_phase(F, (float*)(ws + WS_RS) + 16384); } SEAM(14);
    if (TS_ON && 15 == TS_LO) ts0 = __builtin_amdgcn_s_memrealtime(); if (IN(15)) REP(15) {
        pg8::StaticOrder S; S.init(MTOK, DFF, F.G, (int)blockIdx.x);
        if (Q8_UP_MASK & 2) { pg8::Gemm g{(const bf16*)(ws + WS_XQ), (const bf16*)(ws + WS_WUPQ1), MTOK, DFF, DM};
            pg8::EpiQ8<2> E{BIG, DFF, (const float*)(ws + CTL_CMAX) + 16384, (const float*)(ws + WS_RS) + 24576};
            pg8::gemm_phase<pg8::EpiQ8<2>, pg8::StaticOrder, true, true, 2>(F.lds + RING_OFF, g, S, E); }
        else { pg8::Gemm g{X3, (const bf16*)(ws + WS_WUP1), MTOK, DFF, DM};
            pg8::EpiBf16<2, true> E{BIG, DFF, (const float*)(ws + WS_RS) + 16384};
            pg8::gemm_phase<pg8::EpiBf16<2, true>, pg8::StaticOrder, true, true>(F.lds + RING_OFF, g, S, E); }
    } SEAM(15);
    if (TS_ON && 16 == TS_LO) ts0 = __builtin_amdgcn_s_memrealtime(); if (IN(16)) REP(16) {
        pg8::Gemm g{BIG, (const bf16*)(ws + WS_WDN1), MTOK, DM, DFF}; pg8::StaticOrder S; S.init(MTOK, DM, F.G, (int)blockIdx.x);
        pg8::EpiRes<true, false> E{X3, F.out, nullptr, DM};
        pg8::gemm_phase<pg8::EpiRes<true, false>, pg8::StaticOrder, true, true>(F.lds + RING_OFF, g, S, E);
    }
#if TS_ON
    if (TS_HI == 16) ts1 = __builtin_amdgcn_s_memrealtime();
    xcd_barrier(bar);
    if (blockIdx.x == 0 && F.tid == 0) F.out[0] = (float)(ts1 - ts0) * 0.01f;
#endif
#undef IN
#undef SEAM
}

extern "C" void kernel_launch(void* const* d_in, const int* in_sizes, int n_in, void* d_out, int out_size, void* d_ws, size_t ws_size, hipStream_t stream) {
    static int grid = 0;
    if (grid == 0) {
        if (n_in != 18 || in_sizes[0] != MTOK * DM || out_size != MTOK * DM || ws_size < WS_END) { fprintf(stderr, "kernel_launch: unexpected shapes (n_in %d, in0 %d, out %d, ws %zu); nothing launched\n", n_in, n_in > 0 ? in_sizes[0] : -1, out_size, ws_size); grid = -1; return; }
        int dev = 0, cus = 0, per_cu = 0;
        if (hipGetDevice(&dev) != hipSuccess || hipDeviceGetAttribute(&cus, hipDeviceAttributeMultiprocessorCount, dev) != hipSuccess) { grid = -1; return; }
        if (hipFuncSetAttribute((const void*)skel_fwd, hipFuncAttributeMaxDynamicSharedMemorySize, LDS_BYTES) != hipSuccess) { fprintf(stderr, "kernel_launch: hipFuncSetAttribute failed\n"); grid = -1; return; }
        if (hipOccupancyMaxActiveBlocksPerMultiprocessor(&per_cu, (const void*)skel_fwd, NWAVES * 64, LDS_BYTES) != hipSuccess || per_cu < 1) fprintf(stderr, "kernel_launch: occupancy query reports %d\n", per_cu);
        (void)hipGetLastError();
        grid = cus;
    }
    if (grid < 0) return;
    if (hipMemsetAsync((char*)d_ws + WS_CTL, 0, CTL_ZERO_BYTES, stream) != hipSuccess) return;
    Args a{};
    for (int i = 0; i < 18; ++i) a.in[i] = (const float*)d_in[i];
    a.out = (float*)d_out; a.ws = (unsigned char*)d_ws;
#if MK_PER_PHASE
    for (int p = 0; p < N_PHASES; ++p) { a.ph_lo = p; a.ph_hi = p + 1; hipLaunchKernelGGL(skel_fwd, dim3(grid), dim3(NWAVES * 64), LDS_BYTES, stream, a); }
#else
    a.ph_lo = 0; a.ph_hi = N_PHASES; hipLaunchKernelGGL(skel_fwd, dim3(grid), dim3(NWAVES * 64), LDS_BYTES, stream, a);
#endif
}
```

```cpp
#include <hip/hip_runtime.h>
#include <hip/hip_bf16.h>
#include <cstdio>
#include <cstdint>
#include <cmath>
namespace pg8 {
#define PG8_LAS __attribute__((address_space(3)))
typedef unsigned short bf16_t;
typedef short bf16x8 __attribute__((ext_vector_type(8)));
typedef float f32x4 __attribute__((ext_vector_type(4)));
typedef unsigned u32x4 __attribute__((ext_vector_type(4)));
typedef int v8i32_t __attribute__((ext_vector_type(8)));
typedef int v4i32_t __attribute__((ext_vector_type(4)));
constexpr int BM = 256, BK = 64, HALF = 128, HTB = HALF * BK * 2  , STAGE_BYTES = 8 * HTB, NXCD = 8, WGM = 8;

__host__ __device__ __forceinline__ int lds_byte(int r, int c) { const int st = (r >> 4) * 2 + (c >> 5), rr = r & 15, cc = c & 31, ob = rr * 64 + cc * 2; return st * 1024 + (ob ^ (((ob >> 9) & 1) << 5)); }
__host__ __device__ __forceinline__ void stage_rc(int b, int& R, int& C) { const int st = b / 1024, sb = b % 1024, swz = sb ^ (((sb >> 9) & 1) << 5); R = (st >> 1) * 16 + swz / 64; C = (st & 1) * 32 + (swz % 64) / 2; }
__host__ __device__ __forceinline__ int perm32(int rho) { const int n = rho >> 4, i = rho & 15; return 8 * (i >> 2) + 4 * n + (i & 3); }

struct Unit { int pm, pn; };
struct Gemm { const bf16_t* A; const bf16_t* Bt; int M, N, K; };

struct StaticOrder {
    int nM, nN, nwg, G, c;
    __host__ __device__ void init(int M, int N, int G_, int c_) { nM = M / BM; nN = N / BM; nwg = nM * nN; G = G_; c = c_; }
    __host__ __device__ bool next(int i, Unit& u) const {
        const long L = (long)i * G + c; if (L >= nwg) return false;
        int wgid = (int)L; { const int q = nwg / NXCD, r = nwg % NXCD, xcd = wgid % NXCD, off = wgid / NXCD; wgid = (xcd < r ? xcd * (q + 1) : r * (q + 1) + (xcd - r) * q) + off; }
        const int nig = WGM * nN, gid = wgid / nig, fm = gid * WGM, gsz = (nM - fm) < WGM ? (nM - fm) : WGM;
        u.pm = fm + ((wgid % nig) % gsz); u.pn = (wgid % nig) / gsz; return true;
    }
    __device__ __forceinline__ void a_ready(const Unit&) const {}
    __device__ __forceinline__ void done(const Unit&) const {}
};

typedef float f32x2c __attribute__((ext_vector_type(2))); typedef __bf16 bf16x2c __attribute__((ext_vector_type(2)));
__device__ __forceinline__ unsigned cvt_pk_bf16(float lo, float hi) { f32x2c v = {lo, hi}; bf16x2c b = __builtin_convertvector(v, bf16x2c); return __builtin_bit_cast(unsigned, b); }
template <int ACT  , bool SCALED = false> struct EpiBf16 {
    static constexpr bool PERM = true, AFTER_DRAIN = false;
    bf16_t* O; int ldc; const float* rstd; float osc = 1.f;
    __device__ __forceinline__ void operator()(const f32x4 (&acc)[2][2][4][2], const Unit& u, int wr, int wc, int fr, int fq) const {
        const int row0 = u.pm * BM + wr * 64 + fr, col0 = u.pn * BM + wc * 32 + 8 * fq;
#pragma unroll
        for (int ai = 0; ai < 2; ++ai)
#pragma unroll
            for (int m = 0; m < 4; ++m) { const int row = row0 + ai * HALF + m * 16; bf16_t* rowp = O + (size_t)row * ldc + col0;
                const float rs = (SCALED ? rstd[row] : 1.f) * osc;
#pragma unroll
                for (int bj = 0; bj < 2; ++bj) { f32x4 v0 = acc[ai][bj][m][0], v1 = acc[ai][bj][m][1];
                    v0 = v0 * rs; v1 = v1 * rs;
                    if (ACT == 2) {
#pragma unroll
                        for (int e = 0; e < 4; ++e) { const float a = fmaxf(v0[e], 0.f), b = fmaxf(v1[e], 0.f); v0[e] = a * a; v1[e] = b * b; } }
                    u32x4 w; w.x = cvt_pk_bf16(v0[0], v0[1]); w.y = cvt_pk_bf16(v0[2], v0[3]); w.z = cvt_pk_bf16(v1[0], v1[1]); w.w = cvt_pk_bf16(v1[2], v1[3]);
                    *(u32x4*)(rowp + bj * HALF) = w; } }
    }
};
template <bool BASE_BF16, bool OUT_BF16, bool Q8 = false> struct EpiRes {
    static constexpr bool PERM = true, AFTER_DRAIN = false;
    const void* base; void* out; float* part; int ldc; float osc = 1.f; unsigned char* o8 = nullptr; const float* ra = nullptr; const float* cmax = nullptr;
    __device__ __forceinline__ void operator()(const f32x4 (&acc)[2][2][4][2], const Unit& u, int wr, int wc, int fr, int fq) const {
        const int col0 = u.pn * BM + wc * 32 + 8 * fq;
        f32x4 cs[2][2];
        if (Q8) {
#pragma unroll
            for (int bj = 0; bj < 2; ++bj) { cs[bj][0] = *(const f32x4*)(cmax + col0 + bj * HALF) * (1.f / 127.f); cs[bj][1] = *(const f32x4*)(cmax + col0 + bj * HALF + 4) * (1.f / 127.f); } }
#pragma unroll
        for (int ai = 0; ai < 2; ++ai)
#pragma unroll
            for (int m = 0; m < 4; ++m) { const int row = u.pm * BM + ai * HALF + wr * 64 + m * 16 + fr; const size_t off = (size_t)row * ldc + col0; float s = 0.f; float rr = 0.f; if (Q8) rr = ra[row];
#pragma unroll
                for (int bj = 0; bj < 2; ++bj) { f32x4 b0, b1;
                    if (BASE_BF16) { const u32x4 w = *(const u32x4*)((const bf16_t*)base + off + bj * HALF);
                        b0 = (f32x4){__uint_as_float(w.x << 16), __uint_as_float(w.x & 0xffff0000u), __uint_as_float(w.y << 16), __uint_as_float(w.y & 0xffff0000u)};
                        b1 = (f32x4){__uint_as_float(w.z << 16), __uint_as_float(w.z & 0xffff0000u), __uint_as_float(w.w << 16), __uint_as_float(w.w & 0xffff0000u)}; }
                    else { b0 = *(const f32x4*)((const float*)base + off + bj * HALF); b1 = *(const f32x4*)((const float*)base + off + bj * HALF + 4); }
                    f32x4 o0, o1;
                    if (Q8) { const v4i32_t i0 = __builtin_bit_cast(v4i32_t, acc[ai][bj][m][0]), i1 = __builtin_bit_cast(v4i32_t, acc[ai][bj][m][1]);
#pragma unroll
                        for (int e = 0; e < 4; ++e) { o0[e] = b0[e] + (float)i0[e] * rr * cs[bj][0][e]; o1[e] = b1[e] + (float)i1[e] * rr * cs[bj][1][e]; } }
                    else { o0 = b0 + acc[ai][bj][m][0] * osc; o1 = b1 + acc[ai][bj][m][1] * osc; }
                    if (o8) { typedef int i32x2 __attribute__((ext_vector_type(2))); i32x2 q; q.x = __builtin_amdgcn_cvt_pk_fp8_f32(o0[0], o0[1], 0, false); q.x = __builtin_amdgcn_cvt_pk_fp8_f32(o0[2], o0[3], q.x, true);
                        q.y = __builtin_amdgcn_cvt_pk_fp8_f32(o1[0], o1[1], 0, false); q.y = __builtin_amdgcn_cvt_pk_fp8_f32(o1[2], o1[3], q.y, true); *(i32x2*)(o8 + off + bj * HALF) = q; }
                    s += ((o0[0] * o0[0] + o0[1] * o0[1]) + (o0[2] * o0[2] + o0[3] * o0[3])) + ((o1[0] * o1[0] + o1[1] * o1[1]) + (o1[2] * o1[2] + o1[3] * o1[3]));
                    if (OUT_BF16) { u32x4 w; w.x = cvt_pk_bf16(o0[0], o0[1]); w.y = cvt_pk_bf16(o0[2], o0[3]); w.z = cvt_pk_bf16(o1[0], o1[1]); w.w = cvt_pk_bf16(o1[2], o1[3]); *(u32x4*)((bf16_t*)out + off + bj * HALF) = w; }
                    else { *(f32x4*)((float*)out + off + bj * HALF) = o0; *(f32x4*)((float*)out + off + bj * HALF + 4) = o1; } }
                if (part) { s += __shfl_xor(s, 16); s += __shfl_xor(s, 32); if (fq == 0) part[(size_t)row * 64 + u.pn * 4 + wc] = s; } }
    }
};
template <int ACT> struct EpiQ8 {
    static constexpr bool PERM = true, AFTER_DRAIN = false;
    bf16_t* O; int ldc; const float* cmax; const float* ra;
    __device__ __forceinline__ void operator()(const f32x4 (&acc)[2][2][4][2], const Unit& u, int wr, int wc, int fr, int fq) const {
        const int row0 = u.pm * BM + wr * 64 + fr, col0 = u.pn * BM + wc * 32 + 8 * fq;
        f32x4 cs[2][2];
#pragma unroll
        for (int bj = 0; bj < 2; ++bj) { cs[bj][0] = *(const f32x4*)(cmax + col0 + bj * HALF) * (1.f / 127.f); cs[bj][1] = *(const f32x4*)(cmax + col0 + bj * HALF + 4) * (1.f / 127.f); }
#pragma unroll
        for (int ai = 0; ai < 2; ++ai)
#pragma unroll
            for (int m = 0; m < 4; ++m) { const int row = row0 + ai * HALF + m * 16; bf16_t* rowp = O + (size_t)row * ldc + col0; const float rr = ra[row];
#pragma unroll
                for (int bj = 0; bj < 2; ++bj) { const v4i32_t i0 = __builtin_bit_cast(v4i32_t, acc[ai][bj][m][0]), i1 = __builtin_bit_cast(v4i32_t, acc[ai][bj][m][1]); f32x4 v0, v1;
#pragma unroll
                    for (int e = 0; e < 4; ++e) { float a = (float)i0[e] * rr * cs[bj][0][e], b = (float)i1[e] * rr * cs[bj][1][e]; if (ACT == 2) { a = fmaxf(a, 0.f); b = fmaxf(b, 0.f); a *= a; b *= b; } v0[e] = a; v1[e] = b; }
                    u32x4 w; w.x = cvt_pk_bf16(v0[0], v0[1]); w.y = cvt_pk_bf16(v0[2], v0[3]); w.z = cvt_pk_bf16(v1[0], v1[1]); w.w = cvt_pk_bf16(v1[2], v1[3]);
                    *(u32x4*)(rowp + bj * HALF) = w; } }
    }
};
template <class Epi, class Sched, bool ALIGN_EPI = false, bool SP2 = false, int QM = 0>
__device__ __forceinline__ void gemm_phase(PG8_LAS unsigned char* lds, const Gemm g, const Sched& S, const Epi& E) {
    const int tid = threadIdx.x, wid = __builtin_amdgcn_readfirstlane(tid >> 6), lane = tid & 63, wr = wid >> 2, wc = wid & 3, fr = lane & 15, fq = lane >> 4;
    constexpr bool F8 = QM == 1, I8 = QM == 2;
    constexpr int ES = QM ? 1 : 2;
    const int K = g.K, nt = K / (QM ? 2 * BK : BK);
    unsigned voffA[2], voffB[2];
#pragma unroll
    for (int i = 0; i < 2; ++i) { int R, C; stage_rc(tid * 16 + i * 8192, R, C); const int Rb = Epi::PERM ? ((R & ~31) + perm32(R & 31)) : R;
        voffA[i] = (unsigned)(R * K * ES + C * 2); voffB[i] = (unsigned)(Rb * K * ES + C * 2); }
    const size_t kstep = (size_t)(BK * 2);
    const size_t hstep = (size_t)HALF * K * ES;
    const size_t tstep = 2 * hstep;
    const unsigned ldsw = (unsigned)wid * 1024u;
    const int aoff = lds_byte(wr * 64 + fr, F8 ? fq * 16 : fq * 8), boff = lds_byte(wc * 32 + fr, F8 ? fq * 16 : fq * 8);
#define PG8_SA(b, h) (((b) * 2 + (h)) * HTB)
#define PG8_SB(b, h) ((4 + (b) * 2 + (h)) * HTB)
#define PG8_STAGE(bufoff, gbase, voff) do { _Pragma("unroll") for (int _i = 0; _i < 2; ++_i) \
        __builtin_amdgcn_global_load_lds((const unsigned*)((const char*)(gbase) + (voff)[_i]), (PG8_LAS unsigned*)(lds + (bufoff) + ldsw + _i * 8192), 16, 0, 0); } while (0)
#define PG8_LDA(dst, b, h) do { if constexpr (F8) { _Pragma("unroll") for (int m = 0; m < 4; ++m) dst##8[m] = *(const PG8_LAS v8i32_t*)(lds + PG8_SA(b, h) + aoff + m * 2048); } \
        else { _Pragma("unroll") for (int m = 0; m < 4; ++m) _Pragma("unroll") for (int k = 0; k < 2; ++k) dst[m][k] = *(const PG8_LAS bf16x8*)(lds + PG8_SA(b, h) + aoff + m * 2048 + k * 1024); } } while (0)
#define PG8_LDB(dst, b, h) do { if constexpr (F8) { _Pragma("unroll") for (int n = 0; n < 2; ++n) dst##8[n] = *(const PG8_LAS v8i32_t*)(lds + PG8_SB(b, h) + boff + n * 2048); } \
        else { _Pragma("unroll") for (int n = 0; n < 2; ++n) _Pragma("unroll") for (int k = 0; k < 2; ++k) dst[n][k] = *(const PG8_LAS bf16x8*)(lds + PG8_SB(b, h) + boff + n * 2048 + k * 1024); } } while (0)
#define PG8_MMA(ai, bj, At, Bt) do { __builtin_amdgcn_s_setprio(1); _Pragma("unroll") for (int m = 0; m < 4; ++m) _Pragma("unroll") for (int n = 0; n < 2; ++n) { \
        if constexpr (F8) asm volatile("v_mfma_scale_f32_16x16x128_f8f6f4 %0, %1, %2, %0, %3, %3 op_sel_hi:[0,0,0]" : "+v"(acc[ai][bj][m][n]) : "v"(Bt##8[n]), "v"(At##8[m]), "v"(scl8));   \
        else if constexpr (I8) { _Pragma("unroll") for (int k = 0; k < 2; ++k) acc[ai][bj][m][n] = __builtin_bit_cast(f32x4, __builtin_amdgcn_mfma_i32_16x16x64_i8(__builtin_bit_cast(v4i32_t, Bt[n][k]), __builtin_bit_cast(v4i32_t, At[m][k]), __builtin_bit_cast(v4i32_t, acc[ai][bj][m][n]), 0, 0, 0)); } \
        else { _Pragma("unroll") for (int k = 0; k < 2; ++k) acc[ai][bj][m][n] = __builtin_amdgcn_mfma_f32_16x16x32_bf16(Bt[n][k], At[m][k], acc[ai][bj][m][n], 0, 0, 0); } } \
        __builtin_amdgcn_s_setprio(0); } while (0)
#define PG8_WAIT_V(n) asm volatile("s_waitcnt vmcnt(" #n ")" ::: "memory")
#define PG8_WAIT_L(n) asm volatile("s_waitcnt lgkmcnt(" #n ")" ::: "memory")
#define PG8_BAR __builtin_amdgcn_s_barrier()
#define PG8_SCHED __builtin_amdgcn_sched_barrier(0)
    Unit cur, nxt; int ui = 0;
    if (!S.next(0, cur)) return;
    f32x4 acc[2][2][4][2];
#pragma unroll
    for (int a = 0; a < 2; ++a)
#pragma unroll
        for (int b = 0; b < 2; ++b)
#pragma unroll
            for (int m = 0; m < 4; ++m)
#pragma unroll
                for (int n = 0; n < 2; ++n) acc[a][b][m][n] = (f32x4){0.f, 0.f, 0.f, 0.f};
    bf16x8 At[4][2], B0[2][2], B1[2][2]; v8i32_t At8[4], B08[2], B18[2];
    int scl8 = 0x7F7F7F7F; asm volatile("" : "+v"(scl8));
    const char* cA = (const char*)g.A + (size_t)cur.pm * tstep; const char* cB = (const char*)g.Bt + (size_t)cur.pn * tstep;
    S.a_ready(cur);
    if constexpr (SP2) {
        PG8_STAGE(PG8_SB(0, 0), cB, voffB); PG8_STAGE(PG8_SB(0, 1), cB + hstep, voffB); PG8_STAGE(PG8_SA(0, 0), cA, voffA); PG8_STAGE(PG8_SA(0, 1), cA + hstep, voffA);
        if (wr == 1) PG8_BAR;
        PG8_WAIT_V(2); PG8_BAR;
        PG8_STAGE(PG8_SB(1, 0), cB + kstep, voffB); PG8_STAGE(PG8_SA(1, 0), cA + kstep, voffA); PG8_STAGE(PG8_SB(1, 1), cB + hstep + kstep, voffB);
        PG8_WAIT_V(6); PG8_BAR;
    } else {
        PG8_STAGE(PG8_SB(0, 0), cB, voffB); PG8_STAGE(PG8_SA(0, 0), cA, voffA); PG8_STAGE(PG8_SB(0, 1), cB + hstep, voffB); PG8_STAGE(PG8_SA(0, 1), cA + hstep, voffA);
        if (wr == 1) PG8_BAR;
        PG8_WAIT_V(4); PG8_BAR;
        PG8_STAGE(PG8_SB(1, 0), cB + kstep, voffB); PG8_STAGE(PG8_SA(1, 0), cA + kstep, voffA); PG8_STAGE(PG8_SB(1, 1), cB + hstep + kstep, voffB);
        PG8_WAIT_V(6); PG8_BAR;
    }
    for (;;) {
        const bool has_next = S.next(ui + 1, nxt);
        const char* nA = has_next ? (const char*)g.A + (size_t)nxt.pm * tstep : cA; const char* nB = has_next ? (const char*)g.Bt + (size_t)nxt.pn * tstep : cB;
        for (int t = 0; t < nt; t += 2) {
            const bool last = (t == nt - 2);
            const char* a1 = cA + (size_t)(t + 1) * kstep;
            const char* a2 = last ? nA : cA + (size_t)(t + 2) * kstep; const char* b2 = last ? nB : cB + (size_t)(t + 2) * kstep;
            const char* a3 = a2 + kstep; const char* b3 = b2 + kstep;
            if (last && has_next) S.a_ready(nxt);
            if constexpr (SP2) {
            PG8_LDB(B0, 0, 0); PG8_LDB(B1, 0, 1); PG8_SCHED; PG8_LDA(At, 0, 0); PG8_STAGE(PG8_SA(1, 1), a1 + hstep, voffA);
            PG8_WAIT_V(8); PG8_WAIT_L(0); PG8_BAR; PG8_MMA(0, 0, At, B0); PG8_MMA(0, 1, At, B1); PG8_BAR; PG8_SCHED;
            PG8_LDA(At, 0, 1); PG8_STAGE(PG8_SB(0, 0), b2, voffB); PG8_STAGE(PG8_SB(0, 1), b2 + hstep, voffB); PG8_STAGE(PG8_SA(0, 0), a2, voffA);
            PG8_WAIT_V(8); PG8_WAIT_L(0); PG8_BAR; PG8_MMA(1, 0, At, B0); PG8_MMA(1, 1, At, B1); PG8_BAR; PG8_SCHED;
            PG8_LDB(B0, 1, 0); PG8_LDB(B1, 1, 1); PG8_SCHED; PG8_LDA(At, 1, 0); PG8_STAGE(PG8_SA(0, 1), a2 + hstep, voffA);
            PG8_WAIT_V(8); PG8_WAIT_L(0); PG8_BAR; PG8_MMA(0, 0, At, B0); PG8_MMA(0, 1, At, B1); PG8_BAR; PG8_SCHED;
            PG8_LDA(At, 1, 1); PG8_STAGE(PG8_SB(1, 0), b3, voffB); PG8_STAGE(PG8_SB(1, 1), b3 + hstep, voffB); PG8_STAGE(PG8_SA(1, 0), a3, voffA);
            PG8_WAIT_V(8); PG8_WAIT_L(0); PG8_BAR; PG8_MMA(1, 0, At, B0); PG8_MMA(1, 1, At, B1); PG8_BAR; PG8_SCHED;
            } else {
            PG8_LDB(B0, 0, 0); PG8_SCHED; PG8_LDA(At, 0, 0); PG8_STAGE(PG8_SA(1, 1), a1 + hstep, voffA);
            PG8_WAIT_L(8); PG8_BAR; PG8_WAIT_L(0); PG8_MMA(0, 0, At, B0); PG8_BAR; PG8_SCHED;
            PG8_LDB(B1, 0, 1); PG8_STAGE(PG8_SB(0, 0), b2, voffB);
            PG8_BAR; PG8_WAIT_L(0); PG8_MMA(0, 1, At, B1); PG8_BAR;
            PG8_LDA(At, 0, 1); PG8_STAGE(PG8_SA(0, 0), a2, voffA);
            PG8_BAR; PG8_WAIT_L(0); PG8_MMA(1, 0, At, B0); PG8_BAR; PG8_SCHED;
            PG8_STAGE(PG8_SB(0, 1), b2 + hstep, voffB);
            PG8_WAIT_V(6); PG8_BAR; PG8_MMA(1, 1, At, B1); PG8_BAR;
            PG8_LDB(B0, 1, 0); PG8_SCHED; PG8_LDA(At, 1, 0); PG8_STAGE(PG8_SA(0, 1), a2 + hstep, voffA);
            PG8_WAIT_L(8); PG8_BAR; PG8_WAIT_L(0); PG8_MMA(0, 0, At, B0); PG8_BAR; PG8_SCHED;
            PG8_LDB(B1, 1, 1); PG8_STAGE(PG8_SB(1, 0), b3, voffB);
            PG8_BAR; PG8_WAIT_L(0); PG8_MMA(0, 1, At, B1); PG8_BAR;
            PG8_LDA(At, 1, 1); PG8_STAGE(PG8_SA(1, 0), a3, voffA);
            PG8_BAR; PG8_WAIT_L(0); PG8_MMA(1, 0, At, B0); PG8_BAR; PG8_SCHED;
            PG8_STAGE(PG8_SB(1, 1), b3 + hstep, voffB);
            PG8_WAIT_V(6); PG8_BAR; PG8_MMA(1, 1, At, B1); PG8_BAR;
            }
        }
        if constexpr (F8) { asm volatile("s_nop 15\n\ts_nop 15" ::: "memory"); PG8_SCHED; }
        if constexpr (ALIGN_EPI) { if (wr == 0) PG8_BAR; }
        if constexpr (!Epi::AFTER_DRAIN) { E(acc, cur, wr, wc, fr, fq); S.done(cur); }
        if (!has_next) break;
#pragma unroll
        for (int a = 0; a < 2; ++a)
#pragma unroll
            for (int b = 0; b < 2; ++b)
#pragma unroll
                for (int m = 0; m < 4; ++m)
#pragma unroll
                    for (int n = 0; n < 2; ++n) acc[a][b][m][n] = (f32x4){0.f, 0.f, 0.f, 0.f};
        cur = nxt; cA = nA; cB = nB; ++ui;
        if constexpr (ALIGN_EPI) { if (wr == 1) PG8_BAR; }
    }
    PG8_WAIT_V(0);
    if constexpr (!ALIGN_EPI) { if (wr == 0) PG8_BAR; }
    PG8_BAR;
    if constexpr (Epi::AFTER_DRAIN) { E.fused(acc, cur, wr, wc, fr, fq, lds, wid, lane); S.done(cur); }
#undef PG8_SA
#undef PG8_SB
#undef PG8_STAGE
#undef PG8_LDA
#undef PG8_LDB
#undef PG8_MMA
#undef PG8_WAIT_V
#undef PG8_WAIT_L
#undef PG8_BAR
#undef PG8_SCHED
}
}
#define GAS __attribute__((address_space(1)))
#define LAS __attribute__((address_space(3)))
typedef unsigned short bf16;
typedef unsigned v4u __attribute__((ext_vector_type(4)));
typedef float f32x4 __attribute__((ext_vector_type(4)));
typedef short bf16x8 __attribute__((ext_vector_type(8)));
typedef GAS unsigned gu32;
typedef GAS unsigned long long gu64;
#define RLX_AGENT __ATOMIC_RELAXED, __HIP_MEMORY_SCOPE_AGENT
#define LDS_WAIT() asm volatile("s_waitcnt lgkmcnt(0)" ::: "memory")
#define VM_WAIT() asm volatile("s_waitcnt vmcnt(0)" ::: "memory")
__device__ __forceinline__ unsigned long long rt() { return __builtin_amdgcn_s_memrealtime(); }

#define XB_TMO      128
#define XB_XCNT(j)  (256  + 64 * (j))
#define XB_XSUB(j)  (1280 + 64 * (j))
#define XB_XGEN(j)  (2304 + 64 * (j))
#define XB_TOP      3328
#define XB_TOPGEN   3392
#define XCD_BAR_WORDS 3456
#define XB_SPIN_CAP (1u << 18)

__device__ __forceinline__ unsigned xb_ld(unsigned* p)              { return __hip_atomic_load(p, __ATOMIC_RELAXED, __HIP_MEMORY_SCOPE_AGENT); }
__device__ __forceinline__ unsigned xb_add(unsigned* p, unsigned v) { return __hip_atomic_fetch_add(p, v, __ATOMIC_RELAXED, __HIP_MEMORY_SCOPE_AGENT); }
__device__ __forceinline__ unsigned xb_xcc_id() { return (unsigned)__builtin_amdgcn_s_getreg((3 << 11) | 20) & 0xFu; }
#define XB_SPIN(cond, bar) do { unsigned _sp = 0; while (cond) { __builtin_amdgcn_s_sleep(1); \
    if ((++_sp & 255u) == 0u) { if (xb_ld(&(bar)[XB_TMO])) break; if (_sp > XB_SPIN_CAP) { atomicAdd(&(bar)[XB_TMO], 1u); break; } } } } while (0)

struct XcdBarrier {
    unsigned* bar; unsigned x;
    volatile LAS unsigned* st;
};

__device__ __forceinline__ XcdBarrier xcd_barrier_post(unsigned* bar, volatile LAS unsigned* st) {
    XcdBarrier b; b.bar = bar; b.x = xb_xcc_id(); b.st = st;
    if (threadIdx.x == 0) (void)xb_add(&bar[XB_XCNT(b.x)], 1u);
    return b;
}
__device__ __forceinline__ void xcd_barrier_complete(unsigned* bar, unsigned x, unsigned& nloc, unsigned& nx) {
    const unsigned G = gridDim.x * gridDim.y * gridDim.z;
    unsigned sum, cnt, mine, sp = 0u;
    for (;;) {
        sum = 0u; cnt = 0u; mine = 0u;
#pragma unroll
        for (unsigned j = 0; j < 16; ++j) { const unsigned c = xb_ld(&bar[XB_XCNT(j)]); sum += c; cnt += (c > 0u) ? 1u : 0u; mine = (j == x) ? c : mine; }
        if (sum == G) break;
        __builtin_amdgcn_s_sleep(1);
        if ((++sp & 255u) == 0u) { if (xb_ld(&bar[XB_TMO])) break; if (sp > XB_SPIN_CAP) { atomicAdd(&bar[XB_TMO], 1u); break; } }
    }
    nloc = mine > 0u ? mine : 1u; nx = cnt > 0u ? cnt : 1u;
}

__device__ __forceinline__ void xcd_barrier(const XcdBarrier& b) {
    asm volatile("s_waitcnt vmcnt(0)" ::: "memory");
    __syncthreads();
    if (threadIdx.x == 0) {
        unsigned* bar = b.bar;
        __builtin_amdgcn_s_waitcnt(0);
        unsigned nloc = b.st[0], nx = b.st[1];
        if (nloc == 0u) { xcd_barrier_complete(bar, b.x, nloc, nx); b.st[0] = nloc; b.st[1] = nx; }
        const unsigned old = xb_add(&bar[XB_XSUB(b.x)], 1u);
        const unsigned gen = old / nloc;
        if (old + 1u == (gen + 1u) * nloc) {
            __builtin_amdgcn_fence(__ATOMIC_RELEASE, "agent");
            asm volatile("s_waitcnt vmcnt(0)" ::: "memory");
            const unsigned og = xb_add(&bar[XB_TOP], 1u);
            const unsigned tg = og / nx;
            if (og + 1u == (tg + 1u) * nx) xb_add(&bar[XB_TOPGEN], 1u);
            else XB_SPIN(xb_ld(&bar[XB_TOPGEN]) == tg, bar);
            __builtin_amdgcn_fence(__ATOMIC_ACQUIRE, "agent");
            xb_add(&bar[XB_XGEN(b.x)], 1u);
            asm volatile("s_waitcnt vmcnt(0)" ::: "memory");
        } else {
            XB_SPIN(xb_ld(&bar[XB_XGEN(b.x)]) == gen, bar);
            __builtin_amdgcn_fence(__ATOMIC_ACQUIRE, "agent");
            asm volatile("s_waitcnt vmcnt(0)" ::: "memory");
        }
    }
    __syncthreads();
}

constexpr int NWAVES = 8;
#ifndef MK_PER_PHASE
#define MK_PER_PHASE 0
#endif
constexpr int N_PHASES = 17;
constexpr int BATCH = 2, SEQ = 4096, DM = 4096, MTOK = BATCH * SEQ, DFF = 16384;
constexpr int MH = 8, MDK = 256, MDV = 512, M_MAIN = 12288, M_IN = 12304;
constexpr int NKVQ = 7168, NQG = 4192, KVW = 3072;
constexpr float EPS = 1e-6f;
#ifndef Q8_UP_MASK
#define Q8_STRIPS 1
#define Q8_KVQ 1
#define Q8_WMO 1
#define Q8_UP_MASK 3
#endif
constexpr float ATT_SCALE = 0.08838834764831845f;

constexpr size_t MiB = 1u << 20;
constexpr size_t WS_CTL = 0, CTL_CMAX = 65536  , CTL_ZERO_BYTES = 65536 + 4 * 16384 * 4;
constexpr size_t WS_WG1 = 1 * MiB, WS_WG2 = 2 * MiB, WS_W2C = 3 * MiB, WS_POSB = 3 * MiB + 512 * 1024, WS_POSP = 3 * MiB + 640 * 1024;
constexpr size_t WS_LI = 4 * MiB, WS_LF = 4 * MiB + 512 * 1024, WS_GT = 5 * MiB, WS_HC = 8 * MiB, WS_KC = 12 * MiB, WS_VC = 12 * MiB + 512 * 1024, WS_SELM = 13 * MiB;
constexpr size_t WS_WIN = 16 * MiB, WS_WMO = 112 * MiB, WS_WUP0 = 144 * MiB, WS_WDN0 = 272 * MiB, WS_WKVQ = 400 * MiB, WS_W1C = 456 * MiB, WS_WNO = 464 * MiB, WS_WUP1 = 496 * MiB, WS_WDN1 = 624 * MiB;
constexpr size_t WS_XB = 752 * MiB, WS_A3 = 816 * MiB, WS_HR = 880 * MiB, WS_X1 = 944 * MiB, WS_X2 = 1008 * MiB, WS_BIG = 1200 * MiB, WS_AOF = 1328 * MiB, WS_WUPQ0 = 1456 * MiB, WS_WUPQ1 = 1520 * MiB  , WS_XQ = 1584 * MiB  , WS_WKVQ8 = 1616 * MiB  , WS_WMOQ = 1644 * MiB  , WS_END = 1660 * MiB;
constexpr int CW_BAR = 4096;
constexpr int CW_QHEAD = 16384;
constexpr size_t WS_PART = 13 * MiB, WS_RS = 15 * MiB;

constexpr int RING_OFF = 0, RING_BYTES = 147456;
constexpr int LDSCTL_OFF = RING_BYTES, MISC_OFF = LDSCTL_OFF + 320;
constexpr int LDS_BYTES = 159744;
static_assert(MISC_OFF + 128 <= LDS_BYTES, "LDS map");

typedef float f32x16 __attribute__((ext_vector_type(16)));
typedef short s16x4 __attribute__((ext_vector_type(4)));
typedef float f32x2v __attribute__((ext_vector_type(2)));

struct Frame {
    LAS unsigned char* lds;
    volatile LAS unsigned* MISC;
    gu32* ctl;
    int tid, lane, wave, G;
    const float* in[18]; float* out; unsigned char* ws;
};

__device__ __forceinline__ float wave_sum(float v) {
#pragma unroll
    for (int o = 1; o < 64; o <<= 1) v += __shfl_xor(v, o);
    return v;
}
typedef float f32x2_t __attribute__((ext_vector_type(2))); typedef __bf16 bf16x2_t __attribute__((ext_vector_type(2)));
__device__ __forceinline__ unsigned pk2(float lo, float hi) { f32x2_t v = {lo, hi}; bf16x2_t b = __builtin_convertvector(v, bf16x2_t); return __builtin_bit_cast(unsigned, b); }
__device__ __forceinline__ float bf_lo(unsigned w) { return __uint_as_float(w << 16); }
__device__ __forceinline__ float bf_hi(unsigned w) { return __uint_as_float(w & 0xffff0000u); }
__device__ __forceinline__ float bf1(unsigned short h) { return __uint_as_float(((unsigned)h) << 16); }
__device__ __forceinline__ unsigned short f2bf1(float f) { return (unsigned short)(pk2(f, 0.f) & 0xffffu); }
__device__ __forceinline__ f32x4 mfma16(bf16x8 a, bf16x8 b, f32x4 c) { return __builtin_amdgcn_mfma_f32_16x16x32_bf16(a, b, c, 0, 0, 0); }
typedef short v4i16_t __attribute__((ext_vector_type(4)));
__device__ __forceinline__ s16x4 tr16(const LAS unsigned char* p) { return __builtin_bit_cast(s16x4, __builtin_amdgcn_ds_read_tr16_b64_v4i16((LAS v4i16_t*)p)); }
__device__ __forceinline__ bf16x8 cat8(s16x4 lo, s16x4 hi) { return (bf16x8){lo[0], lo[1], lo[2], lo[3], hi[0], hi[1], hi[2], hi[3]}; }

__device__ __forceinline__ void tr_item(const float* W, int K, int ldw, int col0, int ncols, const float* gain, float cscale, int cs_lo, int cs_hi, bf16* WT, int row_off, LAS float* scr, int item, int lane) {
    const int nblk = (ncols + 31) / 32, kb = item / nblk, nb = item % nblk, k0 = 64 * kb, n0 = 32 * nb;
    const int nn = n0 + (lane & 31); const bool nok = nn < ncols; const float cs = (nn >= cs_lo && nn < cs_hi) ? cscale : 1.f;
#pragma unroll 8
    for (int i = 0; i < 32; ++i) { const int kk = 2 * i + (lane >> 5);
        float v = nok ? W[(size_t)(k0 + kk) * ldw + col0 + nn] : 0.f;
        if (gain) v *= gain[k0 + kk];
        scr[kk * 33 + (lane & 31)] = v * cs; }
    LDS_WAIT(); asm volatile("" ::: "memory");
    const int c = lane & 7;
#pragma unroll
    for (int j = 0; j < 4; ++j) { const int n = (lane >> 3) + 8 * j; const LAS float* s = scr + (8 * c) * 33 + n;
        v4u o; o.x = pk2(s[0 * 33], s[1 * 33]); o.y = pk2(s[2 * 33], s[3 * 33]); o.z = pk2(s[4 * 33], s[5 * 33]); o.w = pk2(s[6 * 33], s[7 * 33]);
        if (n0 + n < ncols) *(GAS v4u*)(WT + (size_t)(row_off + n0 + n) * K + k0 + 8 * c) = o; }
    LDS_WAIT(); asm volatile("" ::: "memory");
}
struct CvJob { const float* W; const float* gain; bf16* WT; int K, ldw, col0, ncols, row_off, cs_lo, cs_hi, r, f8; float cscale, osc; unsigned* cmax; };
__device__ __forceinline__ void cv_load(const CvJob& J, f32x4 (&v)[16], float (&gk)[16], int lane) {
    const int nblk = J.ncols >> 6, kb = J.r / nblk, nb = J.r - kb * nblk, k0 = 64 * kb, n0 = 64 * nb;
    const float* src = J.W + (size_t)(k0 + (lane >> 4)) * J.ldw + J.col0 + n0 + 4 * (lane & 15);
    const float* gp = J.gain ? J.gain : J.W;
    const float gmul = J.gain ? 1.f : 0.f, gadd = J.gain ? 0.f : 1.f;
#pragma unroll
    for (int i = 0; i < 16; ++i) { const float g = gp[k0 + 4 * i + (lane >> 4)]; gk[i] = fmaf(g, gmul, gadd); }
#pragma unroll
    for (int i = 0; i < 16; ++i) v[i] = __builtin_nontemporal_load((const GAS f32x4*)(src + (size_t)(4 * i) * J.ldw));
}
__device__ __forceinline__ void cv_store(const CvJob& J, f32x4 (&v)[16], const float (&gkv)[16], LAS unsigned char* scr, int lane) {
    const int nblk = J.ncols >> 6, kb = J.r / nblk, nb = J.r - kb * nblk, k0 = 64 * kb, n0 = 64 * nb;
    const int c = lane & 15, kr = lane >> 4;
    const float cs = ((n0 >= J.cs_lo && n0 < J.cs_hi) ? J.cscale : 1.f) * J.osc;
    f32x4 cm = {0.f, 0.f, 0.f, 0.f};
#pragma unroll
    for (int i = 0; i < 16; ++i) { const float gk = gkv[i] * cs; const f32x4 x = v[i] * gk; cm = __builtin_elementwise_max(cm, __builtin_elementwise_abs(x));
        typedef unsigned u32x2_t __attribute__((ext_vector_type(2)));
        u32x2_t w; w.x = pk2(x.x, x.y); w.y = pk2(x.z, x.w);
        *(LAS u32x2_t*)(scr + (4 * i + kr) * 136 + c * 8) = w; }
    if (J.cmax) {
#pragma unroll
        for (int e = 0; e < 4; ++e) { float m_ = cm[e]; m_ = fmaxf(m_, __shfl_xor(m_, 16)); m_ = fmaxf(m_, __shfl_xor(m_, 32)); if (kr == 0) atomicMax(J.cmax + n0 + 4 * c + e, __float_as_uint(m_)); } }
    LDS_WAIT(); asm volatile("" ::: "memory");
    const int g = lane >> 4, i16 = lane & 15, j = i16 >> 2, q = i16 & 3;
#pragma unroll
    for (int it = 0; it < 8; ++it) { const int nbk = it >> 1, kb8 = (it & 1) * 4 + g;
        const LAS unsigned char* a = scr + (kb8 * 8 + j) * 136 + (nbk * 16 + 4 * q) * 2;
        const bf16x8 o = cat8(tr16(a), tr16(a + 4 * 136));
        if (J.f8) { const v4u w = __builtin_bit_cast(v4u, o); typedef int i32x2 __attribute__((ext_vector_type(2))); i32x2 q;
            q.x = __builtin_amdgcn_cvt_pk_fp8_f32(bf_lo(w.x), bf_hi(w.x), 0, false); q.x = __builtin_amdgcn_cvt_pk_fp8_f32(bf_lo(w.y), bf_hi(w.y), q.x, true);
            q.y = __builtin_amdgcn_cvt_pk_fp8_f32(bf_lo(w.z), bf_hi(w.z), 0, false); q.y = __builtin_amdgcn_cvt_pk_fp8_f32(bf_lo(w.w), bf_hi(w.w), q.y, true);
            *(GAS i32x2*)((unsigned char*)J.WT + (size_t)(J.row_off + n0 + nbk * 16 + i16) * J.K + k0 + kb8 * 8) = q; }
        else __builtin_nontemporal_store(o, (GAS bf16x8*)(J.WT + (size_t)(J.row_off + n0 + nbk * 16 + i16) * J.K + k0 + kb8 * 8)); }
    LDS_WAIT(); asm volatile("" ::: "memory");
}
__device__ __forceinline__ void rownorm_row(const float* xrow, bf16* orow, int lane) {
    const GAS f32x4* xr = (const GAS f32x4*)xrow + lane;
    f32x4 v[16]; float s = 0.f;
#pragma unroll
    for (int j = 0; j < 16; ++j) { v[j] = xr[64 * j]; s += (v[j].x * v[j].x + v[j].y * v[j].y) + (v[j].z * v[j].z + v[j].w * v[j].w); }
    const float rstd = 1.f / sqrtf(wave_sum(s) * (1.f / DM) + EPS);
    GAS unsigned long long* o8 = (GAS unsigned long long*)orow + lane;
#pragma unroll
    for (int j = 0; j < 16; ++j) o8[64 * j] = (unsigned long long)pk2(v[j].x * rstd, v[j].y * rstd) | ((unsigned long long)pk2(v[j].z * rstd, v[j].w * rstd) << 32);
}
__device__ __forceinline__ void rownorm_phase(Frame& F, const float* src, bf16* dst) {
    const int gw = blockIdx.x * NWAVES + F.wave, NGW = F.G * NWAVES;
    for (int m = gw; m < MTOK; m += NGW) rownorm_row(src + (size_t)m * DM, dst + (size_t)m * DM, F.lane);
}

constexpr int CW_0 = 64 * 192, CW_2 = Q8_STRIPS ? 0 : 64 * 64, CW_3 = Q8_STRIPS ? 0 : 64 * 256, CW_4 = 256 * 64, CW_5 = Q8_STRIPS ? 0 : 64 * 48, CW_6 = Q8_STRIPS ? 0 : 64 * 64, CW_8 = 64 * 8, CW_9 = 64 * 8, CW_10 = 16, CW_11 = 16, CW_12 = 64 * 64, CW_13 = Q8_STRIPS ? 0 : 64 * 256, CW_14 = 256 * 64;
constexpr int CW_EARLY = CW_0, CW_TOTAL = CW_0 + CW_2 + CW_3 + CW_4 + CW_5 + CW_6 + CW_8 + CW_9 + CW_10 + CW_11 + CW_12 + CW_13 + CW_14;
__device__ __forceinline__ CvJob cv_decode(Frame& F, int it) {
    unsigned char* ws = F.ws; CvJob J; J.gain = nullptr; J.row_off = 0; J.cs_lo = 0; J.cs_hi = 0; J.cscale = 1.f; J.col0 = 0; J.f8 = 0; J.osc = 1.f; J.cmax = nullptr; int r = it;
    if (r < CW_0) { J.W = F.in[3]; J.K = 4096; J.ldw = M_IN; J.ncols = M_MAIN; J.gain = F.in[1]; J.cscale = 0.0625f; J.cs_lo = 2048; J.cs_hi = 4096; J.WT = (bf16*)(ws + WS_WIN); }
    else if ((r -= CW_0) < CW_2) { J.W = F.in[6]; J.K = 4096; J.ldw = 4096; J.ncols = 4096; J.gain = F.in[5]; J.WT = (bf16*)(ws + WS_WMO); if (Q8_WMO) J.cmax = (unsigned*)(ws + CTL_CMAX) + 49152; }
    else if ((r -= CW_2) < CW_3) { J.W = F.in[16]; J.K = 4096; J.ldw = DFF; J.ncols = DFF; J.gain = F.in[2]; J.WT = (bf16*)(ws + WS_WUP0); if (Q8_UP_MASK & 1) J.cmax = (unsigned*)(ws + CTL_CMAX); }
    else if ((r -= CW_3) < CW_4) { J.W = F.in[17]; J.K = DFF; J.ldw = 4096; J.ncols = 4096; J.WT = (bf16*)(ws + WS_WDN0); }
    else if ((r -= CW_4) < CW_5) { J.W = F.in[8]; J.K = 4096; J.ldw = KVW; J.ncols = KVW; J.gain = F.in[7]; J.WT = (bf16*)(ws + WS_WKVQ); if (Q8_KVQ) J.cmax = (unsigned*)(ws + CTL_CMAX) + 32768; else { J.f8 = 1; J.osc = 256.f; } }
    else if ((r -= CW_5) < CW_6) { J.W = F.in[13]; J.K = 4096; J.ldw = NQG; J.ncols = 4096; J.gain = F.in[1] + 4096; J.WT = (bf16*)(ws + WS_WKVQ); J.row_off = KVW; if (Q8_KVQ) J.cmax = (unsigned*)(ws + CTL_CMAX) + 32768 + KVW; else { J.f8 = 1; J.osc = 256.f; } }
    else if ((r -= CW_6) < CW_8) { J.W = F.in[11]; J.K = 4096; J.ldw = 512; J.ncols = 512; J.WT = (bf16*)(ws + WS_W1C); }
    else if ((r -= CW_8) < CW_9) { J.W = F.in[11] + (size_t)4096 * 512; J.K = 4096; J.ldw = 512; J.ncols = 512; J.WT = (bf16*)(ws + WS_W1C) + (size_t)512 * 4096; }
    else if ((r -= CW_9) < CW_10) { J.W = F.in[12]; J.K = 512; J.ldw = 128; J.ncols = 128; J.WT = (bf16*)(ws + WS_W2C); }
    else if ((r -= CW_10) < CW_11) { J.W = F.in[12] + (size_t)512 * 128; J.K = 512; J.ldw = 128; J.ncols = 128; J.WT = (bf16*)(ws + WS_W2C) + (size_t)128 * 512; }
    else if ((r -= CW_11) < CW_12) { J.W = F.in[15]; J.K = 4096; J.ldw = 4096; J.ncols = 4096; J.WT = (bf16*)(ws + WS_WNO); J.f8 = 1; J.osc = 256.f; }
    else if ((r -= CW_12) < CW_13) { J.W = F.in[16] + (size_t)4096 * DFF; J.K = 4096; J.ldw = DFF; J.ncols = DFF; J.gain = F.in[2] + 4096; J.WT = (bf16*)(ws + WS_WUP1); if (Q8_UP_MASK & 2) J.cmax = (unsigned*)(ws + CTL_CMAX) + 16384; }
    else { r -= CW_13; J.W = F.in[17] + (size_t)DFF * 4096; J.K = DFF; J.ldw = 4096; J.ncols = 4096; J.WT = (bf16*)(ws + WS_WDN1); }
    J.r = r; return J;
}
__device__ __forceinline__ void convert_wide(Frame& F, int lo, int hi, int worker, int nworkers) {
    LAS unsigned char* scr = F.lds + RING_OFF + F.wave * 16384;
    int it = lo + worker; if (it >= hi) return;
    f32x4 va[16], vb[16]; float ga[16], gb[16]; CvJob ja = cv_decode(F, it), jb = ja;
    cv_load(ja, va, ga, F.lane);
    for (;;) {
        const int itb = it + nworkers; const bool hb = itb < hi;
        if (hb) { jb = cv_decode(F, itb); cv_load(jb, vb, gb, F.lane); }
        cv_store(ja, va, ga, scr, F.lane);
        if (!hb) break;
        const int ita = itb + nworkers; const bool ha = ita < hi;
        if (ha) { ja = cv_decode(F, ita); cv_load(ja, va, ga, F.lane); }
        cv_store(jb, vb, gb, scr, F.lane);
        if (!ha) break;
        it = ita;
    }
}
struct CvQ { gu32* head; int lo, hi, cur, end; };
__device__ __forceinline__ int cvq_next(CvQ& Q, int lane) {
    if (Q.cur == Q.end) { unsigned v = 0u; if (lane == 0) v = __hip_atomic_fetch_add(Q.head, 8u, RLX_AGENT);
        Q.cur = Q.lo + __builtin_amdgcn_readfirstlane((int)v); Q.end = Q.cur + 8 < Q.hi ? Q.cur + 8 : Q.hi; if (Q.cur >= Q.hi) { Q.cur = Q.end = Q.hi; return Q.hi; } }
    return Q.cur++;
}
__device__ __forceinline__ void convert_queue(Frame& F, int lo, int hi, gu32* head) {
    LAS unsigned char* scr = F.lds + RING_OFF + F.wave * 16384;
    CvQ Q{head, lo, hi, 0, 0};
    int it = cvq_next(Q, F.lane); if (it >= hi) return;
    f32x4 va[16], vb[16]; float ga[16], gb[16]; CvJob ja = cv_decode(F, it), jb = ja;
    cv_load(ja, va, ga, F.lane);
    for (;;) {
        const int itb = cvq_next(Q, F.lane); const bool hb = itb < hi;
        if (hb) { jb = cv_decode(F, itb); cv_load(jb, vb, gb, F.lane); }
        cv_store(ja, va, ga, scr, F.lane);
        if (!hb) break;
        const int ita = cvq_next(Q, F.lane); const bool ha = ita < hi;
        if (ha) { ja = cv_decode(F, ita); cv_load(ja, va, ga, F.lane); }
        cv_store(jb, vb, gb, scr, F.lane);
        if (!ha) break;
    }
}
__device__ __forceinline__ void convert_narrow(Frame& F, int lo, int hi, int worker, int nworkers) {
    LAS float* scr = (LAS float*)(F.lds + RING_OFF + F.wave * 16384);
    for (int it = lo + worker; it < hi; it += nworkers) {
        if (it < 64) tr_item(F.in[3], 4096, M_IN, M_MAIN, 16, F.in[1], 1.f, 0, 0, (bf16*)(F.ws + WS_WG1), 0, scr, it, F.lane);
        else tr_item(F.in[13], 4096, NQG, 4096, 96, F.in[1] + 4096, 1.f, 0, 0, (bf16*)(F.ws + WS_WG2), 0, scr, it - 64, F.lane);
    }
}
__device__ __forceinline__ void p0_prologue(Frame& F) {
    const int gw = blockIdx.x * NWAVES + F.wave, NGW = F.G * NWAVES;
    unsigned char* ws = F.ws;
    { float* pp = (float*)(ws + WS_POSP);
      for (int task = gw; task < 512; task += NGW) { const int j = task >> 8, nbk = (task >> 5) & 7, ch = task & 31, n = nbk * 64 + F.lane;
          const float* pos = F.in[10] + (size_t)j * 4096 + ch * 128; const float* w1 = F.in[11] + ((size_t)j * 4096 + ch * 128) * 512 + n;
          float a0 = 0.f, a1 = 0.f, a2 = 0.f, a3 = 0.f;
#pragma unroll 4
          for (int kk = 0; kk < 128; kk += 4) { a0 += pos[kk] * w1[(size_t)kk * 512]; a1 += pos[kk + 1] * w1[(size_t)(kk + 1) * 512]; a2 += pos[kk + 2] * w1[(size_t)(kk + 2) * 512]; a3 += pos[kk + 3] * w1[(size_t)(kk + 3) * 512]; }
          pp[ch * 1024 + j * 512 + n] = (a0 + a1) + (a2 + a3); } }
    convert_wide(F, 0, CW_EARLY, gw, NGW); convert_narrow(F, 0, 64, gw, NGW);
    rownorm_phase(F, F.in[0], (bf16*)(ws + WS_XB));
}

__device__ __forceinline__ unsigned q8_pack4(float a, float b, float c, float d, float sc) {
    const float M = 12582912.f;
    const unsigned ya = __float_as_uint(fmaf(a, sc, M)), yb = __float_as_uint(fmaf(b, sc, M)), yc = __float_as_uint(fmaf(c, sc, M)), yd = __float_as_uint(fmaf(d, sc, M));
    return __builtin_amdgcn_perm(yb, ya, 0x0c0c0400u) | __builtin_amdgcn_perm(yd, yc, 0x04000c0cu);
}
__device__ __forceinline__ float quant_row(const bf16* src, unsigned char* dst, float sc, int lane) {
    v4u w[8]; float am = 0.f;
#pragma unroll
    for (int i = 0; i < 8; ++i) { w[i] = *(const v4u*)(src + (i * 64 + lane) * 8);
        am = fmaxf(fmaxf(fmaxf(am, fmaxf(fabsf(bf_lo(w[i].x)), fabsf(bf_hi(w[i].x)))), fmaxf(fabsf(bf_lo(w[i].y)), fabsf(bf_hi(w[i].y)))), fmaxf(fmaxf(fabsf(bf_lo(w[i].z)), fabsf(bf_hi(w[i].z))), fmaxf(fabsf(bf_lo(w[i].w)), fabsf(bf_hi(w[i].w))))); }
    float step = 0.f;
    if (sc <= 0.f) {
#pragma unroll
        for (int o = 1; o < 64; o <<= 1) am = fmaxf(am, __shfl_xor(am, o));
        sc = am > 0.f ? 127.f / am : 0.f; step = am * (1.f / 127.f); }
#pragma unroll
    for (int i = 0; i < 8; ++i) { typedef unsigned u32x2_t __attribute__((ext_vector_type(2))); u32x2_t o;
        o.x = q8_pack4(bf_lo(w[i].x), bf_hi(w[i].x), bf_lo(w[i].y), bf_hi(w[i].y), sc); o.y = q8_pack4(bf_lo(w[i].z), bf_hi(w[i].z), bf_lo(w[i].w), bf_hi(w[i].w), sc);
        *(u32x2_t*)(dst + (i * 64 + lane) * 8) = o; }
    return step;
}
__device__ __forceinline__ void wquant_phase(Frame& F, const bf16* W, const float* cmax, unsigned char* WQ, int N) {
    const int gw = blockIdx.x * NWAVES + F.wave, NGW = F.G * NWAVES;
    for (int n = gw; n < N; n += NGW) { const float m_ = cmax[n]; (void)quant_row(W + (size_t)n * DM, WQ + (size_t)n * DM, m_ > 0.f ? 127.f / m_ : 1e-30f, F.lane); }
}
__device__ __forceinline__ void rstd_phase(Frame& F, float* rs, const bf16* X = nullptr, unsigned char* XQ = nullptr, float* ra = nullptr) {
    const int gw = blockIdx.x * NWAVES + F.wave, NGW = F.G * NWAVES; const float* part = (const float*)(F.ws + WS_PART);
    for (int row = gw; row < MTOK; row += NGW) { const float t = wave_sum(part[(size_t)row * 64 + F.lane]); const float r_ = 1.f / sqrtf(t * (1.f / DM) + EPS); if (F.lane == 0) rs[row] = r_;
        if (X) { const float st = quant_row(X + (size_t)row * DM, XQ + (size_t)row * DM, 0.f, F.lane); if (F.lane == 0) ra[row] = st * r_; } }
}
template <int NT, class AP>
__device__ __forceinline__ void mini_gemm16(f32x4 (&acc)[NT], const AP& ap, const bf16* Bt, int ldb, int K, int lane, int kstart = 0) {
    const int r16 = lane & 15, kq = lane >> 4;
#pragma unroll
    for (int n = 0; n < NT; ++n) acc[n] = (f32x4){0.f, 0.f, 0.f, 0.f};
    const bf16* brow = Bt + (size_t)r16 * ldb + kq * 8;
#pragma unroll 8
    for (int kk = 0; kk < K; kk += 32) { const int k0 = (kk + kstart) & (K - 1);
        const bf16x8 a = *(const bf16x8*)ap(r16, k0 + kq * 8);
#pragma unroll
        for (int n = 0; n < NT; ++n) { const bf16x8 b = *(const bf16x8*)(brow + (size_t)n * 16 * ldb + k0); acc[n] = mfma16(a, b, acc[n]); }
    }
}
struct RowMajorA { const bf16* A; int lda; __device__ __forceinline__ const bf16* operator()(int r16, int k) const { return A + (size_t)r16 * lda + k; } };

template <int NT, class AP>
__device__ __forceinline__ void mini_gemm16_splitk(f32x4& out, const AP& ap, const bf16* Bt, int ldb, int K, LAS float* red, int wid, int lane) {
    const int r16 = lane & 15, kq = lane >> 4, kc = K >> 3;
    f32x4 acc[NT];
#pragma unroll
    for (int n = 0; n < NT; ++n) acc[n] = (f32x4){0.f, 0.f, 0.f, 0.f};
    const bf16* brow = Bt + (size_t)r16 * ldb + kq * 8;
#pragma unroll 4
    for (int k0 = wid * kc; k0 < (wid + 1) * kc; k0 += 32) {
        const bf16x8 a = *(const bf16x8*)ap(r16, k0 + kq * 8);
#pragma unroll
        for (int n = 0; n < NT; ++n) { const bf16x8 b = *(const bf16x8*)(brow + (size_t)n * 16 * ldb + k0); acc[n] = mfma16(a, b, acc[n]); }
    }
#pragma unroll
    for (int n = 0; n < NT; ++n) *(LAS f32x4*)(red + ((wid * NT + n) * 64 + lane) * 4) = acc[n];
    __syncthreads();
    out = (f32x4){0.f, 0.f, 0.f, 0.f};
    if (wid < NT) {
#pragma unroll
        for (int w = 0; w < 8; ++w) out = out + *(const LAS f32x4*)(red + ((w * NT + wid) * 64 + lane) * 4); }
    __syncthreads();
}
__device__ __forceinline__ void gates1_phase(Frame& F) {
    const int r16 = F.lane & 15, kq = F.lane >> 4;
    const bf16* XB = (const bf16*)(F.ws + WS_XB); const bf16* Wg = (const bf16*)(F.ws + WS_WG1);
    float* LI = (float*)(F.ws + WS_LI); float* LF = (float*)(F.ws + WS_LF);
    const float bias = F.in[4][r16];
    for (int rt = blockIdx.x; rt < MTOK / 16; rt += F.G) {
        f32x4 acc; RowMajorA ap{XB + (size_t)rt * 16 * DM, DM};
        mini_gemm16_splitk<1>(acc, ap, Wg, DM, DM, (LAS float*)(F.lds + RING_OFF), F.wave, F.lane);
        if (F.wave == 0) {
#pragma unroll
            for (int i = 0; i < 4; ++i) { const int row = rt * 16 + 4 * kq + i, b = row >> 12, t = row & 4095;
                float g = acc[i] + bias; g = 15.f * tanhf(g * (1.f / 15.f));
                if (r16 < 8) LI[(size_t)(b * 8 + r16) * SEQ + t] = g;
                else LF[(size_t)(b * 8 + (r16 - 8)) * SEQ + t] = fminf(g, 0.f) - log1pf(__expf(-fabsf(g))); } }
    }
}
__device__ __forceinline__ void gates2_phase(Frame& F) {
    const int r16 = F.lane & 15, kq = F.lane >> 4;
    const bf16* XB = (const bf16*)(F.ws + WS_X2); const bf16* Wg = (const bf16*)(F.ws + WS_WG2); float* GT = (float*)(F.ws + WS_GT);
    for (int rt = blockIdx.x; rt < MTOK / 16; rt += F.G) {
        f32x4 acc; RowMajorA ap{XB + (size_t)rt * 16 * DM, DM};
        mini_gemm16_splitk<6>(acc, ap, Wg, DM, DM, (LAS float*)(F.lds + RING_OFF), F.wave, F.lane);
        if (F.wave < 6) {
#pragma unroll
            for (int i = 0; i < 4; ++i) { const int row = rt * 16 + 4 * kq + i; const float rs = ((const float*)(F.ws + WS_RS))[8192 + row];
                GT[(size_t)row * 96 + F.wave * 16 + r16] = 1.f / (1.f + __expf(-acc[i] * rs)); } }
    }
}

#define QS_BAR() do { asm volatile("s_waitcnt lgkmcnt(0)" ::: "memory"); __builtin_amdgcn_s_barrier(); asm volatile("" ::: "memory"); } while (0)
#define QS_SB() __builtin_amdgcn_sched_barrier(0)
constexpr int QS_RS = 4112, QS_NSTRIPS = 512 + 512 + 96 + 128 + 128;
struct QsJob { const float* W; const float* gain; unsigned char* WQ; float* cmax; int ldw, n0; };
__device__ __forceinline__ QsJob qs_decode(Frame& F, int s_) {
    unsigned char* ws = F.ws; QsJob J; float* cm = (float*)(ws + CTL_CMAX); int s = s_;
    if (s < 512) { J.W = F.in[16]; J.ldw = DFF; J.gain = F.in[2]; J.WQ = ws + WS_WUPQ0; J.cmax = cm; }
    else if ((s -= 512) < 512) { J.W = F.in[16] + (size_t)4096 * DFF; J.ldw = DFF; J.gain = F.in[2] + 4096; J.WQ = ws + WS_WUPQ1; J.cmax = cm + 16384; }
    else if ((s -= 512) < 96) { J.W = F.in[8]; J.ldw = KVW; J.gain = F.in[7]; J.WQ = ws + WS_WKVQ8; J.cmax = cm + 32768; }
    else if ((s -= 96) < 128) { J.W = F.in[13]; J.ldw = NQG; J.gain = F.in[1] + 4096; J.WQ = ws + WS_WKVQ8 + (size_t)KVW * 4096; J.cmax = cm + 32768 + KVW; }
    else { s -= 128; J.W = F.in[6]; J.ldw = 4096; J.gain = F.in[5]; J.WQ = ws + WS_WMOQ; J.cmax = cm + 49152; }
    J.n0 = 32 * s; return J;
}
__device__ __forceinline__ void qs_load(const QsJob& J, int q, f32x4 (&v)[8], f32x2_t (&g)[4], int tid) {
    const int seg = tid & 7, kp = tid >> 3;
    unsigned off_w = (unsigned)(2 * kp * J.ldw + 4 * seg) * 4u, off_g = (unsigned)kp * 8u;
    asm volatile("" : "+v"(off_w), "+v"(off_g));
    const char* wb = (const char*)(J.W + J.n0); const char* gb = (const char*)J.gain;
#pragma unroll
    for (int i = 0; i < 4; ++i) g[i] = *(const f32x2_t*)(gb + (size_t)((q * 4 + i) * 128) * 4 + off_g);
#pragma unroll
    for (int i = 0; i < 4; ++i) { const char* p = wb + (size_t)((q * 4 + i) * 128) * (size_t)J.ldw * 4;
        v[2 * i] = __builtin_nontemporal_load((const GAS f32x4*)(p + off_w)); v[2 * i + 1] = __builtin_nontemporal_load((const GAS f32x4*)(p + (size_t)J.ldw * 4 + off_w)); }
}
__device__ __forceinline__ void qs_put(const f32x4 (&v)[8], const f32x2_t (&g)[4], int q, f32x4& cm, LAS unsigned char* lds, int tid) {
    const int seg = tid & 7, kp = tid >> 3;
    unsigned lb = (unsigned)((4 * seg) * QS_RS + 4 * kp); asm volatile("" : "+v"(lb));
#pragma unroll
    for (int i = 0; i < 4; ++i) { const f32x4 x0 = v[2 * i] * g[i].x, x1 = v[2 * i + 1] * g[i].y;
        cm = __builtin_elementwise_max(cm, __builtin_elementwise_max(__builtin_elementwise_abs(x0), __builtin_elementwise_abs(x1)));
        LAS unsigned char* b = lds + lb + (q * 4 + i) * 256;
        *(LAS unsigned*)(b) = pk2(x0.x, x1.x); *(LAS unsigned*)(b + QS_RS) = pk2(x0.y, x1.y); *(LAS unsigned*)(b + 2 * QS_RS) = pk2(x0.z, x1.z); *(LAS unsigned*)(b + 3 * QS_RS) = pk2(x0.w, x1.w); }
}
__device__ __forceinline__ void qs_park(const f32x4 (&v)[8], const f32x2_t (&g)[4], int q, f32x4& cm, unsigned (&park)[16][4]) {
#pragma unroll
    for (int i = 0; i < 4; ++i) { const f32x4 x0 = v[2 * i] * g[i].x, x1 = v[2 * i + 1] * g[i].y;
        cm = __builtin_elementwise_max(cm, __builtin_elementwise_max(__builtin_elementwise_abs(x0), __builtin_elementwise_abs(x1)));
        unsigned p0 = pk2(x0.x, x1.x), p1 = pk2(x0.y, x1.y), p2 = pk2(x0.z, x1.z), p3 = pk2(x0.w, x1.w);
        asm volatile("" : "+v"(p0), "+v"(p1), "+v"(p2), "+v"(p3));
        park[(q - 4) * 4 + i][0] = p0; park[(q - 4) * 4 + i][1] = p1; park[(q - 4) * 4 + i][2] = p2; park[(q - 4) * 4 + i][3] = p3; }
}
__device__ __forceinline__ void qs_flush(const QsJob& J, LAS unsigned char* lds, const float (&sc4)[4], int half, int wave, unsigned l16, unsigned l8) {
#pragma unroll
    for (int rr = 0; rr < 4; ++rr) { const int n = wave + 8 * rr; unsigned char* dst = J.WQ + (size_t)(J.n0 + n) * 4096 + half * 2048;
#pragma unroll
        for (int i = 0; i < 4; ++i) { const v4u w = *(const LAS v4u*)(lds + n * QS_RS + l16 + i * 1024);
            typedef unsigned u32x2_t __attribute__((ext_vector_type(2))); u32x2_t o;
            o.x = q8_pack4(bf_lo(w.x), bf_hi(w.x), bf_lo(w.y), bf_hi(w.y), sc4[rr]); o.y = q8_pack4(bf_lo(w.z), bf_hi(w.z), bf_lo(w.w), bf_hi(w.w), sc4[rr]);
            *(u32x2_t*)(dst + l8 + i * 512) = o; } }
}
__device__ __forceinline__ void convert_strips(Frame& F, int cw, int ncw) {
    LAS unsigned char* lds = F.lds + RING_OFF; LAS float* wm = (LAS float*)(lds + 32 * QS_RS);
    const int tid = F.tid, lane = F.lane, wave = F.wave;
    QS_BAR();
    int s = cw; if (s >= QS_NSTRIPS) return;
    f32x4 A[8], B[8]; f32x2_t gA[4], gB[4];
    unsigned l16 = (unsigned)lane * 16u, l8 = (unsigned)lane * 8u; asm volatile("" : "+v"(l16), "+v"(l8));
    QsJob J = qs_decode(F, s); qs_load(J, 0, A, gA, tid); qs_load(J, 1, B, gB, tid);
    for (;;) {
        f32x4 cm = {0.f, 0.f, 0.f, 0.f}; unsigned park[16][4];
#pragma unroll 1
        for (int qq = 0; qq < 2; ++qq) {
            qs_put(A, gA, 2 * qq, cm, lds, tid); QS_SB(); qs_load(J, 2 * qq + 2, A, gA, tid); QS_SB();
            qs_put(B, gB, 2 * qq + 1, cm, lds, tid); QS_SB(); qs_load(J, 2 * qq + 3, B, gB, tid); QS_SB(); }
        qs_park(A, gA, 4, cm, park); QS_SB(); qs_load(J, 6, A, gA, tid); QS_SB();
        qs_park(B, gB, 5, cm, park); QS_SB(); qs_load(J, 7, B, gB, tid); QS_SB();
        const int sn = s + ncw; const bool more = sn < QS_NSTRIPS; QsJob Jn = J; if (more) Jn = qs_decode(F, sn);
        qs_park(A, gA, 6, cm, park); QS_SB(); if (more) qs_load(Jn, 0, A, gA, tid); QS_SB();
        qs_park(B, gB, 7, cm, park); QS_SB();
#pragma unroll
        for (int e = 0; e < 4; ++e) { float m_ = cm[e]; m_ = fmaxf(m_, __shfl_xor(m_, 8)); m_ = fmaxf(m_, __shfl_xor(m_, 16)); m_ = fmaxf(m_, __shfl_xor(m_, 32)); cm[e] = m_; }
        if (lane < 8) *(LAS f32x4*)(wm + wave * 32 + 4 * lane) = cm;
        QS_BAR();
        float sc4[4];
#pragma unroll
        for (int rr = 0; rr < 4; ++rr) { const int n = wave + 8 * rr; float m_ = 0.f;
#pragma unroll
            for (int w8 = 0; w8 < 8; ++w8) m_ = fmaxf(m_, wm[w8 * 32 + n]);
            sc4[rr] = m_ > 0.f ? 127.f / m_ : 0.f;
            if (lane == 0) J.cmax[J.n0 + n] = m_; }
        qs_flush(J, lds, sc4, 0, wave, l16, l8);
        QS_BAR();
        { const int seg = tid & 7, kp = tid >> 3; unsigned lb = (unsigned)((4 * seg) * QS_RS + 4 * kp); asm volatile("" : "+v"(lb));
#pragma unroll
          for (int d = 0; d < 16; ++d) { LAS unsigned char* b = lds + lb + d * 256;
              *(LAS unsigned*)(b) = park[d][0]; *(LAS unsigned*)(b + QS_RS) = park[d][1]; *(LAS unsigned*)(b + 2 * QS_RS) = park[d][2]; *(LAS unsigned*)(b + 3 * QS_RS) = park[d][3]; } }
        QS_SB(); if (more) qs_load(Jn, 1, B, gB, tid); QS_SB();
        QS_BAR();
        qs_flush(J, lds, sc4, 1, wave, l16, l8);
        QS_BAR();
        if (!more) break;
        s = sn; J = Jn;
    }
}

#define ML_BAR() do { asm volatile("s_waitcnt lgkmcnt(0)" ::: "memory"); __builtin_amdgcn_s_barrier(); asm volatile("" ::: "memory"); } while (0)
constexpr int ML_QS = 528, ML_VS = 144, ML_PS = 144;
constexpr int ML_Q = 0, ML_K = ML_Q + 64 * ML_QS, ML_V = ML_K + 64 * ML_QS, ML_VW = ML_V + 64 * ML_VS, ML_P = ML_VW + 64 * ML_VS, ML_CT = ML_P + 64 * ML_PS, ML_SC = ML_CT + 64 * ML_QS, ML_H = ML_SC + 4096;
static_assert(ML_H + 64 * ML_VS <= RING_BYTES, "mlstm LDS");
struct MlPref { bf16x8 q[4], k[4], v; float li, lf; };
struct MlK { LAS unsigned char* L; const bf16* QKVO; bf16* HR; const float* LI; const float* LF; size_t rowb; int bh, hd, e0, tid, lane, wid; };
__device__ __forceinline__ void ml_load(MlPref& P, const MlK& K, int c) {
    const int qr_ = K.tid >> 3, qc_ = K.tid & 7;
    const bf16* base = K.QKVO + (K.rowb + (size_t)c * 64 + qr_) * M_MAIN;
#pragma unroll
    for (int i = 0; i < 4; ++i) { P.q[i] = *(const bf16x8*)(base + K.hd * 256 + (qc_ + 8 * i) * 8); P.k[i] = *(const bf16x8*)(base + 2048 + K.hd * 256 + (qc_ + 8 * i) * 8); }
    P.v = *(const bf16x8*)(base + 4096 + K.hd * 512 + K.e0 + qc_ * 8);
    P.li = K.LI[(size_t)K.bh * SEQ + c * 64 + K.lane]; P.lf = K.LF[(size_t)K.bh * SEQ + c * 64 + K.lane];
}
__device__ __forceinline__ void ml_chunk(MlPref& P, f32x4 (&CT)[2][4], float& m_state, const MlK& K, int c) {
    LAS unsigned char* L = K.L;
    LAS float* sc_a = (LAS float*)(L + ML_SC); LAS float* sc_M = sc_a + 64; LAS float* sc_b = sc_a + 128; LAS float* sc_w = sc_a + 192;
    LAS float* sc_rs = sc_a + 256; LAS float* sc_qn = sc_a + 512; LAS float* sc_nv = sc_a + 576;
    const int tid = K.tid, lane = K.lane, wid = K.wid, r16 = lane & 15, kq = lane >> 4;
    const int tt = wid >> 1, sp = wid & 1, ep = wid & 1, qr_ = tid >> 3, qc_ = tid & 7;
    float bsum = P.lf;
#pragma unroll
    for (int o = 1; o < 64; o <<= 1) { const float t_ = __shfl_up(bsum, o); if (lane >= o) bsum += t_; }
    const float a_s = P.li - bsum;
    float pm = a_s;
#pragma unroll
    for (int o = 1; o < 64; o <<= 1) { const float t_ = __shfl_up(pm, o); if (lane >= o) pm = fmaxf(pm, t_); }
    const float Mt = fmaxf(m_state, pm);
    const float M63 = __uint_as_float(__builtin_amdgcn_readlane(__float_as_uint(Mt), 63)), b63 = __uint_as_float(__builtin_amdgcn_readlane(__float_as_uint(bsum), 63));
    const float w_s = __expf(a_s - M63), decay = __expf(m_state - M63);
    if (wid == 0) { sc_a[lane] = a_s; sc_M[lane] = Mt; sc_b[lane] = bsum; sc_w[lane] = w_s; }
#pragma unroll
    for (int i = 0; i < 4; ++i) { *(LAS bf16x8*)(L + ML_Q + qr_ * ML_QS + (qc_ + 8 * i) * 16) = P.q[i]; *(LAS bf16x8*)(L + ML_K + qr_ * ML_QS + (qc_ + 8 * i) * 16) = P.k[i]; }
    { *(LAS bf16x8*)(L + ML_V + qr_ * ML_VS + qc_ * 16) = P.v;
        const float wv = __shfl(w_s, 8 * wid + (lane >> 3)); const v4u raw = __builtin_bit_cast(v4u, P.v); v4u o;
        o.x = pk2(bf_lo(raw.x) * wv, bf_hi(raw.x) * wv); o.y = pk2(bf_lo(raw.y) * wv, bf_hi(raw.y) * wv); o.z = pk2(bf_lo(raw.z) * wv, bf_hi(raw.z) * wv); o.w = pk2(bf_lo(raw.w) * wv, bf_hi(raw.w) * wv);
        *(LAS v4u*)(L + ML_VW + qr_ * ML_VS + qc_ * 16) = o; }
    ml_load(P, K, c + 2 < 64 ? c + 2 : 63);
    ML_BAR();
    f32x4 sacc0 = {0.f, 0.f, 0.f, 0.f}, sacc1 = sacc0, iacc0 = sacc0, iacc1 = sacc0;
    { const LAS unsigned char* qrow = L + ML_Q + (tt * 16 + r16) * ML_QS + kq * 16;
      const LAS unsigned char* krow = L + ML_K + (sp * 32 + r16) * ML_QS + kq * 16;
      const LAS unsigned char* crow_ = L + ML_CT + (ep * 32 + r16) * ML_QS + kq * 16;
#pragma unroll 2
      for (int k0 = 0; k0 < 8; ++k0) { const bf16x8 a = *(const LAS bf16x8*)(qrow + k0 * 64);
          const bf16x8 b0 = *(const LAS bf16x8*)(krow + k0 * 64), b1 = *(const LAS bf16x8*)(krow + 16 * ML_QS + k0 * 64);
          const bf16x8 bc0 = *(const LAS bf16x8*)(crow_ + k0 * 64), bc1 = *(const LAS bf16x8*)(crow_ + 16 * ML_QS + k0 * 64);
          sacc0 = mfma16(b0, a, sacc0); sacc1 = mfma16(b1, a, sacc1); iacc0 = mfma16(bc0, a, iacc0); iacc1 = mfma16(bc1, a, iacc1); } }
    const int tl = tt * 16 + r16;
    const float Mt_t = sc_M[tl];
#pragma unroll
    for (int st2 = 0; st2 < 2; ++st2) { const int s0 = (2 * sp + st2) * 16 + 4 * kq; const f32x4 a4 = *(const LAS f32x4*)(sc_a + s0); const f32x4 sv = st2 ? sacc1 : sacc0;
        float pv4[4]; float rsum = 0.f;
#pragma unroll
        for (int i = 0; i < 4; ++i) { pv4[i] = (s0 + i <= tl) ? sv[i] * __expf(a4[i] - Mt_t) : 0.f; rsum += pv4[i]; }
        rsum += __shfl_xor(rsum, 16); rsum += __shfl_xor(rsum, 32);
        if (kq == 0) sc_rs[(2 * sp + st2) * 64 + tl] = rsum;
        typedef unsigned u32x2_t __attribute__((ext_vector_type(2)));
        u32x2_t w; w.x = pk2(pv4[0], pv4[1]); w.y = pk2(pv4[2], pv4[3]);
        *(LAS u32x2_t*)(L + ML_P + tl * ML_PS + s0 * 2) = w; }
    { const int t = tid >> 3, part = tid & 7; float qn = 0.f;
      const LAS v4u* qp = (const LAS v4u*)(L + ML_Q + t * ML_QS + part * 64); const LAS f32x4* np_ = (const LAS f32x4*)(sc_nv + part * 32);
#pragma unroll
      for (int j = 0; j < 4; ++j) { const v4u w = qp[j]; const f32x4 n0 = np_[2 * j], n1 = np_[2 * j + 1];
          qn += (bf_lo(w.x) * n0[0] + bf_hi(w.x) * n0[1]) + (bf_lo(w.y) * n0[2] + bf_hi(w.y) * n0[3]) + (bf_lo(w.z) * n1[0] + bf_hi(w.z) * n1[1]) + (bf_lo(w.w) * n1[2] + bf_hi(w.w) * n1[3]); }
      qn += __shfl_xor(qn, 1); qn += __shfl_xor(qn, 2); qn += __shfl_xor(qn, 4);
      if (part == 0) sc_qn[t] = qn; }
    ML_BAR();
    { f32x4 xacc[2] = {{0.f, 0.f, 0.f, 0.f}, {0.f, 0.f, 0.f, 0.f}}; const int j = r16 >> 2, q = r16 & 3;
#pragma unroll
      for (int ks = 0; ks < 2; ++ks) { const bf16x8 pf = *(const LAS bf16x8*)(L + ML_P + tl * ML_PS + (ks * 32 + kq * 8) * 2);
#pragma unroll
          for (int e2 = 0; e2 < 2; ++e2) { const LAS unsigned char* va = L + ML_V + (ks * 32 + 8 * kq + j) * ML_VS + ((2 * ep + e2) * 16 + 4 * q) * 2;
              xacc[e2] = mfma16(cat8(tr16(va), tr16(va + 4 * ML_VS)), pf, xacc[e2]); } }
      const float bb_t = sc_b[tl], winter = __expf(m_state - Mt_t);
      const float den = winter * sc_qn[tl] + ((sc_rs[tl] + sc_rs[64 + tl]) + (sc_rs[128 + tl] + sc_rs[192 + tl]));
      const float rdd = 1.f / fmaxf(fabsf(den), __expf(-(bb_t + Mt_t)));
#pragma unroll
      for (int e2 = 0; e2 < 2; ++e2) { const f32x4 ia = e2 ? iacc1 : iacc0; float hv[4];
#pragma unroll
          for (int i = 0; i < 4; ++i) hv[i] = (winter * ia[i] + xacc[e2][i]) * rdd;
          typedef unsigned u32x2_t __attribute__((ext_vector_type(2)));
          u32x2_t w; w.x = pk2(hv[0], hv[1]); w.y = pk2(hv[2], hv[3]);
          *(LAS u32x2_t*)(L + ML_H + tl * ML_VS + ((2 * ep + e2) * 16 + 4 * kq) * 2) = w; } }
    { const int j = r16 >> 2, q = r16 & 3; bf16x8 af[2][2];
#pragma unroll
      for (int e2 = 0; e2 < 2; ++e2)
#pragma unroll
          for (int ks = 0; ks < 2; ++ks) { const LAS unsigned char* va = L + ML_VW + (ks * 32 + 8 * kq + j) * ML_VS + ((2 * ep + e2) * 16 + 4 * q) * 2; af[e2][ks] = cat8(tr16(va), tr16(va + 4 * ML_VS)); }
#pragma unroll
      for (int jt = 0; jt < 4; ++jt) { const int dt = 4 * (wid >> 1) + jt; bf16x8 bfr[2];
#pragma unroll
          for (int ks = 0; ks < 2; ++ks) { const LAS unsigned char* ka = L + ML_K + (ks * 32 + 8 * kq + j) * ML_QS + (dt * 16 + 4 * q) * 2; bfr[ks] = cat8(tr16(ka), tr16(ka + 4 * ML_QS)); }
#pragma unroll
          for (int e2 = 0; e2 < 2; ++e2) { f32x4 acc = CT[e2][jt] * decay;
              acc = mfma16(bfr[0], af[e2][0], acc); acc = mfma16(bfr[1], af[e2][1], acc);
              CT[e2][jt] = acc;
              typedef unsigned u32x2_t __attribute__((ext_vector_type(2)));
              u32x2_t w; w.x = pk2(acc[0], acc[1]); w.y = pk2(acc[2], acc[3]);
              *(LAS u32x2_t*)(L + ML_CT + ((2 * ep + e2) * 16 + r16) * ML_QS + (dt * 16 + 4 * kq) * 2) = w; } } }
    if (tid < 256) { float nv = sc_nv[tid] * decay;
#pragma unroll
        for (int s = 0; s < 64; ++s) nv += __uint_as_float(__builtin_amdgcn_readlane(__float_as_uint(w_s), s)) * bf1(*(const LAS unsigned short*)(L + ML_K + s * ML_QS + tid * 2));
        sc_nv[tid] = nv; }
    m_state = b63 + M63;
    ML_BAR();
    *(bf16x8*)(K.HR + (K.rowb + (size_t)c * 64 + qr_) * DM + K.hd * 512 + K.e0 + qc_ * 8) = *(const LAS bf16x8*)(L + ML_H + qr_ * ML_VS + qc_ * 16);
}
__device__ __forceinline__ void mlstm_phase(Frame& F, int worker, int nworkers) {
    LAS unsigned char* L = F.lds + RING_OFF;
    LAS float* sc_nv = (LAS float*)(L + ML_SC) + 576;
    for (int unit = worker; unit < 128; unit += nworkers) {
        const int bh = unit >> 3, sl = unit & 7, b = bh >> 3;
        MlK K; K.L = L; K.QKVO = (const bf16*)(F.ws + WS_BIG); K.HR = (bf16*)(F.ws + WS_HR); K.LI = (const float*)(F.ws + WS_LI); K.LF = (const float*)(F.ws + WS_LF);
        K.rowb = (size_t)b * SEQ; K.bh = bh; K.hd = bh & 7; K.e0 = sl * 64; K.tid = F.tid; K.lane = F.lane; K.wid = F.wave;
        f32x4 CT[2][4];
#pragma unroll
        for (int a = 0; a < 2; ++a)
#pragma unroll
            for (int j = 0; j < 4; ++j) CT[a][j] = (f32x4){0.f, 0.f, 0.f, 0.f};
        float m_state = 0.f;
        if (F.tid < 256) sc_nv[F.tid] = 0.f;
        for (int i = F.tid; i < 64 * ML_QS / 4; i += NWAVES * 64) ((LAS unsigned*)(L + ML_CT))[i] = 0u;
        MlPref P0, P1;
        ml_load(P0, K, 0); ml_load(P1, K, 1);
        __syncthreads();
        for (int c = 0; c < 64; c += 2) { ml_chunk(P0, CT, m_state, K, c); ml_chunk(P1, CT, m_state, K, c + 1); }
    }
}

__device__ __forceinline__ void gating_phase(Frame& F) {
    const int gw = blockIdx.x * NWAVES + F.wave, NGW = F.G * NWAVES, lane = F.lane;
    const bf16* HR = (const bf16*)(F.ws + WS_HR); const bf16* QKVO = (const bf16*)(F.ws + WS_BIG); bf16* A3 = (bf16*)(F.ws + WS_A3);
    float* ra = (float*)(F.ws + WS_RS) + 24576;
    for (int row = gw; row < MTOK; row += NGW) {
        unsigned pk[8][4]; float am = 0.f;
#pragma unroll
        for (int hd = 0; hd < 8; ++hd) {
            const v4u hv = *(const v4u*)(HR + (size_t)row * DM + hd * 512 + lane * 8);
            const v4u ov = *(const v4u*)(QKVO + (size_t)row * M_MAIN + 8192 + hd * 512 + lane * 8);
            float h[8] = {bf_lo(hv.x), bf_hi(hv.x), bf_lo(hv.y), bf_hi(hv.y), bf_lo(hv.z), bf_hi(hv.z), bf_lo(hv.w), bf_hi(hv.w)};
            float o[8] = {bf_lo(ov.x), bf_hi(ov.x), bf_lo(ov.y), bf_hi(ov.y), bf_lo(ov.z), bf_hi(ov.z), bf_lo(ov.w), bf_hi(ov.w)};
            float ss = 0.f;
#pragma unroll
            for (int e = 0; e < 8; ++e) ss += h[e] * h[e];
            const float rstd = 1.f / sqrtf(wave_sum(ss) * (1.f / 512.f) + EPS);
            float r[8];
#pragma unroll
            for (int e = 0; e < 8; ++e) { r[e] = h[e] * rstd / (1.f + __expf(-o[e])); am = fmaxf(am, fabsf(r[e])); }
#pragma unroll
            for (int j = 0; j < 4; ++j) pk[hd][j] = pk2(r[2 * j], r[2 * j + 1]);
            if (!Q8_WMO) { v4u w; w.x = pk[hd][0]; w.y = pk[hd][1]; w.z = pk[hd][2]; w.w = pk[hd][3]; *(v4u*)(A3 + (size_t)row * DM + hd * 512 + lane * 8) = w; }
        }
        if (Q8_WMO) {
#pragma unroll
            for (int o = 1; o < 64; o <<= 1) am = fmaxf(am, __shfl_xor(am, o));
            const float sc = am > 0.f ? 127.f / am : 0.f;
#pragma unroll
            for (int hd = 0; hd < 8; ++hd) { typedef unsigned u32x2_t __attribute__((ext_vector_type(2))); u32x2_t o;
                o.x = q8_pack4(bf_lo(pk[hd][0]), bf_hi(pk[hd][0]), bf_lo(pk[hd][1]), bf_hi(pk[hd][1]), sc); o.y = q8_pack4(bf_lo(pk[hd][2]), bf_hi(pk[hd][2]), bf_lo(pk[hd][3]), bf_hi(pk[hd][3]), sc);
                *(u32x2_t*)((unsigned char*)A3 + (size_t)row * DM + hd * 512 + lane * 8) = o; }
            if (lane == 0) ra[row] = am * (1.f / 127.f); }
    }
}

__device__ __forceinline__ float gelu_tanh(float v) { const float u = 0.7978845608028654f * (v + 0.044715f * v * v * v); return 0.5f * v * (1.f + tanhf(u)); }
struct CmpA { const bf16* KVQ; int j, rt; __device__ __forceinline__ const bf16* operator()(int r16, int k) const {
    const int row = rt * 16 + r16, bg = row >> 8; int c = row & 255; c = c > 254 ? 254 : c; const int b = bg >> 2, g = bg & 3;
    return KVQ + ((size_t)b * SEQ + 16 * c + (k >> 7)) * NKVQ + j * 512 + g * 128 + (k & 127); } };
__device__ __forceinline__ void nsa_prep_phase(Frame& F) {
    const int gw = blockIdx.x * NWAVES + F.wave, NGW = F.G * NWAVES, lane = F.lane, r16 = lane & 15, kq = lane >> 4;
    bf16* KVQ = (bf16*)(F.ws + WS_BIG);
    { const int v = lane >> 3, br = v >> 2, g = v & 3, d0 = (lane & 7) * 16;
      float gn[16];
#pragma unroll
      for (int e = 0; e < 16; ++e) gn[e] = F.in[9][(br + 1) * 128 + d0 + e] * F.in[14][(br + 1) * 128 + d0 + e] * ATT_SCALE;
      for (int row = gw; row < MTOK; row += NGW) {
          bf16* p = KVQ + (size_t)row * NKVQ + (2 + 2 * br) * 512 + g * 128 + d0;
          const v4u a = *(const v4u*)p, c = *(const v4u*)(p + 8);
          float x[16] = {bf_lo(a.x), bf_hi(a.x), bf_lo(a.y), bf_hi(a.y), bf_lo(a.z), bf_hi(a.z), bf_lo(a.w), bf_hi(a.w), bf_lo(c.x), bf_hi(c.x), bf_lo(c.y), bf_hi(c.y), bf_lo(c.z), bf_hi(c.z), bf_lo(c.w), bf_hi(c.w)};
          float ss = 0.f;
#pragma unroll
          for (int e = 0; e < 16; ++e) ss += x[e] * x[e];
          ss += __shfl_xor(ss, 1); ss += __shfl_xor(ss, 2); ss += __shfl_xor(ss, 4);
          const float rstd = 1.f / sqrtf(ss * (1.f / 128.f) + EPS);
#pragma unroll
          for (int e = 0; e < 16; ++e) x[e] *= rstd * gn[e];
          v4u o0, o1; o0.x = pk2(x[0], x[1]); o0.y = pk2(x[2], x[3]); o0.z = pk2(x[4], x[5]); o0.w = pk2(x[6], x[7]); o1.x = pk2(x[8], x[9]); o1.y = pk2(x[10], x[11]); o1.z = pk2(x[12], x[13]); o1.w = pk2(x[14], x[15]);
          *(v4u*)p = o0; *(v4u*)(p + 8) = o1; } }
    { const bf16* W1C = (const bf16*)(F.ws + WS_W1C); const bf16* W2C = (const bf16*)(F.ws + WS_W2C); const float* posb = (const float*)(F.ws + WS_POSB);
      bf16* KC = (bf16*)(F.ws + WS_KC); bf16* VC = (bf16*)(F.ws + WS_VC);
      LAS unsigned char* As = F.lds + RING_OFF;
      LAS unsigned char* Hs = F.lds + RING_OFF; LAS float* ps = (LAS float*)(F.lds + RING_OFF + 16 * 8208);
      const int wid = F.wave;
      for (int task = blockIdx.x; task < 256; task += F.G) { const int j = (task & 7) >> 2, rt = (task & 3) * 32 + (task >> 3);
          { f32x4 acc[4]; CmpA ap{KVQ, j, rt};
            { const int l16 = F.tid & 15, ch = F.tid >> 4; v4u tmp[16];
#pragma unroll
              for (int p = 0; p < 16; ++p) tmp[p] = *(const v4u*)(ap(p, ch * 128 + l16 * 8));
#pragma unroll
              for (int p = 0; p < 16; ++p) *(LAS v4u*)(As + p * 8208 + (ch * 128 + l16 * 8) * 2) = tmp[p]; }
            __syncthreads();
#pragma unroll
            for (int n = 0; n < 4; ++n) acc[n] = (f32x4){0.f, 0.f, 0.f, 0.f};
#pragma unroll
            for (int hf = 0; hf < 2; ++hf) { const bf16* brow = W1C + ((size_t)j * 512 + hf * 256 + wid * 32 + r16) * 4096 + kq * 16; LAS unsigned char* arow = As + r16 * 8208 + kq * 32;
              bf16x8 b0[8][2], b1[8][2];
#pragma unroll
              for (int s8 = 0; s8 < 8; ++s8)
#pragma unroll
                  for (int n = 0; n < 2; ++n) b0[s8][n] = *(const bf16x8*)(brow + (size_t)n * 16 * 4096 + (s8 >> 1) * 64 + (s8 & 1) * 8);
#pragma unroll 1
              for (int kb = 0; kb < 16; kb += 2) {
#pragma unroll
                  for (int s8 = 0; s8 < 8; ++s8)
#pragma unroll
                      for (int n = 0; n < 2; ++n) b1[s8][n] = *(const bf16x8*)(brow + (size_t)n * 16 * 4096 + (kb + 1) * 256 + (s8 >> 1) * 64 + (s8 & 1) * 8);
                  __builtin_amdgcn_sched_barrier(0);
#pragma unroll
                  for (int s8 = 0; s8 < 8; ++s8) { const bf16x8 a = *(const LAS bf16x8*)(arow + (kb * 256 + (s8 >> 1) * 64 + (s8 & 1) * 8) * 2);
#pragma unroll
                      for (int n = 0; n < 2; ++n) acc[hf * 2 + n] = mfma16(a, b0[s8][n], acc[hf * 2 + n]); }
                  __builtin_amdgcn_sched_barrier(0);
                  if (kb + 2 < 16) {
#pragma unroll
                      for (int s8 = 0; s8 < 8; ++s8)
#pragma unroll
                          for (int n = 0; n < 2; ++n) b0[s8][n] = *(const bf16x8*)(brow + (size_t)n * 16 * 4096 + (kb + 2) * 256 + (s8 >> 1) * 64 + (s8 & 1) * 8); }
                  __builtin_amdgcn_sched_barrier(0);
#pragma unroll
                  for (int s8 = 0; s8 < 8; ++s8) { const bf16x8 a = *(const LAS bf16x8*)(arow + ((kb + 1) * 256 + (s8 >> 1) * 64 + (s8 & 1) * 8) * 2);
#pragma unroll
                      for (int n = 0; n < 2; ++n) acc[hf * 2 + n] = mfma16(a, b1[s8][n], acc[hf * 2 + n]); }
                  __builtin_amdgcn_sched_barrier(0); } }
            __syncthreads();
#pragma unroll
            for (int n = 0; n < 4; ++n) { const int col = (n >> 1) * 256 + wid * 32 + (n & 1) * 16 + r16; const float pb = posb[j * 512 + col];
#pragma unroll
                for (int i = 0; i < 4; ++i) *(LAS unsigned short*)(Hs + (4 * kq + i) * 1040 + col * 2) = f2bf1(gelu_tanh(acc[n][i] + pb)); } }
          __syncthreads();
          f32x4 o = {0.f, 0.f, 0.f, 0.f};
          { const bf16* brow = W2C + ((size_t)j * 128 + wid * 16 + r16) * 512 + kq * 8;
#pragma unroll 4
            for (int k0 = 0; k0 < 512; k0 += 32) o = mfma16(*(const LAS bf16x8*)(Hs + r16 * 1040 + (k0 + kq * 8) * 2), *(const bf16x8*)(brow + k0), o); }
          const int col = wid * 16 + r16;
          if (j == 0) {
#pragma unroll
              for (int i = 0; i < 4; ++i) { float ss = o[i] * o[i]; ss += __shfl_xor(ss, 1); ss += __shfl_xor(ss, 2); ss += __shfl_xor(ss, 4); ss += __shfl_xor(ss, 8);
                  if (r16 == 0) ps[wid * 16 + 4 * kq + i] = ss; } }
          __syncthreads();
          const float gsc = (j == 0) ? F.in[9][col] * F.in[14][col] * ATT_SCALE : 1.f;
#pragma unroll
          for (int i = 0; i < 4; ++i) { const int row = rt * 16 + 4 * kq + i; float v = o[i];
              if (j == 0) { float ss = 0.f;
#pragma unroll
                  for (int w = 0; w < 8; ++w) ss += ps[w * 16 + 4 * kq + i];
                  v *= gsc / sqrtf(ss * (1.f / 128.f) + EPS); }
              if ((row & 255) == 255) v = 0.f;
              (j == 0 ? KC : VC)[(size_t)row * 128 + col] = f2bf1(v); }
          __syncthreads(); } }
}
__device__ __forceinline__ void nsa_cmp2_phase(Frame& F) {
    const int gw = blockIdx.x * NWAVES + F.wave, NGW = F.G * NWAVES, lane = F.lane, r16 = lane & 15, kq = lane >> 4;
    const bf16* HC = (const bf16*)(F.ws + WS_HC); const bf16* W2C = (const bf16*)(F.ws + WS_W2C); bf16* KC = (bf16*)(F.ws + WS_KC); bf16* VC = (bf16*)(F.ws + WS_VC);
    for (int task = gw; task < 256; task += NGW) { const int j = task >> 7, rt = task & 127;
        f32x4 acc[8]; RowMajorA ap{HC + ((size_t)j * 2048 + rt * 16) * 512, 512};
        mini_gemm16<8>(acc, ap, W2C + (size_t)j * 128 * 512, 512, 512, lane);
#pragma unroll
        for (int i = 0; i < 4; ++i) { const int row = rt * 16 + 4 * kq + i; const bool pad = (row & 255) == 255;
            float sc = 1.f;
            if (j == 0) { float ss = 0.f;
#pragma unroll
                for (int n = 0; n < 8; ++n) ss += acc[n][i] * acc[n][i];
                ss += __shfl_xor(ss, 1); ss += __shfl_xor(ss, 2); ss += __shfl_xor(ss, 4); ss += __shfl_xor(ss, 8);
                sc = ATT_SCALE / sqrtf(ss * (1.f / 128.f) + EPS); }
#pragma unroll
            for (int n = 0; n < 8; ++n) { const int col = n * 16 + r16; float v = acc[n][i] * sc;
                if (j == 0) v *= F.in[9][col] * F.in[14][col];
                if (pad) v = 0.f;
                (j == 0 ? KC : VC)[(size_t)row * 128 + col] = f2bf1(v); } } }
}

namespace nsa {
constexpr int D = 128, KVBLK = 64, SHM_K = 16384, SHM_V = 16384;
constexpr int O_V = 0, O_K = SHM_V, BUF1 = SHM_V + SHM_K  , O_WS = 2 * BUF1, O_PB = O_WS + NWAVES * 64 * 4, O_SELM = O_PB + 32 * 65 * 4, O_OT = ((O_SELM + 32 * 8 + 1023) / 1024) * 1024  , O_END = O_OT + 32 * 2048;
static_assert(O_END <= RING_BYTES, "nsa LDS");
constexpr float THR2 = 11.0f;
#define KSWZ(row, colB) ((row) * 256 + ((colB) ^ (((row) & 7) << 4)))
#define SBAR() __builtin_amdgcn_sched_barrier(0)
__device__ __forceinline__ int v_st(int k, int c) { const int kk = (k & ~0xC) | ((k & 4) << 1) | ((k & 8) >> 1); return ((kk >> 3) * 4 + (c >> 5)) * 512 + ((kk & 7) * 32 + (c & 31)) * 2; }
__device__ __forceinline__ int v_rd_base(int lane) { return ((lane & 3) << 3) | (((lane >> 2) & 3) << 6) | (((lane >> 4) & 1) << 5) | (((lane >> 5) & 1) << 8); }
constexpr int v_rd_off(int d0, int ks, int half) { return d0 * 512 + ks * 4096 + half * 2048; }
__device__ __forceinline__ int crow(int r, int hi) { return (r & 3) + 8 * (r >> 2) + 4 * hi; }
__device__ __forceinline__ void mask_tile(f32x16& p0, f32x16& p1, int dq, unsigned W) {
    const float NEG = -__builtin_inff();
#pragma unroll
    for (int r = 0; r < 16; ++r) { const int c = (r & 3) + 8 * (r >> 2);
        if ((unsigned)(dq - c) >= W) p0[r] = NEG;
        if ((unsigned)(dq - c - 32) >= W) p1[r] = NEG; }
}
__device__ __forceinline__ float rowmax32(const f32x16& p0, const f32x16& p1) {
    float pmax = p0[0];
#pragma unroll
    for (int r = 1; r < 16; ++r) pmax = fmaxf(pmax, p0[r]);
#pragma unroll
    for (int r = 0; r < 16; ++r) pmax = fmaxf(pmax, p1[r]);
    auto rr = __builtin_amdgcn_permlane32_swap(__float_as_uint(pmax), __float_as_uint(pmax), false, false);
    return fmaxf(__uint_as_float(rr[0]), __uint_as_float(rr[1]));
}
__device__ __forceinline__ float rowsum32(const f32x16& p0, const f32x16& p1) {
    float ps = 0.f;
#pragma unroll
    for (int r = 0; r < 16; ++r) ps += p0[r];
#pragma unroll
    for (int r = 0; r < 16; ++r) ps += p1[r];
    auto rr = __builtin_amdgcn_permlane32_swap(__float_as_uint(ps), __float_as_uint(ps), false, false);
    return __uint_as_float(rr[0]) + __uint_as_float(rr[1]);
}
__device__ __forceinline__ void partialSM(f32x16& p0, f32x16& p1, float& m_reg, float& alpha, float c2) {
    const float pmax = rowmax32(p0, p1); float mn;
    if (__builtin_expect(__all((pmax - m_reg) * c2 <= THR2), 1)) { mn = m_reg; alpha = 1.f; }
    else { mn = fmaxf(m_reg, pmax); alpha = __builtin_amdgcn_exp2f((m_reg - mn) * c2); m_reg = mn; }
    const float mnL = -mn * c2;
#pragma unroll
    for (int r = 0; r < 16; ++r) p0[r] = fmaf(p0[r], c2, mnL);
#pragma unroll
    for (int r = 0; r < 16; ++r) p1[r] = fmaf(p1[r], c2, mnL);
#pragma unroll
    for (int r = 0; r < 16; ++r) p0[r] = __builtin_amdgcn_exp2f(p0[r]);
}
__device__ __forceinline__ void packP(const f32x16& p0, const f32x16& p1, bf16x8& pa0, bf16x8& pa1, bf16x8& pa2, bf16x8& pa3) {
#define PK4(P, B_, OUT) do { unsigned a0 = pk2(P[B_+0], P[B_+1]), a1 = pk2(P[B_+2], P[B_+3]);                          \
        unsigned b0 = pk2(P[B_+4], P[B_+5]), b1 = pk2(P[B_+6], P[B_+7]);                                             \
        auto r0 = __builtin_amdgcn_permlane32_swap(a0, b0, false, false); auto r1 = __builtin_amdgcn_permlane32_swap(a1, b1, false, false); \
        u32x4_t w = {r0[0], r1[0], r0[1], r1[1]}; OUT = __builtin_bit_cast(bf16x8, w); } while (0)
    typedef unsigned u32x4_t __attribute__((ext_vector_type(4)));
    PK4(p0, 0, pa0); PK4(p0, 8, pa1); PK4(p1, 0, pa2); PK4(p1, 8, pa3);
#undef PK4
}
__device__ __forceinline__ void finishSM(f32x16& p0, f32x16& p1, float alpha, float& l_reg, bf16x8& pa0, bf16x8& pa1, bf16x8& pa2, bf16x8& pa3) {
#pragma unroll
    for (int r = 0; r < 16; ++r) p1[r] = __builtin_amdgcn_exp2f(p1[r]);
    l_reg = l_reg * alpha + rowsum32(p0, p1);
    packP(p0, p1, pa0, pa1, pa2, pa3);
}
__device__ __forceinline__ void qkt(f32x16& p0, f32x16& p1, const char* K_lds, int r32, int hi, const bf16x8* qr, float cinit) {
#pragma unroll
    for (int r = 0; r < 16; ++r) { p0[r] = cinit; p1[r] = cinit; }
    const char* kb[4];
#pragma unroll
    for (int dd = 0; dd < 4; ++dd) kb[dd] = K_lds + KSWZ(r32, (dd * 16 + hi * 8) * 2);
#pragma unroll
    for (int d0 = 0; d0 < 8; ++d0) { const char* a = kb[d0 & 3] + (d0 >> 2) * 128;
        const bf16x8 b0 = *reinterpret_cast<const bf16x8*>(a);
        const bf16x8 b1 = *reinterpret_cast<const bf16x8*>(a + 32 * 256);
        p0 = __builtin_amdgcn_mfma_f32_32x32x16_bf16(b0, qr[d0], p0, 0, 0, 0);
        p1 = __builtin_amdgcn_mfma_f32_32x32x16_bf16(b1, qr[d0], p1, 0, 0, 0); }
}
__device__ __forceinline__ void pv_tile(f32x16* o, int vb0, bf16x8 pa0, bf16x8 pa1, bf16x8 pa2, bf16x8 pa3) {
#define TRRD(dst, off) asm volatile("ds_read_b64_tr_b16 %0, %1 offset:%2" : "=&v"(dst) : "v"(vb0), "i"(off) : "memory")
#define PV_D0(d0) do { s16x4 l0, l1, l2, l3, h0, h1, h2, h3; constexpr int b_ = v_rd_off(d0, 0, 0); \
        TRRD(l0, b_); TRRD(h0, b_ + 2048); TRRD(l1, b_ + 4096); TRRD(h1, b_ + 6144); TRRD(l2, b_ + 8192); TRRD(h2, b_ + 10240); TRRD(l3, b_ + 12288); TRRD(h3, b_ + 14336); \
        asm volatile("s_waitcnt lgkmcnt(0)" ::: "memory"); SBAR();   \
        o[d0] = __builtin_amdgcn_mfma_f32_32x32x16_bf16(pa0, (bf16x8){l0[0], l0[1], l0[2], l0[3], h0[0], h0[1], h0[2], h0[3]}, o[d0], 0, 0, 0);   \
        o[d0] = __builtin_amdgcn_mfma_f32_32x32x16_bf16(pa1, (bf16x8){l1[0], l1[1], l1[2], l1[3], h1[0], h1[1], h1[2], h1[3]}, o[d0], 0, 0, 0);   \
        o[d0] = __builtin_amdgcn_mfma_f32_32x32x16_bf16(pa2, (bf16x8){l2[0], l2[1], l2[2], l2[3], h2[0], h2[1], h2[2], h2[3]}, o[d0], 0, 0, 0);   \
        o[d0] = __builtin_amdgcn_mfma_f32_32x32x16_bf16(pa3, (bf16x8){l3[0], l3[1], l3[2], l3[3], h3[0], h3[1], h3[2], h3[3]}, o[d0], 0, 0, 0); } while (0)
    PV_D0(0); PV_D0(1); PV_D0(2); PV_D0(3);
#undef PV_D0
#undef TRRD
}
struct Stage { bf16x8 k0, k1, v0, v1; };
__device__ __forceinline__ void stage_load(Stage& S, const bf16* Kp, const bf16* Vp, int ld, int kb, int sr, int sc, bool withV) {
    const bf16* kt = Kp + (size_t)kb * ld; const bf16* vt = Vp + (size_t)kb * ld;
    const unsigned voff = (unsigned)(sr * ld + sc);
    S.k0 = *(const bf16x8*)(kt + voff); S.k1 = *(const bf16x8*)(kt + (size_t)32 * ld + voff);
    if (withV) { S.v0 = *(const bf16x8*)(vt + voff); S.v1 = *(const bf16x8*)(vt + (size_t)32 * ld + voff); }
}
__device__ __forceinline__ void stage_write(const Stage& S, char* lds, int sr, int sc, bool withV) {
    const int kws = KSWZ(sr, sc * 2);
    *(bf16x8*)(lds + O_K + kws) = S.k0; *(bf16x8*)(lds + O_K + kws + 32 * 256) = S.k1;
    if (withV) { *(bf16x8*)(lds + O_V + v_st(sr, sc)) = S.v0; *(bf16x8*)(lds + O_V + v_st(32 + sr, sc)) = S.v1; }
}
template <int ACC>
__device__ __forceinline__ void emit(const f32x16* o, const float* fl, char* OTw, int r32, int hi) {
    int r32o = r32, hio = hi; asm volatile("" : "+v"(r32o), "+v"(hio));
    char* base = OTw + 4 * hio * 2048 + r32o * 2;
#pragma unroll
    for (int r = 0; r < 16; ++r) { const float f = fl[(r & 3) + 8 * (r >> 2) + 4 * hio]; unsigned short* p = (unsigned short*)(base + ((r & 3) + 8 * (r >> 2)) * 2048);
#pragma unroll
        for (int d0 = 0; d0 < 4; ++d0) { float v = o[d0][r] * f;
            if (ACC >= 1) v += bf1(p[d0 * 32]);
            p[d0 * 32] = f2bf1(v); } }
}
template <int MODE, int ACC>
__device__ __forceinline__ void flash_pass(char* lds, const bf16* Kp, const bf16* Vp, int ld, unsigned long long tiles, int t, int qb, unsigned long long mymask, const bf16x8* qr, float c2, float gate, char* OTw,
                                           Stage& S, const bf16* Kn, const bf16* Vn, Stage* Sn, int tid, int wid, int lane) {
    const int r32 = lane & 31, hi = lane >> 5, sr = tid >> 4, sc = (tid & 15) * 8;
    float* ws = (float*)(lds + O_WS) + wid * 64; float* li_l = ws; float* al_l = ws + 32;
    const int vb0 = (int)(uintptr_t)(lds + O_V) + v_rd_base(lane);
    f32x16 o[4] = {}; float m_reg = -1e30f, l_reg = 0.f;
    unsigned long long rem = tiles;
    int j = __builtin_ctzll(rem); rem &= rem - 1;
    __syncthreads();
    stage_write(S, lds, sr, sc, true);
    int jn = rem ? __builtin_ctzll(rem) : -1;
    if (jn >= 0) { rem &= rem - 1; stage_load(S, Kp, Vp, ld, jn * KVBLK, sr, sc, true); }
    int cur = 0;
    for (;;) {
        __syncthreads();
        int jnn = -1;
        if (jn >= 0) { stage_write(S, lds + (cur ^ 1) * BUF1, sr, sc, true); jnn = rem ? __builtin_ctzll(rem) : -1;
            if (jnn >= 0) { rem &= rem - 1; stage_load(S, Kp, Vp, ld, jnn * KVBLK, sr, sc, true); } }
        f32x16 p0, p1; float alpha; bf16x8 pa0, pa1, pa2, pa3;
        float cinit = 0.f;
        if (MODE == 1) cinit = ((mymask >> j) & 1ull) ? 0.f : -__builtin_inff();
        qkt(p0, p1, lds + cur * BUF1 + O_K, r32, hi, qr, cinit);
        if (MODE == 0) { const int tok0_ = t - r32; if (!(j * KVBLK + 63 <= tok0_ && j * KVBLK >= tok0_ - 480)) mask_tile(p0, p1, t - j * KVBLK - 4 * hi, 512u); }
        else if (j == qb) mask_tile(p0, p1, t - j * KVBLK - 4 * hi, 0x7fffffffu);
        partialSM(p0, p1, m_reg, alpha, c2);
        finishSM(p0, p1, alpha, l_reg, pa0, pa1, pa2, pa3);
        if (__any(alpha < 1.f)) { if (hi == 0) al_l[r32] = alpha; asm volatile("s_waitcnt lgkmcnt(0)" ::: "memory");
#pragma unroll
            for (int d_ = 0; d_ < 4; ++d_)
#pragma unroll
                for (int r = 0; r < 16; ++r) o[d_][r] *= al_l[crow(r, hi)]; }
        pv_tile(o, vb0 + cur * BUF1, pa0, pa1, pa2, pa3);
        if (jn < 0) break;
        j = jn; jn = jnn; cur ^= 1;
    }
    if (Sn) stage_load(*Sn, Kn, Vn, ld, 0, sr, sc, true);
    if (hi == 0) li_l[r32] = gate / l_reg; asm volatile("s_waitcnt lgkmcnt(0)" ::: "memory");
    emit<ACC>(o, li_l, OTw, r32, hi);
}

__device__ __forceinline__ void unit(Frame& F, char* lds, int b, int g, int tg) {
    const int tid = F.tid, lane = F.lane, wid = F.wave, r32 = lane & 31, hi = lane >> 5, sr = tid >> 4, sc = (tid & 15) * 8;
    const int head = g * 8 + wid, tok0 = tg * 32, t = tok0 + r32, qb = tg >> 1, bg = b * 4 + g;
    const bf16* KVQ = (const bf16*)(F.ws + WS_BIG); const float* GT = (const float*)(F.ws + WS_GT);
    const bf16* KC = (const bf16*)(F.ws + WS_KC) + (size_t)bg * 256 * 128; const bf16* VC = (const bf16*)(F.ws + WS_VC) + (size_t)bg * 256 * 128;
    const size_t rowq = (size_t)b * SEQ + t;
    float* ws = (float*)(lds + O_WS) + wid * 64; float* li_l = ws;
    unsigned* pb = (unsigned*)(lds + O_PB); unsigned* selm = (unsigned*)(lds + O_SELM);
    const int vb0 = (int)(uintptr_t)(lds + O_V) + v_rd_base(lane);
    bf16x8 qr[8]; float ss = 0.f;
#pragma unroll
    for (int d0 = 0; d0 < 8; ++d0) { qr[d0] = *(const bf16x8*)(KVQ + rowq * NKVQ + KVW + head * 128 + d0 * 16 + hi * 8);
        const v4u w = __builtin_bit_cast(v4u, qr[d0]);
        ss += (bf_lo(w.x) * bf_lo(w.x) + bf_hi(w.x) * bf_hi(w.x)) + (bf_lo(w.y) * bf_lo(w.y) + bf_hi(w.y) * bf_hi(w.y)) + (bf_lo(w.z) * bf_lo(w.z) + bf_hi(w.z) * bf_hi(w.z)) + (bf_lo(w.w) * bf_lo(w.w) + bf_hi(w.w) * bf_hi(w.w)); }
    { auto rr = __builtin_amdgcn_permlane32_swap(__float_as_uint(ss), __float_as_uint(ss), false, false); ss = __uint_as_float(rr[0]) + __uint_as_float(rr[1]); }
    const float c2 = 1.4426950408889634f / sqrtf(ss * (1.f / 128.f) + EPS);
    const float g_cmp = GT[rowq * 96 + head], g_sel = GT[rowq * 96 + 32 + head], g_win = GT[rowq * 96 + 64 + head];
    for (int i = tid; i < 32 * 65; i += NWAVES * 64) pb[i] = 0u;
    char* OTw = lds + O_OT + wid * 256;
    const int nct = (tg >> 5) + 1; const int cmax = (t - 31) >> 4;
    float m_c = -1e30f, l_c = 0.f;
    { Stage S;
      for (int kt = 0; kt < nct; ++kt) {
          stage_load(S, KC, VC, 128, kt * 64, sr, sc, false);
          __syncthreads(); stage_write(S, lds, sr, sc, false); __syncthreads();
          f32x16 p0, p1; qkt(p0, p1, lds + O_K, r32, hi, qr, 0.f);
          mask_tile(p0, p1, cmax - kt * 64 - 4 * hi, 0x7fffffffu);
          const float pmax = rowmax32(p0, p1), mn = fmaxf(m_c, pmax), al = __builtin_amdgcn_exp2f((m_c - mn) * c2), mnL = -mn * c2;
#pragma unroll
          for (int r = 0; r < 16; ++r) { p0[r] = __builtin_amdgcn_exp2f(fmaf(p0[r], c2, mnL)); p1[r] = __builtin_amdgcn_exp2f(fmaf(p1[r], c2, mnL)); }
          l_c = l_c * al + rowsum32(p0, p1); m_c = mn; }
      const float inv_l = l_c > 0.f ? 1.f / l_c : 0.f; const float mnL = -m_c * c2;
      f32x16 o[4] = {};
      for (int kt = 0; kt < nct; ++kt) {
          stage_load(S, KC, VC, 128, kt * 64, sr, sc, true);
          __syncthreads(); stage_write(S, lds, sr, sc, true); __syncthreads();
          f32x16 p0, p1; qkt(p0, p1, lds + O_K, r32, hi, qr, 0.f);
          mask_tile(p0, p1, cmax - kt * 64 - 4 * hi, 0x7fffffffu);
#pragma unroll
          for (int r = 0; r < 16; ++r) { p0[r] = __builtin_amdgcn_exp2f(fmaf(p0[r], c2, mnL)) * inv_l; p1[r] = __builtin_amdgcn_exp2f(fmaf(p1[r], c2, mnL)) * inv_l; }
#pragma unroll
          for (int rg = 0; rg < 4; ++rg) { const int j0 = 16 * kt + 2 * rg + hi;
              const float a0 = (p0[4 * rg] + p0[4 * rg + 1]) + (p0[4 * rg + 2] + 0.5f * p0[4 * rg + 3]), b0 = 0.5f * p0[4 * rg + 3];
              const float a1 = (p1[4 * rg] + p1[4 * rg + 1]) + (p1[4 * rg + 2] + 0.5f * p1[4 * rg + 3]), b1 = 0.5f * p1[4 * rg + 3];
              atomicAdd(&pb[r32 * 65 + j0], (unsigned)(a0 * 67108864.f + 0.5f)); atomicAdd(&pb[r32 * 65 + j0 + 1], (unsigned)(b0 * 67108864.f + 0.5f));
              atomicAdd(&pb[r32 * 65 + j0 + 8], (unsigned)(a1 * 67108864.f + 0.5f)); atomicAdd(&pb[r32 * 65 + j0 + 9], (unsigned)(b1 * 67108864.f + 0.5f)); }
          bf16x8 pa0, pa1, pa2, pa3; packP(p0, p1, pa0, pa1, pa2, pa3);
          pv_tile(o, vb0, pa0, pa1, pa2, pa3); }
      if (hi == 0) li_l[r32] = g_cmp; asm volatile("s_waitcnt lgkmcnt(0)" ::: "memory");
      emit<0>(o, li_l, OTw, r32, hi); }
    const int lowk_ = tok0 - 511, wj_lo = lowk_ > 0 ? lowk_ >> 6 : 0, wj_hi = ((tok0 + 31) >> 6) + 1;
    const unsigned long long wtiles = ((wj_hi >= 64) ? ~0ull : ((1ull << wj_hi) - 1ull)) & ~((1ull << wj_lo) - 1ull);
    const bf16* Kw = KVQ + (size_t)b * SEQ * NKVQ + 4 * 512 + g * 128; const bf16* Vw = KVQ + (size_t)b * SEQ * NKVQ + 5 * 512 + g * 128;
    Stage SW; stage_load(SW, Kw, Vw, NKVQ, wj_lo * KVBLK, sr, sc, true);
    __syncthreads();
#pragma unroll 1
    for (int tt = 0; tt < 4; ++tt) { const int tok = 4 * wid + tt; const bool valid = lane <= qb; const bool forced = lane == 0 || lane == qb;
        const unsigned key = forced ? 0xFFFFFFFFu : pb[tok * 65 + lane]; int rank = 0;
        for (int i = 0; i <= qb; ++i) { const unsigned ki = (unsigned)__builtin_amdgcn_readlane((int)key, i); rank += (ki > key || (ki == key && i < lane)) ? 1 : 0; }
        const unsigned long long mk = __ballot(valid && rank < 16);
        if (lane == 0) { selm[2 * tok] = (unsigned)mk; selm[2 * tok + 1] = (unsigned)(mk >> 32); } }
    __syncthreads();
    const unsigned long long mymask = (unsigned long long)selm[2 * r32] | ((unsigned long long)selm[2 * r32 + 1] << 32);
    unsigned ulo = (unsigned)mymask, uhi = (unsigned)(mymask >> 32);
#pragma unroll
    for (int o_ = 1; o_ < 32; o_ <<= 1) { ulo |= __shfl_xor(ulo, o_); uhi |= __shfl_xor(uhi, o_); }
    const unsigned long long uni = (unsigned long long)(unsigned)__builtin_amdgcn_readfirstlane((int)ulo) | ((unsigned long long)(unsigned)__builtin_amdgcn_readfirstlane((int)uhi) << 32);
    { const bf16* Ks = KVQ + (size_t)b * SEQ * NKVQ + 2 * 512 + g * 128; const bf16* Vs = KVQ + (size_t)b * SEQ * NKVQ + 3 * 512 + g * 128;
      Stage SS;
      flash_pass<0, 1>(lds, Kw, Vw, NKVQ, wtiles, t, qb, 0ull, qr, c2, g_win, OTw, SW, Ks, Vs, &SS, tid, wid, lane);
      flash_pass<1, 2>(lds, Ks, Vs, NKVQ, uni, t, qb, mymask, qr, c2, g_sel, OTw, SS, nullptr, nullptr, nullptr, tid, wid, lane); }
    __syncthreads();
    { const int tok = tid >> 4, ch = tid & 15;
      const char* src = lds + O_OT + tok * 2048 + ch * 128; unsigned char* dst = (unsigned char*)(F.ws + WS_A3) + ((size_t)b * SEQ + tok0 + tok) * DM + g * 1024 + ch * 64;
#pragma unroll
      for (int i = 0; i < 4; ++i) { const v4u w0 = *(const v4u*)(src + i * 32), w1 = *(const v4u*)(src + i * 32 + 16); v4u q; const unsigned ws_[8] = {w0.x, w0.y, w0.z, w0.w, w1.x, w1.y, w1.z, w1.w}; int qq[4];
#pragma unroll
          for (int e = 0; e < 4; ++e) { int t_ = __builtin_amdgcn_cvt_pk_fp8_f32(bf_lo(ws_[2 * e]) * 64.f, bf_hi(ws_[2 * e]) * 64.f, 0, false); qq[e] = __builtin_amdgcn_cvt_pk_fp8_f32(bf_lo(ws_[2 * e + 1]) * 64.f, bf_hi(ws_[2 * e + 1]) * 64.f, t_, true); }
          q.x = (unsigned)qq[0]; q.y = (unsigned)qq[1]; q.z = (unsigned)qq[2]; q.w = (unsigned)qq[3]; *(v4u*)(dst + i * 16) = q; } }
    __syncthreads();
}
#undef KSWZ
#undef SBAR
}
__device__ __forceinline__ void nsa_attn_phase(Frame& F) {
    for (int ui = blockIdx.x; ui < 1024; ui += F.G) { const int vw = ui & 255, rnd = ui >> 8, bg = vw & 7, s = vw >> 3;
        const int tg = rnd == 0 ? s : rnd == 1 ? 63 - s : rnd == 2 ? 64 + s : 127 - s;
        nsa::unit(F, (char*)(F.lds + RING_OFF), bg >> 2, bg & 3, tg); }
}

struct Args { const float* in[18]; float* out; unsigned char* ws; int ph_lo, ph_hi; };
__global__ void __launch_bounds__(NWAVES * 64, 2) skel_fwd(Args args) {
    extern __shared__ __attribute__((aligned(16))) unsigned char lds[];
    Frame F;
    F.lds = (LAS unsigned char*)lds;
    F.MISC = (volatile LAS unsigned*)(F.lds + MISC_OFF);
    F.tid = threadIdx.x; F.lane = F.tid & 63; F.wave = __builtin_amdgcn_readfirstlane(F.tid >> 6);
    F.G = gridDim.x;
    unsigned char* ws = args.ws; F.ws = ws; F.out = args.out;
#pragma unroll
    for (int i = 0; i < 18; ++i) F.in[i] = args.in[i];
    F.ctl = (gu32*)(ws + WS_CTL);
    for (int u = F.tid; u < (LDS_BYTES - LDSCTL_OFF) / 4; u += NWAVES * 64) ((LAS unsigned*)(F.lds + LDSCTL_OFF))[u] = 0u;
    __syncthreads();
    XcdBarrier bar; bar.bar = (unsigned*)(F.ctl + CW_BAR); bar.x = 0; bar.st = nullptr;
    if (!MK_PER_PHASE) bar = xcd_barrier_post((unsigned*)(F.ctl + CW_BAR), F.MISC + 8);
    const int lo = args.ph_lo, hi = args.ph_hi;
#ifndef PHASE_MASK
#define PHASE_MASK 0x1ffff
#endif
#define IN(k) (((PHASE_MASK >> (k)) & 1) && lo <= (k) && (k) < hi)
#ifndef DUP_MASK
#define DUP_MASK 0
#endif
#ifndef PROBE_ML
#define PROBE_ML 0
#endif
#ifndef PROBE2
#define PROBE2 0
#endif
#ifndef CW_TAIL
#define CW_TAIL 10240
#endif
#ifndef TS_ON
#define TS_ON 0
#define TS_LO 0
#define TS_HI 0
#endif
#define REP(k) for (int rep_ = 0, nrep_ = 1 + ((DUP_MASK >> (k)) & 1); rep_ < nrep_; ++rep_, (rep_ < nrep_ ? xcd_barrier(bar) : (void)0))
#define SEAM(k) do { if (IN(k) && (hi > (k) + 1)) xcd_barrier(bar); if (TS_ON && (k) == TS_HI) ts1 = __builtin_amdgcn_s_memrealtime(); } while (0)
    unsigned long long ts0 = 0, ts1 = 0;
    bf16* XB = (bf16*)(ws + WS_XB); bf16* A3 = (bf16*)(ws + WS_A3); bf16* BIG = (bf16*)(ws + WS_BIG);
    bf16* X1 = (bf16*)(ws + WS_X1); bf16* X2 = (bf16*)(ws + WS_X2); bf16* X3 = X1;

    if (TS_ON && 0 == TS_LO) ts0 = __builtin_amdgcn_s_memrealtime(); if (IN(0)) REP(0) { p0_prologue(F); } SEAM(0);
    if (TS_ON && 1 == TS_LO) ts0 = __builtin_amdgcn_s_memrealtime(); if (IN(1)) REP(1) {
        pg8::Gemm g{XB, (const bf16*)(ws + WS_WIN), MTOK, M_MAIN, DM}; pg8::StaticOrder S; S.init(MTOK, M_MAIN, F.G, (int)blockIdx.x);
        pg8::EpiBf16<0> E{BIG, M_MAIN, nullptr};
        pg8::gemm_phase<pg8::EpiBf16<0>, pg8::StaticOrder, true, true>(F.lds + RING_OFF, g, S, E);
        gates1_phase(F);
    } SEAM(1);
    if (TS_ON && 2 == TS_LO) ts0 = __builtin_amdgcn_s_memrealtime(); if (IN(2)) REP(2) {
        const int bid = (int)blockIdx.x;
        if (F.G == 256) {
            const int x = bid & 7, y = bid >> 3;
            if (x < 4) mlstm_phase(F, (x * 4 + (y >> 3)) * 8 + (y & 7), 128);
            else if (!(PROBE_ML && rep_)) { const int wk = (y * 4 + (x - 4)) * NWAVES + F.wave; convert_narrow(F, 64, 256, wk, 128 * NWAVES); if (Q8_STRIPS) convert_strips(F, (x - 4) * 32 + y, 128); convert_wide(F, CW_EARLY, CW_TOTAL, wk, 128 * NWAVES); }
        } else {
            mlstm_phase(F, bid, F.G); if (Q8_STRIPS) convert_strips(F, bid, F.G); convert_wide(F, CW_EARLY, CW_TOTAL, bid * NWAVES + F.wave, F.G * NWAVES); convert_narrow(F, 64, 256, bid * NWAVES + F.wave, F.G * NWAVES);
        }
    } SEAM(2);
#if PROBE2 == 1
    { xcd_barrier(bar); const int bid = (int)blockIdx.x, x = bid & 7, y = bid >> 3; if (x < 4) mlstm_phase(F, (x * 4 + (y >> 3)) * 8 + (y & 7), 128); xcd_barrier(bar); }
#elif PROBE2 == 2
    { xcd_barrier(bar); const int bid = (int)blockIdx.x, x = bid & 7, y = bid >> 3; if (x >= 4) { const int wk = (y * 4 + (x - 4)) * NWAVES + F.wave; convert_wide(F, CW_EARLY, CW_TOTAL, wk, 128 * NWAVES); } xcd_barrier(bar); }
#elif PROBE2 == 4
    { xcd_barrier(bar); const int bid = (int)blockIdx.x, x = bid & 7, y = bid >> 3;
      if (x < 4) mlstm_phase(F, (x * 4 + (y >> 3)) * 8 + (y & 7), 128);
      else { const int wk = (y * 4 + (x - 4)) * NWAVES + F.wave; convert_wide(F, CW_EARLY, CW_TOTAL, wk, 128 * NWAVES); }
      xcd_barrier(bar); }
#elif PROBE2 == 3
    { xcd_barrier(bar); convert_wide(F, CW_EARLY, CW_TOTAL, blockIdx.x * NWAVES + F.wave, F.G * NWAVES); xcd_barrier(bar); }
#endif
    if (TS_ON && 3 == TS_LO) ts0 = __builtin_amdgcn_s_memrealtime(); if (IN(3)) REP(3) { gating_phase(F);
        if (Q8_WMO && !Q8_STRIPS) wquant_phase(F, (const bf16*)(ws + WS_WMO), (const float*)(ws + CTL_CMAX) + 49152, (unsigned char*)(ws + WS_WMOQ), DM);
        if ((Q8_UP_MASK & 1) && !Q8_STRIPS) wquant_phase(F, (const bf16*)(ws + WS_WUP0), (const float*)(ws + CTL_CMAX), (unsigned char*)(ws + WS_WUPQ0), DFF);
        if ((Q8_UP_MASK & 2) && !Q8_STRIPS) wquant_phase(F, (const bf16*)(ws + WS_WUP1), (const float*)(ws + CTL_CMAX) + 16384, (unsigned char*)(ws + WS_WUPQ1), DFF);
        if (Q8_KVQ && !Q8_STRIPS) wquant_phase(F, (const bf16*)(ws + WS_WKVQ), (const float*)(ws + CTL_CMAX) + 32768, (unsigned char*)(ws + WS_WKVQ8), NKVQ);
        if (blockIdx.x == 0) { const float* pp = (const float*)(ws + WS_POSP); float* posb = (float*)(ws + WS_POSB);
            for (int i = F.tid; i < 1024; i += NWAVES * 64) { float a = 0.f;
#pragma unroll 8
                for (int ch = 0; ch < 32; ++ch) a += pp[ch * 1024 + i];
                posb[i] = a; } }
    } SEAM(3);
    if (TS_ON && 4 == TS_LO) ts0 = __builtin_amdgcn_s_memrealtime(); if (IN(4)) REP(4) {
        pg8::StaticOrder S; S.init(MTOK, DM, F.G, (int)blockIdx.x);
        if (Q8_WMO) { pg8::Gemm g{A3, (const bf16*)(ws + WS_WMOQ), MTOK, DM, DM};
            pg8::EpiRes<false, true, true> E{F.in[0], X1, (float*)(ws + WS_PART), DM, 1.f, nullptr, (const float*)(ws + WS_RS) + 24576, (const float*)(ws + CTL_CMAX) + 49152};
            pg8::gemm_phase<pg8::EpiRes<false, true, true>, pg8::StaticOrder, true, true, 2>(F.lds + RING_OFF, g, S, E); }
        else { pg8::Gemm g{A3, (const bf16*)(ws + WS_WMO), MTOK, DM, DM};
            pg8::EpiRes<false, true> E{F.in[0], X1, (float*)(ws + WS_PART), DM};
            pg8::gemm_phase<pg8::EpiRes<false, true>, pg8::StaticOrder, true, true>(F.lds + RING_OFF, g, S, E); }
    } SEAM(4);
    if (TS_ON && 5 == TS_LO) ts0 = __builtin_amdgcn_s_memrealtime(); if (IN(5)) REP(5) { if (Q8_UP_MASK & 1) rstd_phase(F, (float*)(ws + WS_RS), X1, (unsigned char*)(ws + WS_XQ), (float*)(ws + WS_RS) + 24576); else rstd_phase(F, (float*)(ws + WS_RS)); } SEAM(5);
    if (TS_ON && 6 == TS_LO) ts0 = __builtin_amdgcn_s_memrealtime(); if (IN(6)) REP(6) {
        pg8::StaticOrder S; S.init(MTOK, DFF, F.G, (int)blockIdx.x);
        if (Q8_UP_MASK & 1) { pg8::Gemm g{(const bf16*)(ws + WS_XQ), (const bf16*)(ws + WS_WUPQ0), MTOK, DFF, DM};
            pg8::EpiQ8<2> E{BIG, DFF, (const float*)(ws + CTL_CMAX), (const float*)(ws + WS_RS) + 24576};
            pg8::gemm_phase<pg8::EpiQ8<2>, pg8::StaticOrder, true, true, 2>(F.lds + RING_OFF, g, S, E); }
        else { pg8::Gemm g{X1, (const bf16*)(ws + WS_WUP0), MTOK, DFF, DM};
            pg8::EpiBf16<2, true> E{BIG, DFF, (const float*)(ws + WS_RS)};
            pg8::gemm_phase<pg8::EpiBf16<2, true>, pg8::StaticOrder, true, true>(F.lds + RING_OFF, g, S, E); }
    } SEAM(6);
    if (TS_ON && 7 == TS_LO) ts0 = __builtin_amdgcn_s_memrealtime(); if (IN(7)) REP(7) {
        pg8::Gemm g{BIG, (const bf16*)(ws + WS_WDN0), MTOK, DM, DFF}; pg8::StaticOrder S; S.init(MTOK, DM, F.G, (int)blockIdx.x);
        pg8::EpiRes<true, true> E{X1, X2, (float*)(ws + WS_PART), DM, 1.f, Q8_KVQ ? nullptr : (unsigned char*)(ws + WS_HR)};
        pg8::gemm_phase<pg8::EpiRes<true, true>, pg8::StaticOrder, true, true>(F.lds + RING_OFF, g, S, E);
    } SEAM(7);
    if (TS_ON && 8 == TS_LO) ts0 = __builtin_amdgcn_s_memrealtime(); if (IN(8)) REP(8) { if (Q8_KVQ) rstd_phase(F, (float*)(ws + WS_RS) + 8192, X2, (unsigned char*)(ws + WS_XQ), (float*)(ws + WS_RS) + 24576); else rstd_phase(F, (float*)(ws + WS_RS) + 8192); } SEAM(8);
    if (TS_ON && 9 == TS_LO) ts0 = __builtin_amdgcn_s_memrealtime(); if (IN(9)) REP(9) {
        pg8::StaticOrder S; S.init(MTOK, NKVQ, F.G, (int)blockIdx.x);
        if (Q8_KVQ) { pg8::Gemm g{(const bf16*)(ws + WS_XQ), (const bf16*)(ws + WS_WKVQ8), MTOK, NKVQ, DM};
            pg8::EpiQ8<0> E{BIG, NKVQ, (const float*)(ws + CTL_CMAX) + 32768, (const float*)(ws + WS_RS) + 24576};
            pg8::gemm_phase<pg8::EpiQ8<0>, pg8::StaticOrder, true, true, 2>(F.lds + RING_OFF, g, S, E); }
        else { pg8::Gemm g{(const bf16*)(ws + WS_HR), (const bf16*)(ws + WS_WKVQ), MTOK, NKVQ, DM};
            pg8::EpiBf16<0, true> E{BIG, NKVQ, (const float*)(ws + WS_RS) + 8192, 1.f / 256.f};
            pg8::gemm_phase<pg8::EpiBf16<0, true>, pg8::StaticOrder, true, true, 1>(F.lds + RING_OFF, g, S, E); }
        gates2_phase(F);
    } SEAM(9);
    if (TS_ON && 10 == TS_LO) ts0 = __builtin_amdgcn_s_memrealtime(); if (IN(10)) REP(10) { nsa_prep_phase(F); } SEAM(10);
    if (TS_ON && 11 == TS_LO) ts0 = __builtin_amdgcn_s_memrealtime();
    if (TS_ON && 12 == TS_LO) ts0 = __builtin_amdgcn_s_memrealtime(); if (IN(12)) REP(12) { nsa_attn_phase(F); } SEAM(12);
    if (TS_ON && 13 == TS_LO) ts0 = __builtin_amdgcn_s_memrealtime(); if (IN(13)) REP(13) {
        pg8::Gemm g{A3, (const bf16*)(ws + WS_WNO), MTOK, DM, DM}; pg8::StaticOrder S; S.init(MTOK, DM, F.G, (int)blockIdx.x);
        pg8::EpiRes<true, true> E{X2, X3, (float*)(ws + WS_PART), DM, 1.f / 16384.f};
        pg8::gemm_phase<pg8::EpiRes<true, true>, pg8::StaticOrder, true, true, 1>(F.lds + RING_OFF, g, S, E);
    } SEAM(13);
    if (TS_ON && 14 == TS_LO) ts0 = __builtin_amdgcn_s_memrealtime(); if (IN(14)) REP(14) { if (Q8_UP_MASK & 2) rstd_phase(F, (float*)(ws + WS_RS) + 16384, X3, (unsigned char*)(ws + WS_XQ), (float*)(ws + WS_RS) + 24576); else rstd_phase(F, (float*)(ws + WS_RS) + 16384); } SEAM(14);
    if (TS_ON && 15 == TS_LO) ts0 = __builtin_amdgcn_s_memrealtime(); if (IN(15)) REP(15) {
        pg8::StaticOrder S; S.init(MTOK, DFF, F.G, (int)blockIdx.x);
        if (Q8_UP_MASK & 2) { pg8::Gemm g{(const bf16*)(ws + WS_XQ), (const bf16*)(ws + WS_WUPQ1), MTOK, DFF, DM};
            pg8::EpiQ8<2> E{BIG, DFF, (const float*)(ws + CTL_CMAX) + 16384, (const float*)(ws + WS_RS) + 24576};
            pg8::gemm_phase<pg8::EpiQ8<2>, pg8::StaticOrder, true, true, 2>(F.lds + RING_OFF, g, S, E); }
        else { pg8::Gemm g{X3, (const bf16*)(ws + WS_WUP1), MTOK, DFF, DM};
            pg8::EpiBf16<2, true> E{BIG, DFF, (const float*)(ws + WS_RS) + 16384};
            pg8::gemm_phase<pg8::EpiBf16<2, true>, pg8::StaticOrder, true, true>(F.lds + RING_OFF, g, S, E); }
    } SEAM(15);
    if (TS_ON && 16 == TS_LO) ts0 = __builtin_amdgcn_s_memrealtime(); if (IN(16)) REP(16) {
        pg8::Gemm g{BIG, (const bf16*)(ws + WS_WDN1), MTOK, DM, DFF}; pg8::StaticOrder S; S.init(MTOK, DM, F.G, (int)blockIdx.x);
        pg8::EpiRes<true, false> E{X3, F.out, nullptr, DM};
        pg8::gemm_phase<pg8::EpiRes<true, false>, pg8::StaticOrder, true, true>(F.lds + RING_OFF, g, S, E);
    }
#if TS_ON
    if (TS_HI == 16) ts1 = __builtin_amdgcn_s_memrealtime();
    xcd_barrier(bar);
    if (blockIdx.x == 0 && F.tid == 0) F.out[0] = (float)(ts1 - ts0) * 0.01f;
#endif
#undef IN
#undef SEAM
}

extern "C" void kernel_launch(void* const* d_in, const int* in_sizes, int n_in, void* d_out, int out_size, void* d_ws, size_t ws_size, hipStream_t stream) {
    static int grid = 0;
    if (grid == 0) {
        if (n_in != 18 || in_sizes[0] != MTOK * DM || out_size != MTOK * DM || ws_size < WS_END) { fprintf(stderr, "kernel_launch: unexpected shapes (n_in %d, in0 %d, out %d, ws %zu); nothing launched\n", n_in, n_in > 0 ? in_sizes[0] : -1, out_size, ws_size); grid = -1; return; }
        int dev = 0, cus = 0, per_cu = 0;
        if (hipGetDevice(&dev) != hipSuccess || hipDeviceGetAttribute(&cus, hipDeviceAttributeMultiprocessorCount, dev) != hipSuccess) { grid = -1; return; }
        if (hipFuncSetAttribute((const void*)skel_fwd, hipFuncAttributeMaxDynamicSharedMemorySize, LDS_BYTES) != hipSuccess) { fprintf(stderr, "kernel_launch: hipFuncSetAttribute failed\n"); grid = -1; return; }
        if (hipOccupancyMaxActiveBlocksPerMultiprocessor(&per_cu, (const void*)skel_fwd, NWAVES * 64, LDS_BYTES) != hipSuccess || per_cu < 1) fprintf(stderr, "kernel_launch: occupancy query reports %d\n", per_cu);
        (void)hipGetLastError();
        grid = cus;
    }
    if (grid < 0) return;
    if (hipMemsetAsync((char*)d_ws + WS_CTL, 0, CTL_ZERO_BYTES, stream) != hipSuccess) return;
    Args a{};
    for (int i = 0; i < 18; ++i) a.in[i] = (const float*)d_in[i];
    a.out = (float*)d_out; a.ws = (unsigned char*)d_ws;
#if MK_PER_PHASE
    for (int p = 0; p < N_PHASES; ++p) { a.ph_lo = p; a.ph_hi = p + 1; hipLaunchKernelGGL(skel_fwd, dim3(grid), dim3(NWAVES * 64), LDS_BYTES, stream, a); }
#else
    a.ph_lo = 0; a.ph_hi = N_PHASES; hipLaunchKernelGGL(skel_fwd, dim3(grid), dim3(NWAVES * 64), LDS_BYTES, stream, a);
#endif
}
```

```cpp
#include <hip/hip_runtime.h>
#include <hip/hip_bf16.h>
#include <cstdio>
#include <cstdint>
#include <cmath>
namespace pg8 {
#define PG8_LAS __attribute__((address_space(3)))
typedef unsigned short bf16_t;
typedef short bf16x8 __attribute__((ext_vector_type(8)));
typedef float f32x4 __attribute__((ext_vector_type(4)));
typedef unsigned u32x4 __attribute__((ext_vector_type(4)));
typedef int v8i32_t __attribute__((ext_vector_type(8)));
typedef int v4i32_t __attribute__((ext_vector_type(4)));
constexpr int BM = 256, BK = 64, HALF = 128, HTB = HALF * BK * 2  , STAGE_BYTES = 8 * HTB, NXCD = 8, WGM = 8;

__host__ __device__ __forceinline__ int lds_byte(int r, int c) { const int st = (r >> 4) * 2 + (c >> 5), rr = r & 15, cc = c & 31, ob = rr * 64 + cc * 2; return st * 1024 + (ob ^ (((ob >> 9) & 1) << 5)); }
__host__ __device__ __forceinline__ void stage_rc(int b, int& R, int& C) { const int st = b / 1024, sb = b % 1024, swz = sb ^ (((sb >> 9) & 1) << 5); R = (st >> 1) * 16 + swz / 64; C = (st & 1) * 32 + (swz % 64) / 2; }
__host__ __device__ __forceinline__ int perm32(int rho) { const int n = rho >> 4, i = rho & 15; return 8 * (i >> 2) + 4 * n + (i & 3); }

struct Unit { int pm, pn; };
struct Gemm { const bf16_t* A; const bf16_t* Bt; int M, N, K; };

struct StaticOrder {
    int nM, nN, nwg, G, c;
    __host__ __device__ void init(int M, int N, int G_, int c_) { nM = M / BM; nN = N / BM; nwg = nM * nN; G = G_; c = c_; }
    __host__ __device__ bool next(int i, Unit& u) const {
        const long L = (long)i * G + c; if (L >= nwg) return false;
        int wgid = (int)L; { const int q = nwg / NXCD, r = nwg % NXCD, xcd = wgid % NXCD, off = wgid / NXCD; wgid = (xcd < r ? xcd * (q + 1) : r * (q + 1) + (xcd - r) * q) + off; }
        const int nig = WGM * nN, gid = wgid / nig, fm = gid * WGM, gsz = (nM - fm) < WGM ? (nM - fm) : WGM;
        u.pm = fm + ((wgid % nig) % gsz); u.pn = (wgid % nig) / gsz; return true;
    }
    __device__ __forceinline__ void a_ready(const Unit&) const {}
    __device__ __forceinline__ void done(const Unit&) const {}
};

typedef float f32x2c __attribute__((ext_vector_type(2))); typedef __bf16 bf16x2c __attribute__((ext_vector_type(2)));
__device__ __forceinline__ unsigned cvt_pk_bf16(float lo, float hi) { f32x2c v = {lo, hi}; bf16x2c b = __builtin_convertvector(v, bf16x2c); return __builtin_bit_cast(unsigned, b); }
template <int ACT  , bool SCALED = false> struct EpiBf16 {
    static constexpr bool PERM = true, AFTER_DRAIN = false;
    bf16_t* O; int ldc; const float* rstd; float osc = 1.f;
    __device__ __forceinline__ void operator()(const f32x4 (&acc)[2][2][4][2], const Unit& u, int wr, int wc, int fr, int fq) const {
        const int row0 = u.pm * BM + wr * 64 + fr, col0 = u.pn * BM + wc * 32 + 8 * fq;
#pragma unroll
        for (int ai = 0; ai < 2; ++ai)
#pragma unroll
            for (int m = 0; m < 4; ++m) { const int row = row0 + ai * HALF + m * 16; bf16_t* rowp = O + (size_t)row * ldc + col0;
                const float rs = (SCALED ? rstd[row] : 1.f) * osc;
#pragma unroll
                for (int bj = 0; bj < 2; ++bj) { f32x4 v0 = acc[ai][bj][m][0], v1 = acc[ai][bj][m][1];
                    v0 = v0 * rs; v1 = v1 * rs;
                    if (ACT == 2) {
#pragma unroll
                        for (int e = 0; e < 4; ++e) { const float a = fmaxf(v0[e], 0.f), b = fmaxf(v1[e], 0.f); v0[e] = a * a; v1[e] = b * b; } }
                    u32x4 w; w.x = cvt_pk_bf16(v0[0], v0[1]); w.y = cvt_pk_bf16(v0[2], v0[3]); w.z = cvt_pk_bf16(v1[0], v1[1]); w.w = cvt_pk_bf16(v1[2], v1[3]);
                    *(u32x4*)(rowp + bj * HALF) = w; } }
    }
};
template <bool BASE_BF16, bool OUT_BF16, bool Q8 = false> struct EpiRes {
    static constexpr bool PERM = true, AFTER_DRAIN = false;
    const void* base; void* out; float* part; int ldc; float osc = 1.f; unsigned char* o8 = nullptr; const float* ra = nullptr; const float* cmax = nullptr;
    __device__ __forceinline__ void operator()(const f32x4 (&acc)[2][2][4][2], const Unit& u, int wr, int wc, int fr, int fq) const {
        const int col0 = u.pn * BM + wc * 32 + 8 * fq;
        f32x4 cs[2][2];
        if (Q8) {
#pragma unroll
            for (int bj = 0; bj < 2; ++bj) { cs[bj][0] = *(const f32x4*)(cmax + col0 + bj * HALF) * (1.f / 127.f); cs[bj][1] = *(const f32x4*)(cmax + col0 + bj * HALF + 4) * (1.f / 127.f); } }
#pragma unroll
        for (int ai = 0; ai < 2; ++ai)
#pragma unroll
            for (int m = 0; m < 4; ++m) { const int row = u.pm * BM + ai * HALF + wr * 64 + m * 16 + fr; const size_t off = (size_t)row * ldc + col0; float s = 0.f; float rr = 0.f; if (Q8) rr = ra[row];
#pragma unroll
                for (int bj = 0; bj < 2; ++bj) { f32x4 b0, b1;
                    if (BASE_BF16) { const u32x4 w = *(const u32x4*)((const bf16_t*)base + off + bj * HALF);
                        b0 = (f32x4){__uint_as_float(w.x << 16), __uint_as_float(w.x & 0xffff0000u), __uint_as_float(w.y << 16), __uint_as_float(w.y & 0xffff0000u)};
                        b1 = (f32x4){__uint_as_float(w.z << 16), __uint_as_float(w.z & 0xffff0000u), __uint_as_float(w.w << 16), __uint_as_float(w.w & 0xffff0000u)}; }
                    else { b0 = *(const f32x4*)((const float*)base + off + bj * HALF); b1 = *(const f32x4*)((const float*)base + off + bj * HALF + 4); }
                    f32x4 o0, o1;
                    if (Q8) { const v4i32_t i0 = __builtin_bit_cast(v4i32_t, acc[ai][bj][m][0]), i1 = __builtin_bit_cast(v4i32_t, acc[ai][bj][m][1]);
#pragma unroll
                        for (int e = 0; e < 4; ++e) { o0[e] = b0[e] + (float)i0[e] * rr * cs[bj][0][e]; o1[e] = b1[e] + (float)i1[e] * rr * cs[bj][1][e]; } }
                    else { o0 = b0 + acc[ai][bj][m][0] * osc; o1 = b1 + acc[ai][bj][m][1] * osc; }
                    if (o8) { typedef int i32x2 __attribute__((ext_vector_type(2))); i32x2 q; q.x = __builtin_amdgcn_cvt_pk_fp8_f32(o0[0], o0[1], 0, false); q.x = __builtin_amdgcn_cvt_pk_fp8_f32(o0[2], o0[3], q.x, true);
                        q.y = __builtin_amdgcn_cvt_pk_fp8_f32(o1[0], o1[1], 0, false); q.y = __builtin_amdgcn_cvt_pk_fp8_f32(o1[2], o1[3], q.y, true); *(i32x2*)(o8 + off + bj * HALF) = q; }
                    s += ((o0[0] * o0[0] + o0[1] * o0[1]) + (o0[2] * o0[2] + o0[3] * o0[3])) + ((o1[0] * o1[0] + o1[1] * o1[1]) + (o1[2] * o1[2] + o1[3] * o1[3]));
                    if (OUT_BF16) { u32x4 w; w.x = cvt_pk_bf16(o0[0], o0[1]); w.y = cvt_pk_bf16(o0[2], o0[3]); w.z = cvt_pk_bf16(o1[0], o1[1]); w.w = cvt_pk_bf16(o1[2], o1[3]); *(u32x4*)((bf16_t*)out + off + bj * HALF) = w; }
                    else { *(f32x4*)((float*)out + off + bj * HALF) = o0; *(f32x4*)((float*)out + off + bj * HALF + 4) = o1; } }
                if (part) { s += __shfl_xor(s, 16); s += __shfl_xor(s, 32); if (fq == 0) part[(size_t)row * 64 + u.pn * 4 + wc] = s; } }
    }
};
template <int ACT> struct EpiQ8 {
    static constexpr bool PERM = true, AFTER_DRAIN = false;
    bf16_t* O; int ldc; const float* cmax; const float* ra;
    __device__ __forceinline__ void operator()(const f32x4 (&acc)[2][2][4][2], const Unit& u, int wr, int wc, int fr, int fq) const {
        const int row0 = u.pm * BM + wr * 64 + fr, col0 = u.pn * BM + wc * 32 + 8 * fq;
        f32x4 cs[2][2];
#pragma unroll
        for (int bj = 0; bj < 2; ++bj) { cs[bj][0] = *(const f32x4*)(cmax + col0 + bj * HALF) * (1.f / 127.f); cs[bj][1] = *(const f32x4*)(cmax + col0 + bj * HALF + 4) * (1.f / 127.f); }
#pragma unroll
        for (int ai = 0; ai < 2; ++ai)
#pragma unroll
            for (int m = 0; m < 4; ++m) { const int row = row0 + ai * HALF + m * 16; bf16_t* rowp = O + (size_t)row * ldc + col0; const float rr = ra[row];
#pragma unroll
                for (int bj = 0; bj < 2; ++bj) { const v4i32_t i0 = __builtin_bit_cast(v4i32_t, acc[ai][bj][m][0]), i1 = __builtin_bit_cast(v4i32_t, acc[ai][bj][m][1]); f32x4 v0, v1;
#pragma unroll
                    for (int e = 0; e < 4; ++e) { float a = (float)i0[e] * rr * cs[bj][0][e], b = (float)i1[e] * rr * cs[bj][1][e]; if (ACT == 2) { a = fmaxf(a, 0.f); b = fmaxf(b, 0.f); a *= a; b *= b; } v0[e] = a; v1[e] = b; }
                    u32x4 w; w.x = cvt_pk_bf16(v0[0], v0[1]); w.y = cvt_pk_bf16(v0[2], v0[3]); w.z = cvt_pk_bf16(v1[0], v1[1]); w.w = cvt_pk_bf16(v1[2], v1[3]);
                    *(u32x4*)(rowp + bj * HALF) = w; } }
    }
};
template <class Epi, class Sched, bool ALIGN_EPI = false, bool SP2 = false, int QM = 0>
__device__ __forceinline__ void gemm_phase(PG8_LAS unsigned char* lds, const Gemm g, const Sched& S, const Epi& E) {
    const int tid = threadIdx.x, wid = __builtin_amdgcn_readfirstlane(tid >> 6), lane = tid & 63, wr = wid >> 2, wc = wid & 3, fr = lane & 15, fq = lane >> 4;
    constexpr bool F8 = QM == 1, I8 = QM == 2;
    constexpr int ES = QM ? 1 : 2;
    const int K = g.K, nt = K / (QM ? 2 * BK : BK);
    unsigned voffA[2], voffB[2];
#pragma unroll
    for (int i = 0; i < 2; ++i) { int R, C; stage_rc(tid * 16 + i * 8192, R, C); const int Rb = Epi::PERM ? ((R & ~31) + perm32(R & 31)) : R;
        voffA[i] = (unsigned)(R * K * ES + C * 2); voffB[i] = (unsigned)(Rb * K * ES + C * 2); }
    const size_t kstep = (size_t)(BK * 2);
    const size_t hstep = (size_t)HALF * K * ES;
    const size_t tstep = 2 * hstep;
    const unsigned ldsw = (unsigned)wid * 1024u;
    const int aoff = lds_byte(wr * 64 + fr, F8 ? fq * 16 : fq * 8), boff = lds_byte(wc * 32 + fr, F8 ? fq * 16 : fq * 8);
#define PG8_SA(b, h) (((b) * 2 + (h)) * HTB)
#define PG8_SB(b, h) ((4 + (b) * 2 + (h)) * HTB)
#define PG8_STAGE(bufoff, gbase, voff) do { _Pragma("unroll") for (int _i = 0; _i < 2; ++_i) \
        __builtin_amdgcn_global_load_lds((const unsigned*)((const char*)(gbase) + (voff)[_i]), (PG8_LAS unsigned*)(lds + (bufoff) + ldsw + _i * 8192), 16, 0, 0); } while (0)
#define PG8_LDA(dst, b, h) do { if constexpr (F8) { _Pragma("unroll") for (int m = 0; m < 4; ++m) dst##8[m] = *(const PG8_LAS v8i32_t*)(lds + PG8_SA(b, h) + aoff + m * 2048); } \
        else { _Pragma("unroll") for (int m = 0; m < 4; ++m) _Pragma("unroll") for (int k = 0; k < 2; ++k) dst[m][k] = *(const PG8_LAS bf16x8*)(lds + PG8_SA(b, h) + aoff + m * 2048 + k * 1024); } } while (0)
#define PG8_LDB(dst, b, h) do { if constexpr (F8) { _Pragma("unroll") for (int n = 0; n < 2; ++n) dst##8[n] = *(const PG8_LAS v8i32_t*)(lds + PG8_SB(b, h) + boff + n * 2048); } \
        else { _Pragma("unroll") for (int n = 0; n < 2; ++n) _Pragma("unroll") for (int k = 0; k < 2; ++k) dst[n][k] = *(const PG8_LAS bf16x8*)(lds + PG8_SB(b, h) + boff + n * 2048 + k * 1024); } } while (0)
#define PG8_MMA(ai, bj, At, Bt) do { __builtin_amdgcn_s_setprio(1); _Pragma("unroll") for (int m = 0; m < 4; ++m) _Pragma("unroll") for (int n = 0; n < 2; ++n) { \
        if constexpr (F8) asm volatile("v_mfma_scale_f32_16x16x128_f8f6f4 %0, %1, %2, %0, %3, %3 op_sel_hi:[0,0,0]" : "+v"(acc[ai][bj][m][n]) : "v"(Bt##8[n]), "v"(At##8[m]), "v"(scl8));   \
        else if constexpr (I8) { _Pragma("unroll") for (int k = 0; k < 2; ++k) acc[ai][bj][m][n] = __builtin_bit_cast(f32x4, __builtin_amdgcn_mfma_i32_16x16x64_i8(__builtin_bit_cast(v4i32_t, Bt[n][k]), __builtin_bit_cast(v4i32_t, At[m][k]), __builtin_bit_cast(v4i32_t, acc[ai][bj][m][n]), 0, 0, 0)); } \
        else { _Pragma("unroll") for (int k = 0; k < 2; ++k) acc[ai][bj][m][n] = __builtin_amdgcn_mfma_f32_16x16x32_bf16(Bt[n][k], At[m][k], acc[ai][bj][m][n], 0, 0, 0); } } \
        __builtin_amdgcn_s_setprio(0); } while (0)
#define PG8_WAIT_V(n) asm volatile("s_waitcnt vmcnt(" #n ")" ::: "memory")
#define PG8_WAIT_L(n) asm volatile("s_waitcnt lgkmcnt(" #n ")" ::: "memory")
#define PG8_BAR __builtin_amdgcn_s_barrier()
#define PG8_SCHED __builtin_amdgcn_sched_barrier(0)
    Unit cur, nxt; int ui = 0;
    if (!S.next(0, cur)) return;
    f32x4 acc[2][2][4][2];
#pragma unroll
    for (int a = 0; a < 2; ++a)
#pragma unroll
        for (int b = 0; b < 2; ++b)
#pragma unroll
            for (int m = 0; m < 4; ++m)
#pragma unroll
                for (int n = 0; n < 2; ++n) acc[a][b][m][n] = (f32x4){0.f, 0.f, 0.f, 0.f};
    bf16x8 At[4][2], B0[2][2], B1[2][2]; v8i32_t At8[4], B08[2], B18[2];
    int scl8 = 0x7F7F7F7F; asm volatile("" : "+v"(scl8));
    const char* cA = (const char*)g.A + (size_t)cur.pm * tstep; const char* cB = (const char*)g.Bt + (size_t)cur.pn * tstep;
    S.a_ready(cur);
    if constexpr (SP2) {
        PG8_STAGE(PG8_SB(0, 0), cB, voffB); PG8_STAGE(PG8_SB(0, 1), cB + hstep, voffB); PG8_STAGE(PG8_SA(0, 0), cA, voffA); PG8_STAGE(PG8_SA(0, 1), cA + hstep, voffA);
        if (wr == 1) PG8_BAR;
        PG8_WAIT_V(2); PG8_BAR;
        PG8_STAGE(PG8_SB(1, 0), cB + kstep, voffB); PG8_STAGE(PG8_SA(1, 0), cA + kstep, voffA); PG8_STAGE(PG8_SB(1, 1), cB + hstep + kstep, voffB);
        PG8_WAIT_V(6); PG8_BAR;
    } else {
        PG8_STAGE(PG8_SB(0, 0), cB, voffB); PG8_STAGE(PG8_SA(0, 0), cA, voffA); PG8_STAGE(PG8_SB(0, 1), cB + hstep, voffB); PG8_STAGE(PG8_SA(0, 1), cA + hstep, voffA);
        if (wr == 1) PG8_BAR;
        PG8_WAIT_V(4); PG8_BAR;
        PG8_STAGE(PG8_SB(1, 0), cB + kstep, voffB); PG8_STAGE(PG8_SA(1, 0), cA + kstep, voffA); PG8_STAGE(PG8_SB(1, 1), cB + hstep + kstep, voffB);
        PG8_WAIT_V(6); PG8_BAR;
    }
    for (;;) {
        const bool has_next = S.next(ui + 1, nxt);
        const char* nA = has_next ? (const char*)g.A + (size_t)nxt.pm * tstep : cA; const char* nB = has_next ? (const char*)g.Bt + (size_t)nxt.pn * tstep : cB;
        for (int t = 0; t < nt; t += 2) {
            const bool last = (t == nt - 2);
            const char* a1 = cA + (size_t)(t + 1) * kstep;
            const char* a2 = last ? nA : cA + (size_t)(t + 2) * kstep; const char* b2 = last ? nB : cB + (size_t)(t + 2) * kstep;
            const char* a3 = a2 + kstep; const char* b3 = b2 + kstep;
            if (last && has_next) S.a_ready(nxt);
            if constexpr (SP2) {
            PG8_LDB(B0, 0, 0); PG8_LDB(B1, 0, 1); PG8_SCHED; PG8_LDA(At, 0, 0); PG8_STAGE(PG8_SA(1, 1), a1 + hstep, voffA);
            PG8_WAIT_V(8); PG8_WAIT_L(0); PG8_BAR; PG8_MMA(0, 0, At, B0); PG8_MMA(0, 1, At, B1); PG8_BAR; PG8_SCHED;
            PG8_LDA(At, 0, 1); PG8_STAGE(PG8_SB(0, 0), b2, voffB); PG8_STAGE(PG8_SB(0, 1), b2 + hstep, voffB); PG8_STAGE(PG8_SA(0, 0), a2, voffA);
            PG8_WAIT_V(8); PG8_WAIT_L(0); PG8_BAR; PG8_MMA(1, 0, At, B0); PG8_MMA(1, 1, At, B1); PG8_BAR; PG8_SCHED;
            PG8_LDB(B0, 1, 0); PG8_LDB(B1, 1, 1); PG8_SCHED; PG8_LDA(At, 1, 0); PG8_STAGE(PG8_SA(0, 1), a2 + hstep, voffA);
            PG8_WAIT_V(8); PG8_WAIT_L(0); PG8_BAR; PG8_MMA(0, 0, At, B0); PG8_MMA(0, 1, At, B1); PG8_BAR; PG8_SCHED;
            PG8_LDA(At, 1, 1); PG8_STAGE(PG8_SB(1, 0), b3, voffB); PG8_STAGE(PG8_SB(1, 1), b3 + hstep, voffB); PG8_STAGE(PG8_SA(1, 0), a3, voffA);
            PG8_WAIT_V(8); PG8_WAIT_L(0); PG8_BAR; PG8_MMA(1, 0, At, B0); PG8_MMA(1, 1, At, B1); PG8_BAR; PG8_SCHED;
            } else {
            PG8_LDB(B0, 0, 0); PG8_SCHED; PG8_LDA(At, 0, 0); PG8_STAGE(PG8_SA(1, 1), a1 + hstep, voffA);
            PG8_WAIT_L(8); PG8_BAR; PG8_WAIT_L(0); PG8_MMA(0, 0, At, B0); PG8_BAR; PG8_SCHED;
            PG8_LDB(B1, 0, 1); PG8_STAGE(PG8_SB(0, 0), b2, voffB);
            PG8_BAR; PG8_WAIT_L(0); PG8_MMA(0, 1, At, B1); PG8_BAR;
            PG8_LDA(At, 0, 1); PG8_STAGE(PG8_SA(0, 0), a2, voffA);
            PG8_BAR; PG8_WAIT_L(0); PG8_MMA(1, 0, At, B0); PG8_BAR; PG8_SCHED;
            PG8_STAGE(PG8_SB(0, 1), b2 + hstep, voffB);
            PG8_WAIT_V(6); PG8_BAR; PG8_MMA(1, 1, At, B1); PG8_BAR;
            PG8_LDB(B0, 1, 0); PG8_SCHED; PG8_LDA(At, 1, 0); PG8_STAGE(PG8_SA(0, 1), a2 + hstep, voffA);
            PG8_WAIT_L(8); PG8_BAR; PG8_WAIT_L(0); PG8_MMA(0, 0, At, B0); PG8_BAR; PG8_SCHED;
            PG8_LDB(B1, 1, 1); PG8_STAGE(PG8_SB(1, 0), b3, voffB);
            PG8_BAR; PG8_WAIT_L(0); PG8_MMA(0, 1, At, B1); PG8_BAR;
            PG8_LDA(At, 1, 1); PG8_STAGE(PG8_SA(1, 0), a3, voffA);
            PG8_BAR; PG8_WAIT_L(0); PG8_MMA(1, 0, At, B0); PG8_BAR; PG8_SCHED;
            PG8_STAGE(PG8_SB(1, 1), b3 + hstep, voffB);
            PG8_WAIT_V(6); PG8_BAR; PG8_MMA(1, 1, At, B1); PG8_BAR;
            }
        }
        if constexpr (F8) { asm volatile("s_nop 15\n\ts_nop 15" ::: "memory"); PG8_SCHED; }
        if constexpr (ALIGN_EPI) { if (wr == 0) PG8_BAR; }
        if constexpr (!Epi::AFTER_DRAIN) { E(acc, cur, wr, wc, fr, fq); S.done(cur); }
        if (!has_next) break;
#pragma unroll
        for (int a = 0; a < 2; ++a)
#pragma unroll
            for (int b = 0; b < 2; ++b)
#pragma unroll
                for (int m = 0; m < 4; ++m)
#pragma unroll
                    for (int n = 0; n < 2; ++n) acc[a][b][m][n] = (f32x4){0.f, 0.f, 0.f, 0.f};
        cur = nxt; cA = nA; cB = nB; ++ui;
        if constexpr (ALIGN_EPI) { if (wr == 1) PG8_BAR; }
    }
    PG8_WAIT_V(0);
    if constexpr (!ALIGN_EPI) { if (wr == 0) PG8_BAR; }
    PG8_BAR;
    if constexpr (Epi::AFTER_DRAIN) { E.fused(acc, cur, wr, wc, fr, fq, lds, wid, lane); S.done(cur); }
#undef PG8_SA
#undef PG8_SB
#undef PG8_STAGE
#undef PG8_LDA
#undef PG8_LDB
#undef PG8_MMA
#undef PG8_WAIT_V
#undef PG8_WAIT_L
#undef PG8_BAR
#undef PG8_SCHED
}
}
#define GAS __attribute__((address_space(1)))
#define LAS __attribute__((address_space(3)))
typedef unsigned short bf16;
typedef unsigned v4u __attribute__((ext_vector_type(4)));
typedef float f32x4 __attribute__((ext_vector_type(4)));
typedef short bf16x8 __attribute__((ext_vector_type(8)));
typedef GAS unsigned gu32;
typedef GAS unsigned long long gu64;
#define RLX_AGENT __ATOMIC_RELAXED, __HIP_MEMORY_SCOPE_AGENT
#define LDS_WAIT() asm volatile("s_waitcnt lgkmcnt(0)" ::: "memory")
#define VM_WAIT() asm volatile("s_waitcnt vmcnt(0)" ::: "memory")
__device__ __forceinline__ unsigned long long rt() { return __builtin_amdgcn_s_memrealtime(); }

#define XB_TMO      128
#define XB_XCNT(j)  (256  + 64 * (j))
#define XB_XSUB(j)  (1280 + 64 * (j))
#define XB_XGEN(j)  (2304 + 64 * (j))
#define XB_TOP      3328
#define XB_TOPGEN   3392
#define XCD_BAR_WORDS 3456
#define XB_SPIN_CAP (1u << 18)

__device__ __forceinline__ unsigned xb_ld(unsigned* p)              { return __hip_atomic_load(p, __ATOMIC_RELAXED, __HIP_MEMORY_SCOPE_AGENT); }
__device__ __forceinline__ unsigned xb_add(unsigned* p, unsigned v) { return __hip_atomic_fetch_add(p, v, __ATOMIC_RELAXED, __HIP_MEMORY_SCOPE_AGENT); }
__device__ __forceinline__ unsigned xb_xcc_id() { return (unsigned)__builtin_amdgcn_s_getreg((3 << 11) | 20) & 0xFu; }
#define XB_SPIN(cond, bar) do { unsigned _sp = 0; while (cond) { __builtin_amdgcn_s_sleep(1); \
    if ((++_sp & 255u) == 0u) { if (xb_ld(&(bar)[XB_TMO])) break; if (_sp > XB_SPIN_CAP) { atomicAdd(&(bar)[XB_TMO], 1u); break; } } } } while (0)

struct XcdBarrier {
    unsigned* bar; unsigned x;
    volatile LAS unsigned* st;
};

__device__ __forceinline__ XcdBarrier xcd_barrier_post(unsigned* bar, volatile LAS unsigned* st) {
    XcdBarrier b; b.bar = bar; b.x = xb_xcc_id(); b.st = st;
    if (threadIdx.x == 0) (void)xb_add(&bar[XB_XCNT(b.x)], 1u);
    return b;
}
__device__ __forceinline__ void xcd_barrier_complete(unsigned* bar, unsigned x, unsigned& nloc, unsigned& nx) {
    const unsigned G = gridDim.x * gridDim.y * gridDim.z;
    unsigned sum, cnt, mine, sp = 0u;
    for (;;) {
        sum = 0u; cnt = 0u; mine = 0u;
#pragma unroll
        for (unsigned j = 0; j < 16; ++j) { const unsigned c = xb_ld(&bar[XB_XCNT(j)]); sum += c; cnt += (c > 0u) ? 1u : 0u; mine = (j == x) ? c : mine; }
        if (sum == G) break;
        __builtin_amdgcn_s_sleep(1);
        if ((++sp & 255u) == 0u) { if (xb_ld(&bar[XB_TMO])) break; if (sp > XB_SPIN_CAP) { atomicAdd(&bar[XB_TMO], 1u); break; } }
    }
    nloc = mine > 0u ? mine : 1u; nx = cnt > 0u ? cnt : 1u;
}

__device__ __forceinline__ void xcd_barrier(const XcdBarrier& b) {
    asm volatile("s_waitcnt vmcnt(0)" ::: "memory");
    __syncthreads();
    if (threadIdx.x == 0) {
        unsigned* bar = b.bar;
        __builtin_amdgcn_s_waitcnt(0);
        unsigned nloc = b.st[0], nx = b.st[1];
        if (nloc == 0u) { xcd_barrier_complete(bar, b.x, nloc, nx); b.st[0] = nloc; b.st[1] = nx; }
        const unsigned old = xb_add(&bar[XB_XSUB(b.x)], 1u);
        const unsigned gen = old / nloc;
        if (old + 1u == (gen + 1u) * nloc) {
            __builtin_amdgcn_fence(__ATOMIC_RELEASE, "agent");
            asm volatile("s_waitcnt vmcnt(0)" ::: "memory");
            const unsigned og = xb_add(&bar[XB_TOP], 1u);
            const unsigned tg = og / nx;
            if (og + 1u == (tg + 1u) * nx) xb_add(&bar[XB_TOPGEN], 1u);
            else XB_SPIN(xb_ld(&bar[XB_TOPGEN]) == tg, bar);
            __builtin_amdgcn_fence(__ATOMIC_ACQUIRE, "agent");
            xb_add(&bar[XB_XGEN(b.x)], 1u);
            asm volatile("s_waitcnt vmcnt(0)" ::: "memory");
        } else {
            XB_SPIN(xb_ld(&bar[XB_XGEN(b.x)]) == gen, bar);
            __builtin_amdgcn_fence(__ATOMIC_ACQUIRE, "agent");
            asm volatile("s_waitcnt vmcnt(0)" ::: "memory");
        }
    }
    __syncthreads();
}

constexpr int NWAVES = 8;
#ifndef MK_PER_PHASE
#define MK_PER_PHASE 0
#endif
constexpr int N_PHASES = 17;
constexpr int BATCH = 2, SEQ = 4096, DM = 4096, MTOK = BATCH * SEQ, DFF = 16384;
constexpr int MH = 8, MDK = 256, MDV = 512, M_MAIN = 12288, M_IN = 12304;
constexpr int NKVQ = 7168, NQG = 4192, KVW = 3072;
constexpr float EPS = 1e-6f;
#ifndef Q8_UP_MASK
#define Q8_STRIPS 1
#define Q8_KVQ 1
#define Q8_WMO 1
#define Q8_UP_MASK 3
#endif
constexpr float ATT_SCALE = 0.08838834764831845f;

constexpr size_t MiB = 1u << 20;
constexpr size_t WS_CTL = 0, CTL_CMAX = 65536  , CTL_ZERO_BYTES = 65536 + 4 * 16384 * 4;
constexpr size_t WS_WG1 = 1 * MiB, WS_WG2 = 2 * MiB, WS_W2C = 3 * MiB, WS_POSB = 3 * MiB + 512 * 1024, WS_POSP = 3 * MiB + 640 * 1024;
constexpr size_t WS_LI = 4 * MiB, WS_LF = 4 * MiB + 512 * 1024, WS_GT = 5 * MiB, WS_HC = 8 * MiB, WS_KC = 12 * MiB, WS_VC = 12 * MiB + 512 * 1024, WS_SELM = 13 * MiB;
constexpr size_t WS_WIN = 16 * MiB, WS_WMO = 112 * MiB, WS_WUP0 = 144 * MiB, WS_WDN0 = 272 * MiB, WS_WKVQ = 400 * MiB, WS_W1C = 456 * MiB, WS_WNO = 464 * MiB, WS_WUP1 = 496 * MiB, WS_WDN1 = 624 * MiB;
constexpr size_t WS_XB = 752 * MiB, WS_A3 = 816 * MiB, WS_HR = 880 * MiB, WS_X1 = 944 * MiB, WS_X2 = 1008 * MiB, WS_BIG = 1200 * MiB, WS_AOF = 1328 * MiB, WS_WUPQ0 = 1456 * MiB, WS_WUPQ1 = 1520 * MiB  , WS_XQ = 1584 * MiB  , WS_WKVQ8 = 1616 * MiB  , WS_WMOQ = 1644 * MiB  , WS_END = 1660 * MiB;
constexpr int CW_BAR = 4096;
constexpr int CW_QHEAD = 16384;
constexpr size_t WS_PART = 13 * MiB, WS_RS = 15 * MiB;

constexpr int RING_OFF = 0, RING_BYTES = 147456;
constexpr int LDSCTL_OFF = RING_BYTES, MISC_OFF = LDSCTL_OFF + 320;
constexpr int LDS_BYTES = 159744;
static_assert(MISC_OFF + 128 <= LDS_BYTES, "LDS map");

typedef float f32x16 __attribute__((ext_vector_type(16)));
typedef short s16x4 __attribute__((ext_vector_type(4)));
typedef float f32x2v __attribute__((ext_vector_type(2)));

struct Frame {
    LAS unsigned char* lds;
    volatile LAS unsigned* MISC;
    gu32* ctl;
    int tid, lane, wave, G;
    const float* in[18]; float* out; unsigned char* ws;
};

__device__ __forceinline__ float wave_sum(float v) {
#pragma unroll
    for (int o = 1; o < 64; o <<= 1) v += __shfl_xor(v, o);
    return v;
}
typedef float f32x2_t __attribute__((ext_vector_type(2))); typedef __bf16 bf16x2_t __attribute__((ext_vector_type(2)));
__device__ __forceinline__ unsigned pk2(float lo, float hi) { f32x2_t v = {lo, hi}; bf16x2_t b = __builtin_convertvector(v, bf16x2_t); return __builtin_bit_cast(unsigned, b); }
__device__ __forceinline__ float bf_lo(unsigned w) { return __uint_as_float(w << 16); }
__device__ __forceinline__ float bf_hi(unsigned w) { return __uint_as_float(w & 0xffff0000u); }
__device__ __forceinline__ float bf1(unsigned short h) { return __uint_as_float(((unsigned)h) << 16); }
__device__ __forceinline__ unsigned short f2bf1(float f) { return (unsigned short)(pk2(f, 0.f) & 0xffffu); }
__device__ __forceinline__ f32x4 mfma16(bf16x8 a, bf16x8 b, f32x4 c) { return __builtin_amdgcn_mfma_f32_16x16x32_bf16(a, b, c, 0, 0, 0); }
typedef short v4i16_t __attribute__((ext_vector_type(4)));
__device__ __forceinline__ s16x4 tr16(const LAS unsigned char* p) { return __builtin_bit_cast(s16x4, __builtin_amdgcn_ds_read_tr16_b64_v4i16((LAS v4i16_t*)p)); }
__device__ __forceinline__ bf16x8 cat8(s16x4 lo, s16x4 hi) { return (bf16x8){lo[0], lo[1], lo[2], lo[3], hi[0], hi[1], hi[2], hi[3]}; }

__device__ __forceinline__ void tr_item(const float* W, int K, int ldw, int col0, int ncols, const float* gain, float cscale, int cs_lo, int cs_hi, bf16* WT, int row_off, LAS float* scr, int item, int lane) {
    const int nblk = (ncols + 31) / 32, kb = item / nblk, nb = item % nblk, k0 = 64 * kb, n0 = 32 * nb;
    const int nn = n0 + (lane & 31); const bool nok = nn < ncols; const float cs = (nn >= cs_lo && nn < cs_hi) ? cscale : 1.f;
#pragma unroll 8
    for (int i = 0; i < 32; ++i) { const int kk = 2 * i + (lane >> 5);
        float v = nok ? W[(size_t)(k0 + kk) * ldw + col0 + nn] : 0.f;
        if (gain) v *= gain[k0 + kk];
        scr[kk * 33 + (lane & 31)] = v * cs; }
    LDS_WAIT(); asm volatile("" ::: "memory");
    const int c = lane & 7;
#pragma unroll
    for (int j = 0; j < 4; ++j) { const int n = (lane >> 3) + 8 * j; const LAS float* s = scr + (8 * c) * 33 + n;
        v4u o; o.x = pk2(s[0 * 33], s[1 * 33]); o.y = pk2(s[2 * 33], s[3 * 33]); o.z = pk2(s[4 * 33], s[5 * 33]); o.w = pk2(s[6 * 33], s[7 * 33]);
        if (n0 + n < ncols) *(GAS v4u*)(WT + (size_t)(row_off + n0 + n) * K + k0 + 8 * c) = o; }
    LDS_WAIT(); asm volatile("" ::: "memory");
}
struct CvJob { const float* W; const float* gain; bf16* WT; int K, ldw, col0, ncols, row_off, cs_lo, cs_hi, r, f8; float cscale, osc; unsigned* cmax; };
__device__ __forceinline__ void cv_load(const CvJob& J, f32x4 (&v)[16], float (&gk)[16], int lane) {
    const int nblk = J.ncols >> 6, kb = J.r / nblk, nb = J.r - kb * nblk, k0 = 64 * kb, n0 = 64 * nb;
    const float* src = J.W + (size_t)(k0 + (lane >> 4)) * J.ldw + J.col0 + n0 + 4 * (lane & 15);
    const float* gp = J.gain ? J.gain : J.W;
    const float gmul = J.gain ? 1.f : 0.f, gadd = J.gain ? 0.f : 1.f;
#pragma unroll
    for (int i = 0; i < 16; ++i) { const float g = gp[k0 + 4 * i + (lane >> 4)]; gk[i] = fmaf(g, gmul, gadd); }
#pragma unroll
    for (int i = 0; i < 16; ++i) v[i] = __builtin_nontemporal_load((const GAS f32x4*)(src + (size_t)(4 * i) * J.ldw));
}
__device__ __forceinline__ void cv_store(const CvJob& J, f32x4 (&v)[16], const float (&gkv)[16], LAS unsigned char* scr, int lane) {
    const int nblk = J.ncols >> 6, kb = J.r / nblk, nb = J.r - kb * nblk, k0 = 64 * kb, n0 = 64 * nb;
    const int c = lane & 15, kr = lane >> 4;
    const float cs = ((n0 >= J.cs_lo && n0 < J.cs_hi) ? J.cscale : 1.f) * J.osc;
    f32x4 cm = {0.f, 0.f, 0.f, 0.f};
#pragma unroll
    for (int i = 0; i < 16; ++i) { const float gk = gkv[i] * cs; const f32x4 x = v[i] * gk; cm = __builtin_elementwise_max(cm, __builtin_elementwise_abs(x));
        typedef unsigned u32x2_t __attribute__((ext_vector_type(2)));
        u32x2_t w; w.x = pk2(x.x, x.y); w.y = pk2(x.z, x.w);
        *(LAS u32x2_t*)(scr + (4 * i + kr) * 136 + c * 8) = w; }
    if (J.cmax) {
#pragma unroll
        for (int e = 0; e < 4; ++e) { float m_ = cm[e]; m_ = fmaxf(m_, __shfl_xor(m_, 16)); m_ = fmaxf(m_, __shfl_xor(m_, 32)); if (kr == 0) atomicMax(J.cmax + n0 + 4 * c + e, __float_as_uint(m_)); } }
    LDS_WAIT(); asm volatile("" ::: "memory");
    const int g = lane >> 4, i16 = lane & 15, j = i16 >> 2, q = i16 & 3;
#pragma unroll
    for (int it = 0; it < 8; ++it) { const int nbk = it >> 1, kb8 = (it & 1) * 4 + g;
        const LAS unsigned char* a = scr + (kb8 * 8 + j) * 136 + (nbk * 16 + 4 * q) * 2;
        const bf16x8 o = cat8(tr16(a), tr16(a + 4 * 136));
        if (J.f8) { const v4u w = __builtin_bit_cast(v4u, o); typedef int i32x2 __attribute__((ext_vector_type(2))); i32x2 q;
            q.x = __builtin_amdgcn_cvt_pk_fp8_f32(bf_lo(w.x), bf_hi(w.x), 0, false); q.x = __builtin_amdgcn_cvt_pk_fp8_f32(bf_lo(w.y), bf_hi(w.y), q.x, true);
            q.y = __builtin_amdgcn_cvt_pk_fp8_f32(bf_lo(w.z), bf_hi(w.z), 0, false); q.y = __builtin_amdgcn_cvt_pk_fp8_f32(bf_lo(w.w), bf_hi(w.w), q.y, true);
            *(GAS i32x2*)((unsigned char*)J.WT + (size_t)(J.row_off + n0 + nbk * 16 + i16) * J.K + k0 + kb8 * 8) = q; }
        else __builtin_nontemporal_store(o, (GAS bf16x8*)(J.WT + (size_t)(J.row_off + n0 + nbk * 16 + i16) * J.K + k0 + kb8 * 8)); }
    LDS_WAIT(); asm volatile("" ::: "memory");
}
__device__ __forceinline__ void rownorm_row(const float* xrow, bf16* orow, int lane) {
    const GAS f32x4* xr = (const GAS f32x4*)xrow + lane;
    f32x4 v[16]; float s = 0.f;
#pragma unroll
    for (int j = 0; j < 16; ++j) { v[j] = xr[64 * j]; s += (v[j].x * v[j].x + v[j].y * v[j].y) + (v[j].z * v[j].z + v[j].w * v[j].w); }
    const float rstd = 1.f / sqrtf(wave_sum(s) * (1.f / DM) + EPS);
    GAS unsigned long long* o8 = (GAS unsigned long long*)orow + lane;
#pragma unroll
    for (int j = 0; j < 16; ++j) o8[64 * j] = (unsigned long long)pk2(v[j].x * rstd, v[j].y * rstd) | ((unsigned long long)pk2(v[j].z * rstd, v[j].w * rstd) << 32);
}
__device__ __forceinline__ void rownorm_phase(Frame& F, const float* src, bf16* dst) {
    const int gw = blockIdx.x * NWAVES + F.wave, NGW = F.G * NWAVES;
    for (int m = gw; m < MTOK; m += NGW) rownorm_row(src + (size_t)m * DM, dst + (size_t)m * DM, F.lane);
}

constexpr int CW_0 = 64 * 192, CW_2 = Q8_STRIPS ? 0 : 64 * 64, CW_3 = Q8_STRIPS ? 0 : 64 * 256, CW_4 = 256 * 64, CW_5 = Q8_STRIPS ? 0 : 64 * 48, CW_6 = Q8_STRIPS ? 0 : 64 * 64, CW_8 = 64 * 8, CW_9 = 64 * 8, CW_10 = 16, CW_11 = 16, CW_12 = 64 * 64, CW_13 = Q8_STRIPS ? 0 : 64 * 256, CW_14 = 256 * 64;
constexpr int CW_EARLY = CW_0, CW_TOTAL = CW_0 + CW_2 + CW_3 + CW_4 + CW_5 + CW_6 + CW_8 + CW_9 + CW_10 + CW_11 + CW_12 + CW_13 + CW_14;
__device__ __forceinline__ CvJob cv_decode(Frame& F, int it) {
    unsigned char* ws = F.ws; CvJob J; J.gain = nullptr; J.row_off = 0; J.cs_lo = 0; J.cs_hi = 0; J.cscale = 1.f; J.col0 = 0; J.f8 = 0; J.osc = 1.f; J.cmax = nullptr; int r = it;
    if (r < CW_0) { J.W = F.in[3]; J.K = 4096; J.ldw = M_IN; J.ncols = M_MAIN; J.gain = F.in[1]; J.cscale = 0.0625f; J.cs_lo = 2048; J.cs_hi = 4096; J.WT = (bf16*)(ws + WS_WIN); }
    else if ((r -= CW_0) < CW_2) { J.W = F.in[6]; J.K = 4096; J.ldw = 4096; J.ncols = 4096; J.gain = F.in[5]; J.WT = (bf16*)(ws + WS_WMO); if (Q8_WMO) J.cmax = (unsigned*)(ws + CTL_CMAX) + 49152; }
    else if ((r -= CW_2) < CW_3) { J.W = F.in[16]; J.K = 4096; J.ldw = DFF; J.ncols = DFF; J.gain = F.in[2]; J.WT = (bf16*)(ws + WS_WUP0); if (Q8_UP_MASK & 1) J.cmax = (unsigned*)(ws + CTL_CMAX); }
    else if ((r -= CW_3) < CW_4) { J.W = F.in[17]; J.K = DFF; J.ldw = 4096; J.ncols = 4096; J.WT = (bf16*)(ws + WS_WDN0); }
    else if ((r -= CW_4) < CW_5) { J.W = F.in[8]; J.K = 4096; J.ldw = KVW; J.ncols = KVW; J.gain = F.in[7]; J.WT = (bf16*)(ws + WS_WKVQ); if (Q8_KVQ) J.cmax = (unsigned*)(ws + CTL_CMAX) + 32768; else { J.f8 = 1; J.osc = 256.f; } }
    else if ((r -= CW_5) < CW_6) { J.W = F.in[13]; J.K = 4096; J.ldw = NQG; J.ncols = 4096; J.gain = F.in[1] + 4096; J.WT = (bf16*)(ws + WS_WKVQ); J.row_off = KVW; if (Q8_KVQ) J.cmax = (unsigned*)(ws + CTL_CMAX) + 32768 + KVW; else { J.f8 = 1; J.osc = 256.f; } }
    else if ((r -= CW_6) < CW_8) { J.W = F.in[11]; J.K = 4096; J.ldw = 512; J.ncols = 512; J.WT = (bf16*)(ws + WS_W1C); }
    else if ((r -= CW_8) < CW_9) { J.W = F.in[11] + (size_t)4096 * 512; J.K = 4096; J.ldw = 512; J.ncols = 512; J.WT = (bf16*)(ws + WS_W1C) + (size_t)512 * 4096; }
    else if ((r -= CW_9) < CW_10) { J.W = F.in[12]; J.K = 512; J.ldw = 128; J.ncols = 128; J.WT = (bf16*)(ws + WS_W2C); }
    else if ((r -= CW_10) < CW_11) { J.W = F.in[12] + (size_t)512 * 128; J.K = 512; J.ldw = 128; J.ncols = 128; J.WT = (bf16*)(ws + WS_W2C) + (size_t)128 * 512; }
    else if ((r -= CW_11) < CW_12) { J.W = F.in[15]; J.K = 4096; J.ldw = 4096; J.ncols = 4096; J.WT = (bf16*)(ws + WS_WNO); J.f8 = 1; J.osc = 256.f; }
    else if ((r -= CW_12) < CW_13) { J.W = F.in[16] + (size_t)4096 * DFF; J.K = 4096; J.ldw = DFF; J.ncols = DFF; J.gain = F.in[2] + 4096; J.WT = (bf16*)(ws + WS_WUP1); if (Q8_UP_MASK & 2) J.cmax = (unsigned*)(ws + CTL_CMAX) + 16384; }
    else { r -= CW_13; J.W = F.in[17] + (size_t)DFF * 4096; J.K = DFF; J.ldw = 4096; J.ncols = 4096; J.WT = (bf16*)(ws + WS_WDN1); }
    J.r = r; return J;
}
__device__ __forceinline__ void convert_wide(Frame& F, int lo, int hi, int worker, int nworkers) {
    LAS unsigned char* scr = F.lds + RING_OFF + F.wave * 16384;
    int it = lo + worker; if (it >= hi) return;
    f32x4 va[16], vb[16]; float ga[16], gb[16]; CvJob ja = cv_decode(F, it), jb = ja;
    cv_load(ja, va, ga, F.lane);
    for (;;) {
        const int itb = it + nworkers; const bool hb = itb < hi;
        if (hb) { jb = cv_decode(F, itb); cv_load(jb, vb, gb, F.lane); }
        cv_store(ja, va, ga, scr, F.lane);
        if (!hb) break;
        const int ita = itb + nworkers; const bool ha = ita < hi;
        if (ha) { ja = cv_decode(F, ita); cv_load(ja, va, ga, F.lane); }
        cv_store(jb, vb, gb, scr, F.lane);
        if (!ha) break;
        it = ita;
    }
}
struct CvQ { gu32* head; int lo, hi, cur, end; };
__device__ __forceinline__ int cvq_next(CvQ& Q, int lane) {
    if (Q.cur == Q.end) { unsigned v = 0u; if (lane == 0) v = __hip_atomic_fetch_add(Q.head, 8u, RLX_AGENT);
        Q.cur = Q.lo + __builtin_amdgcn_readfirstlane((int)v); Q.end = Q.cur + 8 < Q.hi ? Q.cur + 8 : Q.hi; if (Q.cur >= Q.hi) { Q.cur = Q.end = Q.hi; return Q.hi; } }
    return Q.cur++;
}
__device__ __forceinline__ void convert_queue(Frame& F, int lo, int hi, gu32* head) {
    LAS unsigned char* scr = F.lds + RING_OFF + F.wave * 16384;
    CvQ Q{head, lo, hi, 0, 0};
    int it = cvq_next(Q, F.lane); if (it >= hi) return;
    f32x4 va[16], vb[16]; float ga[16], gb[16]; CvJob ja = cv_decode(F, it), jb = ja;
    cv_load(ja, va, ga, F.lane);
    for (;;) {
        const int itb = cvq_next(Q, F.lane); const bool hb = itb < hi;
        if (hb) { jb = cv_decode(F, itb); cv_load(jb, vb, gb, F.lane); }
        cv_store(ja, va, ga, scr, F.lane);
        if (!hb) break;
        const int ita = cvq_next(Q, F.lane); const bool ha = ita < hi;
        if (ha) { ja = cv_decode(F, ita); cv_load(ja, va, ga, F.lane); }
        cv_store(jb, vb, gb, scr, F.lane);
        if (!ha) break;
    }
}
__device__ __forceinline__ void convert_narrow(Frame& F, int lo, int hi, int worker, int nworkers) {
    LAS float* scr = (LAS float*)(F.lds + RING_OFF + F.wave * 16384);
    for (int it = lo + worker; it < hi; it += nworkers) {
        if (it < 64) tr_item(F.in[3], 4096, M_IN, M_MAIN, 16, F.in[1], 1.f, 0, 0, (bf16*)(F.ws + WS_WG1), 0, scr, it, F.lane);
        else tr_item(F.in[13], 4096, NQG, 4096, 96, F.in[1] + 4096, 1.f, 0, 0, (bf16*)(F.ws + WS_WG2), 0, scr, it - 64, F.lane);
    }
}
__device__ __forceinline__ void p0_prologue(Frame& F) {
    const int gw = blockIdx.x * NWAVES + F.wave, NGW = F.G * NWAVES;
    unsigned char* ws = F.ws;
    { float* pp = (float*)(ws + WS_POSP);
      for (int task = gw; task < 512; task += NGW) { const int j = task >> 8, nbk = (task >> 5) & 7, ch = task & 31, n = nbk * 64 + F.lane;
          const float* pos = F.in[10] + (size_t)j * 4096 + ch * 128; const float* w1 = F.in[11] + ((size_t)j * 4096 + ch * 128) * 512 + n;
          float a0 = 0.f, a1 = 0.f, a2 = 0.f, a3 = 0.f;
#pragma unroll 4
          for (int kk = 0; kk < 128; kk += 4) { a0 += pos[kk] * w1[(size_t)kk * 512]; a1 += pos[kk + 1] * w1[(size_t)(kk + 1) * 512]; a2 += pos[kk + 2] * w1[(size_t)(kk + 2) * 512]; a3 += pos[kk + 3] * w1[(size_t)(kk + 3) * 512]; }
          pp[ch * 1024 + j * 512 + n] = (a0 + a1) + (a2 + a3); } }
    convert_wide(F, 0, CW_EARLY, gw, NGW); convert_narrow(F, 0, 64, gw, NGW);
    rownorm_phase(F, F.in[0], (bf16*)(ws + WS_XB));
}

__device__ __forceinline__ unsigned q8_pack4(float a, float b, float c, float d, float sc) {
    const float M = 12582912.f;
    const unsigned ya = __float_as_uint(fmaf(a, sc, M)), yb = __float_as_uint(fmaf(b, sc, M)), yc = __float_as_uint(fmaf(c, sc, M)), yd = __float_as_uint(fmaf(d, sc, M));
    return __builtin_amdgcn_perm(yb, ya, 0x0c0c0400u) | __builtin_amdgcn_perm(yd, yc, 0x04000c0cu);
}
__device__ __forceinline__ float quant_row(const bf16* src, unsigned char* dst, float sc, int lane) {
    v4u w[8]; float am = 0.f;
#pragma unroll
    for (int i = 0; i < 8; ++i) { w[i] = *(const v4u*)(src + (i * 64 + lane) * 8);
        am = fmaxf(fmaxf(fmaxf(am, fmaxf(fabsf(bf_lo(w[i].x)), fabsf(bf_hi(w[i].x)))), fmaxf(fabsf(bf_lo(w[i].y)), fabsf(bf_hi(w[i].y)))), fmaxf(fmaxf(fabsf(bf_lo(w[i].z)), fabsf(bf_hi(w[i].z))), fmaxf(fabsf(bf_lo(w[i].w)), fabsf(bf_hi(w[i].w))))); }
    float step = 0.f;
    if (sc <= 0.f) {
#pragma unroll
        for (int o = 1; o < 64; o <<= 1) am = fmaxf(am, __shfl_xor(am, o));
        sc = am > 0.f ? 127.f / am : 0.f; step = am * (1.f / 127.f); }
#pragma unroll
    for (int i = 0; i < 8; ++i) { typedef unsigned u32x2_t __attribute__((ext_vector_type(2))); u32x2_t o;
        o.x = q8_pack4(bf_lo(w[i].x), bf_hi(w[i].x), bf_lo(w[i].y), bf_hi(w[i].y), sc); o.y = q8_pack4(bf_lo(w[i].z), bf_hi(w[i].z), bf_lo(w[i].w), bf_hi(w[i].w), sc);
        *(u32x2_t*)(dst + (i * 64 + lane) * 8) = o; }
    return step;
}
__device__ __forceinline__ void wquant_phase(Frame& F, const bf16* W, const float* cmax, unsigned char* WQ, int N) {
    const int gw = blockIdx.x * NWAVES + F.wave, NGW = F.G * NWAVES;
    for (int n = gw; n < N; n += NGW) { const float m_ = cmax[n]; (void)quant_row(W + (size_t)n * DM, WQ + (size_t)n * DM, m_ > 0.f ? 127.f / m_ : 1e-30f, F.lane); }
}
__device__ __forceinline__ void rstd_phase(Frame& F, float* rs, const bf16* X = nullptr, unsigned char* XQ = nullptr, float* ra = nullptr) {
    const int gw = blockIdx.x * NWAVES + F.wave, NGW = F.G * NWAVES; const float* part = (const float*)(F.ws + WS_PART);
    for (int row = gw; row < MTOK; row += NGW) { const float t = wave_sum(part[(size_t)row * 64 + F.lane]); const float r_ = 1.f / sqrtf(t * (1.f / DM) + EPS); if (F.lane == 0) rs[row] = r_;
        if (X) { const float st = quant_row(X + (size_t)row * DM, XQ + (size_t)row * DM, 0.f, F.lane); if (F.lane == 0) ra[row] = st * r_; } }
}
template <int NT, class AP>
__device__ __forceinline__ void mini_gemm16(f32x4 (&acc)[NT], const AP& ap, const bf16* Bt, int ldb, int K, int lane, int kstart = 0) {
    const int r16 = lane & 15, kq = lane >> 4;
#pragma unroll
    for (int n = 0; n < NT; ++n) acc[n] = (f32x4){0.f, 0.f, 0.f, 0.f};
    const bf16* brow = Bt + (size_t)r16 * ldb + kq * 8;
#pragma unroll 8
    for (int kk = 0; kk < K; kk += 32) { const int k0 = (kk + kstart) & (K - 1);
        const bf16x8 a = *(const bf16x8*)ap(r16, k0 + kq * 8);
#pragma unroll
        for (int n = 0; n < NT; ++n) { const bf16x8 b = *(const bf16x8*)(brow + (size_t)n * 16 * ldb + k0); acc[n] = mfma16(a, b, acc[n]); }
    }
}
struct RowMajorA { const bf16* A; int lda; __device__ __forceinline__ const bf16* operator()(int r16, int k) const { return A + (size_t)r16 * lda + k; } };

template <int NT, class AP>
__device__ __forceinline__ void mini_gemm16_splitk(f32x4& out, const AP& ap, const bf16* Bt, int ldb, int K, LAS float* red, int wid, int lane) {
    const int r16 = lane & 15, kq = lane >> 4, kc = K >> 3;
    f32x4 acc[NT];
#pragma unroll
    for (int n = 0; n < NT; ++n) acc[n] = (f32x4){0.f, 0.f, 0.f, 0.f};
    const bf16* brow = Bt + (size_t)r16 * ldb + kq * 8;
#pragma unroll 4
    for (int k0 = wid * kc; k0 < (wid + 1) * kc; k0 += 32) {
        const bf16x8 a = *(const bf16x8*)ap(r16, k0 + kq * 8);
#pragma unroll
        for (int n = 0; n < NT; ++n) { const bf16x8 b = *(const bf16x8*)(brow + (size_t)n * 16 * ldb + k0); acc[n] = mfma16(a, b, acc[n]); }
    }
#pragma unroll
    for (int n = 0; n < NT; ++n) *(LAS f32x4*)(red + ((wid * NT + n) * 64 + lane) * 4) = acc[n];
    __syncthreads();
    out = (f32x4){0.f, 0.f, 0.f, 0.f};
    if (wid < NT) {
#pragma unroll
        for (int w = 0; w < 8; ++w) out = out + *(const LAS f32x4*)(red + ((w * NT + wid) * 64 + lane) * 4); }
    __syncthreads();
}
template <int NT>
__device__ __forceinline__ void mini_gemm32_splitk(f32x4& out0, f32x4& out1, const bf16* A0, const bf16* A1, int lda, const bf16* Bt, int ldb, int K, LAS float* red, int wid, int lane) {
    const int r16 = lane & 15, kq = lane >> 4, kc = K >> 3;
    f32x4 acc0[NT], acc1[NT];
#pragma unroll
    for (int n = 0; n < NT; ++n) { acc0[n] = (f32x4){0.f, 0.f, 0.f, 0.f}; acc1[n] = (f32x4){0.f, 0.f, 0.f, 0.f}; }
    const bf16* a0 = A0 + (size_t)r16 * lda + kq * 16; const bf16* a1 = A1 + (size_t)r16 * lda + kq * 16; const bf16* brow = Bt + (size_t)r16 * ldb + kq * 16;
#pragma unroll 1
    for (int k0 = wid * kc; k0 < (wid + 1) * kc; k0 += 128) {
        bf16x8 fa0[4], fa1[4], fb[4][NT];
#pragma unroll
        for (int s4 = 0; s4 < 4; ++s4) { const int off = k0 + (s4 >> 1) * 64 + (s4 & 1) * 8; fa0[s4] = *(const bf16x8*)(a0 + off); fa1[s4] = *(const bf16x8*)(a1 + off);
#pragma unroll
            for (int n = 0; n < NT; ++n) fb[s4][n] = *(const bf16x8*)(brow + (size_t)n * 16 * ldb + off); }
        __builtin_amdgcn_sched_barrier(0);
#pragma unroll
        for (int s4 = 0; s4 < 4; ++s4)
#pragma unroll
            for (int n = 0; n < NT; ++n) { acc0[n] = mfma16(fa0[s4], fb[s4][n], acc0[n]); acc1[n] = mfma16(fa1[s4], fb[s4][n], acc1[n]); }
        __builtin_amdgcn_sched_barrier(0);
    }
#pragma unroll
    for (int n = 0; n < NT; ++n) { *(LAS f32x4*)(red + ((wid * NT + n) * 64 + lane) * 4) = acc0[n]; *(LAS f32x4*)(red + 8 * NT * 256 + ((wid * NT + n) * 64 + lane) * 4) = acc1[n]; }
    __syncthreads();
    out0 = (f32x4){0.f, 0.f, 0.f, 0.f}; out1 = (f32x4){0.f, 0.f, 0.f, 0.f};
    if (wid < NT) {
#pragma unroll
        for (int w = 0; w < 8; ++w) { out0 = out0 + *(const LAS f32x4*)(red + ((w * NT + wid) * 64 + lane) * 4); out1 = out1 + *(const LAS f32x4*)(red + 8 * NT * 256 + ((w * NT + wid) * 64 + lane) * 4); } }
    __syncthreads();
}
__device__ __forceinline__ void gates1_phase(Frame& F) {
    const int r16 = F.lane & 15, kq = F.lane >> 4;
    const bf16* XB = (const bf16*)(F.ws + WS_XB); const bf16* Wg = (const bf16*)(F.ws + WS_WG1);
    float* LI = (float*)(F.ws + WS_LI); float* LF = (float*)(F.ws + WS_LF);
    const float bias = F.in[4][r16];
    for (int rt0 = blockIdx.x; rt0 < MTOK / 16; rt0 += 2 * F.G) { const int rt1 = rt0 + F.G; const bool two = rt1 < MTOK / 16;
        f32x4 acc2[2];
        mini_gemm32_splitk<1>(acc2[0], acc2[1], XB + (size_t)rt0 * 16 * DM, XB + (size_t)(two ? rt1 : rt0) * 16 * DM, DM, Wg, DM, DM, (LAS float*)(F.lds + RING_OFF), F.wave, F.lane);
        if (F.wave == 0) {
#pragma unroll
            for (int h = 0; h < 2; ++h) { if (h == 1 && !two) break; const int rt = h ? rt1 : rt0;
#pragma unroll
                for (int i = 0; i < 4; ++i) { const int row = rt * 16 + 4 * kq + i, b = row >> 12, t = row & 4095;
                    float g = acc2[h][i] + bias; g = 15.f * tanhf(g * (1.f / 15.f));
                    if (r16 < 8) LI[(size_t)(b * 8 + r16) * SEQ + t] = g;
                    else LF[(size_t)(b * 8 + (r16 - 8)) * SEQ + t] = fminf(g, 0.f) - log1pf(__expf(-fabsf(g))); } } }
    }
}
__device__ __forceinline__ void gates2_phase(Frame& F) {
    const int r16 = F.lane & 15, kq = F.lane >> 4;
    const bf16* XB = (const bf16*)(F.ws + WS_X2); const bf16* Wg = (const bf16*)(F.ws + WS_WG2); float* GT = (float*)(F.ws + WS_GT);
    for (int rt0 = blockIdx.x; rt0 < MTOK / 16; rt0 += 2 * F.G) { const int rt1 = rt0 + F.G; const bool two = rt1 < MTOK / 16;
        f32x4 acc2[2];
        mini_gemm32_splitk<6>(acc2[0], acc2[1], XB + (size_t)rt0 * 16 * DM, XB + (size_t)(two ? rt1 : rt0) * 16 * DM, DM, Wg, DM, DM, (LAS float*)(F.lds + RING_OFF), F.wave, F.lane);
        if (F.wave < 6) {
#pragma unroll
            for (int h = 0; h < 2; ++h) { if (h == 1 && !two) break; const int rt = h ? rt1 : rt0;
#pragma unroll
                for (int i = 0; i < 4; ++i) { const int row = rt * 16 + 4 * kq + i; const float rs = ((const float*)(F.ws + WS_RS))[8192 + row];
                    GT[(size_t)row * 96 + F.wave * 16 + r16] = 1.f / (1.f + __expf(-acc2[h][i] * rs)); } } }
    }
}

#define QS_BAR() do { asm volatile("s_waitcnt lgkmcnt(0)" ::: "memory"); __builtin_amdgcn_s_barrier(); asm volatile("" ::: "memory"); } while (0)
#define QS_SB() __builtin_amdgcn_sched_barrier(0)
constexpr int QS_RS = 4112, QS_NSTRIPS = 512 + 512 + 96 + 128 + 128;
struct QsJob { const float* W; const float* gain; unsigned char* WQ; float* cmax; int ldw, n0; };
__device__ __forceinline__ QsJob qs_decode(Frame& F, int s_) {
    unsigned char* ws = F.ws; QsJob J; float* cm = (float*)(ws + CTL_CMAX); int s = s_;
    if (s < 512) { J.W = F.in[16]; J.ldw = DFF; J.gain = F.in[2]; J.WQ = ws + WS_WUPQ0; J.cmax = cm; }
    else if ((s -= 512) < 512) { J.W = F.in[16] + (size_t)4096 * DFF; J.ldw = DFF; J.gain = F.in[2] + 4096; J.WQ = ws + WS_WUPQ1; J.cmax = cm + 16384; }
    else if ((s -= 512) < 96) { J.W = F.in[8]; J.ldw = KVW; J.gain = F.in[7]; J.WQ = ws + WS_WKVQ8; J.cmax = cm + 32768; }
    else if ((s -= 96) < 128) { J.W = F.in[13]; J.ldw = NQG; J.gain = F.in[1] + 4096; J.WQ = ws + WS_WKVQ8 + (size_t)KVW * 4096; J.cmax = cm + 32768 + KVW; }
    else { s -= 128; J.W = F.in[6]; J.ldw = 4096; J.gain = F.in[5]; J.WQ = ws + WS_WMOQ; J.cmax = cm + 49152; }
    J.n0 = 32 * s; return J;
}
__device__ __forceinline__ void qs_load(const QsJob& J, int q, f32x4 (&v)[8], f32x2_t (&g)[4], int tid) {
    const int seg = tid & 7, kp = tid >> 3;
    unsigned off_w = (unsigned)(2 * kp * J.ldw + 4 * seg) * 4u, off_g = (unsigned)kp * 8u;
    asm volatile("" : "+v"(off_w), "+v"(off_g));
    const char* wb = (const char*)(J.W + J.n0); const char* gb = (const char*)J.gain;
#pragma unroll
    for (int i = 0; i < 4; ++i) g[i] = *(const f32x2_t*)(gb + (size_t)((q * 4 + i) * 128) * 4 + off_g);
#pragma unroll
    for (int i = 0; i < 4; ++i) { const char* p = wb + (size_t)((q * 4 + i) * 128) * (size_t)J.ldw * 4;
        v[2 * i] = __builtin_nontemporal_load((const GAS f32x4*)(p + off_w)); v[2 * i + 1] = __builtin_nontemporal_load((const GAS f32x4*)(p + (size_t)J.ldw * 4 + off_w)); }
}
__device__ __forceinline__ void qs_put(const f32x4 (&v)[8], const f32x2_t (&g)[4], int q, f32x4& cm, LAS unsigned char* lds, int tid) {
    const int seg = tid & 7, kp = tid >> 3;
    unsigned lb = (unsigned)((4 * seg) * QS_RS + 4 * kp); asm volatile("" : "+v"(lb));
#pragma unroll
    for (int i = 0; i < 4; ++i) { const f32x4 x0 = v[2 * i] * g[i].x, x1 = v[2 * i + 1] * g[i].y;
        cm = __builtin_elementwise_max(cm, __builtin_elementwise_max(__builtin_elementwise_abs(x0), __builtin_elementwise_abs(x1)));
        LAS unsigned char* b = lds + lb + (q * 4 + i) * 256;
        *(LAS unsigned*)(b) = pk2(x0.x, x1.x); *(LAS unsigned*)(b + QS_RS) = pk2(x0.y, x1.y); *(LAS unsigned*)(b + 2 * QS_RS) = pk2(x0.z, x1.z); *(LAS unsigned*)(b + 3 * QS_RS) = pk2(x0.w, x1.w); }
}
__device__ __forceinline__ void qs_park(const f32x4 (&v)[8], const f32x2_t (&g)[4], int q, f32x4& cm, unsigned (&park)[16][4]) {
#pragma unroll
    for (int i = 0; i < 4; ++i) { const f32x4 x0 = v[2 * i] * g[i].x, x1 = v[2 * i + 1] * g[i].y;
        cm = __builtin_elementwise_max(cm, __builtin_elementwise_max(__builtin_elementwise_abs(x0), __builtin_elementwise_abs(x1)));
        unsigned p0 = pk2(x0.x, x1.x), p1 = pk2(x0.y, x1.y), p2 = pk2(x0.z, x1.z), p3 = pk2(x0.w, x1.w);
        asm volatile("" : "+v"(p0), "+v"(p1), "+v"(p2), "+v"(p3));
        park[(q - 4) * 4 + i][0] = p0; park[(q - 4) * 4 + i][1] = p1; park[(q - 4) * 4 + i][2] = p2; park[(q - 4) * 4 + i][3] = p3; }
}
__device__ __forceinline__ void qs_flush(const QsJob& J, LAS unsigned char* lds, const float (&sc4)[4], int half, int wave, unsigned l16, unsigned l8) {
#pragma unroll
    for (int rr = 0; rr < 4; ++rr) { const int n = wave + 8 * rr; unsigned char* dst = J.WQ + (size_t)(J.n0 + n) * 4096 + half * 2048;
#pragma unroll
        for (int i = 0; i < 4; ++i) { const v4u w = *(const LAS v4u*)(lds + n * QS_RS + l16 + i * 1024);
            typedef unsigned u32x2_t __attribute__((ext_vector_type(2))); u32x2_t o;
            o.x = q8_pack4(bf_lo(w.x), bf_hi(w.x), bf_lo(w.y), bf_hi(w.y), sc4[rr]); o.y = q8_pack4(bf_lo(w.z), bf_hi(w.z), bf_lo(w.w), bf_hi(w.w), sc4[rr]);
            *(u32x2_t*)(dst + l8 + i * 512) = o; } }
}
__device__ __forceinline__ void convert_strips(Frame& F, int cw, int ncw) {
    LAS unsigned char* lds = F.lds + RING_OFF; LAS float* wm = (LAS float*)(lds + 32 * QS_RS);
    const int tid = F.tid, lane = F.lane, wave = F.wave;
    QS_BAR();
    int s = cw; if (s >= QS_NSTRIPS) return;
    f32x4 A[8], B[8]; f32x2_t gA[4], gB[4];
    unsigned l16 = (unsigned)lane * 16u, l8 = (unsigned)lane * 8u; asm volatile("" : "+v"(l16), "+v"(l8));
    QsJob J = qs_decode(F, s); qs_load(J, 0, A, gA, tid); qs_load(J, 1, B, gB, tid);
    for (;;) {
        f32x4 cm = {0.f, 0.f, 0.f, 0.f}; unsigned park[16][4];
#pragma unroll 1
        for (int qq = 0; qq < 2; ++qq) {
            qs_put(A, gA, 2 * qq, cm, lds, tid); QS_SB(); qs_load(J, 2 * qq + 2, A, gA, tid); QS_SB();
            qs_put(B, gB, 2 * qq + 1, cm, lds, tid); QS_SB(); qs_load(J, 2 * qq + 3, B, gB, tid); QS_SB(); }
        qs_park(A, gA, 4, cm, park); QS_SB(); qs_load(J, 6, A, gA, tid); QS_SB();
        qs_park(B, gB, 5, cm, park); QS_SB(); qs_load(J, 7, B, gB, tid); QS_SB();
        const int sn = s + ncw; const bool more = sn < QS_NSTRIPS; QsJob Jn = J; if (more) Jn = qs_decode(F, sn);
        qs_park(A, gA, 6, cm, park); QS_SB(); if (more) qs_load(Jn, 0, A, gA, tid); QS_SB();
        qs_park(B, gB, 7, cm, park); QS_SB();
#pragma unroll
        for (int e = 0; e < 4; ++e) { float m_ = cm[e]; m_ = fmaxf(m_, __shfl_xor(m_, 8)); m_ = fmaxf(m_, __shfl_xor(m_, 16)); m_ = fmaxf(m_, __shfl_xor(m_, 32)); cm[e] = m_; }
        if (lane < 8) *(LAS f32x4*)(wm + wave * 32 + 4 * lane) = cm;
        QS_BAR();
        float sc4[4];
#pragma unroll
        for (int rr = 0; rr < 4; ++rr) { const int n = wave + 8 * rr; float m_ = 0.f;
#pragma unroll
            for (int w8 = 0; w8 < 8; ++w8) m_ = fmaxf(m_, wm[w8 * 32 + n]);
            sc4[rr] = m_ > 0.f ? 127.f / m_ : 0.f;
            if (lane == 0) J.cmax[J.n0 + n] = m_; }
        qs_flush(J, lds, sc4, 0, wave, l16, l8);
        QS_BAR();
        { const int seg = tid & 7, kp = tid >> 3; unsigned lb = (unsigned)((4 * seg) * QS_RS + 4 * kp); asm volatile("" : "+v"(lb));
#pragma unroll
          for (int d = 0; d < 16; ++d) { LAS unsigned char* b = lds + lb + d * 256;
              *(LAS unsigned*)(b) = park[d][0]; *(LAS unsigned*)(b + QS_RS) = park[d][1]; *(LAS unsigned*)(b + 2 * QS_RS) = park[d][2]; *(LAS unsigned*)(b + 3 * QS_RS) = park[d][3]; } }
        QS_SB(); if (more) qs_load(Jn, 1, B, gB, tid); QS_SB();
        QS_BAR();
        qs_flush(J, lds, sc4, 1, wave, l16, l8);
        QS_BAR();
        if (!more) break;
        s = sn; J = Jn;
    }
}

#define ML_BAR() do { asm volatile("s_waitcnt lgkmcnt(0)" ::: "memory"); __builtin_amdgcn_s_barrier(); asm volatile("" ::: "memory"); } while (0)
constexpr int ML_QS = 528, ML_VS = 144, ML_PS = 144;
constexpr int ML_Q = 0, ML_K = ML_Q + 64 * ML_QS, ML_V = ML_K + 64 * ML_QS, ML_VW = ML_V + 64 * ML_VS, ML_P = ML_VW + 64 * ML_VS, ML_CT = ML_P + 64 * ML_PS, ML_SC = ML_CT + 64 * ML_QS, ML_H = ML_SC + 4096;
static_assert(ML_H + 64 * ML_VS <= RING_BYTES, "mlstm LDS");
struct MlPref { bf16x8 q[4], k[4], v; float li, lf; };
struct MlK { LAS unsigned char* L; const bf16* QKVO; bf16* HR; const float* LI; const float* LF; size_t rowb; int bh, hd, e0, tid, lane, wid; };
__device__ __forceinline__ void ml_load(MlPref& P, const MlK& K, int c) {
    const int qr_ = K.tid >> 3, qc_ = K.tid & 7;
    const bf16* base = K.QKVO + (K.rowb + (size_t)c * 64 + qr_) * M_MAIN;
#pragma unroll
    for (int i = 0; i < 4; ++i) { P.q[i] = *(const bf16x8*)(base + K.hd * 256 + (qc_ + 8 * i) * 8); P.k[i] = *(const bf16x8*)(base + 2048 + K.hd * 256 + (qc_ + 8 * i) * 8); }
    P.v = *(const bf16x8*)(base + 4096 + K.hd * 512 + K.e0 + qc_ * 8);
    P.li = K.LI[(size_t)K.bh * SEQ + c * 64 + K.lane]; P.lf = K.LF[(size_t)K.bh * SEQ + c * 64 + K.lane];
}
__device__ __forceinline__ void ml_chunk(MlPref& P, f32x4 (&CT)[2][4], float& m_state, const MlK& K, int c) {
    LAS unsigned char* L = K.L;
    LAS float* sc_a = (LAS float*)(L + ML_SC); LAS float* sc_M = sc_a + 64; LAS float* sc_b = sc_a + 128; LAS float* sc_w = sc_a + 192;
    LAS float* sc_rs = sc_a + 256; LAS float* sc_qn = sc_a + 512; LAS float* sc_nv = sc_a + 576;
    const int tid = K.tid, lane = K.lane, wid = K.wid, r16 = lane & 15, kq = lane >> 4;
    const int tt = wid >> 1, sp = wid & 1, ep = wid & 1, qr_ = tid >> 3, qc_ = tid & 7;
    float bsum = P.lf;
#pragma unroll
    for (int o = 1; o < 64; o <<= 1) { const float t_ = __shfl_up(bsum, o); if (lane >= o) bsum += t_; }
    const float a_s = P.li - bsum;
    float pm = a_s;
#pragma unroll
    for (int o = 1; o < 64; o <<= 1) { const float t_ = __shfl_up(pm, o); if (lane >= o) pm = fmaxf(pm, t_); }
    const float Mt = fmaxf(m_state, pm);
    const float M63 = __uint_as_float(__builtin_amdgcn_readlane(__float_as_uint(Mt), 63)), b63 = __uint_as_float(__builtin_amdgcn_readlane(__float_as_uint(bsum), 63));
    const float w_s = __expf(a_s - M63), decay = __expf(m_state - M63);
    if (wid == 0) { sc_a[lane] = a_s; sc_M[lane] = Mt; sc_b[lane] = bsum; sc_w[lane] = w_s; }
#pragma unroll
    for (int i = 0; i < 4; ++i) { *(LAS bf16x8*)(L + ML_Q + qr_ * ML_QS + (qc_ + 8 * i) * 16) = P.q[i]; *(LAS bf16x8*)(L + ML_K + qr_ * ML_QS + (qc_ + 8 * i) * 16) = P.k[i]; }
    { *(LAS bf16x8*)(L + ML_V + qr_ * ML_VS + qc_ * 16) = P.v;
        const float wv = __shfl(w_s, 8 * wid + (lane >> 3)); const v4u raw = __builtin_bit_cast(v4u, P.v); v4u o;
        o.x = pk2(bf_lo(raw.x) * wv, bf_hi(raw.x) * wv); o.y = pk2(bf_lo(raw.y) * wv, bf_hi(raw.y) * wv); o.z = pk2(bf_lo(raw.z) * wv, bf_hi(raw.z) * wv); o.w = pk2(bf_lo(raw.w) * wv, bf_hi(raw.w) * wv);
        *(LAS v4u*)(L + ML_VW + qr_ * ML_VS + qc_ * 16) = o; }
    ml_load(P, K, c + 2 < 64 ? c + 2 : 63);
    ML_BAR();
    f32x4 sacc0 = {0.f, 0.f, 0.f, 0.f}, sacc1 = sacc0, iacc0 = sacc0, iacc1 = sacc0;
    { const LAS unsigned char* qrow = L + ML_Q + (tt * 16 + r16) * ML_QS + kq * 16;
      const LAS unsigned char* krow = L + ML_K + (sp * 32 + r16) * ML_QS + kq * 16;
      const LAS unsigned char* crow_ = L + ML_CT + (ep * 32 + r16) * ML_QS + kq * 16;
#pragma unroll 2
      for (int k0 = 0; k0 < 8; ++k0) { const bf16x8 a = *(const LAS bf16x8*)(qrow + k0 * 64);
          const bf16x8 b0 = *(const LAS bf16x8*)(krow + k0 * 64), b1 = *(const LAS bf16x8*)(krow + 16 * ML_QS + k0 * 64);
          const bf16x8 bc0 = *(const LAS bf16x8*)(crow_ + k0 * 64), bc1 = *(const LAS bf16x8*)(crow_ + 16 * ML_QS + k0 * 64);
          sacc0 = mfma16(b0, a, sacc0); sacc1 = mfma16(b1, a, sacc1); iacc0 = mfma16(bc0, a, iacc0); iacc1 = mfma16(bc1, a, iacc1); } }
    const int tl = tt * 16 + r16;
    const float Mt_t = sc_M[tl];
#pragma unroll
    for (int st2 = 0; st2 < 2; ++st2) { const int s0 = (2 * sp + st2) * 16 + 4 * kq; const f32x4 a4 = *(const LAS f32x4*)(sc_a + s0); const f32x4 sv = st2 ? sacc1 : sacc0;
        float pv4[4]; float rsum = 0.f;
#pragma unroll
        for (int i = 0; i < 4; ++i) { pv4[i] = (s0 + i <= tl) ? sv[i] * __expf(a4[i] - Mt_t) : 0.f; rsum += pv4[i]; }
        rsum += __shfl_xor(rsum, 16); rsum += __shfl_xor(rsum, 32);
        if (kq == 0) sc_rs[(2 * sp + st2) * 64 + tl] = rsum;
        typedef unsigned u32x2_t __attribute__((ext_vector_type(2)));
        u32x2_t w; w.x = pk2(pv4[0], pv4[1]); w.y = pk2(pv4[2], pv4[3]);
        *(LAS u32x2_t*)(L + ML_P + tl * ML_PS + s0 * 2) = w; }
    { const int t = tid >> 3, part = tid & 7; float qn = 0.f;
      const LAS v4u* qp = (const LAS v4u*)(L + ML_Q + t * ML_QS + part * 64); const LAS f32x4* np_ = (const LAS f32x4*)(sc_nv + part * 32);
#pragma unroll
      for (int j = 0; j < 4; ++j) { const v4u w = qp[j]; const f32x4 n0 = np_[2 * j], n1 = np_[2 * j + 1];
          qn += (bf_lo(w.x) * n0[0] + bf_hi(w.x) * n0[1]) + (bf_lo(w.y) * n0[2] + bf_hi(w.y) * n0[3]) + (bf_lo(w.z) * n1[0] + bf_hi(w.z) * n1[1]) + (bf_lo(w.w) * n1[2] + bf_hi(w.w) * n1[3]); }
      qn += __shfl_xor(qn, 1); qn += __shfl_xor(qn, 2); qn += __shfl_xor(qn, 4);
      if (part == 0) sc_qn[t] = qn; }
    ML_BAR();
    { f32x4 xacc[2] = {{0.f, 0.f, 0.f, 0.f}, {0.f, 0.f, 0.f, 0.f}}; const int j = r16 >> 2, q = r16 & 3;
#pragma unroll
      for (int ks = 0; ks < 2; ++ks) { const bf16x8 pf = *(const LAS bf16x8*)(L + ML_P + tl * ML_PS + (ks * 32 + kq * 8) * 2);
#pragma unroll
          for (int e2 = 0; e2 < 2; ++e2) { const LAS unsigned char* va = L + ML_V + (ks * 32 + 8 * kq + j) * ML_VS + ((2 * ep + e2) * 16 + 4 * q) * 2;
              xacc[e2] = mfma16(cat8(tr16(va), tr16(va + 4 * ML_VS)), pf, xacc[e2]); } }
      const float bb_t = sc_b[tl], winter = __expf(m_state - Mt_t);
      const float den = winter * sc_qn[tl] + ((sc_rs[tl] + sc_rs[64 + tl]) + (sc_rs[128 + tl] + sc_rs[192 + tl]));
      const float rdd = 1.f / fmaxf(fabsf(den), __expf(-(bb_t + Mt_t)));
#pragma unroll
      for (int e2 = 0; e2 < 2; ++e2) { const f32x4 ia = e2 ? iacc1 : iacc0; float hv[4];
#pragma unroll
          for (int i = 0; i < 4; ++i) hv[i] = (winter * ia[i] + xacc[e2][i]) * rdd;
          typedef unsigned u32x2_t __attribute__((ext_vector_type(2)));
          u32x2_t w; w.x = pk2(hv[0], hv[1]); w.y = pk2(hv[2], hv[3]);
          *(LAS u32x2_t*)(L + ML_H + tl * ML_VS + ((2 * ep + e2) * 16 + 4 * kq) * 2) = w; } }
    { const int j = r16 >> 2, q = r16 & 3; bf16x8 af[2][2];
#pragma unroll
      for (int e2 = 0; e2 < 2; ++e2)
#pragma unroll
          for (int ks = 0; ks < 2; ++ks) { const LAS unsigned char* va = L + ML_VW + (ks * 32 + 8 * kq + j) * ML_VS + ((2 * ep + e2) * 16 + 4 * q) * 2; af[e2][ks] = cat8(tr16(va), tr16(va + 4 * ML_VS)); }
#pragma unroll
      for (int jt = 0; jt < 4; ++jt) { const int dt = 4 * (wid >> 1) + jt; bf16x8 bfr[2];
#pragma unroll
          for (int ks = 0; ks < 2; ++ks) { const LAS unsigned char* ka = L + ML_K + (ks * 32 + 8 * kq + j) * ML_QS + (dt * 16 + 4 * q) * 2; bfr[ks] = cat8(tr16(ka), tr16(ka + 4 * ML_QS)); }
#pragma unroll
          for (int e2 = 0; e2 < 2; ++e2) { f32x4 acc = CT[e2][jt] * decay;
              acc = mfma16(bfr[0], af[e2][0], acc); acc = mfma16(bfr[1], af[e2][1], acc);
              CT[e2][jt] = acc;
              typedef unsigned u32x2_t __attribute__((ext_vector_type(2)));
              u32x2_t w; w.x = pk2(acc[0], acc[1]); w.y = pk2(acc[2], acc[3]);
              *(LAS u32x2_t*)(L + ML_CT + ((2 * ep + e2) * 16 + r16) * ML_QS + (dt * 16 + 4 * kq) * 2) = w; } } }
    if (tid < 256) { float nv = sc_nv[tid] * decay;
#pragma unroll
        for (int s = 0; s < 64; ++s) nv += __uint_as_float(__builtin_amdgcn_readlane(__float_as_uint(w_s), s)) * bf1(*(const LAS unsigned short*)(L + ML_K + s * ML_QS + tid * 2));
        sc_nv[tid] = nv; }
    m_state = b63 + M63;
    ML_BAR();
    *(bf16x8*)(K.HR + (K.rowb + (size_t)c * 64 + qr_) * DM + K.hd * 512 + K.e0 + qc_ * 8) = *(const LAS bf16x8*)(L + ML_H + qr_ * ML_VS + qc_ * 16);
}
__device__ __forceinline__ void mlstm_phase(Frame& F, int worker, int nworkers) {
    LAS unsigned char* L = F.lds + RING_OFF;
    LAS float* sc_nv = (LAS float*)(L + ML_SC) + 576;
    for (int unit = worker; unit < 128; unit += nworkers) {
        const int bh = unit >> 3, sl = unit & 7, b = bh >> 3;
        MlK K; K.L = L; K.QKVO = (const bf16*)(F.ws + WS_BIG); K.HR = (bf16*)(F.ws + WS_HR); K.LI = (const float*)(F.ws + WS_LI); K.LF = (const float*)(F.ws + WS_LF);
        K.rowb = (size_t)b * SEQ; K.bh = bh; K.hd = bh & 7; K.e0 = sl * 64; K.tid = F.tid; K.lane = F.lane; K.wid = F.wave;
        f32x4 CT[2][4];
#pragma unroll
        for (int a = 0; a < 2; ++a)
#pragma unroll
            for (int j = 0; j < 4; ++j) CT[a][j] = (f32x4){0.f, 0.f, 0.f, 0.f};
        float m_state = 0.f;
        if (F.tid < 256) sc_nv[F.tid] = 0.f;
        for (int i = F.tid; i < 64 * ML_QS / 4; i += NWAVES * 64) ((LAS unsigned*)(L + ML_CT))[i] = 0u;
        MlPref P0, P1;
        ml_load(P0, K, 0); ml_load(P1, K, 1);
        __syncthreads();
        for (int c = 0; c < 64; c += 2) { ml_chunk(P0, CT, m_state, K, c); ml_chunk(P1, CT, m_state, K, c + 1); }
    }
}

__device__ __forceinline__ void gating_phase(Frame& F) {
    const int gw = blockIdx.x * NWAVES + F.wave, NGW = F.G * NWAVES, lane = F.lane;
    const bf16* HR = (const bf16*)(F.ws + WS_HR); const bf16* QKVO = (const bf16*)(F.ws + WS_BIG); bf16* A3 = (bf16*)(F.ws + WS_A3);
    float* ra = (float*)(F.ws + WS_RS) + 24576;
    for (int row = gw; row < MTOK; row += NGW) {
        unsigned pk[8][4]; float am = 0.f;
#pragma unroll
        for (int hd = 0; hd < 8; ++hd) {
            const v4u hv = *(const v4u*)(HR + (size_t)row * DM + hd * 512 + lane * 8);
            const v4u ov = *(const v4u*)(QKVO + (size_t)row * M_MAIN + 8192 + hd * 512 + lane * 8);
            float h[8] = {bf_lo(hv.x), bf_hi(hv.x), bf_lo(hv.y), bf_hi(hv.y), bf_lo(hv.z), bf_hi(hv.z), bf_lo(hv.w), bf_hi(hv.w)};
            float o[8] = {bf_lo(ov.x), bf_hi(ov.x), bf_lo(ov.y), bf_hi(ov.y), bf_lo(ov.z), bf_hi(ov.z), bf_lo(ov.w), bf_hi(ov.w)};
            float ss = 0.f;
#pragma unroll
            for (int e = 0; e < 8; ++e) ss += h[e] * h[e];
            const float rstd = 1.f / sqrtf(wave_sum(ss) * (1.f / 512.f) + EPS);
            float r[8];
#pragma unroll
            for (int e = 0; e < 8; ++e) { r[e] = h[e] * rstd / (1.f + __expf(-o[e])); am = fmaxf(am, fabsf(r[e])); }
#pragma unroll
            for (int j = 0; j < 4; ++j) pk[hd][j] = pk2(r[2 * j], r[2 * j + 1]);
            if (!Q8_WMO) { v4u w; w.x = pk[hd][0]; w.y = pk[hd][1]; w.z = pk[hd][2]; w.w = pk[hd][3]; *(v4u*)(A3 + (size_t)row * DM + hd * 512 + lane * 8) = w; }
        }
        if (Q8_WMO) {
#pragma unroll
            for (int o = 1; o < 64; o <<= 1) am = fmaxf(am, __shfl_xor(am, o));
            const float sc = am > 0.f ? 127.f / am : 0.f;
#pragma unroll
            for (int hd = 0; hd < 8; ++hd) { typedef unsigned u32x2_t __attribute__((ext_vector_type(2))); u32x2_t o;
                o.x = q8_pack4(bf_lo(pk[hd][0]), bf_hi(pk[hd][0]), bf_lo(pk[hd][1]), bf_hi(pk[hd][1]), sc); o.y = q8_pack4(bf_lo(pk[hd][2]), bf_hi(pk[hd][2]), bf_lo(pk[hd][3]), bf_hi(pk[hd][3]), sc);
                *(u32x2_t*)((unsigned char*)A3 + (size_t)row * DM + hd * 512 + lane * 8) = o; }
            if (lane == 0) ra[row] = am * (1.f / 127.f); }
    }
}

__device__ __forceinline__ float gelu_tanh(float v) { const float u = 0.7978845608028654f * (v + 0.044715f * v * v * v); return 0.5f * v * (1.f + tanhf(u)); }
struct CmpA { const bf16* KVQ; int j, rt; __device__ __forceinline__ const bf16* operator()(int r16, int k) const {
    const int row = rt * 16 + r16, bg = row >> 8; int c = row & 255; c = c > 254 ? 254 : c; const int b = bg >> 2, g = bg & 3;
    return KVQ + ((size_t)b * SEQ + 16 * c + (k >> 7)) * NKVQ + j * 512 + g * 128 + (k & 127); } };
__device__ __forceinline__ void nsa_prep_phase(Frame& F) {
    const int gw = blockIdx.x * NWAVES + F.wave, NGW = F.G * NWAVES, lane = F.lane, r16 = lane & 15, kq = lane >> 4;
    bf16* KVQ = (bf16*)(F.ws + WS_BIG);
    { const int v = lane >> 3, br = v >> 2, g = v & 3, d0 = (lane & 7) * 16;
      float gn[16];
#pragma unroll
      for (int e = 0; e < 16; ++e) gn[e] = F.in[9][(br + 1) * 128 + d0 + e] * F.in[14][(br + 1) * 128 + d0 + e] * ATT_SCALE;
      for (int row = gw; row < MTOK; row += NGW) {
          bf16* p = KVQ + (size_t)row * NKVQ + (2 + 2 * br) * 512 + g * 128 + d0;
          const v4u a = *(const v4u*)p, c = *(const v4u*)(p + 8);
          float x[16] = {bf_lo(a.x), bf_hi(a.x), bf_lo(a.y), bf_hi(a.y), bf_lo(a.z), bf_hi(a.z), bf_lo(a.w), bf_hi(a.w), bf_lo(c.x), bf_hi(c.x), bf_lo(c.y), bf_hi(c.y), bf_lo(c.z), bf_hi(c.z), bf_lo(c.w), bf_hi(c.w)};
          float ss = 0.f;
#pragma unroll
          for (int e = 0; e < 16; ++e) ss += x[e] * x[e];
          ss += __shfl_xor(ss, 1); ss += __shfl_xor(ss, 2); ss += __shfl_xor(ss, 4);
          const float rstd = 1.f / sqrtf(ss * (1.f / 128.f) + EPS);
#pragma unroll
          for (int e = 0; e < 16; ++e) x[e] *= rstd * gn[e];
          v4u o0, o1; o0.x = pk2(x[0], x[1]); o0.y = pk2(x[2], x[3]); o0.z = pk2(x[4], x[5]); o0.w = pk2(x[6], x[7]); o1.x = pk2(x[8], x[9]); o1.y = pk2(x[10], x[11]); o1.z = pk2(x[12], x[13]); o1.w = pk2(x[14], x[15]);
          *(v4u*)p = o0; *(v4u*)(p + 8) = o1; } }
    { const bf16* W1C = (const bf16*)(F.ws + WS_W1C); const bf16* W2C = (const bf16*)(F.ws + WS_W2C); const float* posb = (const float*)(F.ws + WS_POSB);
      bf16* KC = (bf16*)(F.ws + WS_KC); bf16* VC = (bf16*)(F.ws + WS_VC);
      LAS unsigned char* As = F.lds + RING_OFF;
      LAS unsigned char* Hs = F.lds + RING_OFF; LAS float* ps = (LAS float*)(F.lds + RING_OFF + 16 * 8208);
      const int wid = F.wave;
      for (int task = blockIdx.x; task < 256; task += F.G) { const int j = (task & 7) >> 2, rt = (task & 3) * 32 + (task >> 3);
          { f32x4 acc[4]; CmpA ap{KVQ, j, rt};
            { const int l16 = F.tid & 15, ch = F.tid >> 4; v4u tmp[16];
#pragma unroll
              for (int p = 0; p < 16; ++p) tmp[p] = *(const v4u*)(ap(p, ch * 128 + l16 * 8));
#pragma unroll
              for (int p = 0; p < 16; ++p) *(LAS v4u*)(As + p * 8208 + (ch * 128 + l16 * 8) * 2) = tmp[p]; }
            __syncthreads();
#pragma unroll
            for (int n = 0; n < 4; ++n) acc[n] = (f32x4){0.f, 0.f, 0.f, 0.f};
#pragma unroll
            for (int hf = 0; hf < 2; ++hf) { const bf16* brow = W1C + ((size_t)j * 512 + hf * 256 + wid * 32 + r16) * 4096 + kq * 16; LAS unsigned char* arow = As + r16 * 8208 + kq * 32;
              bf16x8 b0[8][2], b1[8][2];
#pragma unroll
              for (int s8 = 0; s8 < 8; ++s8)
#pragma unroll
                  for (int n = 0; n < 2; ++n) b0[s8][n] = *(const bf16x8*)(brow + (size_t)n * 16 * 4096 + (s8 >> 1) * 64 + (s8 & 1) * 8);
#pragma unroll 1
              for (int kb = 0; kb < 16; kb += 2) {
#pragma unroll
                  for (int s8 = 0; s8 < 8; ++s8)
#pragma unroll
                      for (int n = 0; n < 2; ++n) b1[s8][n] = *(const bf16x8*)(brow + (size_t)n * 16 * 4096 + (kb + 1) * 256 + (s8 >> 1) * 64 + (s8 & 1) * 8);
                  __builtin_amdgcn_sched_barrier(0);
#pragma unroll
                  for (int s8 = 0; s8 < 8; ++s8) { const bf16x8 a = *(const LAS bf16x8*)(arow + (kb * 256 + (s8 >> 1) * 64 + (s8 & 1) * 8) * 2);
#pragma unroll
                      for (int n = 0; n < 2; ++n) acc[hf * 2 + n] = mfma16(a, b0[s8][n], acc[hf * 2 + n]); }
                  __builtin_amdgcn_sched_barrier(0);
                  if (kb + 2 < 16) {
#pragma unroll
                      for (int s8 = 0; s8 < 8; ++s8)
#pragma unroll
                          for (int n = 0; n < 2; ++n) b0[s8][n] = *(const bf16x8*)(brow + (size_t)n * 16 * 4096 + (kb + 2) * 256 + (s8 >> 1) * 64 + (s8 & 1) * 8); }
                  __builtin_amdgcn_sched_barrier(0);
#pragma unroll
                  for (int s8 = 0; s8 < 8; ++s8) { const bf16x8 a = *(const LAS bf16x8*)(arow + ((kb + 1) * 256 + (s8 >> 1) * 64 + (s8 & 1) * 8) * 2);
#pragma unroll
                      for (int n = 0; n < 2; ++n) acc[hf * 2 + n] = mfma16(a, b1[s8][n], acc[hf * 2 + n]); }
                  __builtin_amdgcn_sched_barrier(0); } }
            __syncthreads();
#pragma unroll
            for (int n = 0; n < 4; ++n) { const int col = (n >> 1) * 256 + wid * 32 + (n & 1) * 16 + r16; const float pb = posb[j * 512 + col];
#pragma unroll
                for (int i = 0; i < 4; ++i) *(LAS unsigned short*)(Hs + (4 * kq + i) * 1040 + col * 2) = f2bf1(gelu_tanh(acc[n][i] + pb)); } }
          __syncthreads();
          f32x4 o = {0.f, 0.f, 0.f, 0.f};
          { const bf16* brow = W2C + ((size_t)j * 128 + wid * 16 + r16) * 512 + kq * 8;
#pragma unroll 4
            for (int k0 = 0; k0 < 512; k0 += 32) o = mfma16(*(const LAS bf16x8*)(Hs + r16 * 1040 + (k0 + kq * 8) * 2), *(const bf16x8*)(brow + k0), o); }
          const int col = wid * 16 + r16;
          if (j == 0) {
#pragma unroll
              for (int i = 0; i < 4; ++i) { float ss = o[i] * o[i]; ss += __shfl_xor(ss, 1); ss += __shfl_xor(ss, 2); ss += __shfl_xor(ss, 4); ss += __shfl_xor(ss, 8);
                  if (r16 == 0) ps[wid * 16 + 4 * kq + i] = ss; } }
          __syncthreads();
          const float gsc = (j == 0) ? F.in[9][col] * F.in[14][col] * ATT_SCALE : 1.f;
#pragma unroll
          for (int i = 0; i < 4; ++i) { const int row = rt * 16 + 4 * kq + i; float v = o[i];
              if (j == 0) { float ss = 0.f;
#pragma unroll
                  for (int w = 0; w < 8; ++w) ss += ps[w * 16 + 4 * kq + i];
                  v *= gsc / sqrtf(ss * (1.f / 128.f) + EPS); }
              if ((row & 255) == 255) v = 0.f;
              (j == 0 ? KC : VC)[(size_t)row * 128 + col] = f2bf1(v); }
          __syncthreads(); } }
}
__device__ __forceinline__ void nsa_cmp2_phase(Frame& F) {
    const int gw = blockIdx.x * NWAVES + F.wave, NGW = F.G * NWAVES, lane = F.lane, r16 = lane & 15, kq = lane >> 4;
    const bf16* HC = (const bf16*)(F.ws + WS_HC); const bf16* W2C = (const bf16*)(F.ws + WS_W2C); bf16* KC = (bf16*)(F.ws + WS_KC); bf16* VC = (bf16*)(F.ws + WS_VC);
    for (int task = gw; task < 256; task += NGW) { const int j = task >> 7, rt = task & 127;
        f32x4 acc[8]; RowMajorA ap{HC + ((size_t)j * 2048 + rt * 16) * 512, 512};
        mini_gemm16<8>(acc, ap, W2C + (size_t)j * 128 * 512, 512, 512, lane);
#pragma unroll
        for (int i = 0; i < 4; ++i) { const int row = rt * 16 + 4 * kq + i; const bool pad = (row & 255) == 255;
            float sc = 1.f;
            if (j == 0) { float ss = 0.f;
#pragma unroll
                for (int n = 0; n < 8; ++n) ss += acc[n][i] * acc[n][i];
                ss += __shfl_xor(ss, 1); ss += __shfl_xor(ss, 2); ss += __shfl_xor(ss, 4); ss += __shfl_xor(ss, 8);
                sc = ATT_SCALE / sqrtf(ss * (1.f / 128.f) + EPS); }
#pragma unroll
            for (int n = 0; n < 8; ++n) { const int col = n * 16 + r16; float v = acc[n][i] * sc;
                if (j == 0) v *= F.in[9][col] * F.in[14][col];
                if (pad) v = 0.f;
                (j == 0 ? KC : VC)[(size_t)row * 128 + col] = f2bf1(v); } } }
}

namespace nsa {
constexpr int D = 128, KVBLK = 64, SHM_K = 16384, SHM_V = 16384;
constexpr int O_V = 0, O_K = SHM_V, BUF1 = SHM_V + SHM_K  , O_WS = 2 * BUF1, O_PB = O_WS + NWAVES * 64 * 4, O_SELM = O_PB + 32 * 65 * 4, O_OT = ((O_SELM + 32 * 8 + 1023) / 1024) * 1024  , O_END = O_OT + 32 * 2048;
static_assert(O_END <= RING_BYTES, "nsa LDS");
constexpr float THR2 = 11.0f;
#define KSWZ(row, colB) ((row) * 256 + ((colB) ^ (((row) & 7) << 4)))
#define SBAR() __builtin_amdgcn_sched_barrier(0)
__device__ __forceinline__ int v_st(int k, int c) { const int kk = (k & ~0xC) | ((k & 4) << 1) | ((k & 8) >> 1); return ((kk >> 3) * 4 + (c >> 5)) * 512 + ((kk & 7) * 32 + (c & 31)) * 2; }
__device__ __forceinline__ int v_rd_base(int lane) { return ((lane & 3) << 3) | (((lane >> 2) & 3) << 6) | (((lane >> 4) & 1) << 5) | (((lane >> 5) & 1) << 8); }
constexpr int v_rd_off(int d0, int ks, int half) { return d0 * 512 + ks * 4096 + half * 2048; }
__device__ __forceinline__ int crow(int r, int hi) { return (r & 3) + 8 * (r >> 2) + 4 * hi; }
__device__ __forceinline__ void mask_tile(f32x16& p0, f32x16& p1, int dq, unsigned W) {
    const float NEG = -__builtin_inff();
#pragma unroll
    for (int r = 0; r < 16; ++r) { const int c = (r & 3) + 8 * (r >> 2);
        if ((unsigned)(dq - c) >= W) p0[r] = NEG;
        if ((unsigned)(dq - c - 32) >= W) p1[r] = NEG; }
}
__device__ __forceinline__ float rowmax32(const f32x16& p0, const f32x16& p1) {
    float pmax = p0[0];
#pragma unroll
    for (int r = 1; r < 16; ++r) pmax = fmaxf(pmax, p0[r]);
#pragma unroll
    for (int r = 0; r < 16; ++r) pmax = fmaxf(pmax, p1[r]);
    auto rr = __builtin_amdgcn_permlane32_swap(__float_as_uint(pmax), __float_as_uint(pmax), false, false);
    return fmaxf(__uint_as_float(rr[0]), __uint_as_float(rr[1]));
}
__device__ __forceinline__ float rowsum32(const f32x16& p0, const f32x16& p1) {
    float ps = 0.f;
#pragma unroll
    for (int r = 0; r < 16; ++r) ps += p0[r];
#pragma unroll
    for (int r = 0; r < 16; ++r) ps += p1[r];
    auto rr = __builtin_amdgcn_permlane32_swap(__float_as_uint(ps), __float_as_uint(ps), false, false);
    return __uint_as_float(rr[0]) + __uint_as_float(rr[1]);
}
__device__ __forceinline__ void partialSM(f32x16& p0, f32x16& p1, float& m_reg, float& alpha, float c2) {
    const float pmax = rowmax32(p0, p1); float mn;
    if (__builtin_expect(__all((pmax - m_reg) * c2 <= THR2), 1)) { mn = m_reg; alpha = 1.f; }
    else { mn = fmaxf(m_reg, pmax); alpha = __builtin_amdgcn_exp2f((m_reg - mn) * c2); m_reg = mn; }
    const float mnL = -mn * c2;
#pragma unroll
    for (int r = 0; r < 16; ++r) p0[r] = fmaf(p0[r], c2, mnL);
#pragma unroll
    for (int r = 0; r < 16; ++r) p1[r] = fmaf(p1[r], c2, mnL);
#pragma unroll
    for (int r = 0; r < 16; ++r) p0[r] = __builtin_amdgcn_exp2f(p0[r]);
}
__device__ __forceinline__ void packP(const f32x16& p0, const f32x16& p1, bf16x8& pa0, bf16x8& pa1, bf16x8& pa2, bf16x8& pa3) {
#define PK4(P, B_, OUT) do { unsigned a0 = pk2(P[B_+0], P[B_+1]), a1 = pk2(P[B_+2], P[B_+3]);                          \
        unsigned b0 = pk2(P[B_+4], P[B_+5]), b1 = pk2(P[B_+6], P[B_+7]);                                             \
        auto r0 = __builtin_amdgcn_permlane32_swap(a0, b0, false, false); auto r1 = __builtin_amdgcn_permlane32_swap(a1, b1, false, false); \
        u32x4_t w = {r0[0], r1[0], r0[1], r1[1]}; OUT = __builtin_bit_cast(bf16x8, w); } while (0)
    typedef unsigned u32x4_t __attribute__((ext_vector_type(4)));
    PK4(p0, 0, pa0); PK4(p0, 8, pa1); PK4(p1, 0, pa2); PK4(p1, 8, pa3);
#undef PK4
}
__device__ __forceinline__ void finishSM(f32x16& p0, f32x16& p1, float alpha, float& l_reg, bf16x8& pa0, bf16x8& pa1, bf16x8& pa2, bf16x8& pa3) {
#pragma unroll
    for (int r = 0; r < 16; ++r) p1[r] = __builtin_amdgcn_exp2f(p1[r]);
    l_reg = l_reg * alpha + rowsum32(p0, p1);
    packP(p0, p1, pa0, pa1, pa2, pa3);
}
__device__ __forceinline__ void qkt(f32x16& p0, f32x16& p1, const char* K_lds, int r32, int hi, const bf16x8* qr, float cinit) {
#pragma unroll
    for (int r = 0; r < 16; ++r) { p0[r] = cinit; p1[r] = cinit; }
    const char* kb[4];
#pragma unroll
    for (int dd = 0; dd < 4; ++dd) kb[dd] = K_lds + KSWZ(r32, (dd * 16 + hi * 8) * 2);
#pragma unroll
    for (int d0 = 0; d0 < 8; ++d0) { const char* a = kb[d0 & 3] + (d0 >> 2) * 128;
        const bf16x8 b0 = *reinterpret_cast<const bf16x8*>(a);
        const bf16x8 b1 = *reinterpret_cast<const bf16x8*>(a + 32 * 256);
        p0 = __builtin_amdgcn_mfma_f32_32x32x16_bf16(b0, qr[d0], p0, 0, 0, 0);
        p1 = __builtin_amdgcn_mfma_f32_32x32x16_bf16(b1, qr[d0], p1, 0, 0, 0); }
}
__device__ __forceinline__ void pv_tile(f32x16* o, int vb0, bf16x8 pa0, bf16x8 pa1, bf16x8 pa2, bf16x8 pa3) {
#define TRRD(dst, off) asm volatile("ds_read_b64_tr_b16 %0, %1 offset:%2" : "=&v"(dst) : "v"(vb0), "i"(off) : "memory")
#define PV_D0(d0) do { s16x4 l0, l1, l2, l3, h0, h1, h2, h3; constexpr int b_ = v_rd_off(d0, 0, 0); \
        TRRD(l0, b_); TRRD(h0, b_ + 2048); TRRD(l1, b_ + 4096); TRRD(h1, b_ + 6144); TRRD(l2, b_ + 8192); TRRD(h2, b_ + 10240); TRRD(l3, b_ + 12288); TRRD(h3, b_ + 14336); \
        asm volatile("s_waitcnt lgkmcnt(0)" ::: "memory"); SBAR();   \
        o[d0] = __builtin_amdgcn_mfma_f32_32x32x16_bf16(pa0, (bf16x8){l0[0], l0[1], l0[2], l0[3], h0[0], h0[1], h0[2], h0[3]}, o[d0], 0, 0, 0);   \
        o[d0] = __builtin_amdgcn_mfma_f32_32x32x16_bf16(pa1, (bf16x8){l1[0], l1[1], l1[2], l1[3], h1[0], h1[1], h1[2], h1[3]}, o[d0], 0, 0, 0);   \
        o[d0] = __builtin_amdgcn_mfma_f32_32x32x16_bf16(pa2, (bf16x8){l2[0], l2[1], l2[2], l2[3], h2[0], h2[1], h2[2], h2[3]}, o[d0], 0, 0, 0);   \
        o[d0] = __builtin_amdgcn_mfma_f32_32x32x16_bf16(pa3, (bf16x8){l3[0], l3[1], l3[2], l3[3], h3[0], h3[1], h3[2], h3[3]}, o[d0], 0, 0, 0); } while (0)
    PV_D0(0); PV_D0(1); PV_D0(2); PV_D0(3);
#undef PV_D0
#undef TRRD
}
struct Stage { bf16x8 k0, k1, v0, v1; };
__device__ __forceinline__ void stage_load(Stage& S, const bf16* Kp, const bf16* Vp, int ld, int kb, int sr, int sc, bool withV) {
    const bf16* kt = Kp + (size_t)kb * ld; const bf16* vt = Vp + (size_t)kb * ld;
    const unsigned voff = (unsigned)(sr * ld + sc);
    S.k0 = *(const bf16x8*)(kt + voff); S.k1 = *(const bf16x8*)(kt + (size_t)32 * ld + voff);
    if (withV) { S.v0 = *(const bf16x8*)(vt + voff); S.v1 = *(const bf16x8*)(vt + (size_t)32 * ld + voff); }
}
__device__ __forceinline__ void stage_write(const Stage& S, char* lds, int sr, int sc, bool withV) {
    const int kws = KSWZ(sr, sc * 2);
    *(bf16x8*)(lds + O_K + kws) = S.k0; *(bf16x8*)(lds + O_K + kws + 32 * 256) = S.k1;
    if (withV) { *(bf16x8*)(lds + O_V + v_st(sr, sc)) = S.v0; *(bf16x8*)(lds + O_V + v_st(32 + sr, sc)) = S.v1; }
}
template <int ACC>
__device__ __forceinline__ void emit(const f32x16* o, const float* fl, char* OTw, int r32, int hi) {
    int r32o = r32, hio = hi; asm volatile("" : "+v"(r32o), "+v"(hio));
    char* base = OTw + 4 * hio * 2048 + r32o * 2;
#pragma unroll
    for (int r = 0; r < 16; ++r) { const float f = fl[(r & 3) + 8 * (r >> 2) + 4 * hio]; unsigned short* p = (unsigned short*)(base + ((r & 3) + 8 * (r >> 2)) * 2048);
#pragma unroll
        for (int d0 = 0; d0 < 4; ++d0) { float v = o[d0][r] * f;
            if (ACC >= 1) v += bf1(p[d0 * 32]);
            p[d0 * 32] = f2bf1(v); } }
}
template <int MODE, int ACC>
__device__ __forceinline__ void flash_pass(char* lds, const bf16* Kp, const bf16* Vp, int ld, unsigned long long tiles, int t, int qb, unsigned long long mymask, const bf16x8* qr, float c2, float gate, char* OTw,
                                           Stage& S, const bf16* Kn, const bf16* Vn, Stage* Sn, int tid, int wid, int lane) {
    const int r32 = lane & 31, hi = lane >> 5, sr = tid >> 4, sc = (tid & 15) * 8;
    float* ws = (float*)(lds + O_WS) + wid * 64; float* li_l = ws; float* al_l = ws + 32;
    const int vb0 = (int)(uintptr_t)(lds + O_V) + v_rd_base(lane);
    f32x16 o[4] = {}; float m_reg = -1e30f, l_reg = 0.f;
    unsigned long long rem = tiles;
    int j = __builtin_ctzll(rem); rem &= rem - 1;
    __syncthreads();
    stage_write(S, lds, sr, sc, true);
    int jn = rem ? __builtin_ctzll(rem) : -1;
    if (jn >= 0) { rem &= rem - 1; stage_load(S, Kp, Vp, ld, jn * KVBLK, sr, sc, true); }
    int cur = 0;
    for (;;) {
        __syncthreads();
        int jnn = -1;
        if (jn >= 0) { stage_write(S, lds + (cur ^ 1) * BUF1, sr, sc, true); jnn = rem ? __builtin_ctzll(rem) : -1;
            if (jnn >= 0) { rem &= rem - 1; stage_load(S, Kp, Vp, ld, jnn * KVBLK, sr, sc, true); } }
        f32x16 p0, p1; float alpha; bf16x8 pa0, pa1, pa2, pa3;
        float cinit = 0.f;
        if (MODE == 1) cinit = ((mymask >> j) & 1ull) ? 0.f : -__builtin_inff();
        qkt(p0, p1, lds + cur * BUF1 + O_K, r32, hi, qr, cinit);
        if (MODE == 0) { const int tok0_ = t - r32; if (!(j * KVBLK + 63 <= tok0_ && j * KVBLK >= tok0_ - 480)) mask_tile(p0, p1, t - j * KVBLK - 4 * hi, 512u); }
        else if (j == qb) mask_tile(p0, p1, t - j * KVBLK - 4 * hi, 0x7fffffffu);
        partialSM(p0, p1, m_reg, alpha, c2);
        finishSM(p0, p1, alpha, l_reg, pa0, pa1, pa2, pa3);
        if (__any(alpha < 1.f)) { if (hi == 0) al_l[r32] = alpha; asm volatile("s_waitcnt lgkmcnt(0)" ::: "memory");
#pragma unroll
            for (int d_ = 0; d_ < 4; ++d_)
#pragma unroll
                for (int r = 0; r < 16; ++r) o[d_][r] *= al_l[crow(r, hi)]; }
        pv_tile(o, vb0 + cur * BUF1, pa0, pa1, pa2, pa3);
        if (jn < 0) break;
        j = jn; jn = jnn; cur ^= 1;
    }
    if (Sn) stage_load(*Sn, Kn, Vn, ld, 0, sr, sc, true);
    if (hi == 0) li_l[r32] = gate / l_reg; asm volatile("s_waitcnt lgkmcnt(0)" ::: "memory");
    emit<ACC>(o, li_l, OTw, r32, hi);
}

__device__ __forceinline__ void unit(Frame& F, char* lds, int b, int g, int tg) {
    const int tid = F.tid, lane = F.lane, wid = F.wave, r32 = lane & 31, hi = lane >> 5, sr = tid >> 4, sc = (tid & 15) * 8;
    const int head = g * 8 + wid, tok0 = tg * 32, t = tok0 + r32, qb = tg >> 1, bg = b * 4 + g;
    const bf16* KVQ = (const bf16*)(F.ws + WS_BIG); const float* GT = (const float*)(F.ws + WS_GT);
    const bf16* KC = (const bf16*)(F.ws + WS_KC) + (size_t)bg * 256 * 128; const bf16* VC = (const bf16*)(F.ws + WS_VC) + (size_t)bg * 256 * 128;
    const size_t rowq = (size_t)b * SEQ + t;
    float* ws = (float*)(lds + O_WS) + wid * 64; float* li_l = ws;
    unsigned* pb = (unsigned*)(lds + O_PB); unsigned* selm = (unsigned*)(lds + O_SELM);
    const int vb0 = (int)(uintptr_t)(lds + O_V) + v_rd_base(lane);
    bf16x8 qr[8]; float ss = 0.f;
#pragma unroll
    for (int d0 = 0; d0 < 8; ++d0) { qr[d0] = *(const bf16x8*)(KVQ + rowq * NKVQ + KVW + head * 128 + d0 * 16 + hi * 8);
        const v4u w = __builtin_bit_cast(v4u, qr[d0]);
        ss += (bf_lo(w.x) * bf_lo(w.x) + bf_hi(w.x) * bf_hi(w.x)) + (bf_lo(w.y) * bf_lo(w.y) + bf_hi(w.y) * bf_hi(w.y)) + (bf_lo(w.z) * bf_lo(w.z) + bf_hi(w.z) * bf_hi(w.z)) + (bf_lo(w.w) * bf_lo(w.w) + bf_hi(w.w) * bf_hi(w.w)); }
    { auto rr = __builtin_amdgcn_permlane32_swap(__float_as_uint(ss), __float_as_uint(ss), false, false); ss = __uint_as_float(rr[0]) + __uint_as_float(rr[1]); }
    const float c2 = 1.4426950408889634f / sqrtf(ss * (1.f / 128.f) + EPS);
    const float g_cmp = GT[rowq * 96 + head], g_sel = GT[rowq * 96 + 32 + head], g_win = GT[rowq * 96 + 64 + head];
    for (int i = tid; i < 32 * 65; i += NWAVES * 64) pb[i] = 0u;
    char* OTw = lds + O_OT + wid * 256;
    const int nct = (tg >> 5) + 1; const int cmax = (t - 31) >> 4;
    float m_c = -1e30f, l_c = 0.f;
    { Stage S;
      for (int kt = 0; kt < nct; ++kt) {
          stage_load(S, KC, VC, 128, kt * 64, sr, sc, false);
          __syncthreads(); stage_write(S, lds, sr, sc, false); __syncthreads();
          f32x16 p0, p1; qkt(p0, p1, lds + O_K, r32, hi, qr, 0.f);
          mask_tile(p0, p1, cmax - kt * 64 - 4 * hi, 0x7fffffffu);
          const float pmax = rowmax32(p0, p1), mn = fmaxf(m_c, pmax), al = __builtin_amdgcn_exp2f((m_c - mn) * c2), mnL = -mn * c2;
#pragma unroll
          for (int r = 0; r < 16; ++r) { p0[r] = __builtin_amdgcn_exp2f(fmaf(p0[r], c2, mnL)); p1[r] = __builtin_amdgcn_exp2f(fmaf(p1[r], c2, mnL)); }
          l_c = l_c * al + rowsum32(p0, p1); m_c = mn; }
      const float inv_l = l_c > 0.f ? 1.f / l_c : 0.f; const float mnL = -m_c * c2;
      f32x16 o[4] = {};
      for (int kt = 0; kt < nct; ++kt) {
          stage_load(S, KC, VC, 128, kt * 64, sr, sc, true);
          __syncthreads(); stage_write(S, lds, sr, sc, true); __syncthreads();
          f32x16 p0, p1; qkt(p0, p1, lds + O_K, r32, hi, qr, 0.f);
          mask_tile(p0, p1, cmax - kt * 64 - 4 * hi, 0x7fffffffu);
#pragma unroll
          for (int r = 0; r < 16; ++r) { p0[r] = __builtin_amdgcn_exp2f(fmaf(p0[r], c2, mnL)) * inv_l; p1[r] = __builtin_amdgcn_exp2f(fmaf(p1[r], c2, mnL)) * inv_l; }
#pragma unroll
          for (int rg = 0; rg < 4; ++rg) { const int j0 = 16 * kt + 2 * rg + hi;
              const float a0 = (p0[4 * rg] + p0[4 * rg + 1]) + (p0[4 * rg + 2] + 0.5f * p0[4 * rg + 3]), b0 = 0.5f * p0[4 * rg + 3];
              const float a1 = (p1[4 * rg] + p1[4 * rg + 1]) + (p1[4 * rg + 2] + 0.5f * p1[4 * rg + 3]), b1 = 0.5f * p1[4 * rg + 3];
              atomicAdd(&pb[r32 * 65 + j0], (unsigned)(a0 * 67108864.f + 0.5f)); atomicAdd(&pb[r32 * 65 + j0 + 1], (unsigned)(b0 * 67108864.f + 0.5f));
              atomicAdd(&pb[r32 * 65 + j0 + 8], (unsigned)(a1 * 67108864.f + 0.5f)); atomicAdd(&pb[r32 * 65 + j0 + 9], (unsigned)(b1 * 67108864.f + 0.5f)); }
          bf16x8 pa0, pa1, pa2, pa3; packP(p0, p1, pa0, pa1, pa2, pa3);
          pv_tile(o, vb0, pa0, pa1, pa2, pa3); }
      if (hi == 0) li_l[r32] = g_cmp; asm volatile("s_waitcnt lgkmcnt(0)" ::: "memory");
      emit<0>(o, li_l, OTw, r32, hi); }
    const int lowk_ = tok0 - 511, wj_lo = lowk_ > 0 ? lowk_ >> 6 : 0, wj_hi = ((tok0 + 31) >> 6) + 1;
    const unsigned long long wtiles = ((wj_hi >= 64) ? ~0ull : ((1ull << wj_hi) - 1ull)) & ~((1ull << wj_lo) - 1ull);
    const bf16* Kw = KVQ + (size_t)b * SEQ * NKVQ + 4 * 512 + g * 128; const bf16* Vw = KVQ + (size_t)b * SEQ * NKVQ + 5 * 512 + g * 128;
    Stage SW; stage_load(SW, Kw, Vw, NKVQ, wj_lo * KVBLK, sr, sc, true);
    __syncthreads();
#pragma unroll 1
    for (int tt = 0; tt < 4; ++tt) { const int tok = 4 * wid + tt; const bool valid = lane <= qb; const bool forced = lane == 0 || lane == qb;
        const unsigned key = forced ? 0xFFFFFFFFu : pb[tok * 65 + lane]; int rank = 0;
        for (int i = 0; i <= qb; ++i) { const unsigned ki = (unsigned)__builtin_amdgcn_readlane((int)key, i); rank += (ki > key || (ki == key && i < lane)) ? 1 : 0; }
        const unsigned long long mk = __ballot(valid && rank < 16);
        if (lane == 0) { selm[2 * tok] = (unsigned)mk; selm[2 * tok + 1] = (unsigned)(mk >> 32); } }
    __syncthreads();
    const unsigned long long mymask = (unsigned long long)selm[2 * r32] | ((unsigned long long)selm[2 * r32 + 1] << 32);
    unsigned ulo = (unsigned)mymask, uhi = (unsigned)(mymask >> 32);
#pragma unroll
    for (int o_ = 1; o_ < 32; o_ <<= 1) { ulo |= __shfl_xor(ulo, o_); uhi |= __shfl_xor(uhi, o_); }
    const unsigned long long uni = (unsigned long long)(unsigned)__builtin_amdgcn_readfirstlane((int)ulo) | ((unsigned long long)(unsigned)__builtin_amdgcn_readfirstlane((int)uhi) << 32);
    { const bf16* Ks = KVQ + (size_t)b * SEQ * NKVQ + 2 * 512 + g * 128; const bf16* Vs = KVQ + (size_t)b * SEQ * NKVQ + 3 * 512 + g * 128;
      Stage SS;
      flash_pass<0, 1>(lds, Kw, Vw, NKVQ, wtiles, t, qb, 0ull, qr, c2, g_win, OTw, SW, Ks, Vs, &SS, tid, wid, lane);
      flash_pass<1, 2>(lds, Ks, Vs, NKVQ, uni, t, qb, mymask, qr, c2, g_sel, OTw, SS, nullptr, nullptr, nullptr, tid, wid, lane); }
    __syncthreads();
    { const int tok = tid >> 4, ch = tid & 15;
      const char* src = lds + O_OT + tok * 2048 + ch * 128; unsigned char* dst = (unsigned char*)(F.ws + WS_A3) + ((size_t)b * SEQ + tok0 + tok) * DM + g * 1024 + ch * 64;
#pragma unroll
      for (int i = 0; i < 4; ++i) { const v4u w0 = *(const v4u*)(src + i * 32), w1 = *(const v4u*)(src + i * 32 + 16); v4u q; const unsigned ws_[8] = {w0.x, w0.y, w0.z, w0.w, w1.x, w1.y, w1.z, w1.w}; int qq[4];
#pragma unroll
          for (int e = 0; e < 4; ++e) { int t_ = __builtin_amdgcn_cvt_pk_fp8_f32(bf_lo(ws_[2 * e]) * 64.f, bf_hi(ws_[2 * e]) * 64.f, 0, false); qq[e] = __builtin_amdgcn_cvt_pk_fp8_f32(bf_lo(ws_[2 * e + 1]) * 64.f, bf_hi(ws_[2 * e + 1]) * 64.f, t_, true); }
          q.x = (unsigned)qq[0]; q.y = (unsigned)qq[1]; q.z = (unsigned)qq[2]; q.w = (unsigned)qq[3]; *(v4u*)(dst + i * 16) = q; } }
    __syncthreads();
}
#undef KSWZ
#undef SBAR
}
__device__ __forceinline__ void nsa_attn_phase(Frame& F) {
    for (int ui = blockIdx.x; ui < 1024; ui += F.G) { const int vw = ui & 255, rnd = ui >> 8, bg = vw & 7, s = vw >> 3;
        const int tg = rnd == 0 ? s : rnd == 1 ? 63 - s : rnd == 2 ? 64 + s : 127 - s;
        nsa::unit(F, (char*)(F.lds + RING_OFF), bg >> 2, bg & 3, tg); }
}

struct Args { const float* in[18]; float* out; unsigned char* ws; int ph_lo, ph_hi; };
__global__ void __launch_bounds__(NWAVES * 64, 2) skel_fwd(Args args) {
    extern __shared__ __attribute__((aligned(16))) unsigned char lds[];
    Frame F;
    F.lds = (LAS unsigned char*)lds;
    F.MISC = (volatile LAS unsigned*)(F.lds + MISC_OFF);
    F.tid = threadIdx.x; F.lane = F.tid & 63; F.wave = __builtin_amdgcn_readfirstlane(F.tid >> 6);
    F.G = gridDim.x;
    unsigned char* ws = args.ws; F.ws = ws; F.out = args.out;
#pragma unroll
    for (int i = 0; i < 18; ++i) F.in[i] = args.in[i];
    F.ctl = (gu32*)(ws + WS_CTL);
    for (int u = F.tid; u < (LDS_BYTES - LDSCTL_OFF) / 4; u += NWAVES * 64) ((LAS unsigned*)(F.lds + LDSCTL_OFF))[u] = 0u;
    __syncthreads();
    XcdBarrier bar; bar.bar = (unsigned*)(F.ctl + CW_BAR); bar.x = 0; bar.st = nullptr;
    if (!MK_PER_PHASE) bar = xcd_barrier_post((unsigned*)(F.ctl + CW_BAR), F.MISC + 8);
    const int lo = args.ph_lo, hi = args.ph_hi;
#ifndef PHASE_MASK
#define PHASE_MASK 0x1ffff
#endif
#define IN(k) (((PHASE_MASK >> (k)) & 1) && lo <= (k) && (k) < hi)
#ifndef DUP_MASK
#define DUP_MASK 0
#endif
#ifndef PROBE_ML
#define PROBE_ML 0
#endif
#ifndef PROBE2
#define PROBE2 0
#endif
#ifndef CW_TAIL
#define CW_TAIL 10240
#endif
#ifndef TS_ON
#define TS_ON 0
#define TS_LO 0
#define TS_HI 0
#endif
#define REP(k) for (int rep_ = 0, nrep_ = 1 + ((DUP_MASK >> (k)) & 1); rep_ < nrep_; ++rep_, (rep_ < nrep_ ? xcd_barrier(bar) : (void)0))
#define SEAM(k) do { if (IN(k) && (hi > (k) + 1)) xcd_barrier(bar); if (TS_ON && (k) == TS_HI) ts1 = __builtin_amdgcn_s_memrealtime(); } while (0)
    unsigned long long ts0 = 0, ts1 = 0;
    bf16* XB = (bf16*)(ws + WS_XB); bf16* A3 = (bf16*)(ws + WS_A3); bf16* BIG = (bf16*)(ws + WS_BIG);
    bf16* X1 = (bf16*)(ws + WS_X1); bf16* X2 = (bf16*)(ws + WS_X2); bf16* X3 = X1;

    if (TS_ON && 0 == TS_LO) ts0 = __builtin_amdgcn_s_memrealtime(); if (IN(0)) REP(0) { p0_prologue(F); } SEAM(0);
    if (TS_ON && 1 == TS_LO) ts0 = __builtin_amdgcn_s_memrealtime(); if (IN(1)) REP(1) {
        pg8::Gemm g{XB, (const bf16*)(ws + WS_WIN), MTOK, M_MAIN, DM}; pg8::StaticOrder S; S.init(MTOK, M_MAIN, F.G, (int)blockIdx.x);
        pg8::EpiBf16<0> E{BIG, M_MAIN, nullptr};
        pg8::gemm_phase<pg8::EpiBf16<0>, pg8::StaticOrder, true, true>(F.lds + RING_OFF, g, S, E);
        gates1_phase(F);
    } SEAM(1);
    if (TS_ON && 2 == TS_LO) ts0 = __builtin_amdgcn_s_memrealtime(); if (IN(2)) REP(2) {
        const int bid = (int)blockIdx.x;
        if (F.G == 256) {
            const int x = bid & 7, y = bid >> 3;
            if (x < 4) mlstm_phase(F, (x * 4 + (y >> 3)) * 8 + (y & 7), 128);
            else if (!(PROBE_ML && rep_)) { const int wk = (y * 4 + (x - 4)) * NWAVES + F.wave; convert_narrow(F, 64, 256, wk, 128 * NWAVES); if (Q8_STRIPS) convert_strips(F, (x - 4) * 32 + y, 128); convert_wide(F, CW_EARLY, CW_TOTAL, wk, 128 * NWAVES); }
        } else {
            mlstm_phase(F, bid, F.G); if (Q8_STRIPS) convert_strips(F, bid, F.G); convert_wide(F, CW_EARLY, CW_TOTAL, bid * NWAVES + F.wave, F.G * NWAVES); convert_narrow(F, 64, 256, bid * NWAVES + F.wave, F.G * NWAVES);
        }
    } SEAM(2);
#if PROBE2 == 1
    { xcd_barrier(bar); const int bid = (int)blockIdx.x, x = bid & 7, y = bid >> 3; if (x < 4) mlstm_phase(F, (x * 4 + (y >> 3)) * 8 + (y & 7), 128); xcd_barrier(bar); }
#elif PROBE2 == 2
    { xcd_barrier(bar); const int bid = (int)blockIdx.x, x = bid & 7, y = bid >> 3; if (x >= 4) { const int wk = (y * 4 + (x - 4)) * NWAVES + F.wave; convert_wide(F, CW_EARLY, CW_TOTAL, wk, 128 * NWAVES); } xcd_barrier(bar); }
#elif PROBE2 == 4
    { xcd_barrier(bar); const int bid = (int)blockIdx.x, x = bid & 7, y = bid >> 3;
      if (x < 4) mlstm_phase(F, (x * 4 + (y >> 3)) * 8 + (y & 7), 128);
      else { const int wk = (y * 4 + (x - 4)) * NWAVES + F.wave; convert_wide(F, CW_EARLY, CW_TOTAL, wk, 128 * NWAVES); }
      xcd_barrier(bar); }
#elif PROBE2 == 3
    { xcd_barrier(bar); convert_wide(F, CW_EARLY, CW_TOTAL, blockIdx.x * NWAVES + F.wave, F.G * NWAVES); xcd_barrier(bar); }
#endif
    if (TS_ON && 3 == TS_LO) ts0 = __builtin_amdgcn_s_memrealtime(); if (IN(3)) REP(3) { gating_phase(F);
        if (Q8_WMO && !Q8_STRIPS) wquant_phase(F, (const bf16*)(ws + WS_WMO), (const float*)(ws + CTL_CMAX) + 49152, (unsigned char*)(ws + WS_WMOQ), DM);
        if ((Q8_UP_MASK & 1) && !Q8_STRIPS) wquant_phase(F, (const bf16*)(ws + WS_WUP0), (const float*)(ws + CTL_CMAX), (unsigned char*)(ws + WS_WUPQ0), DFF);
        if ((Q8_UP_MASK & 2) && !Q8_STRIPS) wquant_phase(F, (const bf16*)(ws + WS_WUP1), (const float*)(ws + CTL_CMAX) + 16384, (unsigned char*)(ws + WS_WUPQ1), DFF);
        if (Q8_KVQ && !Q8_STRIPS) wquant_phase(F, (const bf16*)(ws + WS_WKVQ), (const float*)(ws + CTL_CMAX) + 32768, (unsigned char*)(ws + WS_WKVQ8), NKVQ);
        if (blockIdx.x == 0) { const float* pp = (const float*)(ws + WS_POSP); float* posb = (float*)(ws + WS_POSB);
            for (int i = F.tid; i < 1024; i += NWAVES * 64) { float a = 0.f;
#pragma unroll 8
                for (int ch = 0; ch < 32; ++ch) a += pp[ch * 1024 + i];
                posb[i] = a; } }
    } SEAM(3);
    if (TS_ON && 4 == TS_LO) ts0 = __builtin_amdgcn_s_memrealtime(); if (IN(4)) REP(4) {
        pg8::StaticOrder S; S.init(MTOK, DM, F.G, (int)blockIdx.x);
        if (Q8_WMO) { pg8::Gemm g{A3, (const bf16*)(ws + WS_WMOQ), MTOK, DM, DM};
            pg8::EpiRes<false, true, true> E{F.in[0], X1, (float*)(ws + WS_PART), DM, 1.f, nullptr, (const float*)(ws + WS_RS) + 24576, (const float*)(ws + CTL_CMAX) + 49152};
            pg8::gemm_phase<pg8::EpiRes<false, true, true>, pg8::StaticOrder, true, true, 2>(F.lds + RING_OFF, g, S, E); }
        else { pg8::Gemm g{A3, (const bf16*)(ws + WS_WMO), MTOK, DM, DM};
            pg8::EpiRes<false, true> E{F.in[0], X1, (float*)(ws + WS_PART), DM};
            pg8::gemm_phase<pg8::EpiRes<false, true>, pg8::StaticOrder, true, true>(F.lds + RING_OFF, g, S, E); }
    } SEAM(4);
    if (TS_ON && 5 == TS_LO) ts0 = __builtin_amdgcn_s_memrealtime(); if (IN(5)) REP(5) { if (Q8_UP_MASK & 1) rstd_phase(F, (float*)(ws + WS_RS), X1, (unsigned char*)(ws + WS_XQ), (float*)(ws + WS_RS) + 24576); else rstd_phase(F, (float*)(ws + WS_RS)); } SEAM(5);
    if (TS_ON && 6 == TS_LO) ts0 = __builtin_amdgcn_s_memrealtime(); if (IN(6)) REP(6) {
        pg8::StaticOrder S; S.init(MTOK, DFF, F.G, (int)blockIdx.x);
        if (Q8_UP_MASK & 1) { pg8::Gemm g{(const bf16*)(ws + WS_XQ), (const bf16*)(ws + WS_WUPQ0), MTOK, DFF, DM};
            pg8::EpiQ8<2> E{BIG, DFF, (const float*)(ws + CTL_CMAX), (const float*)(ws + WS_RS) + 24576};
            pg8::gemm_phase<pg8::EpiQ8<2>, pg8::StaticOrder, true, true, 2>(F.lds + RING_OFF, g, S, E); }
        else { pg8::Gemm g{X1, (const bf16*)(ws + WS_WUP0), MTOK, DFF, DM};
            pg8::EpiBf16<2, true> E{BIG, DFF, (const float*)(ws + WS_RS)};
            pg8::gemm_phase<pg8::EpiBf16<2, true>, pg8::StaticOrder, true, true>(F.lds + RING_OFF, g, S, E); }
    } SEAM(6);
    if (TS_ON && 7 == TS_LO) ts0 = __builtin_amdgcn_s_memrealtime(); if (IN(7)) REP(7) {
        pg8::Gemm g{BIG, (const bf16*)(ws + WS_WDN0), MTOK, DM, DFF}; pg8::StaticOrder S; S.init(MTOK, DM, F.G, (int)blockIdx.x);
        pg8::EpiRes<true, true> E{X1, X2, (float*)(ws + WS_PART), DM, 1.f, Q8_KVQ ? nullptr : (unsigned char*)(ws + WS_HR)};
        pg8::gemm_phase<pg8::EpiRes<true, true>, pg8::StaticOrder, true, true>(F.lds + RING_OFF, g, S, E);
    } SEAM(7);
    if (TS_ON && 8 == TS_LO) ts0 = __builtin_amdgcn_s_memrealtime(); if (IN(8)) REP(8) { if (Q8_KVQ) rstd_phase(F, (float*)(ws + WS_RS) + 8192, X2, (unsigned char*)(ws + WS_XQ), (float*)(ws + WS_RS) + 24576); else rstd_phase(F, (float*)(ws + WS_RS) + 8192); } SEAM(8);
    if (TS_ON && 9 == TS_LO) ts0 = __builtin_amdgcn_s_memrealtime(); if (IN(9)) REP(9) {
        pg8::StaticOrder S; S.init(MTOK, NKVQ, F.G, (int)blockIdx.x);
        if (Q8_KVQ) { pg8::Gemm g{(const bf16*)(ws + WS_XQ), (const bf16*)(ws + WS_WKVQ8), MTOK, NKVQ, DM};
            pg8::EpiQ8<0> E{BIG, NKVQ, (const float*)(ws + CTL_CMAX) + 32768, (const float*)(ws + WS_RS) + 24576};
            pg8::gemm_phase<pg8::EpiQ8<0>, pg8::StaticOrder, true, true, 2>(F.lds + RING_OFF, g, S, E); }
        else { pg8::Gemm g{(const bf16*)(ws + WS_HR), (const bf16*)(ws + WS_WKVQ), MTOK, NKVQ, DM};
            pg8::EpiBf16<0, true> E{BIG, NKVQ, (const float*)(ws + WS_RS) + 8192, 1.f / 256.f};
            pg8::gemm_phase<pg8::EpiBf16<0, true>, pg8::StaticOrder, true, true, 1>(F.lds + RING_OFF, g, S, E); }
        gates2_phase(F);
    } SEAM(9);
    if (TS_ON && 10 == TS_LO) ts0 = __builtin_amdgcn_s_memrealtime(); if (IN(10)) REP(10) { nsa_prep_phase(F); } SEAM(10);
    if (TS_ON && 11 == TS_LO) ts0 = __builtin_amdgcn_s_memrealtime();
    if (TS_ON && 12 == TS_LO) ts0 = __builtin_amdgcn_s_memrealtime(); if (IN(12)) REP(12) { nsa_attn_phase(F); } SEAM(12);
    if (TS_ON && 13 == TS_LO) ts0 = __builtin_amdgcn_s_memrealtime(); if (IN(13)) REP(13) {
        pg8::Gemm g{A3, (const bf16*)(ws + WS_WNO), MTOK, DM, DM}; pg8::StaticOrder S; S.init(MTOK, DM, F.G, (int)blockIdx.x);
        pg8::EpiRes<true, true> E{X2, X3, (float*)(ws + WS_PART), DM, 1.f / 16384.f};
        pg8::gemm_phase<pg8::EpiRes<true, true>, pg8::StaticOrder, true, true, 1>(F.lds + RING_OFF, g, S, E);
    } SEAM(13);
    if (TS_ON && 14 == TS_LO) ts0 = __builtin_amdgcn_s_memrealtime(); if (IN(14)) REP(14) { if (Q8_UP_MASK & 2) rstd_phase(F, (float*)(ws + WS_RS) + 16384, X3, (unsigned char*)(ws + WS_XQ), (float*)(ws + WS_RS) + 24576); else rstd_phase(F, (float*)(ws + WS_RS) + 16384); } SEAM(14);
    if (TS_ON && 15 == TS_LO) ts0 = __builtin_amdgcn_s_memrealtime(); if (IN(15)) REP(15) {
        pg8::StaticOrder S; S.init(MTOK, DFF, F.G, (int)blockIdx.x);
        if (Q8_UP_MASK & 2) { pg8::Gemm g{(const bf16*)(ws + WS_XQ), (const bf16*)(ws + WS_WUPQ1), MTOK, DFF, DM};
            pg8::EpiQ8<2> E{BIG, DFF, (const float*)(ws + CTL_CMAX) + 16384, (const float*)(ws + WS_RS) + 24576};
            pg8::gemm_phase<pg8::EpiQ8<2>, pg8::StaticOrder, true, true, 2>(F.lds + RING_OFF, g, S, E); }
        else { pg8::Gemm g{X3, (const bf16*)(ws + WS_WUP1), MTOK, DFF, DM};
            pg8::EpiBf16<2, true> E{BIG, DFF, (const float*)(ws + WS_RS) + 16384};
            pg8::gemm_phase<pg8::EpiBf16<2, true>, pg8::StaticOrder, true, true>(F.lds + RING_OFF, g, S, E); }
    } SEAM(15);
    if (TS_ON && 16 == TS_LO) ts0 = __builtin_amdgcn_s_memrealtime(); if (IN(16)) REP(16) {
        pg8::Gemm g{BIG, (const bf16*)(ws + WS_WDN1), MTOK, DM, DFF}; pg8::StaticOrder S; S.init(MTOK, DM, F.G, (int)blockIdx.x);
        pg8::EpiRes<true, false> E{X3, F.out, nullptr, DM};
        pg8::gemm_phase<pg8::EpiRes<true, false>, pg8::StaticOrder, true, true>(F.lds + RING_OFF, g, S, E);
    }
#if TS_ON
    if (TS_HI == 16) ts1 = __builtin_amdgcn_s_memrealtime();
    xcd_barrier(bar);
    if (blockIdx.x == 0 && F.tid == 0) F.out[0] = (float)(ts1 - ts0) * 0.01f;
#endif
#undef IN
#undef SEAM
}

extern "C" void kernel_launch(void* const* d_in, const int* in_sizes, int n_in, void* d_out, int out_size, void* d_ws, size_t ws_size, hipStream_t stream) {
    static int grid = 0;
    if (grid == 0) {
        if (n_in != 18 || in_sizes[0] != MTOK * DM || out_size != MTOK * DM || ws_size < WS_END) { fprintf(stderr, "kernel_launch: unexpected shapes (n_in %d, in0 %d, out %d, ws %zu); nothing launched\n", n_in, n_in > 0 ? in_sizes[0] : -1, out_size, ws_size); grid = -1; return; }
        int dev = 0, cus = 0, per_cu = 0;
        if (hipGetDevice(&dev) != hipSuccess || hipDeviceGetAttribute(&cus, hipDeviceAttributeMultiprocessorCount, dev) != hipSuccess) { grid = -1; return; }
        if (hipFuncSetAttribute((const void*)skel_fwd, hipFuncAttributeMaxDynamicSharedMemorySize, LDS_BYTES) != hipSuccess) { fprintf(stderr, "kernel_launch: hipFuncSetAttribute failed\n"); grid = -1; return; }
        if (hipOccupancyMaxActiveBlocksPerMultiprocessor(&per_cu, (const void*)skel_fwd, NWAVES * 64, LDS_BYTES) != hipSuccess || per_cu < 1) fprintf(stderr, "kernel_launch: occupancy query reports %d\n", per_cu);
        (void)hipGetLastError();
        grid = cus;
    }
    if (grid < 0) return;
    if (hipMemsetAsync((char*)d_ws + WS_CTL, 0, CTL_ZERO_BYTES, stream) != hipSuccess) return;
    Args a{};
    for (int i = 0; i < 18; ++i) a.in[i] = (const float*)d_in[i];
    a.out = (float*)d_out; a.ws = (unsigned char*)d_ws;
#if MK_PER_PHASE
    for (int p = 0; p < N_PHASES; ++p) { a.ph_lo = p; a.ph_hi = p + 1; hipLaunchKernelGGL(skel_fwd, dim3(grid), dim3(NWAVES * 64), LDS_BYTES, stream, a); }
#else
    a.ph_lo = 0; a.ph_hi = N_PHASES; hipLaunchKernelGGL(skel_fwd, dim3(grid), dim3(NWAVES * 64), LDS_BYTES, stream, a);
#endif
}
```

```cpp
#include <hip/hip_runtime.h>
#include <hip/hip_bf16.h>
#include <cstdio>
#include <cstdint>
#include <cmath>
namespace pg8 {
#define PG8_LAS __attribute__((address_space(3)))
typedef unsigned short bf16_t;
typedef short bf16x8 __attribute__((ext_vector_type(8)));
typedef float f32x4 __attribute__((ext_vector_type(4)));
typedef unsigned u32x4 __attribute__((ext_vector_type(4)));
typedef int v8i32_t __attribute__((ext_vector_type(8)));
typedef int v4i32_t __attribute__((ext_vector_type(4)));
constexpr int BM = 256, BK = 64, HALF = 128, HTB = HALF * BK * 2  , STAGE_BYTES = 8 * HTB, NXCD = 8, WGM = 8;

__host__ __device__ __forceinline__ int lds_byte(int r, int c) { const int st = (r >> 4) * 2 + (c >> 5), rr = r & 15, cc = c & 31, ob = rr * 64 + cc * 2; return st * 1024 + (ob ^ (((ob >> 9) & 1) << 5)); }
__host__ __device__ __forceinline__ void stage_rc(int b, int& R, int& C) { const int st = b / 1024, sb = b % 1024, swz = sb ^ (((sb >> 9) & 1) << 5); R = (st >> 1) * 16 + swz / 64; C = (st & 1) * 32 + (swz % 64) / 2; }
__host__ __device__ __forceinline__ int perm32(int rho) { const int n = rho >> 4, i = rho & 15; return 8 * (i >> 2) + 4 * n + (i & 3); }

struct Unit { int pm, pn; };
struct Gemm { const bf16_t* A; const bf16_t* Bt; int M, N, K; };

struct StaticOrder {
    int nM, nN, nwg, G, c;
    __host__ __device__ void init(int M, int N, int G_, int c_) { nM = M / BM; nN = N / BM; nwg = nM * nN; G = G_; c = c_; }
    __host__ __device__ bool next(int i, Unit& u) const {
        const long L = (long)i * G + c; if (L >= nwg) return false;
        int wgid = (int)L; { const int q = nwg / NXCD, r = nwg % NXCD, xcd = wgid % NXCD, off = wgid / NXCD; wgid = (xcd < r ? xcd * (q + 1) : r * (q + 1) + (xcd - r) * q) + off; }
        const int nig = WGM * nN, gid = wgid / nig, fm = gid * WGM, gsz = (nM - fm) < WGM ? (nM - fm) : WGM;
        u.pm = fm + ((wgid % nig) % gsz); u.pn = (wgid % nig) / gsz; return true;
    }
    __device__ __forceinline__ void a_ready(const Unit&) const {}
    __device__ __forceinline__ void done(const Unit&) const {}
};

typedef float f32x2c __attribute__((ext_vector_type(2))); typedef __bf16 bf16x2c __attribute__((ext_vector_type(2)));
__device__ __forceinline__ unsigned cvt_pk_bf16(float lo, float hi) { f32x2c v = {lo, hi}; bf16x2c b = __builtin_convertvector(v, bf16x2c); return __builtin_bit_cast(unsigned, b); }
template <int ACT  , bool SCALED = false> struct EpiBf16 {
    static constexpr bool PERM = true, AFTER_DRAIN = false;
    bf16_t* O; int ldc; const float* rstd; float osc = 1.f;
    __device__ __forceinline__ void operator()(const f32x4 (&acc)[2][2][4][2], const Unit& u, int wr, int wc, int fr, int fq) const {
        const int row0 = u.pm * BM + wr * 64 + fr, col0 = u.pn * BM + wc * 32 + 8 * fq;
#pragma unroll
        for (int ai = 0; ai < 2; ++ai)
#pragma unroll
            for (int m = 0; m < 4; ++m) { const int row = row0 + ai * HALF + m * 16; bf16_t* rowp = O + (size_t)row * ldc + col0;
                const float rs = (SCALED ? rstd[row] : 1.f) * osc;
#pragma unroll
                for (int bj = 0; bj < 2; ++bj) { f32x4 v0 = acc[ai][bj][m][0], v1 = acc[ai][bj][m][1];
                    v0 = v0 * rs; v1 = v1 * rs;
                    if (ACT == 2) {
#pragma unroll
                        for (int e = 0; e < 4; ++e) { const float a = fmaxf(v0[e], 0.f), b = fmaxf(v1[e], 0.f); v0[e] = a * a; v1[e] = b * b; } }
                    u32x4 w; w.x = cvt_pk_bf16(v0[0], v0[1]); w.y = cvt_pk_bf16(v0[2], v0[3]); w.z = cvt_pk_bf16(v1[0], v1[1]); w.w = cvt_pk_bf16(v1[2], v1[3]);
                    *(u32x4*)(rowp + bj * HALF) = w; } }
    }
};
template <bool BASE_BF16, bool OUT_BF16, bool Q8 = false> struct EpiRes {
    static constexpr bool PERM = true, AFTER_DRAIN = false;
    const void* base; void* out; float* part; int ldc; float osc = 1.f; unsigned char* o8 = nullptr; const float* ra = nullptr; const float* cmax = nullptr;
    __device__ __forceinline__ void operator()(const f32x4 (&acc)[2][2][4][2], const Unit& u, int wr, int wc, int fr, int fq) const {
        const int col0 = u.pn * BM + wc * 32 + 8 * fq;
        f32x4 cs[2][2];
        if (Q8) {
#pragma unroll
            for (int bj = 0; bj < 2; ++bj) { cs[bj][0] = *(const f32x4*)(cmax + col0 + bj * HALF) * (1.f / 127.f); cs[bj][1] = *(const f32x4*)(cmax + col0 + bj * HALF + 4) * (1.f / 127.f); } }
#pragma unroll
        for (int ai = 0; ai < 2; ++ai)
#pragma unroll
            for (int m = 0; m < 4; ++m) { const int row = u.pm * BM + ai * HALF + wr * 64 + m * 16 + fr; const size_t off = (size_t)row * ldc + col0; float s = 0.f; float rr = 0.f; if (Q8) rr = ra[row];
#pragma unroll
                for (int bj = 0; bj < 2; ++bj) { f32x4 b0, b1;
                    if (BASE_BF16) { const u32x4 w = *(const u32x4*)((const bf16_t*)base + off + bj * HALF);
                        b0 = (f32x4){__uint_as_float(w.x << 16), __uint_as_float(w.x & 0xffff0000u), __uint_as_float(w.y << 16), __uint_as_float(w.y & 0xffff0000u)};
                        b1 = (f32x4){__uint_as_float(w.z << 16), __uint_as_float(w.z & 0xffff0000u), __uint_as_float(w.w << 16), __uint_as_float(w.w & 0xffff0000u)}; }
                    else { b0 = *(const f32x4*)((const float*)base + off + bj * HALF); b1 = *(const f32x4*)((const float*)base + off + bj * HALF + 4); }
                    f32x4 o0, o1;
                    if (Q8) { const v4i32_t i0 = __builtin_bit_cast(v4i32_t, acc[ai][bj][m][0]), i1 = __builtin_bit_cast(v4i32_t, acc[ai][bj][m][1]);
#pragma unroll
                        for (int e = 0; e < 4; ++e) { o0[e] = b0[e] + (float)i0[e] * rr * cs[bj][0][e]; o1[e] = b1[e] + (float)i1[e] * rr * cs[bj][1][e]; } }
                    else { o0 = b0 + acc[ai][bj][m][0] * osc; o1 = b1 + acc[ai][bj][m][1] * osc; }
                    if (o8) { typedef int i32x2 __attribute__((ext_vector_type(2))); i32x2 q; q.x = __builtin_amdgcn_cvt_pk_fp8_f32(o0[0], o0[1], 0, false); q.x = __builtin_amdgcn_cvt_pk_fp8_f32(o0[2], o0[3], q.x, true);
                        q.y = __builtin_amdgcn_cvt_pk_fp8_f32(o1[0], o1[1], 0, false); q.y = __builtin_amdgcn_cvt_pk_fp8_f32(o1[2], o1[3], q.y, true); *(i32x2*)(o8 + off + bj * HALF) = q; }
                    s += ((o0[0] * o0[0] + o0[1] * o0[1]) + (o0[2] * o0[2] + o0[3] * o0[3])) + ((o1[0] * o1[0] + o1[1] * o1[1]) + (o1[2] * o1[2] + o1[3] * o1[3]));
                    if (OUT_BF16) { u32x4 w; w.x = cvt_pk_bf16(o0[0], o0[1]); w.y = cvt_pk_bf16(o0[2], o0[3]); w.z = cvt_pk_bf16(o1[0], o1[1]); w.w = cvt_pk_bf16(o1[2], o1[3]); *(u32x4*)((bf16_t*)out + off + bj * HALF) = w; }
                    else { *(f32x4*)((float*)out + off + bj * HALF) = o0; *(f32x4*)((float*)out + off + bj * HALF + 4) = o1; } }
                if (part) { s += __shfl_xor(s, 16); s += __shfl_xor(s, 32); if (fq == 0) part[(size_t)row * 64 + u.pn * 4 + wc] = s; } }
    }
};
template <int ACT> struct EpiQ8 {
    static constexpr bool PERM = true, AFTER_DRAIN = false;
    bf16_t* O; int ldc; const float* cmax; const float* ra;
    __device__ __forceinline__ void operator()(const f32x4 (&acc)[2][2][4][2], const Unit& u, int wr, int wc, int fr, int fq) const {
        const int row0 = u.pm * BM + wr * 64 + fr, col0 = u.pn * BM + wc * 32 + 8 * fq;
        f32x4 cs[2][2];
#pragma unroll
        for (int bj = 0; bj < 2; ++bj) { cs[bj][0] = *(const f32x4*)(cmax + col0 + bj * HALF) * (1.f / 127.f); cs[bj][1] = *(const f32x4*)(cmax + col0 + bj * HALF + 4) * (1.f / 127.f); }
#pragma unroll
        for (int ai = 0; ai < 2; ++ai)
#pragma unroll
            for (int m = 0; m < 4; ++m) { const int row = row0 + ai * HALF + m * 16; bf16_t* rowp = O + (size_t)row * ldc + col0; const float rr = ra[row];
#pragma unroll
                for (int bj = 0; bj < 2; ++bj) { const v4i32_t i0 = __builtin_bit_cast(v4i32_t, acc[ai][bj][m][0]), i1 = __builtin_bit_cast(v4i32_t, acc[ai][bj][m][1]); f32x4 v0, v1;
#pragma unroll
                    for (int e = 0; e < 4; ++e) { float a = (float)i0[e] * rr * cs[bj][0][e], b = (float)i1[e] * rr * cs[bj][1][e]; if (ACT == 2) { a = fmaxf(a, 0.f); b = fmaxf(b, 0.f); a *= a; b *= b; } v0[e] = a; v1[e] = b; }
                    u32x4 w; w.x = cvt_pk_bf16(v0[0], v0[1]); w.y = cvt_pk_bf16(v0[2], v0[3]); w.z = cvt_pk_bf16(v1[0], v1[1]); w.w = cvt_pk_bf16(v1[2], v1[3]);
                    *(u32x4*)(rowp + bj * HALF) = w; } }
    }
};
template <class Epi, class Sched, bool ALIGN_EPI = false, bool SP2 = false, int QM = 0>
__device__ __forceinline__ void gemm_phase(PG8_LAS unsigned char* lds, const Gemm g, const Sched& S, const Epi& E) {
    const int tid = threadIdx.x, wid = __builtin_amdgcn_readfirstlane(tid >> 6), lane = tid & 63, wr = wid >> 2, wc = wid & 3, fr = lane & 15, fq = lane >> 4;
    constexpr bool F8 = QM == 1, I8 = QM == 2;
    constexpr int ES = QM ? 1 : 2;
    const int K = g.K, nt = K / (QM ? 2 * BK : BK);
    unsigned voffA[2], voffB[2];
#pragma unroll
    for (int i = 0; i < 2; ++i) { int R, C; stage_rc(tid * 16 + i * 8192, R, C); const int Rb = Epi::PERM ? ((R & ~31) + perm32(R & 31)) : R;
        voffA[i] = (unsigned)(R * K * ES + C * 2); voffB[i] = (unsigned)(Rb * K * ES + C * 2); }
    const size_t kstep = (size_t)(BK * 2);
    const size_t hstep = (size_t)HALF * K * ES;
    const size_t tstep = 2 * hstep;
    const unsigned ldsw = (unsigned)wid * 1024u;
    const int aoff = lds_byte(wr * 64 + fr, F8 ? fq * 16 : fq * 8), boff = lds_byte(wc * 32 + fr, F8 ? fq * 16 : fq * 8);
#define PG8_SA(b, h) (((b) * 2 + (h)) * HTB)
#define PG8_SB(b, h) ((4 + (b) * 2 + (h)) * HTB)
#define PG8_STAGE(bufoff, gbase, voff) do { _Pragma("unroll") for (int _i = 0; _i < 2; ++_i) \
        __builtin_amdgcn_global_load_lds((const unsigned*)((const char*)(gbase) + (voff)[_i]), (PG8_LAS unsigned*)(lds + (bufoff) + ldsw + _i * 8192), 16, 0, 0); } while (0)
#define PG8_LDA(dst, b, h) do { if constexpr (F8) { _Pragma("unroll") for (int m = 0; m < 4; ++m) dst##8[m] = *(const PG8_LAS v8i32_t*)(lds + PG8_SA(b, h) + aoff + m * 2048); } \
        else { _Pragma("unroll") for (int m = 0; m < 4; ++m) _Pragma("unroll") for (int k = 0; k < 2; ++k) dst[m][k] = *(const PG8_LAS bf16x8*)(lds + PG8_SA(b, h) + aoff + m * 2048 + k * 1024); } } while (0)
#define PG8_LDB(dst, b, h) do { if constexpr (F8) { _Pragma("unroll") for (int n = 0; n < 2; ++n) dst##8[n] = *(const PG8_LAS v8i32_t*)(lds + PG8_SB(b, h) + boff + n * 2048); } \
        else { _Pragma("unroll") for (int n = 0; n < 2; ++n) _Pragma("unroll") for (int k = 0; k < 2; ++k) dst[n][k] = *(const PG8_LAS bf16x8*)(lds + PG8_SB(b, h) + boff + n * 2048 + k * 1024); } } while (0)
#define PG8_MMA(ai, bj, At, Bt) do { __builtin_amdgcn_s_setprio(1); _Pragma("unroll") for (int m = 0; m < 4; ++m) _Pragma("unroll") for (int n = 0; n < 2; ++n) { \
        if constexpr (F8) asm volatile("v_mfma_scale_f32_16x16x128_f8f6f4 %0, %1, %2, %0, %3, %3 op_sel_hi:[0,0,0]" : "+v"(acc[ai][bj][m][n]) : "v"(Bt##8[n]), "v"(At##8[m]), "v"(scl8));   \
        else if constexpr (I8) { _Pragma("unroll") for (int k = 0; k < 2; ++k) acc[ai][bj][m][n] = __builtin_bit_cast(f32x4, __builtin_amdgcn_mfma_i32_16x16x64_i8(__builtin_bit_cast(v4i32_t, Bt[n][k]), __builtin_bit_cast(v4i32_t, At[m][k]), __builtin_bit_cast(v4i32_t, acc[ai][bj][m][n]), 0, 0, 0)); } \
        else { _Pragma("unroll") for (int k = 0; k < 2; ++k) acc[ai][bj][m][n] = __builtin_amdgcn_mfma_f32_16x16x32_bf16(Bt[n][k], At[m][k], acc[ai][bj][m][n], 0, 0, 0); } } \
        __builtin_amdgcn_s_setprio(0); } while (0)
#define PG8_WAIT_V(n) asm volatile("s_waitcnt vmcnt(" #n ")" ::: "memory")
#define PG8_WAIT_L(n) asm volatile("s_waitcnt lgkmcnt(" #n ")" ::: "memory")
#define PG8_BAR __builtin_amdgcn_s_barrier()
#define PG8_SCHED __builtin_amdgcn_sched_barrier(0)
    Unit cur, nxt; int ui = 0;
    if (!S.next(0, cur)) return;
    f32x4 acc[2][2][4][2];
#pragma unroll
    for (int a = 0; a < 2; ++a)
#pragma unroll
        for (int b = 0; b < 2; ++b)
#pragma unroll
            for (int m = 0; m < 4; ++m)
#pragma unroll
                for (int n = 0; n < 2; ++n) acc[a][b][m][n] = (f32x4){0.f, 0.f, 0.f, 0.f};
    bf16x8 At[4][2], B0[2][2], B1[2][2]; v8i32_t At8[4], B08[2], B18[2];
    int scl8 = 0x7F7F7F7F; asm volatile("" : "+v"(scl8));
    const char* cA = (const char*)g.A + (size_t)cur.pm * tstep; const char* cB = (const char*)g.Bt + (size_t)cur.pn * tstep;
    S.a_ready(cur);
    if constexpr (SP2) {
        PG8_STAGE(PG8_SB(0, 0), cB, voffB); PG8_STAGE(PG8_SB(0, 1), cB + hstep, voffB); PG8_STAGE(PG8_SA(0, 0), cA, voffA); PG8_STAGE(PG8_SA(0, 1), cA + hstep, voffA);
        if (wr == 1) PG8_BAR;
        PG8_WAIT_V(2); PG8_BAR;
        PG8_STAGE(PG8_SB(1, 0), cB + kstep, voffB); PG8_STAGE(PG8_SA(1, 0), cA + kstep, voffA); PG8_STAGE(PG8_SB(1, 1), cB + hstep + kstep, voffB);
        PG8_WAIT_V(6); PG8_BAR;
    } else {
        PG8_STAGE(PG8_SB(0, 0), cB, voffB); PG8_STAGE(PG8_SA(0, 0), cA, voffA); PG8_STAGE(PG8_SB(0, 1), cB + hstep, voffB); PG8_STAGE(PG8_SA(0, 1), cA + hstep, voffA);
        if (wr == 1) PG8_BAR;
        PG8_WAIT_V(4); PG8_BAR;
        PG8_STAGE(PG8_SB(1, 0), cB + kstep, voffB); PG8_STAGE(PG8_SA(1, 0), cA + kstep, voffA); PG8_STAGE(PG8_SB(1, 1), cB + hstep + kstep, voffB);
        PG8_WAIT_V(6); PG8_BAR;
    }
    for (;;) {
        const bool has_next = S.next(ui + 1, nxt);
        const char* nA = has_next ? (const char*)g.A + (size_t)nxt.pm * tstep : cA; const char* nB = has_next ? (const char*)g.Bt + (size_t)nxt.pn * tstep : cB;
        for (int t = 0; t < nt; t += 2) {
            const bool last = (t == nt - 2);
            const char* a1 = cA + (size_t)(t + 1) * kstep;
            const char* a2 = last ? nA : cA + (size_t)(t + 2) * kstep; const char* b2 = last ? nB : cB + (size_t)(t + 2) * kstep;
            const char* a3 = a2 + kstep; const char* b3 = b2 + kstep;
            if (last && has_next) S.a_ready(nxt);
            if constexpr (SP2) {
            PG8_LDB(B0, 0, 0); PG8_LDB(B1, 0, 1); PG8_SCHED; PG8_LDA(At, 0, 0); PG8_STAGE(PG8_SA(1, 1), a1 + hstep, voffA);
            PG8_WAIT_V(8); PG8_WAIT_L(0); PG8_BAR; PG8_MMA(0, 0, At, B0); PG8_MMA(0, 1, At, B1); PG8_BAR; PG8_SCHED;
            PG8_LDA(At, 0, 1); PG8_STAGE(PG8_SB(0, 0), b2, voffB); PG8_STAGE(PG8_SB(0, 1), b2 + hstep, voffB); PG8_STAGE(PG8_SA(0, 0), a2, voffA);
            PG8_WAIT_V(8); PG8_WAIT_L(0); PG8_BAR; PG8_MMA(1, 0, At, B0); PG8_MMA(1, 1, At, B1); PG8_BAR; PG8_SCHED;
            PG8_LDB(B0, 1, 0); PG8_LDB(B1, 1, 1); PG8_SCHED; PG8_LDA(At, 1, 0); PG8_STAGE(PG8_SA(0, 1), a2 + hstep, voffA);
            PG8_WAIT_V(8); PG8_WAIT_L(0); PG8_BAR; PG8_MMA(0, 0, At, B0); PG8_MMA(0, 1, At, B1); PG8_BAR; PG8_SCHED;
            PG8_LDA(At, 1, 1); PG8_STAGE(PG8_SB(1, 0), b3, voffB); PG8_STAGE(PG8_SB(1, 1), b3 + hstep, voffB); PG8_STAGE(PG8_SA(1, 0), a3, voffA);
            PG8_WAIT_V(8); PG8_WAIT_L(0); PG8_BAR; PG8_MMA(1, 0, At, B0); PG8_MMA(1, 1, At, B1); PG8_BAR; PG8_SCHED;
            } else {
            PG8_LDB(B0, 0, 0); PG8_SCHED; PG8_LDA(At, 0, 0); PG8_STAGE(PG8_SA(1, 1), a1 + hstep, voffA);
            PG8_WAIT_L(8); PG8_BAR; PG8_WAIT_L(0); PG8_MMA(0, 0, At, B0); PG8_BAR; PG8_SCHED;
            PG8_LDB(B1, 0, 1); PG8_STAGE(PG8_SB(0, 0), b2, voffB);
            PG8_BAR; PG8_WAIT_L(0); PG8_MMA(0, 1, At, B1); PG8_BAR;
            PG8_LDA(At, 0, 1); PG8_STAGE(PG8_SA(0, 0), a2, voffA);
            PG8_BAR; PG8_WAIT_L(0); PG8_MMA(1, 0, At, B0); PG8_BAR; PG8_SCHED;
            PG8_STAGE(PG8_SB(0, 1), b2 + hstep, voffB);
            PG8_WAIT_V(6); PG8_BAR; PG8_MMA(1, 1, At, B1); PG8_BAR;
            PG8_LDB(B0, 1, 0); PG8_SCHED; PG8_LDA(At, 1, 0); PG8_STAGE(PG8_SA(0, 1), a2 + hstep, voffA);
            PG8_WAIT_L(8); PG8_BAR; PG8_WAIT_L(0); PG8_MMA(0, 0, At, B0); PG8_BAR; PG8_SCHED;
            PG8_LDB(B1, 1, 1); PG8_STAGE(PG8_SB(1, 0), b3, voffB);
            PG8_BAR; PG8_WAIT_L(0); PG8_MMA(0, 1, At, B1); PG8_BAR;
            PG8_LDA(At, 1, 1); PG8_STAGE(PG8_SA(1, 0), a3, voffA);
            PG8_BAR; PG8_WAIT_L(0); PG8_MMA(1, 0, At, B0); PG8_BAR; PG8_SCHED;
            PG8_STAGE(PG8_SB(1, 1), b3 + hstep, voffB);
            PG8_WAIT_V(6); PG8_BAR; PG8_MMA(1, 1, At, B1); PG8_BAR;
            }
        }
        if constexpr (F8) { asm volatile("s_nop 15\n\ts_nop 15" ::: "memory"); PG8_SCHED; }
        if constexpr (ALIGN_EPI) { if (wr == 0) PG8_BAR; }
        if constexpr (!Epi::AFTER_DRAIN) { E(acc, cur, wr, wc, fr, fq); S.done(cur); }
        if (!has_next) break;
#pragma unroll
        for (int a = 0; a < 2; ++a)
#pragma unroll
            for (int b = 0; b < 2; ++b)
#pragma unroll
                for (int m = 0; m < 4; ++m)
#pragma unroll
                    for (int n = 0; n < 2; ++n) acc[a][b][m][n] = (f32x4){0.f, 0.f, 0.f, 0.f};
        cur = nxt; cA = nA; cB = nB; ++ui;
        if constexpr (ALIGN_EPI) { if (wr == 1) PG8_BAR; }
    }
    PG8_WAIT_V(0);
    if constexpr (!ALIGN_EPI) { if (wr == 0) PG8_BAR; }
    PG8_BAR;
    if constexpr (Epi::AFTER_DRAIN) { E.fused(acc, cur, wr, wc, fr, fq, lds, wid, lane); S.done(cur); }
#undef PG8_SA
#undef PG8_SB
#undef PG8_STAGE
#undef PG8_LDA
#undef PG8_LDB
#undef PG8_MMA
#undef PG8_WAIT_V
#undef PG8_WAIT_L
#undef PG8_BAR
#undef PG8_SCHED
}
}
#define GAS __attribute__((address_space(1)))
#define LAS __attribute__((address_space(3)))
typedef unsigned short bf16;
typedef unsigned v4u __attribute__((ext_vector_type(4)));
typedef float f32x4 __attribute__((ext_vector_type(4)));
typedef short bf16x8 __attribute__((ext_vector_type(8)));
typedef GAS unsigned gu32;
typedef GAS unsigned long long gu64;
#define RLX_AGENT __ATOMIC_RELAXED, __HIP_MEMORY_SCOPE_AGENT
#define LDS_WAIT() asm volatile("s_waitcnt lgkmcnt(0)" ::: "memory")
#define VM_WAIT() asm volatile("s_waitcnt vmcnt(0)" ::: "memory")
__device__ __forceinline__ unsigned long long rt() { return __builtin_amdgcn_s_memrealtime(); }

#define XB_TMO      128
#define XB_XCNT(j)  (256  + 64 * (j))
#define XB_XSUB(j)  (1280 + 64 * (j))
#define XB_XGEN(j)  (2304 + 64 * (j))
#define XB_TOP      3328
#define XB_TOPGEN   3392
#define XCD_BAR_WORDS 3456
#define XB_SPIN_CAP (1u << 18)

__device__ __forceinline__ unsigned xb_ld(unsigned* p)              { return __hip_atomic_load(p, __ATOMIC_RELAXED, __HIP_MEMORY_SCOPE_AGENT); }
__device__ __forceinline__ unsigned xb_add(unsigned* p, unsigned v) { return __hip_atomic_fetch_add(p, v, __ATOMIC_RELAXED, __HIP_MEMORY_SCOPE_AGENT); }
__device__ __forceinline__ unsigned xb_xcc_id() { return (unsigned)__builtin_amdgcn_s_getreg((3 << 11) | 20) & 0xFu; }
#define XB_SPIN(cond, bar) do { unsigned _sp = 0; while (cond) { __builtin_amdgcn_s_sleep(1); \
    if ((++_sp & 255u) == 0u) { if (xb_ld(&(bar)[XB_TMO])) break; if (_sp > XB_SPIN_CAP) { atomicAdd(&(bar)[XB_TMO], 1u); break; } } } } while (0)

struct XcdBarrier {
    unsigned* bar; unsigned x;
    volatile LAS unsigned* st;
};

__device__ __forceinline__ XcdBarrier xcd_barrier_post(unsigned* bar, volatile LAS unsigned* st) {
    XcdBarrier b; b.bar = bar; b.x = xb_xcc_id(); b.st = st;
    if (threadIdx.x == 0) (void)xb_add(&bar[XB_XCNT(b.x)], 1u);
    return b;
}
__device__ __forceinline__ void xcd_barrier_complete(unsigned* bar, unsigned x, unsigned& nloc, unsigned& nx) {
    const unsigned G = gridDim.x * gridDim.y * gridDim.z;
    unsigned sum, cnt, mine, sp = 0u;
    for (;;) {
        sum = 0u; cnt = 0u; mine = 0u;
#pragma unroll
        for (unsigned j = 0; j < 16; ++j) { const unsigned c = xb_ld(&bar[XB_XCNT(j)]); sum += c; cnt += (c > 0u) ? 1u : 0u; mine = (j == x) ? c : mine; }
        if (sum == G) break;
        __builtin_amdgcn_s_sleep(1);
        if ((++sp & 255u) == 0u) { if (xb_ld(&bar[XB_TMO])) break; if (sp > XB_SPIN_CAP) { atomicAdd(&bar[XB_TMO], 1u); break; } }
    }
    nloc = mine > 0u ? mine : 1u; nx = cnt > 0u ? cnt : 1u;
}

__device__ __forceinline__ void xcd_barrier(const XcdBarrier& b) {
    asm volatile("s_waitcnt vmcnt(0)" ::: "memory");
    __syncthreads();
    if (threadIdx.x == 0) {
        unsigned* bar = b.bar;
        __builtin_amdgcn_s_waitcnt(0);
        unsigned nloc = b.st[0], nx = b.st[1];
        if (nloc == 0u) { xcd_barrier_complete(bar, b.x, nloc, nx); b.st[0] = nloc; b.st[1] = nx; }
        const unsigned old = xb_add(&bar[XB_XSUB(b.x)], 1u);
        const unsigned gen = old / nloc;
        if (old + 1u == (gen + 1u) * nloc) {
            __builtin_amdgcn_fence(__ATOMIC_RELEASE, "agent");
            asm volatile("s_waitcnt vmcnt(0)" ::: "memory");
            const unsigned og = xb_add(&bar[XB_TOP], 1u);
            const unsigned tg = og / nx;
            if (og + 1u == (tg + 1u) * nx) xb_add(&bar[XB_TOPGEN], 1u);
            else XB_SPIN(xb_ld(&bar[XB_TOPGEN]) == tg, bar);
            __builtin_amdgcn_fence(__ATOMIC_ACQUIRE, "agent");
            xb_add(&bar[XB_XGEN(b.x)], 1u);
            asm volatile("s_waitcnt vmcnt(0)" ::: "memory");
        } else {
            XB_SPIN(xb_ld(&bar[XB_XGEN(b.x)]) == gen, bar);
            __builtin_amdgcn_fence(__ATOMIC_ACQUIRE, "agent");
            asm volatile("s_waitcnt vmcnt(0)" ::: "memory");
        }
    }
    __syncthreads();
}

constexpr int NWAVES = 8;
#ifndef MK_PER_PHASE
#define MK_PER_PHASE 0
#endif
constexpr int N_PHASES = 17;
constexpr int BATCH = 2, SEQ = 4096, DM = 4096, MTOK = BATCH * SEQ, DFF = 16384;
constexpr int MH = 8, MDK = 256, MDV = 512, M_MAIN = 12288, M_IN = 12304;
constexpr int NKVQ = 7168, NQG = 4192, KVW = 3072;
constexpr float EPS = 1e-6f;
#ifndef Q8_UP_MASK
#define Q8_STRIPS 1
#define Q8_WIN_O 1
#define Q8_KVQ 1
#define Q8_WMO 1
#define Q8_UP_MASK 3
#endif
constexpr float ATT_SCALE = 0.08838834764831845f;

constexpr size_t MiB = 1u << 20;
constexpr size_t WS_CTL = 0, CTL_CMAX = 65536  , CTL_ZERO_BYTES = 65536 + 4 * 16384 * 4;
constexpr size_t WS_WG1 = 1 * MiB, WS_WG2 = 2 * MiB, WS_W2C = 3 * MiB, WS_POSB = 3 * MiB + 512 * 1024, WS_POSP = 3 * MiB + 640 * 1024;
constexpr size_t WS_LI = 4 * MiB, WS_LF = 4 * MiB + 512 * 1024, WS_GT = 5 * MiB, WS_HC = 8 * MiB, WS_KC = 12 * MiB, WS_VC = 12 * MiB + 512 * 1024, WS_SELM = 13 * MiB;
constexpr size_t WS_WIN = 16 * MiB, WS_WMO = 112 * MiB, WS_WUP0 = 144 * MiB, WS_WDN0 = 272 * MiB, WS_WKVQ = 400 * MiB, WS_W1C = 456 * MiB, WS_WNO = 464 * MiB, WS_WUP1 = 496 * MiB, WS_WDN1 = 624 * MiB;
constexpr size_t WS_XB = 752 * MiB, WS_A3 = 816 * MiB, WS_HR = 880 * MiB, WS_X1 = 944 * MiB, WS_X2 = 1008 * MiB, WS_BIG = 1200 * MiB, WS_AOF = 1328 * MiB, WS_WUPQ0 = 1456 * MiB, WS_WUPQ1 = 1520 * MiB  , WS_XQ = 1584 * MiB  , WS_WKVQ8 = 1616 * MiB  , WS_WMOQ = 1644 * MiB  , WS_WINQ = 1660 * MiB  , WS_END = 1676 * MiB;
constexpr int CW_BAR = 4096;
constexpr int CW_QHEAD = 16384;
constexpr size_t WS_PART = 13 * MiB, WS_RS = 15 * MiB;

constexpr int RING_OFF = 0, RING_BYTES = 147456;
constexpr int LDSCTL_OFF = RING_BYTES, MISC_OFF = LDSCTL_OFF + 320;
constexpr int LDS_BYTES = 159744;
static_assert(MISC_OFF + 128 <= LDS_BYTES, "LDS map");

typedef float f32x16 __attribute__((ext_vector_type(16)));
typedef short s16x4 __attribute__((ext_vector_type(4)));
typedef float f32x2v __attribute__((ext_vector_type(2)));

struct Frame {
    LAS unsigned char* lds;
    volatile LAS unsigned* MISC;
    gu32* ctl;
    int tid, lane, wave, G;
    const float* in[18]; float* out; unsigned char* ws;
};

__device__ __forceinline__ float wave_sum(float v) {
#pragma unroll
    for (int o = 1; o < 64; o <<= 1) v += __shfl_xor(v, o);
    return v;
}
typedef float f32x2_t __attribute__((ext_vector_type(2))); typedef __bf16 bf16x2_t __attribute__((ext_vector_type(2)));
__device__ __forceinline__ unsigned pk2(float lo, float hi) { f32x2_t v = {lo, hi}; bf16x2_t b = __builtin_convertvector(v, bf16x2_t); return __builtin_bit_cast(unsigned, b); }
__device__ __forceinline__ float bf_lo(unsigned w) { return __uint_as_float(w << 16); }
__device__ __forceinline__ float bf_hi(unsigned w) { return __uint_as_float(w & 0xffff0000u); }
__device__ __forceinline__ float bf1(unsigned short h) { return __uint_as_float(((unsigned)h) << 16); }
__device__ __forceinline__ unsigned short f2bf1(float f) { return (unsigned short)(pk2(f, 0.f) & 0xffffu); }
__device__ __forceinline__ f32x4 mfma16(bf16x8 a, bf16x8 b, f32x4 c) { return __builtin_amdgcn_mfma_f32_16x16x32_bf16(a, b, c, 0, 0, 0); }
typedef short v4i16_t __attribute__((ext_vector_type(4)));
__device__ __forceinline__ s16x4 tr16(const LAS unsigned char* p) { return __builtin_bit_cast(s16x4, __builtin_amdgcn_ds_read_tr16_b64_v4i16((LAS v4i16_t*)p)); }
__device__ __forceinline__ bf16x8 cat8(s16x4 lo, s16x4 hi) { return (bf16x8){lo[0], lo[1], lo[2], lo[3], hi[0], hi[1], hi[2], hi[3]}; }

__device__ __forceinline__ void tr_item(const float* W, int K, int ldw, int col0, int ncols, const float* gain, float cscale, int cs_lo, int cs_hi, bf16* WT, int row_off, LAS float* scr, int item, int lane) {
    const int nblk = (ncols + 31) / 32, kb = item / nblk, nb = item % nblk, k0 = 64 * kb, n0 = 32 * nb;
    const int nn = n0 + (lane & 31); const bool nok = nn < ncols; const float cs = (nn >= cs_lo && nn < cs_hi) ? cscale : 1.f;
#pragma unroll 8
    for (int i = 0; i < 32; ++i) { const int kk = 2 * i + (lane >> 5);
        float v = nok ? W[(size_t)(k0 + kk) * ldw + col0 + nn] : 0.f;
        if (gain) v *= gain[k0 + kk];
        scr[kk * 33 + (lane & 31)] = v * cs; }
    LDS_WAIT(); asm volatile("" ::: "memory");
    const int c = lane & 7;
#pragma unroll
    for (int j = 0; j < 4; ++j) { const int n = (lane >> 3) + 8 * j; const LAS float* s = scr + (8 * c) * 33 + n;
        v4u o; o.x = pk2(s[0 * 33], s[1 * 33]); o.y = pk2(s[2 * 33], s[3 * 33]); o.z = pk2(s[4 * 33], s[5 * 33]); o.w = pk2(s[6 * 33], s[7 * 33]);
        if (n0 + n < ncols) *(GAS v4u*)(WT + (size_t)(row_off + n0 + n) * K + k0 + 8 * c) = o; }
    LDS_WAIT(); asm volatile("" ::: "memory");
}
struct CvJob { const float* W; const float* gain; bf16* WT; int K, ldw, col0, ncols, row_off, cs_lo, cs_hi, r, f8; float cscale, osc; unsigned* cmax; };
__device__ __forceinline__ void cv_load(const CvJob& J, f32x4 (&v)[16], float (&gk)[16], int lane) {
    const int nblk = J.ncols >> 6, kb = J.r / nblk, nb = J.r - kb * nblk, k0 = 64 * kb, n0 = 64 * nb;
    const float* src = J.W + (size_t)(k0 + (lane >> 4)) * J.ldw + J.col0 + n0 + 4 * (lane & 15);
    const float* gp = J.gain ? J.gain : J.W;
    const float gmul = J.gain ? 1.f : 0.f, gadd = J.gain ? 0.f : 1.f;
#pragma unroll
    for (int i = 0; i < 16; ++i) { const float g = gp[k0 + 4 * i + (lane >> 4)]; gk[i] = fmaf(g, gmul, gadd); }
#pragma unroll
    for (int i = 0; i < 16; ++i) v[i] = __builtin_nontemporal_load((const GAS f32x4*)(src + (size_t)(4 * i) * J.ldw));
}
__device__ __forceinline__ void cv_store(const CvJob& J, f32x4 (&v)[16], const float (&gkv)[16], LAS unsigned char* scr, int lane) {
    const int nblk = J.ncols >> 6, kb = J.r / nblk, nb = J.r - kb * nblk, k0 = 64 * kb, n0 = 64 * nb;
    const int c = lane & 15, kr = lane >> 4;
    const float cs = ((n0 >= J.cs_lo && n0 < J.cs_hi) ? J.cscale : 1.f) * J.osc;
    f32x4 cm = {0.f, 0.f, 0.f, 0.f};
#pragma unroll
    for (int i = 0; i < 16; ++i) { const float gk = gkv[i] * cs; const f32x4 x = v[i] * gk; cm = __builtin_elementwise_max(cm, __builtin_elementwise_abs(x));
        typedef unsigned u32x2_t __attribute__((ext_vector_type(2)));
        u32x2_t w; w.x = pk2(x.x, x.y); w.y = pk2(x.z, x.w);
        *(LAS u32x2_t*)(scr + (4 * i + kr) * 136 + c * 8) = w; }
    if (J.cmax) {
#pragma unroll
        for (int e = 0; e < 4; ++e) { float m_ = cm[e]; m_ = fmaxf(m_, __shfl_xor(m_, 16)); m_ = fmaxf(m_, __shfl_xor(m_, 32)); if (kr == 0) atomicMax(J.cmax + n0 + 4 * c + e, __float_as_uint(m_)); } }
    LDS_WAIT(); asm volatile("" ::: "memory");
    const int g = lane >> 4, i16 = lane & 15, j = i16 >> 2, q = i16 & 3;
#pragma unroll
    for (int it = 0; it < 8; ++it) { const int nbk = it >> 1, kb8 = (it & 1) * 4 + g;
        const LAS unsigned char* a = scr + (kb8 * 8 + j) * 136 + (nbk * 16 + 4 * q) * 2;
        const bf16x8 o = cat8(tr16(a), tr16(a + 4 * 136));
        if (J.f8) { const v4u w = __builtin_bit_cast(v4u, o); typedef int i32x2 __attribute__((ext_vector_type(2))); i32x2 q;
            q.x = __builtin_amdgcn_cvt_pk_fp8_f32(bf_lo(w.x), bf_hi(w.x), 0, false); q.x = __builtin_amdgcn_cvt_pk_fp8_f32(bf_lo(w.y), bf_hi(w.y), q.x, true);
            q.y = __builtin_amdgcn_cvt_pk_fp8_f32(bf_lo(w.z), bf_hi(w.z), 0, false); q.y = __builtin_amdgcn_cvt_pk_fp8_f32(bf_lo(w.w), bf_hi(w.w), q.y, true);
            *(GAS i32x2*)((unsigned char*)J.WT + (size_t)(J.row_off + n0 + nbk * 16 + i16) * J.K + k0 + kb8 * 8) = q; }
        else __builtin_nontemporal_store(o, (GAS bf16x8*)(J.WT + (size_t)(J.row_off + n0 + nbk * 16 + i16) * J.K + k0 + kb8 * 8)); }
    LDS_WAIT(); asm volatile("" ::: "memory");
}
__device__ __forceinline__ unsigned q8_pack4(float a, float b, float c, float d, float sc) {
    const float M = 12582912.f;
    const unsigned ya = __float_as_uint(fmaf(a, sc, M)), yb = __float_as_uint(fmaf(b, sc, M)), yc = __float_as_uint(fmaf(c, sc, M)), yd = __float_as_uint(fmaf(d, sc, M));
    return __builtin_amdgcn_perm(yb, ya, 0x0c0c0400u) | __builtin_amdgcn_perm(yd, yc, 0x04000c0cu);
}
__device__ __forceinline__ void rownorm_row(const float* xrow, bf16* orow, int lane, unsigned char* qrow = nullptr, float* ra = nullptr) {
    const GAS f32x4* xr = (const GAS f32x4*)xrow + lane;
    f32x4 v[16]; float s = 0.f; f32x4 am4 = {0.f, 0.f, 0.f, 0.f};
#pragma unroll
    for (int j = 0; j < 16; ++j) { v[j] = xr[64 * j]; s += (v[j].x * v[j].x + v[j].y * v[j].y) + (v[j].z * v[j].z + v[j].w * v[j].w); am4 = __builtin_elementwise_max(am4, __builtin_elementwise_abs(v[j])); }
    const float rstd = 1.f / sqrtf(wave_sum(s) * (1.f / DM) + EPS);
    GAS unsigned long long* o8 = (GAS unsigned long long*)orow + lane;
#pragma unroll
    for (int j = 0; j < 16; ++j) o8[64 * j] = (unsigned long long)pk2(v[j].x * rstd, v[j].y * rstd) | ((unsigned long long)pk2(v[j].z * rstd, v[j].w * rstd) << 32);
    if (qrow) {
        float am = fmaxf(fmaxf(am4.x, am4.y), fmaxf(am4.z, am4.w));
#pragma unroll
        for (int o = 1; o < 64; o <<= 1) am = fmaxf(am, __shfl_xor(am, o));
        const float sc = am > 0.f ? 127.f / am : 0.f;
        GAS unsigned* q4 = (GAS unsigned*)qrow + lane;
#pragma unroll
        for (int j = 0; j < 16; ++j) q4[64 * j] = q8_pack4(v[j].x, v[j].y, v[j].z, v[j].w, sc);
        if (lane == 0) *ra = am * rstd * (1.f / 127.f); }
}
__device__ __forceinline__ void rownorm_phase(Frame& F, const float* src, bf16* dst, unsigned char* q8 = nullptr, float* ra = nullptr) {
    const int gw = blockIdx.x * NWAVES + F.wave, NGW = F.G * NWAVES;
    for (int m = gw; m < MTOK; m += NGW) rownorm_row(src + (size_t)m * DM, dst + (size_t)m * DM, F.lane, q8 ? q8 + (size_t)m * DM : nullptr, ra ? ra + m : nullptr);
}

constexpr int WIN_BF = Q8_WIN_O ? 8192 : M_MAIN;
constexpr int CW_0 = 64 * (WIN_BF / 64), CW_2 = Q8_STRIPS ? 0 : 64 * 64, CW_3 = Q8_STRIPS ? 0 : 64 * 256, CW_4 = 256 * 64, CW_5 = Q8_STRIPS ? 0 : 64 * 48, CW_6 = Q8_STRIPS ? 0 : 64 * 64, CW_8 = 64 * 8, CW_9 = 64 * 8, CW_10 = 16, CW_11 = 16, CW_12 = 64 * 64, CW_13 = Q8_STRIPS ? 0 : 64 * 256, CW_14 = 256 * 64;
constexpr int CW_EARLY = CW_0, CW_TOTAL = CW_0 + CW_2 + CW_3 + CW_4 + CW_5 + CW_6 + CW_8 + CW_9 + CW_10 + CW_11 + CW_12 + CW_13 + CW_14;
__device__ __forceinline__ CvJob cv_decode(Frame& F, int it) {
    unsigned char* ws = F.ws; CvJob J; J.gain = nullptr; J.row_off = 0; J.cs_lo = 0; J.cs_hi = 0; J.cscale = 1.f; J.col0 = 0; J.f8 = 0; J.osc = 1.f; J.cmax = nullptr; int r = it;
    if (r < CW_0) { J.W = F.in[3]; J.K = 4096; J.ldw = M_IN; J.ncols = WIN_BF; J.gain = F.in[1]; J.cscale = 0.0625f; J.cs_lo = 2048; J.cs_hi = 4096; J.WT = (bf16*)(ws + WS_WIN); }
    else if ((r -= CW_0) < CW_2) { J.W = F.in[6]; J.K = 4096; J.ldw = 4096; J.ncols = 4096; J.gain = F.in[5]; J.WT = (bf16*)(ws + WS_WMO); if (Q8_WMO) J.cmax = (unsigned*)(ws + CTL_CMAX) + 49152; }
    else if ((r -= CW_2) < CW_3) { J.W = F.in[16]; J.K = 4096; J.ldw = DFF; J.ncols = DFF; J.gain = F.in[2]; J.WT = (bf16*)(ws + WS_WUP0); if (Q8_UP_MASK & 1) J.cmax = (unsigned*)(ws + CTL_CMAX); }
    else if ((r -= CW_3) < CW_4) { J.W = F.in[17]; J.K = DFF; J.ldw = 4096; J.ncols = 4096; J.WT = (bf16*)(ws + WS_WDN0); }
    else if ((r -= CW_4) < CW_5) { J.W = F.in[8]; J.K = 4096; J.ldw = KVW; J.ncols = KVW; J.gain = F.in[7]; J.WT = (bf16*)(ws + WS_WKVQ); if (Q8_KVQ) J.cmax = (unsigned*)(ws + CTL_CMAX) + 32768; else { J.f8 = 1; J.osc = 256.f; } }
    else if ((r -= CW_5) < CW_6) { J.W = F.in[13]; J.K = 4096; J.ldw = NQG; J.ncols = 4096; J.gain = F.in[1] + 4096; J.WT = (bf16*)(ws + WS_WKVQ); J.row_off = KVW; if (Q8_KVQ) J.cmax = (unsigned*)(ws + CTL_CMAX) + 32768 + KVW; else { J.f8 = 1; J.osc = 256.f; } }
    else if ((r -= CW_6) < CW_8) { J.W = F.in[11]; J.K = 4096; J.ldw = 512; J.ncols = 512; J.WT = (bf16*)(ws + WS_W1C); }
    else if ((r -= CW_8) < CW_9) { J.W = F.in[11] + (size_t)4096 * 512; J.K = 4096; J.ldw = 512; J.ncols = 512; J.WT = (bf16*)(ws + WS_W1C) + (size_t)512 * 4096; }
    else if ((r -= CW_9) < CW_10) { J.W = F.in[12]; J.K = 512; J.ldw = 128; J.ncols = 128; J.WT = (bf16*)(ws + WS_W2C); }
    else if ((r -= CW_10) < CW_11) { J.W = F.in[12] + (size_t)512 * 128; J.K = 512; J.ldw = 128; J.ncols = 128; J.WT = (bf16*)(ws + WS_W2C) + (size_t)128 * 512; }
    else if ((r -= CW_11) < CW_12) { J.W = F.in[15]; J.K = 4096; J.ldw = 4096; J.ncols = 4096; J.WT = (bf16*)(ws + WS_WNO); J.f8 = 1; J.osc = 256.f; }
    else if ((r -= CW_12) < CW_13) { J.W = F.in[16] + (size_t)4096 * DFF; J.K = 4096; J.ldw = DFF; J.ncols = DFF; J.gain = F.in[2] + 4096; J.WT = (bf16*)(ws + WS_WUP1); if (Q8_UP_MASK & 2) J.cmax = (unsigned*)(ws + CTL_CMAX) + 16384; }
    else { r -= CW_13; J.W = F.in[17] + (size_t)DFF * 4096; J.K = DFF; J.ldw = 4096; J.ncols = 4096; J.WT = (bf16*)(ws + WS_WDN1); }
    J.r = r; return J;
}
__device__ __forceinline__ void convert_wide(Frame& F, int lo, int hi, int worker, int nworkers) {
    LAS unsigned char* scr = F.lds + RING_OFF + F.wave * 16384;
    int it = lo + worker; if (it >= hi) return;
    f32x4 va[16], vb[16]; float ga[16], gb[16]; CvJob ja = cv_decode(F, it), jb = ja;
    cv_load(ja, va, ga, F.lane);
    for (;;) {
        const int itb = it + nworkers; const bool hb = itb < hi;
        if (hb) { jb = cv_decode(F, itb); cv_load(jb, vb, gb, F.lane); }
        cv_store(ja, va, ga, scr, F.lane);
        if (!hb) break;
        const int ita = itb + nworkers; const bool ha = ita < hi;
        if (ha) { ja = cv_decode(F, ita); cv_load(ja, va, ga, F.lane); }
        cv_store(jb, vb, gb, scr, F.lane);
        if (!ha) break;
        it = ita;
    }
}
struct CvQ { gu32* head; int lo, hi, cur, end; };
__device__ __forceinline__ int cvq_next(CvQ& Q, int lane) {
    if (Q.cur == Q.end) { unsigned v = 0u; if (lane == 0) v = __hip_atomic_fetch_add(Q.head, 8u, RLX_AGENT);
        Q.cur = Q.lo + __builtin_amdgcn_readfirstlane((int)v); Q.end = Q.cur + 8 < Q.hi ? Q.cur + 8 : Q.hi; if (Q.cur >= Q.hi) { Q.cur = Q.end = Q.hi; return Q.hi; } }
    return Q.cur++;
}
__device__ __forceinline__ void convert_queue(Frame& F, int lo, int hi, gu32* head) {
    LAS unsigned char* scr = F.lds + RING_OFF + F.wave * 16384;
    CvQ Q{head, lo, hi, 0, 0};
    int it = cvq_next(Q, F.lane); if (it >= hi) return;
    f32x4 va[16], vb[16]; float ga[16], gb[16]; CvJob ja = cv_decode(F, it), jb = ja;
    cv_load(ja, va, ga, F.lane);
    for (;;) {
        const int itb = cvq_next(Q, F.lane); const bool hb = itb < hi;
        if (hb) { jb = cv_decode(F, itb); cv_load(jb, vb, gb, F.lane); }
        cv_store(ja, va, ga, scr, F.lane);
        if (!hb) break;
        const int ita = cvq_next(Q, F.lane); const bool ha = ita < hi;
        if (ha) { ja = cv_decode(F, ita); cv_load(ja, va, ga, F.lane); }
        cv_store(jb, vb, gb, scr, F.lane);
        if (!ha) break;
    }
}
__device__ __forceinline__ void convert_narrow(Frame& F, int lo, int hi, int worker, int nworkers) {
    LAS float* scr = (LAS float*)(F.lds + RING_OFF + F.wave * 16384);
    for (int it = lo + worker; it < hi; it += nworkers) {
        if (it < 64) tr_item(F.in[3], 4096, M_IN, M_MAIN, 16, F.in[1], 1.f, 0, 0, (bf16*)(F.ws + WS_WG1), 0, scr, it, F.lane);
        else tr_item(F.in[13], 4096, NQG, 4096, 96, F.in[1] + 4096, 1.f, 0, 0, (bf16*)(F.ws + WS_WG2), 0, scr, it - 64, F.lane);
    }
}
__device__ __forceinline__ void p0_prologue(Frame& F) {
    const int gw = blockIdx.x * NWAVES + F.wave, NGW = F.G * NWAVES;
    unsigned char* ws = F.ws;
    { float* pp = (float*)(ws + WS_POSP);
      for (int task = gw; task < 512; task += NGW) { const int j = task >> 8, nbk = (task >> 5) & 7, ch = task & 31, n = nbk * 64 + F.lane;
          const float* pos = F.in[10] + (size_t)j * 4096 + ch * 128; const float* w1 = F.in[11] + ((size_t)j * 4096 + ch * 128) * 512 + n;
          float a0 = 0.f, a1 = 0.f, a2 = 0.f, a3 = 0.f;
#pragma unroll 4
          for (int kk = 0; kk < 128; kk += 4) { a0 += pos[kk] * w1[(size_t)kk * 512]; a1 += pos[kk + 1] * w1[(size_t)(kk + 1) * 512]; a2 += pos[kk + 2] * w1[(size_t)(kk + 2) * 512]; a3 += pos[kk + 3] * w1[(size_t)(kk + 3) * 512]; }
          pp[ch * 1024 + j * 512 + n] = (a0 + a1) + (a2 + a3); } }
    convert_wide(F, 0, CW_EARLY, gw, NGW); convert_narrow(F, 0, 64, gw, NGW);
    rownorm_phase(F, F.in[0], (bf16*)(ws + WS_XB), Q8_WIN_O ? (unsigned char*)(ws + WS_XQ) : nullptr, Q8_WIN_O ? (float*)(ws + WS_RS) + 24576 : nullptr);
}

__device__ __forceinline__ float quant_row(const bf16* src, unsigned char* dst, float sc, int lane) {
    v4u w[8]; float am = 0.f;
#pragma unroll
    for (int i = 0; i < 8; ++i) { w[i] = *(const v4u*)(src + (i * 64 + lane) * 8);
        am = fmaxf(fmaxf(fmaxf(am, fmaxf(fabsf(bf_lo(w[i].x)), fabsf(bf_hi(w[i].x)))), fmaxf(fabsf(bf_lo(w[i].y)), fabsf(bf_hi(w[i].y)))), fmaxf(fmaxf(fabsf(bf_lo(w[i].z)), fabsf(bf_hi(w[i].z))), fmaxf(fabsf(bf_lo(w[i].w)), fabsf(bf_hi(w[i].w))))); }
    float step = 0.f;
    if (sc <= 0.f) {
#pragma unroll
        for (int o = 1; o < 64; o <<= 1) am = fmaxf(am, __shfl_xor(am, o));
        sc = am > 0.f ? 127.f / am : 0.f; step = am * (1.f / 127.f); }
#pragma unroll
    for (int i = 0; i < 8; ++i) { typedef unsigned u32x2_t __attribute__((ext_vector_type(2))); u32x2_t o;
        o.x = q8_pack4(bf_lo(w[i].x), bf_hi(w[i].x), bf_lo(w[i].y), bf_hi(w[i].y), sc); o.y = q8_pack4(bf_lo(w[i].z), bf_hi(w[i].z), bf_lo(w[i].w), bf_hi(w[i].w), sc);
        *(u32x2_t*)(dst + (i * 64 + lane) * 8) = o; }
    return step;
}
__device__ __forceinline__ void wquant_phase(Frame& F, const bf16* W, const float* cmax, unsigned char* WQ, int N) {
    const int gw = blockIdx.x * NWAVES + F.wave, NGW = F.G * NWAVES;
    for (int n = gw; n < N; n += NGW) { const float m_ = cmax[n]; (void)quant_row(W + (size_t)n * DM, WQ + (size_t)n * DM, m_ > 0.f ? 127.f / m_ : 1e-30f, F.lane); }
}
__device__ __forceinline__ void rstd_phase(Frame& F, float* rs, const bf16* X = nullptr, unsigned char* XQ = nullptr, float* ra = nullptr) {
    const int gw = blockIdx.x * NWAVES + F.wave, NGW = F.G * NWAVES; const float* part = (const float*)(F.ws + WS_PART);
    for (int row = gw; row < MTOK; row += NGW) { const float t = wave_sum(part[(size_t)row * 64 + F.lane]); const float r_ = 1.f / sqrtf(t * (1.f / DM) + EPS); if (F.lane == 0) rs[row] = r_;
        if (X) { const float st = quant_row(X + (size_t)row * DM, XQ + (size_t)row * DM, 0.f, F.lane); if (F.lane == 0) ra[row] = st * r_; } }
}
template <int NT, class AP>
__device__ __forceinline__ void mini_gemm16(f32x4 (&acc)[NT], const AP& ap, const bf16* Bt, int ldb, int K, int lane, int kstart = 0) {
    const int r16 = lane & 15, kq = lane >> 4;
#pragma unroll
    for (int n = 0; n < NT; ++n) acc[n] = (f32x4){0.f, 0.f, 0.f, 0.f};
    const bf16* brow = Bt + (size_t)r16 * ldb + kq * 8;
#pragma unroll 8
    for (int kk = 0; kk < K; kk += 32) { const int k0 = (kk + kstart) & (K - 1);
        const bf16x8 a = *(const bf16x8*)ap(r16, k0 + kq * 8);
#pragma unroll
        for (int n = 0; n < NT; ++n) { const bf16x8 b = *(const bf16x8*)(brow + (size_t)n * 16 * ldb + k0); acc[n] = mfma16(a, b, acc[n]); }
    }
}
struct RowMajorA { const bf16* A; int lda; __device__ __forceinline__ const bf16* operator()(int r16, int k) const { return A + (size_t)r16 * lda + k; } };

template <int NT, class AP>
__device__ __forceinline__ void mini_gemm16_splitk(f32x4& out, const AP& ap, const bf16* Bt, int ldb, int K, LAS float* red, int wid, int lane) {
    const int r16 = lane & 15, kq = lane >> 4, kc = K >> 3;
    f32x4 acc[NT];
#pragma unroll
    for (int n = 0; n < NT; ++n) acc[n] = (f32x4){0.f, 0.f, 0.f, 0.f};
    const bf16* brow = Bt + (size_t)r16 * ldb + kq * 8;
#pragma unroll 4
    for (int k0 = wid * kc; k0 < (wid + 1) * kc; k0 += 32) {
        const bf16x8 a = *(const bf16x8*)ap(r16, k0 + kq * 8);
#pragma unroll
        for (int n = 0; n < NT; ++n) { const bf16x8 b = *(const bf16x8*)(brow + (size_t)n * 16 * ldb + k0); acc[n] = mfma16(a, b, acc[n]); }
    }
#pragma unroll
    for (int n = 0; n < NT; ++n) *(LAS f32x4*)(red + ((wid * NT + n) * 64 + lane) * 4) = acc[n];
    __syncthreads();
    out = (f32x4){0.f, 0.f, 0.f, 0.f};
    if (wid < NT) {
#pragma unroll
        for (int w = 0; w < 8; ++w) out = out + *(const LAS f32x4*)(red + ((w * NT + wid) * 64 + lane) * 4); }
    __syncthreads();
}
template <int NT>
__device__ __forceinline__ void mini_gemm32_splitk(f32x4& out0, f32x4& out1, const bf16* A0, const bf16* A1, int lda, const bf16* Bt, int ldb, int K, LAS float* red, int wid, int lane) {
    const int r16 = lane & 15, kq = lane >> 4, kc = K >> 3;
    f32x4 acc0[NT], acc1[NT];
#pragma unroll
    for (int n = 0; n < NT; ++n) { acc0[n] = (f32x4){0.f, 0.f, 0.f, 0.f}; acc1[n] = (f32x4){0.f, 0.f, 0.f, 0.f}; }
    const bf16* a0 = A0 + (size_t)r16 * lda + kq * 16; const bf16* a1 = A1 + (size_t)r16 * lda + kq * 16; const bf16* brow = Bt + (size_t)r16 * ldb + kq * 16;
#pragma unroll 1
    for (int k0 = wid * kc; k0 < (wid + 1) * kc; k0 += 128) {
        bf16x8 fa0[4], fa1[4], fb[4][NT];
#pragma unroll
        for (int s4 = 0; s4 < 4; ++s4) { const int off = k0 + (s4 >> 1) * 64 + (s4 & 1) * 8; fa0[s4] = *(const bf16x8*)(a0 + off); fa1[s4] = *(const bf16x8*)(a1 + off);
#pragma unroll
            for (int n = 0; n < NT; ++n) fb[s4][n] = *(const bf16x8*)(brow + (size_t)n * 16 * ldb + off); }
        __builtin_amdgcn_sched_barrier(0);
#pragma unroll
        for (int s4 = 0; s4 < 4; ++s4)
#pragma unroll
            for (int n = 0; n < NT; ++n) { acc0[n] = mfma16(fa0[s4], fb[s4][n], acc0[n]); acc1[n] = mfma16(fa1[s4], fb[s4][n], acc1[n]); }
        __builtin_amdgcn_sched_barrier(0);
    }
#pragma unroll
    for (int n = 0; n < NT; ++n) { *(LAS f32x4*)(red + ((wid * NT + n) * 64 + lane) * 4) = acc0[n]; *(LAS f32x4*)(red + 8 * NT * 256 + ((wid * NT + n) * 64 + lane) * 4) = acc1[n]; }
    __syncthreads();
    out0 = (f32x4){0.f, 0.f, 0.f, 0.f}; out1 = (f32x4){0.f, 0.f, 0.f, 0.f};
    if (wid < NT) {
#pragma unroll
        for (int w = 0; w < 8; ++w) { out0 = out0 + *(const LAS f32x4*)(red + ((w * NT + wid) * 64 + lane) * 4); out1 = out1 + *(const LAS f32x4*)(red + 8 * NT * 256 + ((w * NT + wid) * 64 + lane) * 4); } }
    __syncthreads();
}
__device__ __forceinline__ void gates1_phase(Frame& F) {
    const int r16 = F.lane & 15, kq = F.lane >> 4;
    const bf16* XB = (const bf16*)(F.ws + WS_XB); const bf16* Wg = (const bf16*)(F.ws + WS_WG1);
    float* LI = (float*)(F.ws + WS_LI); float* LF = (float*)(F.ws + WS_LF);
    const float bias = F.in[4][r16];
    for (int rt0 = blockIdx.x; rt0 < MTOK / 16; rt0 += 2 * F.G) { const int rt1 = rt0 + F.G; const bool two = rt1 < MTOK / 16;
        f32x4 acc2[2];
        mini_gemm32_splitk<1>(acc2[0], acc2[1], XB + (size_t)rt0 * 16 * DM, XB + (size_t)(two ? rt1 : rt0) * 16 * DM, DM, Wg, DM, DM, (LAS float*)(F.lds + RING_OFF), F.wave, F.lane);
        if (F.wave == 0) {
#pragma unroll
            for (int h = 0; h < 2; ++h) { if (h == 1 && !two) break; const int rt = h ? rt1 : rt0;
#pragma unroll
                for (int i = 0; i < 4; ++i) { const int row = rt * 16 + 4 * kq + i, b = row >> 12, t = row & 4095;
                    float g = acc2[h][i] + bias; g = 15.f * tanhf(g * (1.f / 15.f));
                    if (r16 < 8) LI[(size_t)(b * 8 + r16) * SEQ + t] = g;
                    else LF[(size_t)(b * 8 + (r16 - 8)) * SEQ + t] = fminf(g, 0.f) - log1pf(__expf(-fabsf(g))); } } }
    }
}
__device__ __forceinline__ void gates2_phase(Frame& F) {
    const int r16 = F.lane & 15, kq = F.lane >> 4;
    const bf16* XB = (const bf16*)(F.ws + WS_X2); const bf16* Wg = (const bf16*)(F.ws + WS_WG2); float* GT = (float*)(F.ws + WS_GT);
    const bool half = F.G == 256; const int wk = half ? (int)blockIdx.x - 128 : (int)blockIdx.x, nwk = half ? 128 : F.G;
    if (wk >= 0)
    for (int rt0 = wk; rt0 < MTOK / 16; rt0 += 2 * nwk) { const int rt1 = rt0 + nwk; const bool two = rt1 < MTOK / 16;
        f32x4 acc2[2];
        mini_gemm32_splitk<6>(acc2[0], acc2[1], XB + (size_t)rt0 * 16 * DM, XB + (size_t)(two ? rt1 : rt0) * 16 * DM, DM, Wg, DM, DM, (LAS float*)(F.lds + RING_OFF), F.wave, F.lane);
        if (F.wave < 6) {
#pragma unroll
            for (int h = 0; h < 2; ++h) { if (h == 1 && !two) break; const int rt = h ? rt1 : rt0;
#pragma unroll
                for (int i = 0; i < 4; ++i) { const int row = rt * 16 + 4 * kq + i; const float rs = ((const float*)(F.ws + WS_RS))[8192 + row];
                    GT[(size_t)row * 96 + F.wave * 16 + r16] = 1.f / (1.f + __expf(-acc2[h][i] * rs)); } } }
    }
}

#define QS_BAR() do { asm volatile("s_waitcnt lgkmcnt(0)" ::: "memory"); __builtin_amdgcn_s_barrier(); asm volatile("" ::: "memory"); } while (0)
#define QS_SB() __builtin_amdgcn_sched_barrier(0)
constexpr int QS_RS = 4112, QS_NSTRIPS = 512 + 512 + 96 + 128 + 128;
struct QsJob { const float* W; const float* gain; unsigned char* WQ; float* cmax; int ldw, n0; };
__device__ __forceinline__ QsJob qs_decode(Frame& F, int s_) {
    unsigned char* ws = F.ws; QsJob J; float* cm = (float*)(ws + CTL_CMAX); int s = s_;
    if (s < 512) { J.W = F.in[16]; J.ldw = DFF; J.gain = F.in[2]; J.WQ = ws + WS_WUPQ0; J.cmax = cm; }
    else if ((s -= 512) < 512) { J.W = F.in[16] + (size_t)4096 * DFF; J.ldw = DFF; J.gain = F.in[2] + 4096; J.WQ = ws + WS_WUPQ1; J.cmax = cm + 16384; }
    else if ((s -= 512) < 96) { J.W = F.in[8]; J.ldw = KVW; J.gain = F.in[7]; J.WQ = ws + WS_WKVQ8; J.cmax = cm + 32768; }
    else if ((s -= 96) < 128) { J.W = F.in[13]; J.ldw = NQG; J.gain = F.in[1] + 4096; J.WQ = ws + WS_WKVQ8 + (size_t)KVW * 4096; J.cmax = cm + 32768 + KVW; }
    else if ((s -= 128) < 128) { J.W = F.in[6]; J.ldw = 4096; J.gain = F.in[5]; J.WQ = ws + WS_WMOQ; J.cmax = cm + 49152; }
    else { s -= 128; J.W = F.in[3] + 8192; J.ldw = M_IN; J.gain = F.in[1]; J.WQ = ws + WS_WINQ; J.cmax = cm + 53248; }
    J.n0 = 32 * s; return J;
}
__device__ __forceinline__ void qs_load(const QsJob& J, int q, f32x4 (&v)[8], f32x2_t (&g)[4], int tid) {
    const int seg = tid & 7, kp = tid >> 3;
    unsigned off_w = (unsigned)(2 * kp * J.ldw + 4 * seg) * 4u, off_g = (unsigned)kp * 8u;
    asm volatile("" : "+v"(off_w), "+v"(off_g));
    const char* wb = (const char*)(J.W + J.n0); const char* gb = (const char*)J.gain;
#pragma unroll
    for (int i = 0; i < 4; ++i) g[i] = *(const f32x2_t*)(gb + (size_t)((q * 4 + i) * 128) * 4 + off_g);
#pragma unroll
    for (int i = 0; i < 4; ++i) { const char* p = wb + (size_t)((q * 4 + i) * 128) * (size_t)J.ldw * 4;
        v[2 * i] = __builtin_nontemporal_load((const GAS f32x4*)(p + off_w)); v[2 * i + 1] = __builtin_nontemporal_load((const GAS f32x4*)(p + (size_t)J.ldw * 4 + off_w)); }
}
__device__ __forceinline__ void qs_put(const f32x4 (&v)[8], const f32x2_t (&g)[4], int q, f32x4& cm, LAS unsigned char* lds, int tid) {
    const int seg = tid & 7, kp = tid >> 3;
    unsigned lb = (unsigned)((4 * seg) * QS_RS + 4 * kp); asm volatile("" : "+v"(lb));
#pragma unroll
    for (int i = 0; i < 4; ++i) { const f32x4 x0 = v[2 * i] * g[i].x, x1 = v[2 * i + 1] * g[i].y;
        cm = __builtin_elementwise_max(cm, __builtin_elementwise_max(__builtin_elementwise_abs(x0), __builtin_elementwise_abs(x1)));
        LAS unsigned char* b = lds + lb + (q * 4 + i) * 256;
        *(LAS unsigned*)(b) = pk2(x0.x, x1.x); *(LAS unsigned*)(b + QS_RS) = pk2(x0.y, x1.y); *(LAS unsigned*)(b + 2 * QS_RS) = pk2(x0.z, x1.z); *(LAS unsigned*)(b + 3 * QS_RS) = pk2(x0.w, x1.w); }
}
__device__ __forceinline__ void qs_park(const f32x4 (&v)[8], const f32x2_t (&g)[4], int q, f32x4& cm, unsigned (&park)[16][4]) {
#pragma unroll
    for (int i = 0; i < 4; ++i) { const f32x4 x0 = v[2 * i] * g[i].x, x1 = v[2 * i + 1] * g[i].y;
        cm = __builtin_elementwise_max(cm, __builtin_elementwise_max(__builtin_elementwise_abs(x0), __builtin_elementwise_abs(x1)));
        unsigned p0 = pk2(x0.x, x1.x), p1 = pk2(x0.y, x1.y), p2 = pk2(x0.z, x1.z), p3 = pk2(x0.w, x1.w);
        asm volatile("" : "+v"(p0), "+v"(p1), "+v"(p2), "+v"(p3));
        park[(q - 4) * 4 + i][0] = p0; park[(q - 4) * 4 + i][1] = p1; park[(q - 4) * 4 + i][2] = p2; park[(q - 4) * 4 + i][3] = p3; }
}
__device__ __forceinline__ void qs_flush(const QsJob& J, LAS unsigned char* lds, const float (&sc4)[4], int half, int wave, unsigned l16, unsigned l8) {
#pragma unroll
    for (int rr = 0; rr < 4; ++rr) { const int n = wave + 8 * rr; unsigned char* dst = J.WQ + (size_t)(J.n0 + n) * 4096 + half * 2048;
#pragma unroll
        for (int i = 0; i < 4; ++i) { const v4u w = *(const LAS v4u*)(lds + n * QS_RS + l16 + i * 1024);
            typedef unsigned u32x2_t __attribute__((ext_vector_type(2))); u32x2_t o;
            o.x = q8_pack4(bf_lo(w.x), bf_hi(w.x), bf_lo(w.y), bf_hi(w.y), sc4[rr]); o.y = q8_pack4(bf_lo(w.z), bf_hi(w.z), bf_lo(w.w), bf_hi(w.w), sc4[rr]);
            *(u32x2_t*)(dst + l8 + i * 512) = o; } }
}
__device__ __forceinline__ void convert_strips(Frame& F, int cw, int ncw, int lo = 0, int hi = QS_NSTRIPS) {
    LAS unsigned char* lds = F.lds + RING_OFF; LAS float* wm = (LAS float*)(lds + 32 * QS_RS);
    const int tid = F.tid, lane = F.lane, wave = F.wave;
    QS_BAR();
    int s = lo + cw; if (s >= hi) return;
    f32x4 A[8], B[8]; f32x2_t gA[4], gB[4];
    unsigned l16 = (unsigned)lane * 16u, l8 = (unsigned)lane * 8u; asm volatile("" : "+v"(l16), "+v"(l8));
    QsJob J = qs_decode(F, s); qs_load(J, 0, A, gA, tid); qs_load(J, 1, B, gB, tid);
    for (;;) {
        f32x4 cm = {0.f, 0.f, 0.f, 0.f}; unsigned park[16][4];
#pragma unroll 1
        for (int qq = 0; qq < 2; ++qq) {
            qs_put(A, gA, 2 * qq, cm, lds, tid); QS_SB(); qs_load(J, 2 * qq + 2, A, gA, tid); QS_SB();
            qs_put(B, gB, 2 * qq + 1, cm, lds, tid); QS_SB(); qs_load(J, 2 * qq + 3, B, gB, tid); QS_SB(); }
        qs_park(A, gA, 4, cm, park); QS_SB(); qs_load(J, 6, A, gA, tid); QS_SB();
        qs_park(B, gB, 5, cm, park); QS_SB(); qs_load(J, 7, B, gB, tid); QS_SB();
        const int sn = s + ncw; const bool more = sn < hi; QsJob Jn = J; if (more) Jn = qs_decode(F, sn);
        qs_park(A, gA, 6, cm, park); QS_SB(); if (more) qs_load(Jn, 0, A, gA, tid); QS_SB();
        qs_park(B, gB, 7, cm, park); QS_SB();
#pragma unroll
        for (int e = 0; e < 4; ++e) { float m_ = cm[e]; m_ = fmaxf(m_, __shfl_xor(m_, 8)); m_ = fmaxf(m_, __shfl_xor(m_, 16)); m_ = fmaxf(m_, __shfl_xor(m_, 32)); cm[e] = m_; }
        if (lane < 8) *(LAS f32x4*)(wm + wave * 32 + 4 * lane) = cm;
        QS_BAR();
        float sc4[4];
#pragma unroll
        for (int rr = 0; rr < 4; ++rr) { const int n = wave + 8 * rr; float m_ = 0.f;
#pragma unroll
            for (int w8 = 0; w8 < 8; ++w8) m_ = fmaxf(m_, wm[w8 * 32 + n]);
            sc4[rr] = m_ > 0.f ? 127.f / m_ : 0.f;
            if (lane == 0) J.cmax[J.n0 + n] = m_; }
        qs_flush(J, lds, sc4, 0, wave, l16, l8);
        QS_BAR();
        { const int seg = tid & 7, kp = tid >> 3; unsigned lb = (unsigned)((4 * seg) * QS_RS + 4 * kp); asm volatile("" : "+v"(lb));
#pragma unroll
          for (int d = 0; d < 16; ++d) { LAS unsigned char* b = lds + lb + d * 256;
              *(LAS unsigned*)(b) = park[d][0]; *(LAS unsigned*)(b + QS_RS) = park[d][1]; *(LAS unsigned*)(b + 2 * QS_RS) = park[d][2]; *(LAS unsigned*)(b + 3 * QS_RS) = park[d][3]; } }
        QS_SB(); if (more) qs_load(Jn, 1, B, gB, tid); QS_SB();
        QS_BAR();
        qs_flush(J, lds, sc4, 1, wave, l16, l8);
        QS_BAR();
        if (!more) break;
        s = sn; J = Jn;
    }
}

#define ML_BAR() do { asm volatile("s_waitcnt lgkmcnt(0)" ::: "memory"); __builtin_amdgcn_s_barrier(); asm volatile("" ::: "memory"); } while (0)
constexpr int ML_QS = 528, ML_VS = 144, ML_PS = 144;
constexpr int ML_Q = 0, ML_K = ML_Q + 64 * ML_QS, ML_V = ML_K + 64 * ML_QS, ML_VW = ML_V + 64 * ML_VS, ML_P = ML_VW + 64 * ML_VS, ML_CT = ML_P + 64 * ML_PS, ML_SC = ML_CT + 64 * ML_QS, ML_H = ML_SC + 4096;
static_assert(ML_H + 64 * ML_VS <= RING_BYTES, "mlstm LDS");
struct MlPref { bf16x8 q[4], k[4], v; float li, lf; };
struct MlK { LAS unsigned char* L; const bf16* QKVO; bf16* HR; const float* LI; const float* LF; size_t rowb; int bh, hd, e0, tid, lane, wid; };
__device__ __forceinline__ void ml_load(MlPref& P, const MlK& K, int c) {
    const int qr_ = K.tid >> 3, qc_ = K.tid & 7;
    const bf16* base = K.QKVO + (K.rowb + (size_t)c * 64 + qr_) * M_MAIN;
#pragma unroll
    for (int i = 0; i < 4; ++i) { P.q[i] = *(const bf16x8*)(base + K.hd * 256 + (qc_ + 8 * i) * 8); P.k[i] = *(const bf16x8*)(base + 2048 + K.hd * 256 + (qc_ + 8 * i) * 8); }
    P.v = *(const bf16x8*)(base + 4096 + K.hd * 512 + K.e0 + qc_ * 8);
    P.li = K.LI[(size_t)K.bh * SEQ + c * 64 + K.lane]; P.lf = K.LF[(size_t)K.bh * SEQ + c * 64 + K.lane];
}
__device__ __forceinline__ void ml_chunk(MlPref& P, f32x4 (&CT)[2][4], float& m_state, const MlK& K, int c) {
    LAS unsigned char* L = K.L;
    LAS float* sc_a = (LAS float*)(L + ML_SC); LAS float* sc_M = sc_a + 64; LAS float* sc_b = sc_a + 128; LAS float* sc_w = sc_a + 192;
    LAS float* sc_rs = sc_a + 256; LAS float* sc_qn = sc_a + 512; LAS float* sc_nv = sc_a + 576;
    const int tid = K.tid, lane = K.lane, wid = K.wid, r16 = lane & 15, kq = lane >> 4;
    const int tt = wid >> 1, sp = wid & 1, ep = wid & 1, qr_ = tid >> 3, qc_ = tid & 7;
    float bsum = P.lf;
#pragma unroll
    for (int o = 1; o < 64; o <<= 1) { const float t_ = __shfl_up(bsum, o); if (lane >= o) bsum += t_; }
    const float a_s = P.li - bsum;
    float pm = a_s;
#pragma unroll
    for (int o = 1; o < 64; o <<= 1) { const float t_ = __shfl_up(pm, o); if (lane >= o) pm = fmaxf(pm, t_); }
    const float Mt = fmaxf(m_state, pm);
    const float M63 = __uint_as_float(__builtin_amdgcn_readlane(__float_as_uint(Mt), 63)), b63 = __uint_as_float(__builtin_amdgcn_readlane(__float_as_uint(bsum), 63));
    const float w_s = __expf(a_s - M63), decay = __expf(m_state - M63);
    if (wid == 0) { sc_a[lane] = a_s; sc_M[lane] = Mt; sc_b[lane] = bsum; sc_w[lane] = w_s; }
#pragma unroll
    for (int i = 0; i < 4; ++i) { *(LAS bf16x8*)(L + ML_Q + qr_ * ML_QS + (qc_ + 8 * i) * 16) = P.q[i]; *(LAS bf16x8*)(L + ML_K + qr_ * ML_QS + (qc_ + 8 * i) * 16) = P.k[i]; }
    { *(LAS bf16x8*)(L + ML_V + qr_ * ML_VS + qc_ * 16) = P.v;
        const float wv = __shfl(w_s, 8 * wid + (lane >> 3)); const v4u raw = __builtin_bit_cast(v4u, P.v); v4u o;
        o.x = pk2(bf_lo(raw.x) * wv, bf_hi(raw.x) * wv); o.y = pk2(bf_lo(raw.y) * wv, bf_hi(raw.y) * wv); o.z = pk2(bf_lo(raw.z) * wv, bf_hi(raw.z) * wv); o.w = pk2(bf_lo(raw.w) * wv, bf_hi(raw.w) * wv);
        *(LAS v4u*)(L + ML_VW + qr_ * ML_VS + qc_ * 16) = o; }
    ml_load(P, K, c + 2 < 64 ? c + 2 : 63);
    ML_BAR();
    f32x4 sacc0 = {0.f, 0.f, 0.f, 0.f}, sacc1 = sacc0, iacc0 = sacc0, iacc1 = sacc0;
    { const LAS unsigned char* qrow = L + ML_Q + (tt * 16 + r16) * ML_QS + kq * 16;
      const LAS unsigned char* krow = L + ML_K + (sp * 32 + r16) * ML_QS + kq * 16;
      const LAS unsigned char* crow_ = L + ML_CT + (ep * 32 + r16) * ML_QS + kq * 16;
#pragma unroll 2
      for (int k0 = 0; k0 < 8; ++k0) { const bf16x8 a = *(const LAS bf16x8*)(qrow + k0 * 64);
          const bf16x8 b0 = *(const LAS bf16x8*)(krow + k0 * 64), b1 = *(const LAS bf16x8*)(krow + 16 * ML_QS + k0 * 64);
          const bf16x8 bc0 = *(const LAS bf16x8*)(crow_ + k0 * 64), bc1 = *(const LAS bf16x8*)(crow_ + 16 * ML_QS + k0 * 64);
          sacc0 = mfma16(b0, a, sacc0); sacc1 = mfma16(b1, a, sacc1); iacc0 = mfma16(bc0, a, iacc0); iacc1 = mfma16(bc1, a, iacc1); } }
    const int tl = tt * 16 + r16;
    const float Mt_t = sc_M[tl];
#pragma unroll
    for (int st2 = 0; st2 < 2; ++st2) { const int s0 = (2 * sp + st2) * 16 + 4 * kq; const f32x4 a4 = *(const LAS f32x4*)(sc_a + s0); const f32x4 sv = st2 ? sacc1 : sacc0;
        float pv4[4]; float rsum = 0.f;
#pragma unroll
        for (int i = 0; i < 4; ++i) { pv4[i] = (s0 + i <= tl) ? sv[i] * __expf(a4[i] - Mt_t) : 0.f; rsum += pv4[i]; }
        rsum += __shfl_xor(rsum, 16); rsum += __shfl_xor(rsum, 32);
        if (kq == 0) sc_rs[(2 * sp + st2) * 64 + tl] = rsum;
        typedef unsigned u32x2_t __attribute__((ext_vector_type(2)));
        u32x2_t w; w.x = pk2(pv4[0], pv4[1]); w.y = pk2(pv4[2], pv4[3]);
        *(LAS u32x2_t*)(L + ML_P + tl * ML_PS + s0 * 2) = w; }
    { const int t = tid >> 3, part = tid & 7; float qn = 0.f;
      const LAS v4u* qp = (const LAS v4u*)(L + ML_Q + t * ML_QS + part * 64); const LAS f32x4* np_ = (const LAS f32x4*)(sc_nv + part * 32);
#pragma unroll
      for (int j = 0; j < 4; ++j) { const v4u w = qp[j]; const f32x4 n0 = np_[2 * j], n1 = np_[2 * j + 1];
          qn += (bf_lo(w.x) * n0[0] + bf_hi(w.x) * n0[1]) + (bf_lo(w.y) * n0[2] + bf_hi(w.y) * n0[3]) + (bf_lo(w.z) * n1[0] + bf_hi(w.z) * n1[1]) + (bf_lo(w.w) * n1[2] + bf_hi(w.w) * n1[3]); }
      qn += __shfl_xor(qn, 1); qn += __shfl_xor(qn, 2); qn += __shfl_xor(qn, 4);
      if (part == 0) sc_qn[t] = qn; }
    ML_BAR();
    { f32x4 xacc[2] = {{0.f, 0.f, 0.f, 0.f}, {0.f, 0.f, 0.f, 0.f}}; const int j = r16 >> 2, q = r16 & 3;
#pragma unroll
      for (int ks = 0; ks < 2; ++ks) { const bf16x8 pf = *(const LAS bf16x8*)(L + ML_P + tl * ML_PS + (ks * 32 + kq * 8) * 2);
#pragma unroll
          for (int e2 = 0; e2 < 2; ++e2) { const LAS unsigned char* va = L + ML_V + (ks * 32 + 8 * kq + j) * ML_VS + ((2 * ep + e2) * 16 + 4 * q) * 2;
              xacc[e2] = mfma16(cat8(tr16(va), tr16(va + 4 * ML_VS)), pf, xacc[e2]); } }
      const float bb_t = sc_b[tl], winter = __expf(m_state - Mt_t);
      const float den = winter * sc_qn[tl] + ((sc_rs[tl] + sc_rs[64 + tl]) + (sc_rs[128 + tl] + sc_rs[192 + tl]));
      const float rdd = 1.f / fmaxf(fabsf(den), __expf(-(bb_t + Mt_t)));
#pragma unroll
      for (int e2 = 0; e2 < 2; ++e2) { const f32x4 ia = e2 ? iacc1 : iacc0; float hv[4];
#pragma unroll
          for (int i = 0; i < 4; ++i) hv[i] = (winter * ia[i] + xacc[e2][i]) * rdd;
          typedef unsigned u32x2_t __attribute__((ext_vector_type(2)));
          u32x2_t w; w.x = pk2(hv[0], hv[1]); w.y = pk2(hv[2], hv[3]);
          *(LAS u32x2_t*)(L + ML_H + tl * ML_VS + ((2 * ep + e2) * 16 + 4 * kq) * 2) = w; } }
    { const int j = r16 >> 2, q = r16 & 3; bf16x8 af[2][2];
#pragma unroll
      for (int e2 = 0; e2 < 2; ++e2)
#pragma unroll
          for (int ks = 0; ks < 2; ++ks) { const LAS unsigned char* va = L + ML_VW + (ks * 32 + 8 * kq + j) * ML_VS + ((2 * ep + e2) * 16 + 4 * q) * 2; af[e2][ks] = cat8(tr16(va), tr16(va + 4 * ML_VS)); }
#pragma unroll
      for (int jt = 0; jt < 4; ++jt) { const int dt = 4 * (wid >> 1) + jt; bf16x8 bfr[2];
#pragma unroll
          for (int ks = 0; ks < 2; ++ks) { const LAS unsigned char* ka = L + ML_K + (ks * 32 + 8 * kq + j) * ML_QS + (dt * 16 + 4 * q) * 2; bfr[ks] = cat8(tr16(ka), tr16(ka + 4 * ML_QS)); }
#pragma unroll
          for (int e2 = 0; e2 < 2; ++e2) { f32x4 acc = CT[e2][jt] * decay;
              acc = mfma16(bfr[0], af[e2][0], acc); acc = mfma16(bfr[1], af[e2][1], acc);
              CT[e2][jt] = acc;
              typedef unsigned u32x2_t __attribute__((ext_vector_type(2)));
              u32x2_t w; w.x = pk2(acc[0], acc[1]); w.y = pk2(acc[2], acc[3]);
              *(LAS u32x2_t*)(L + ML_CT + ((2 * ep + e2) * 16 + r16) * ML_QS + (dt * 16 + 4 * kq) * 2) = w; } } }
    if (tid < 256) { float nv = sc_nv[tid] * decay;
#pragma unroll
        for (int s = 0; s < 64; ++s) nv += __uint_as_float(__builtin_amdgcn_readlane(__float_as_uint(w_s), s)) * bf1(*(const LAS unsigned short*)(L + ML_K + s * ML_QS + tid * 2));
        sc_nv[tid] = nv; }
    m_state = b63 + M63;
    ML_BAR();
    *(bf16x8*)(K.HR + (K.rowb + (size_t)c * 64 + qr_) * DM + K.hd * 512 + K.e0 + qc_ * 8) = *(const LAS bf16x8*)(L + ML_H + qr_ * ML_VS + qc_ * 16);
}
__device__ __forceinline__ void mlstm_phase(Frame& F, int worker, int nworkers) {
    LAS unsigned char* L = F.lds + RING_OFF;
    LAS float* sc_nv = (LAS float*)(L + ML_SC) + 576;
    for (int unit = worker; unit < 128; unit += nworkers) {
        const int bh = unit >> 3, sl = unit & 7, b = bh >> 3;
        MlK K; K.L = L; K.QKVO = (const bf16*)(F.ws + WS_BIG); K.HR = (bf16*)(F.ws + WS_HR); K.LI = (const float*)(F.ws + WS_LI); K.LF = (const float*)(F.ws + WS_LF);
        K.rowb = (size_t)b * SEQ; K.bh = bh; K.hd = bh & 7; K.e0 = sl * 64; K.tid = F.tid; K.lane = F.lane; K.wid = F.wave;
        f32x4 CT[2][4];
#pragma unroll
        for (int a = 0; a < 2; ++a)
#pragma unroll
            for (int j = 0; j < 4; ++j) CT[a][j] = (f32x4){0.f, 0.f, 0.f, 0.f};
        float m_state = 0.f;
        if (F.tid < 256) sc_nv[F.tid] = 0.f;
        for (int i = F.tid; i < 64 * ML_QS / 4; i += NWAVES * 64) ((LAS unsigned*)(L + ML_CT))[i] = 0u;
        MlPref P0, P1;
        ml_load(P0, K, 0); ml_load(P1, K, 1);
        __syncthreads();
        for (int c = 0; c < 64; c += 2) { ml_chunk(P0, CT, m_state, K, c); ml_chunk(P1, CT, m_state, K, c + 1); }
    }
}

__device__ __forceinline__ void gating_phase(Frame& F) {
    const int gw = blockIdx.x * NWAVES + F.wave, NGW = F.G * NWAVES, lane = F.lane;
    const bf16* HR = (const bf16*)(F.ws + WS_HR); const bf16* QKVO = (const bf16*)(F.ws + WS_BIG); bf16* A3 = (bf16*)(F.ws + WS_A3);
    float* ra = (float*)(F.ws + WS_RS) + 24576;
    for (int row = gw; row < MTOK; row += NGW) {
        unsigned pk[8][4]; float am = 0.f;
#pragma unroll
        for (int hd = 0; hd < 8; ++hd) {
            const v4u hv = *(const v4u*)(HR + (size_t)row * DM + hd * 512 + lane * 8);
            const v4u ov = *(const v4u*)(QKVO + (size_t)row * M_MAIN + 8192 + hd * 512 + lane * 8);
            float h[8] = {bf_lo(hv.x), bf_hi(hv.x), bf_lo(hv.y), bf_hi(hv.y), bf_lo(hv.z), bf_hi(hv.z), bf_lo(hv.w), bf_hi(hv.w)};
            float o[8] = {bf_lo(ov.x), bf_hi(ov.x), bf_lo(ov.y), bf_hi(ov.y), bf_lo(ov.z), bf_hi(ov.z), bf_lo(ov.w), bf_hi(ov.w)};
            float ss = 0.f;
#pragma unroll
            for (int e = 0; e < 8; ++e) ss += h[e] * h[e];
            const float rstd = 1.f / sqrtf(wave_sum(ss) * (1.f / 512.f) + EPS);
            float r[8];
#pragma unroll
            for (int e = 0; e < 8; ++e) { r[e] = h[e] * rstd / (1.f + __expf(-o[e])); am = fmaxf(am, fabsf(r[e])); }
#pragma unroll
            for (int j = 0; j < 4; ++j) pk[hd][j] = pk2(r[2 * j], r[2 * j + 1]);
            if (!Q8_WMO) { v4u w; w.x = pk[hd][0]; w.y = pk[hd][1]; w.z = pk[hd][2]; w.w = pk[hd][3]; *(v4u*)(A3 + (size_t)row * DM + hd * 512 + lane * 8) = w; }
        }
        if (Q8_WMO) {
#pragma unroll
            for (int o = 1; o < 64; o <<= 1) am = fmaxf(am, __shfl_xor(am, o));
            const float sc = am > 0.f ? 127.f / am : 0.f;
#pragma unroll
            for (int hd = 0; hd < 8; ++hd) { typedef unsigned u32x2_t __attribute__((ext_vector_type(2))); u32x2_t o;
                o.x = q8_pack4(bf_lo(pk[hd][0]), bf_hi(pk[hd][0]), bf_lo(pk[hd][1]), bf_hi(pk[hd][1]), sc); o.y = q8_pack4(bf_lo(pk[hd][2]), bf_hi(pk[hd][2]), bf_lo(pk[hd][3]), bf_hi(pk[hd][3]), sc);
                *(u32x2_t*)((unsigned char*)A3 + (size_t)row * DM + hd * 512 + lane * 8) = o; }
            if (lane == 0) ra[row] = am * (1.f / 127.f); }
    }
}

__device__ __forceinline__ float gelu_tanh(float v) { const float u = 0.7978845608028654f * (v + 0.044715f * v * v * v); return 0.5f * v * (1.f + tanhf(u)); }
struct CmpA { const bf16* KVQ; int j, rt; __device__ __forceinline__ const bf16* operator()(int r16, int k) const {
    const int row = rt * 16 + r16, bg = row >> 8; int c = row & 255; c = c > 254 ? 254 : c; const int b = bg >> 2, g = bg & 3;
    return KVQ + ((size_t)b * SEQ + 16 * c + (k >> 7)) * NKVQ + j * 512 + g * 128 + (k & 127); } };
__device__ __forceinline__ void nsa_prep_phase(Frame& F) {
    const int gw = blockIdx.x * NWAVES + F.wave, NGW = F.G * NWAVES, lane = F.lane, r16 = lane & 15, kq = lane >> 4;
    bf16* KVQ = (bf16*)(F.ws + WS_BIG);
    { const int v = lane >> 3, br = v >> 2, g = v & 3, d0 = (lane & 7) * 16;
      float gn[16];
#pragma unroll
      for (int e = 0; e < 16; ++e) gn[e] = F.in[9][(br + 1) * 128 + d0 + e] * F.in[14][(br + 1) * 128 + d0 + e] * ATT_SCALE;
      for (int row = gw; row < MTOK; row += NGW) {
          bf16* p = KVQ + (size_t)row * NKVQ + (2 + 2 * br) * 512 + g * 128 + d0;
          const v4u a = *(const v4u*)p, c = *(const v4u*)(p + 8);
          float x[16] = {bf_lo(a.x), bf_hi(a.x), bf_lo(a.y), bf_hi(a.y), bf_lo(a.z), bf_hi(a.z), bf_lo(a.w), bf_hi(a.w), bf_lo(c.x), bf_hi(c.x), bf_lo(c.y), bf_hi(c.y), bf_lo(c.z), bf_hi(c.z), bf_lo(c.w), bf_hi(c.w)};
          float ss = 0.f;
#pragma unroll
          for (int e = 0; e < 16; ++e) ss += x[e] * x[e];
          ss += __shfl_xor(ss, 1); ss += __shfl_xor(ss, 2); ss += __shfl_xor(ss, 4);
          const float rstd = 1.f / sqrtf(ss * (1.f / 128.f) + EPS);
#pragma unroll
          for (int e = 0; e < 16; ++e) x[e] *= rstd * gn[e];
          v4u o0, o1; o0.x = pk2(x[0], x[1]); o0.y = pk2(x[2], x[3]); o0.z = pk2(x[4], x[5]); o0.w = pk2(x[6], x[7]); o1.x = pk2(x[8], x[9]); o1.y = pk2(x[10], x[11]); o1.z = pk2(x[12], x[13]); o1.w = pk2(x[14], x[15]);
          *(v4u*)p = o0; *(v4u*)(p + 8) = o1; } }
    { const bf16* W1C = (const bf16*)(F.ws + WS_W1C); const bf16* W2C = (const bf16*)(F.ws + WS_W2C); const float* posb = (const float*)(F.ws + WS_POSB);
      bf16* KC = (bf16*)(F.ws + WS_KC); bf16* VC = (bf16*)(F.ws + WS_VC);
      LAS unsigned char* As = F.lds + RING_OFF;
      LAS unsigned char* Hs = F.lds + RING_OFF; LAS float* ps = (LAS float*)(F.lds + RING_OFF + 16 * 8208);
      const int wid = F.wave;
      for (int task = blockIdx.x; task < 256; task += F.G) { const int j = (task & 7) >> 2, rt = (task & 3) * 32 + (task >> 3);
          { f32x4 acc[4]; CmpA ap{KVQ, j, rt};
            { const int l16 = F.tid & 15, ch = F.tid >> 4; v4u tmp[16];
#pragma unroll
              for (int p = 0; p < 16; ++p) tmp[p] = *(const v4u*)(ap(p, ch * 128 + l16 * 8));
#pragma unroll
              for (int p = 0; p < 16; ++p) *(LAS v4u*)(As + p * 8208 + (ch * 128 + l16 * 8) * 2) = tmp[p]; }
            __syncthreads();
#pragma unroll
            for (int n = 0; n < 4; ++n) acc[n] = (f32x4){0.f, 0.f, 0.f, 0.f};
#pragma unroll
            for (int hf = 0; hf < 2; ++hf) { const bf16* brow = W1C + ((size_t)j * 512 + hf * 256 + wid * 32 + r16) * 4096 + kq * 16; LAS unsigned char* arow = As + r16 * 8208 + kq * 32;
              bf16x8 b0[8][2], b1[8][2];
#pragma unroll
              for (int s8 = 0; s8 < 8; ++s8)
#pragma unroll
                  for (int n = 0; n < 2; ++n) b0[s8][n] = *(const bf16x8*)(brow + (size_t)n * 16 * 4096 + (s8 >> 1) * 64 + (s8 & 1) * 8);
#pragma unroll 1
              for (int kb = 0; kb < 16; kb += 2) {
#pragma unroll
                  for (int s8 = 0; s8 < 8; ++s8)
#pragma unroll
                      for (int n = 0; n < 2; ++n) b1[s8][n] = *(const bf16x8*)(brow + (size_t)n * 16 * 4096 + (kb + 1) * 256 + (s8 >> 1) * 64 + (s8 & 1) * 8);
                  __builtin_amdgcn_sched_barrier(0);
#pragma unroll
                  for (int s8 = 0; s8 < 8; ++s8) { const bf16x8 a = *(const LAS bf16x8*)(arow + (kb * 256 + (s8 >> 1) * 64 + (s8 & 1) * 8) * 2);
#pragma unroll
                      for (int n = 0; n < 2; ++n) acc[hf * 2 + n] = mfma16(a, b0[s8][n], acc[hf * 2 + n]); }
                  __builtin_amdgcn_sched_barrier(0);
                  if (kb + 2 < 16) {
#pragma unroll
                      for (int s8 = 0; s8 < 8; ++s8)
#pragma unroll
                          for (int n = 0; n < 2; ++n) b0[s8][n] = *(const bf16x8*)(brow + (size_t)n * 16 * 4096 + (kb + 2) * 256 + (s8 >> 1) * 64 + (s8 & 1) * 8); }
                  __builtin_amdgcn_sched_barrier(0);
#pragma unroll
                  for (int s8 = 0; s8 < 8; ++s8) { const bf16x8 a = *(const LAS bf16x8*)(arow + ((kb + 1) * 256 + (s8 >> 1) * 64 + (s8 & 1) * 8) * 2);
#pragma unroll
                      for (int n = 0; n < 2; ++n) acc[hf * 2 + n] = mfma16(a, b1[s8][n], acc[hf * 2 + n]); }
                  __builtin_amdgcn_sched_barrier(0); } }
            __syncthreads();
#pragma unroll
            for (int n = 0; n < 4; ++n) { const int col = (n >> 1) * 256 + wid * 32 + (n & 1) * 16 + r16; const float pb = posb[j * 512 + col];
#pragma unroll
                for (int i = 0; i < 4; ++i) *(LAS unsigned short*)(Hs + (4 * kq + i) * 1040 + col * 2) = f2bf1(gelu_tanh(acc[n][i] + pb)); } }
          __syncthreads();
          f32x4 o = {0.f, 0.f, 0.f, 0.f};
          { const bf16* brow = W2C + ((size_t)j * 128 + wid * 16 + r16) * 512 + kq * 8;
#pragma unroll 4
            for (int k0 = 0; k0 < 512; k0 += 32) o = mfma16(*(const LAS bf16x8*)(Hs + r16 * 1040 + (k0 + kq * 8) * 2), *(const bf16x8*)(brow + k0), o); }
          const int col = wid * 16 + r16;
          if (j == 0) {
#pragma unroll
              for (int i = 0; i < 4; ++i) { float ss = o[i] * o[i]; ss += __shfl_xor(ss, 1); ss += __shfl_xor(ss, 2); ss += __shfl_xor(ss, 4); ss += __shfl_xor(ss, 8);
                  if (r16 == 0) ps[wid * 16 + 4 * kq + i] = ss; } }
          __syncthreads();
          const float gsc = (j == 0) ? F.in[9][col] * F.in[14][col] * ATT_SCALE : 1.f;
#pragma unroll
          for (int i = 0; i < 4; ++i) { const int row = rt * 16 + 4 * kq + i; float v = o[i];
              if (j == 0) { float ss = 0.f;
#pragma unroll
                  for (int w = 0; w < 8; ++w) ss += ps[w * 16 + 4 * kq + i];
                  v *= gsc / sqrtf(ss * (1.f / 128.f) + EPS); }
              if ((row & 255) == 255) v = 0.f;
              (j == 0 ? KC : VC)[(size_t)row * 128 + col] = f2bf1(v); }
          __syncthreads(); } }
}
__device__ __forceinline__ void nsa_cmp2_phase(Frame& F) {
    const int gw = blockIdx.x * NWAVES + F.wave, NGW = F.G * NWAVES, lane = F.lane, r16 = lane & 15, kq = lane >> 4;
    const bf16* HC = (const bf16*)(F.ws + WS_HC); const bf16* W2C = (const bf16*)(F.ws + WS_W2C); bf16* KC = (bf16*)(F.ws + WS_KC); bf16* VC = (bf16*)(F.ws + WS_VC);
    for (int task = gw; task < 256; task += NGW) { const int j = task >> 7, rt = task & 127;
        f32x4 acc[8]; RowMajorA ap{HC + ((size_t)j * 2048 + rt * 16) * 512, 512};
        mini_gemm16<8>(acc, ap, W2C + (size_t)j * 128 * 512, 512, 512, lane);
#pragma unroll
        for (int i = 0; i < 4; ++i) { const int row = rt * 16 + 4 * kq + i; const bool pad = (row & 255) == 255;
            float sc = 1.f;
            if (j == 0) { float ss = 0.f;
#pragma unroll
                for (int n = 0; n < 8; ++n) ss += acc[n][i] * acc[n][i];
                ss += __shfl_xor(ss, 1); ss += __shfl_xor(ss, 2); ss += __shfl_xor(ss, 4); ss += __shfl_xor(ss, 8);
                sc = ATT_SCALE / sqrtf(ss * (1.f / 128.f) + EPS); }
#pragma unroll
            for (int n = 0; n < 8; ++n) { const int col = n * 16 + r16; float v = acc[n][i] * sc;
                if (j == 0) v *= F.in[9][col] * F.in[14][col];
                if (pad) v = 0.f;
                (j == 0 ? KC : VC)[(size_t)row * 128 + col] = f2bf1(v); } } }
}

namespace nsa {
constexpr int D = 128, KVBLK = 64, SHM_K = 16384, SHM_V = 16384;
constexpr int O_V = 0, O_K = SHM_V, BUF1 = SHM_V + SHM_K  , O_WS = 2 * BUF1, O_PB = O_WS + NWAVES * 64 * 4, O_SELM = O_PB + 32 * 65 * 4, O_OT = ((O_SELM + 32 * 8 + 1023) / 1024) * 1024  , O_END = O_OT + 32 * 2048;
static_assert(O_END <= RING_BYTES, "nsa LDS");
constexpr float THR2 = 11.0f;
#define KSWZ(row, colB) ((row) * 256 + ((colB) ^ (((row) & 7) << 4)))
#define SBAR() __builtin_amdgcn_sched_barrier(0)
__device__ __forceinline__ int v_st(int k, int c) { const int kk = (k & ~0xC) | ((k & 4) << 1) | ((k & 8) >> 1); return ((kk >> 3) * 4 + (c >> 5)) * 512 + ((kk & 7) * 32 + (c & 31)) * 2; }
__device__ __forceinline__ int v_rd_base(int lane) { return ((lane & 3) << 3) | (((lane >> 2) & 3) << 6) | (((lane >> 4) & 1) << 5) | (((lane >> 5) & 1) << 8); }
constexpr int v_rd_off(int d0, int ks, int half) { return d0 * 512 + ks * 4096 + half * 2048; }
__device__ __forceinline__ int crow(int r, int hi) { return (r & 3) + 8 * (r >> 2) + 4 * hi; }
__device__ __forceinline__ void mask_tile(f32x16& p0, f32x16& p1, int dq, unsigned W) {
    const float NEG = -__builtin_inff();
#pragma unroll
    for (int r = 0; r < 16; ++r) { const int c = (r & 3) + 8 * (r >> 2);
        if ((unsigned)(dq - c) >= W) p0[r] = NEG;
        if ((unsigned)(dq - c - 32) >= W) p1[r] = NEG; }
}
__device__ __forceinline__ float rowmax32(const f32x16& p0, const f32x16& p1) {
    float pmax = p0[0];
#pragma unroll
    for (int r = 1; r < 16; ++r) pmax = fmaxf(pmax, p0[r]);
#pragma unroll
    for (int r = 0; r < 16; ++r) pmax = fmaxf(pmax, p1[r]);
    auto rr = __builtin_amdgcn_permlane32_swap(__float_as_uint(pmax), __float_as_uint(pmax), false, false);
    return fmaxf(__uint_as_float(rr[0]), __uint_as_float(rr[1]));
}
__device__ __forceinline__ float rowsum32(const f32x16& p0, const f32x16& p1) {
    float ps = 0.f;
#pragma unroll
    for (int r = 0; r < 16; ++r) ps += p0[r];
#pragma unroll
    for (int r = 0; r < 16; ++r) ps += p1[r];
    auto rr = __builtin_amdgcn_permlane32_swap(__float_as_uint(ps), __float_as_uint(ps), false, false);
    return __uint_as_float(rr[0]) + __uint_as_float(rr[1]);
}
__device__ __forceinline__ void partialSM(f32x16& p0, f32x16& p1, float& m_reg, float& alpha, float c2) {
    const float pmax = rowmax32(p0, p1); float mn;
    if (__builtin_expect(__all((pmax - m_reg) * c2 <= THR2), 1)) { mn = m_reg; alpha = 1.f; }
    else { mn = fmaxf(m_reg, pmax); alpha = __builtin_amdgcn_exp2f((m_reg - mn) * c2); m_reg = mn; }
    const float mnL = -mn * c2;
#pragma unroll
    for (int r = 0; r < 16; ++r) p0[r] = fmaf(p0[r], c2, mnL);
#pragma unroll
    for (int r = 0; r < 16; ++r) p1[r] = fmaf(p1[r], c2, mnL);
#pragma unroll
    for (int r = 0; r < 16; ++r) p0[r] = __builtin_amdgcn_exp2f(p0[r]);
}
__device__ __forceinline__ void packP(const f32x16& p0, const f32x16& p1, bf16x8& pa0, bf16x8& pa1, bf16x8& pa2, bf16x8& pa3) {
#define PK4(P, B_, OUT) do { unsigned a0 = pk2(P[B_+0], P[B_+1]), a1 = pk2(P[B_+2], P[B_+3]);                          \
        unsigned b0 = pk2(P[B_+4], P[B_+5]), b1 = pk2(P[B_+6], P[B_+7]);                                             \
        auto r0 = __builtin_amdgcn_permlane32_swap(a0, b0, false, false); auto r1 = __builtin_amdgcn_permlane32_swap(a1, b1, false, false); \
        u32x4_t w = {r0[0], r1[0], r0[1], r1[1]}; OUT = __builtin_bit_cast(bf16x8, w); } while (0)
    typedef unsigned u32x4_t __attribute__((ext_vector_type(4)));
    PK4(p0, 0, pa0); PK4(p0, 8, pa1); PK4(p1, 0, pa2); PK4(p1, 8, pa3);
#undef PK4
}
__device__ __forceinline__ void finishSM(f32x16& p0, f32x16& p1, float alpha, float& l_reg, bf16x8& pa0, bf16x8& pa1, bf16x8& pa2, bf16x8& pa3) {
#pragma unroll
    for (int r = 0; r < 16; ++r) p1[r] = __builtin_amdgcn_exp2f(p1[r]);
    l_reg = l_reg * alpha + rowsum32(p0, p1);
    packP(p0, p1, pa0, pa1, pa2, pa3);
}
__device__ __forceinline__ void qkt(f32x16& p0, f32x16& p1, const char* K_lds, int r32, int hi, const bf16x8* qr, float cinit) {
#pragma unroll
    for (int r = 0; r < 16; ++r) { p0[r] = cinit; p1[r] = cinit; }
    const char* kb[4];
#pragma unroll
    for (int dd = 0; dd < 4; ++dd) kb[dd] = K_lds + KSWZ(r32, (dd * 16 + hi * 8) * 2);
#pragma unroll
    for (int d0 = 0; d0 < 8; ++d0) { const char* a = kb[d0 & 3] + (d0 >> 2) * 128;
        const bf16x8 b0 = *reinterpret_cast<const bf16x8*>(a);
        const bf16x8 b1 = *reinterpret_cast<const bf16x8*>(a + 32 * 256);
        p0 = __builtin_amdgcn_mfma_f32_32x32x16_bf16(b0, qr[d0], p0, 0, 0, 0);
        p1 = __builtin_amdgcn_mfma_f32_32x32x16_bf16(b1, qr[d0], p1, 0, 0, 0); }
}
__device__ __forceinline__ void pv_tile(f32x16* o, int vb0, bf16x8 pa0, bf16x8 pa1, bf16x8 pa2, bf16x8 pa3) {
#define TRRD(dst, off) asm volatile("ds_read_b64_tr_b16 %0, %1 offset:%2" : "=&v"(dst) : "v"(vb0), "i"(off) : "memory")
#define PV_D0(d0) do { s16x4 l0, l1, l2, l3, h0, h1, h2, h3; constexpr int b_ = v_rd_off(d0, 0, 0); \
        TRRD(l0, b_); TRRD(h0, b_ + 2048); TRRD(l1, b_ + 4096); TRRD(h1, b_ + 6144); TRRD(l2, b_ + 8192); TRRD(h2, b_ + 10240); TRRD(l3, b_ + 12288); TRRD(h3, b_ + 14336); \
        asm volatile("s_waitcnt lgkmcnt(0)" ::: "memory"); SBAR();   \
        o[d0] = __builtin_amdgcn_mfma_f32_32x32x16_bf16(pa0, (bf16x8){l0[0], l0[1], l0[2], l0[3], h0[0], h0[1], h0[2], h0[3]}, o[d0], 0, 0, 0);   \
        o[d0] = __builtin_amdgcn_mfma_f32_32x32x16_bf16(pa1, (bf16x8){l1[0], l1[1], l1[2], l1[3], h1[0], h1[1], h1[2], h1[3]}, o[d0], 0, 0, 0);   \
        o[d0] = __builtin_amdgcn_mfma_f32_32x32x16_bf16(pa2, (bf16x8){l2[0], l2[1], l2[2], l2[3], h2[0], h2[1], h2[2], h2[3]}, o[d0], 0, 0, 0);   \
        o[d0] = __builtin_amdgcn_mfma_f32_32x32x16_bf16(pa3, (bf16x8){l3[0], l3[1], l3[2], l3[3], h3[0], h3[1], h3[2], h3[3]}, o[d0], 0, 0, 0); } while (0)
    PV_D0(0); PV_D0(1); PV_D0(2); PV_D0(3);
#undef PV_D0
#undef TRRD
}
struct Stage { bf16x8 k0, k1, v0, v1; };
__device__ __forceinline__ void stage_load(Stage& S, const bf16* Kp, const bf16* Vp, int ld, int kb, int sr, int sc, bool withV) {
    const bf16* kt = Kp + (size_t)kb * ld; const bf16* vt = Vp + (size_t)kb * ld;
    const unsigned voff = (unsigned)(sr * ld + sc);
    S.k0 = *(const bf16x8*)(kt + voff); S.k1 = *(const bf16x8*)(kt + (size_t)32 * ld + voff);
    if (withV) { S.v0 = *(const bf16x8*)(vt + voff); S.v1 = *(const bf16x8*)(vt + (size_t)32 * ld + voff); }
}
__device__ __forceinline__ void stage_write(const Stage& S, char* lds, int sr, int sc, bool withV) {
    const int kws = KSWZ(sr, sc * 2);
    *(bf16x8*)(lds + O_K + kws) = S.k0; *(bf16x8*)(lds + O_K + kws + 32 * 256) = S.k1;
    if (withV) { *(bf16x8*)(lds + O_V + v_st(sr, sc)) = S.v0; *(bf16x8*)(lds + O_V + v_st(32 + sr, sc)) = S.v1; }
}
template <int ACC>
__device__ __forceinline__ void emit(const f32x16* o, const float* fl, char* OTw, int r32, int hi) {
    int r32o = r32, hio = hi; asm volatile("" : "+v"(r32o), "+v"(hio));
    char* base = OTw + 4 * hio * 2048 + r32o * 2;
#pragma unroll
    for (int r = 0; r < 16; ++r) { const float f = fl[(r & 3) + 8 * (r >> 2) + 4 * hio]; unsigned short* p = (unsigned short*)(base + ((r & 3) + 8 * (r >> 2)) * 2048);
#pragma unroll
        for (int d0 = 0; d0 < 4; ++d0) { float v = o[d0][r] * f;
            if (ACC >= 1) v += bf1(p[d0 * 32]);
            p[d0 * 32] = f2bf1(v); } }
}
template <int MODE, int ACC>
__device__ __forceinline__ void flash_pass(char* lds, const bf16* Kp, const bf16* Vp, int ld, unsigned long long tiles, int t, int qb, unsigned long long mymask, const bf16x8* qr, float c2, float gate, char* OTw,
                                           Stage& S, const bf16* Kn, const bf16* Vn, Stage* Sn, int tid, int wid, int lane) {
    const int r32 = lane & 31, hi = lane >> 5, sr = tid >> 4, sc = (tid & 15) * 8;
    float* ws = (float*)(lds + O_WS) + wid * 64; float* li_l = ws; float* al_l = ws + 32;
    const int vb0 = (int)(uintptr_t)(lds + O_V) + v_rd_base(lane);
    f32x16 o[4] = {}; float m_reg = -1e30f, l_reg = 0.f;
    unsigned long long rem = tiles;
    int j = __builtin_ctzll(rem); rem &= rem - 1;
    __syncthreads();
    stage_write(S, lds, sr, sc, true);
    int jn = rem ? __builtin_ctzll(rem) : -1;
    if (jn >= 0) { rem &= rem - 1; stage_load(S, Kp, Vp, ld, jn * KVBLK, sr, sc, true); }
    int cur = 0;
    for (;;) {
        __syncthreads();
        int jnn = -1;
        if (jn >= 0) { stage_write(S, lds + (cur ^ 1) * BUF1, sr, sc, true); jnn = rem ? __builtin_ctzll(rem) : -1;
            if (jnn >= 0) { rem &= rem - 1; stage_load(S, Kp, Vp, ld, jnn * KVBLK, sr, sc, true); } }
        f32x16 p0, p1; float alpha; bf16x8 pa0, pa1, pa2, pa3;
        float cinit = 0.f;
        if (MODE == 1) cinit = ((mymask >> j) & 1ull) ? 0.f : -__builtin_inff();
        qkt(p0, p1, lds + cur * BUF1 + O_K, r32, hi, qr, cinit);
        if (MODE == 0) { const int tok0_ = t - r32; if (!(j * KVBLK + 63 <= tok0_ && j * KVBLK >= tok0_ - 480)) mask_tile(p0, p1, t - j * KVBLK - 4 * hi, 512u); }
        else if (j == qb) mask_tile(p0, p1, t - j * KVBLK - 4 * hi, 0x7fffffffu);
        partialSM(p0, p1, m_reg, alpha, c2);
        finishSM(p0, p1, alpha, l_reg, pa0, pa1, pa2, pa3);
        if (__any(alpha < 1.f)) { if (hi == 0) al_l[r32] = alpha; asm volatile("s_waitcnt lgkmcnt(0)" ::: "memory");
#pragma unroll
            for (int d_ = 0; d_ < 4; ++d_)
#pragma unroll
                for (int r = 0; r < 16; ++r) o[d_][r] *= al_l[crow(r, hi)]; }
        pv_tile(o, vb0 + cur * BUF1, pa0, pa1, pa2, pa3);
        if (jn < 0) break;
        j = jn; jn = jnn; cur ^= 1;
    }
    if (Sn) stage_load(*Sn, Kn, Vn, ld, 0, sr, sc, true);
    if (hi == 0) li_l[r32] = gate / l_reg; asm volatile("s_waitcnt lgkmcnt(0)" ::: "memory");
    emit<ACC>(o, li_l, OTw, r32, hi);
}

__device__ __forceinline__ void unit(Frame& F, char* lds, int b, int g, int tg) {
    const int tid = F.tid, lane = F.lane, wid = F.wave, r32 = lane & 31, hi = lane >> 5, sr = tid >> 4, sc = (tid & 15) * 8;
    const int head = g * 8 + wid, tok0 = tg * 32, t = tok0 + r32, qb = tg >> 1, bg = b * 4 + g;
    const bf16* KVQ = (const bf16*)(F.ws + WS_BIG); const float* GT = (const float*)(F.ws + WS_GT);
    const bf16* KC = (const bf16*)(F.ws + WS_KC) + (size_t)bg * 256 * 128; const bf16* VC = (const bf16*)(F.ws + WS_VC) + (size_t)bg * 256 * 128;
    const size_t rowq = (size_t)b * SEQ + t;
    float* ws = (float*)(lds + O_WS) + wid * 64; float* li_l = ws;
    unsigned* pb = (unsigned*)(lds + O_PB); unsigned* selm = (unsigned*)(lds + O_SELM);
    const int vb0 = (int)(uintptr_t)(lds + O_V) + v_rd_base(lane);
    bf16x8 qr[8]; float ss = 0.f;
#pragma unroll
    for (int d0 = 0; d0 < 8; ++d0) { qr[d0] = *(const bf16x8*)(KVQ + rowq * NKVQ + KVW + head * 128 + d0 * 16 + hi * 8);
        const v4u w = __builtin_bit_cast(v4u, qr[d0]);
        ss += (bf_lo(w.x) * bf_lo(w.x) + bf_hi(w.x) * bf_hi(w.x)) + (bf_lo(w.y) * bf_lo(w.y) + bf_hi(w.y) * bf_hi(w.y)) + (bf_lo(w.z) * bf_lo(w.z) + bf_hi(w.z) * bf_hi(w.z)) + (bf_lo(w.w) * bf_lo(w.w) + bf_hi(w.w) * bf_hi(w.w)); }
    { auto rr = __builtin_amdgcn_permlane32_swap(__float_as_uint(ss), __float_as_uint(ss), false, false); ss = __uint_as_float(rr[0]) + __uint_as_float(rr[1]); }
    const float c2 = 1.4426950408889634f / sqrtf(ss * (1.f / 128.f) + EPS);
    const float g_cmp = GT[rowq * 96 + head], g_sel = GT[rowq * 96 + 32 + head], g_win = GT[rowq * 96 + 64 + head];
    for (int i = tid; i < 32 * 65; i += NWAVES * 64) pb[i] = 0u;
    char* OTw = lds + O_OT + wid * 256;
    const int nct = (tg >> 5) + 1; const int cmax = (t - 31) >> 4;
    float m_c = -1e30f, l_c = 0.f;
    { Stage S;
      for (int kt = 0; kt < nct; ++kt) {
          stage_load(S, KC, VC, 128, kt * 64, sr, sc, false);
          __syncthreads(); stage_write(S, lds, sr, sc, false); __syncthreads();
          f32x16 p0, p1; qkt(p0, p1, lds + O_K, r32, hi, qr, 0.f);
          mask_tile(p0, p1, cmax - kt * 64 - 4 * hi, 0x7fffffffu);
          const float pmax = rowmax32(p0, p1), mn = fmaxf(m_c, pmax), al = __builtin_amdgcn_exp2f((m_c - mn) * c2), mnL = -mn * c2;
#pragma unroll
          for (int r = 0; r < 16; ++r) { p0[r] = __builtin_amdgcn_exp2f(fmaf(p0[r], c2, mnL)); p1[r] = __builtin_amdgcn_exp2f(fmaf(p1[r], c2, mnL)); }
          l_c = l_c * al + rowsum32(p0, p1); m_c = mn; }
      const float inv_l = l_c > 0.f ? 1.f / l_c : 0.f; const float mnL = -m_c * c2;
      f32x16 o[4] = {};
      for (int kt = 0; kt < nct; ++kt) {
          stage_load(S, KC, VC, 128, kt * 64, sr, sc, true);
          __syncthreads(); stage_write(S, lds, sr, sc, true); __syncthreads();
          f32x16 p0, p1; qkt(p0, p1, lds + O_K, r32, hi, qr, 0.f);
          mask_tile(p0, p1, cmax - kt * 64 - 4 * hi, 0x7fffffffu);
#pragma unroll
          for (int r = 0; r < 16; ++r) { p0[r] = __builtin_amdgcn_exp2f(fmaf(p0[r], c2, mnL)) * inv_l; p1[r] = __builtin_amdgcn_exp2f(fmaf(p1[r], c2, mnL)) * inv_l; }
#pragma unroll
          for (int rg = 0; rg < 4; ++rg) { const int j0 = 16 * kt + 2 * rg + hi;
              const float a0 = (p0[4 * rg] + p0[4 * rg + 1]) + (p0[4 * rg + 2] + 0.5f * p0[4 * rg + 3]), b0 = 0.5f * p0[4 * rg + 3];
              const float a1 = (p1[4 * rg] + p1[4 * rg + 1]) + (p1[4 * rg + 2] + 0.5f * p1[4 * rg + 3]), b1 = 0.5f * p1[4 * rg + 3];
              atomicAdd(&pb[r32 * 65 + j0], (unsigned)(a0 * 67108864.f + 0.5f)); atomicAdd(&pb[r32 * 65 + j0 + 1], (unsigned)(b0 * 67108864.f + 0.5f));
              atomicAdd(&pb[r32 * 65 + j0 + 8], (unsigned)(a1 * 67108864.f + 0.5f)); atomicAdd(&pb[r32 * 65 + j0 + 9], (unsigned)(b1 * 67108864.f + 0.5f)); }
          bf16x8 pa0, pa1, pa2, pa3; packP(p0, p1, pa0, pa1, pa2, pa3);
          pv_tile(o, vb0, pa0, pa1, pa2, pa3); }
      if (hi == 0) li_l[r32] = g_cmp; asm volatile("s_waitcnt lgkmcnt(0)" ::: "memory");
      emit<0>(o, li_l, OTw, r32, hi); }
    const int lowk_ = tok0 - 511, wj_lo = lowk_ > 0 ? lowk_ >> 6 : 0, wj_hi = ((tok0 + 31) >> 6) + 1;
    const unsigned long long wtiles = ((wj_hi >= 64) ? ~0ull : ((1ull << wj_hi) - 1ull)) & ~((1ull << wj_lo) - 1ull);
    const bf16* Kw = KVQ + (size_t)b * SEQ * NKVQ + 4 * 512 + g * 128; const bf16* Vw = KVQ + (size_t)b * SEQ * NKVQ + 5 * 512 + g * 128;
    Stage SW; stage_load(SW, Kw, Vw, NKVQ, wj_lo * KVBLK, sr, sc, true);
    __syncthreads();
#pragma unroll 1
    for (int tt = 0; tt < 4; ++tt) { const int tok = 4 * wid + tt; const bool valid = lane <= qb; const bool forced = lane == 0 || lane == qb;
        const unsigned key = forced ? 0xFFFFFFFFu : pb[tok * 65 + lane]; int rank = 0;
        for (int i = 0; i <= qb; ++i) { const unsigned ki = (unsigned)__builtin_amdgcn_readlane((int)key, i); rank += (ki > key || (ki == key && i < lane)) ? 1 : 0; }
        const unsigned long long mk = __ballot(valid && rank < 16);
        if (lane == 0) { selm[2 * tok] = (unsigned)mk; selm[2 * tok + 1] = (unsigned)(mk >> 32); } }
    __syncthreads();
    const unsigned long long mymask = (unsigned long long)selm[2 * r32] | ((unsigned long long)selm[2 * r32 + 1] << 32);
    unsigned ulo = (unsigned)mymask, uhi = (unsigned)(mymask >> 32);
#pragma unroll
    for (int o_ = 1; o_ < 32; o_ <<= 1) { ulo |= __shfl_xor(ulo, o_); uhi |= __shfl_xor(uhi, o_); }
    const unsigned long long uni = (unsigned long long)(unsigned)__builtin_amdgcn_readfirstlane((int)ulo) | ((unsigned long long)(unsigned)__builtin_amdgcn_readfirstlane((int)uhi) << 32);
    { const bf16* Ks = KVQ + (size_t)b * SEQ * NKVQ + 2 * 512 + g * 128; const bf16* Vs = KVQ + (size_t)b * SEQ * NKVQ + 3 * 512 + g * 128;
      Stage SS;
      flash_pass<0, 1>(lds, Kw, Vw, NKVQ, wtiles, t, qb, 0ull, qr, c2, g_win, OTw, SW, Ks, Vs, &SS, tid, wid, lane);
      flash_pass<1, 2>(lds, Ks, Vs, NKVQ, uni, t, qb, mymask, qr, c2, g_sel, OTw, SS, nullptr, nullptr, nullptr, tid, wid, lane); }
    __syncthreads();
    { const int tok = tid >> 4, ch = tid & 15;
      const char* src = lds + O_OT + tok * 2048 + ch * 128; unsigned char* dst = (unsigned char*)(F.ws + WS_A3) + ((size_t)b * SEQ + tok0 + tok) * DM + g * 1024 + ch * 64;
#pragma unroll
      for (int i = 0; i < 4; ++i) { const v4u w0 = *(const v4u*)(src + i * 32), w1 = *(const v4u*)(src + i * 32 + 16); v4u q; const unsigned ws_[8] = {w0.x, w0.y, w0.z, w0.w, w1.x, w1.y, w1.z, w1.w}; int qq[4];
#pragma unroll
          for (int e = 0; e < 4; ++e) { int t_ = __builtin_amdgcn_cvt_pk_fp8_f32(bf_lo(ws_[2 * e]) * 64.f, bf_hi(ws_[2 * e]) * 64.f, 0, false); qq[e] = __builtin_amdgcn_cvt_pk_fp8_f32(bf_lo(ws_[2 * e + 1]) * 64.f, bf_hi(ws_[2 * e + 1]) * 64.f, t_, true); }
          q.x = (unsigned)qq[0]; q.y = (unsigned)qq[1]; q.z = (unsigned)qq[2]; q.w = (unsigned)qq[3]; *(v4u*)(dst + i * 16) = q; } }
    __syncthreads();
}
#undef KSWZ
#undef SBAR
}
__device__ __forceinline__ void nsa_attn_phase(Frame& F) {
    for (int ui = blockIdx.x; ui < 1024; ui += F.G) { const int vw = ui & 255, rnd = ui >> 8, bg = vw & 7, s = vw >> 3;
        const int tg = rnd == 0 ? s : rnd == 1 ? 63 - s : rnd == 2 ? 64 + s : 127 - s;
        nsa::unit(F, (char*)(F.lds + RING_OFF), bg >> 2, bg & 3, tg); }
}

struct Args { const float* in[18]; float* out; unsigned char* ws; int ph_lo, ph_hi; };
__global__ void __launch_bounds__(NWAVES * 64, 2) skel_fwd(Args args) {
    extern __shared__ __attribute__((aligned(16))) unsigned char lds[];
    Frame F;
    F.lds = (LAS unsigned char*)lds;
    F.MISC = (volatile LAS unsigned*)(F.lds + MISC_OFF);
    F.tid = threadIdx.x; F.lane = F.tid & 63; F.wave = __builtin_amdgcn_readfirstlane(F.tid >> 6);
    F.G = gridDim.x;
    unsigned char* ws = args.ws; F.ws = ws; F.out = args.out;
#pragma unroll
    for (int i = 0; i < 18; ++i) F.in[i] = args.in[i];
    F.ctl = (gu32*)(ws + WS_CTL);
    for (int u = F.tid; u < (LDS_BYTES - LDSCTL_OFF) / 4; u += NWAVES * 64) ((LAS unsigned*)(F.lds + LDSCTL_OFF))[u] = 0u;
    __syncthreads();
    XcdBarrier bar; bar.bar = (unsigned*)(F.ctl + CW_BAR); bar.x = 0; bar.st = nullptr;
    if (!MK_PER_PHASE) bar = xcd_barrier_post((unsigned*)(F.ctl + CW_BAR), F.MISC + 8);
    const int lo = args.ph_lo, hi = args.ph_hi;
#ifndef PHASE_MASK
#define PHASE_MASK 0x1ffff
#endif
#define IN(k) (((PHASE_MASK >> (k)) & 1) && lo <= (k) && (k) < hi)
#ifndef DUP_MASK
#define DUP_MASK 0
#endif
#ifndef PROBE_ML
#define PROBE_ML 0
#endif
#ifndef PROBE2
#define PROBE2 0
#endif
#ifndef CW_TAIL
#define CW_TAIL 10240
#endif
#ifndef TS_ON
#define TS_ON 0
#define TS_LO 0
#define TS_HI 0
#endif
#define REP(k) for (int rep_ = 0, nrep_ = 1 + ((DUP_MASK >> (k)) & 1); rep_ < nrep_; ++rep_, (rep_ < nrep_ ? xcd_barrier(bar) : (void)0))
#define SEAM(k) do { if (IN(k) && (hi > (k) + 1)) xcd_barrier(bar); if (TS_ON && (k) == TS_HI) ts1 = __builtin_amdgcn_s_memrealtime(); } while (0)
    unsigned long long ts0 = 0, ts1 = 0;
    bf16* XB = (bf16*)(ws + WS_XB); bf16* A3 = (bf16*)(ws + WS_A3); bf16* BIG = (bf16*)(ws + WS_BIG);
    bf16* X1 = (bf16*)(ws + WS_X1); bf16* X2 = (bf16*)(ws + WS_X2); bf16* X3 = X1;

    if (TS_ON && 0 == TS_LO) ts0 = __builtin_amdgcn_s_memrealtime(); if (IN(0)) REP(0) { if (Q8_WIN_O) convert_strips(F, (int)blockIdx.x, F.G, QS_NSTRIPS, QS_NSTRIPS + 128); p0_prologue(F); } SEAM(0);
    if (TS_ON && 1 == TS_LO) ts0 = __builtin_amdgcn_s_memrealtime(); if (IN(1)) REP(1) {
        { pg8::Gemm g{XB, (const bf16*)(ws + WS_WIN), MTOK, WIN_BF, DM}; pg8::StaticOrder S; S.init(MTOK, WIN_BF, F.G, (int)blockIdx.x);
          pg8::EpiBf16<0> E{BIG, M_MAIN, nullptr};
          pg8::gemm_phase<pg8::EpiBf16<0>, pg8::StaticOrder, true, true>(F.lds + RING_OFF, g, S, E); }
        if (Q8_WIN_O) {
            pg8::Gemm g{(const bf16*)(ws + WS_XQ), (const bf16*)(ws + WS_WINQ), MTOK, M_MAIN - WIN_BF, DM}; pg8::StaticOrder S; S.init(MTOK, M_MAIN - WIN_BF, F.G, (int)blockIdx.x);
            pg8::EpiQ8<0> E{BIG + WIN_BF, M_MAIN, (const float*)(ws + CTL_CMAX) + 53248, (const float*)(ws + WS_RS) + 24576};
            pg8::gemm_phase<pg8::EpiQ8<0>, pg8::StaticOrder, true, true, 2>(F.lds + RING_OFF, g, S, E); }
        gates1_phase(F);
    } SEAM(1);
    if (TS_ON && 2 == TS_LO) ts0 = __builtin_amdgcn_s_memrealtime(); if (IN(2)) REP(2) {
        const int bid = (int)blockIdx.x;
        if (F.G == 256) {
            const int x = bid & 7, y = bid >> 3;
            if (x < 4) mlstm_phase(F, (x * 4 + (y >> 3)) * 8 + (y & 7), 128);
            else if (!(PROBE_ML && rep_)) { const int wk = (y * 4 + (x - 4)) * NWAVES + F.wave; convert_narrow(F, 64, 256, wk, 128 * NWAVES); if (Q8_STRIPS) convert_strips(F, (x - 4) * 32 + y, 128); convert_wide(F, CW_EARLY, CW_TOTAL, wk, 128 * NWAVES); }
        } else {
            mlstm_phase(F, bid, F.G); if (Q8_STRIPS) convert_strips(F, bid, F.G); convert_wide(F, CW_EARLY, CW_TOTAL, bid * NWAVES + F.wave, F.G * NWAVES); convert_narrow(F, 64, 256, bid * NWAVES + F.wave, F.G * NWAVES);
        }
    } SEAM(2);
#if PROBE2 == 1
    { xcd_barrier(bar); const int bid = (int)blockIdx.x, x = bid & 7, y = bid >> 3; if (x < 4) mlstm_phase(F, (x * 4 + (y >> 3)) * 8 + (y & 7), 128); xcd_barrier(bar); }
#elif PROBE2 == 2
    { xcd_barrier(bar); const int bid = (int)blockIdx.x, x = bid & 7, y = bid >> 3; if (x >= 4) { const int wk = (y * 4 + (x - 4)) * NWAVES + F.wave; convert_wide(F, CW_EARLY, CW_TOTAL, wk, 128 * NWAVES); } xcd_barrier(bar); }
#elif PROBE2 == 4
    { xcd_barrier(bar); const int bid = (int)blockIdx.x, x = bid & 7, y = bid >> 3;
      if (x < 4) mlstm_phase(F, (x * 4 + (y >> 3)) * 8 + (y & 7), 128);
      else { const int wk = (y * 4 + (x - 4)) * NWAVES + F.wave; convert_wide(F, CW_EARLY, CW_TOTAL, wk, 128 * NWAVES); }
      xcd_barrier(bar); }
#elif PROBE2 == 3
    { xcd_barrier(bar); convert_wide(F, CW_EARLY, CW_TOTAL, blockIdx.x * NWAVES + F.wave, F.G * NWAVES); xcd_barrier(bar); }
#endif
    if (TS_ON && 3 == TS_LO) ts0 = __builtin_amdgcn_s_memrealtime(); if (IN(3)) REP(3) { gating_phase(F);
        if (Q8_WMO && !Q8_STRIPS) wquant_phase(F, (const bf16*)(ws + WS_WMO), (const float*)(ws + CTL_CMAX) + 49152, (unsigned char*)(ws + WS_WMOQ), DM);
        if ((Q8_UP_MASK & 1) && !Q8_STRIPS) wquant_phase(F, (const bf16*)(ws + WS_WUP0), (const float*)(ws + CTL_CMAX), (unsigned char*)(ws + WS_WUPQ0), DFF);
        if ((Q8_UP_MASK & 2) && !Q8_STRIPS) wquant_phase(F, (const bf16*)(ws + WS_WUP1), (const float*)(ws + CTL_CMAX) + 16384, (unsigned char*)(ws + WS_WUPQ1), DFF);
        if (Q8_KVQ && !Q8_STRIPS) wquant_phase(F, (const bf16*)(ws + WS_WKVQ), (const float*)(ws + CTL_CMAX) + 32768, (unsigned char*)(ws + WS_WKVQ8), NKVQ);
        if (blockIdx.x == 0) { const float* pp = (const float*)(ws + WS_POSP); float* posb = (float*)(ws + WS_POSB);
            for (int i = F.tid; i < 1024; i += NWAVES * 64) { float a = 0.f;
#pragma unroll 8
                for (int ch = 0; ch < 32; ++ch) a += pp[ch * 1024 + i];
                posb[i] = a; } }
    } SEAM(3);
    if (TS_ON && 4 == TS_LO) ts0 = __builtin_amdgcn_s_memrealtime(); if (IN(4)) REP(4) {
        pg8::StaticOrder S; S.init(MTOK, DM, F.G, (int)blockIdx.x);
        if (Q8_WMO) { pg8::Gemm g{A3, (const bf16*)(ws + WS_WMOQ), MTOK, DM, DM};
            pg8::EpiRes<false, true, true> E{F.in[0], X1, (float*)(ws + WS_PART), DM, 1.f, nullptr, (const float*)(ws + WS_RS) + 24576, (const float*)(ws + CTL_CMAX) + 49152};
            pg8::gemm_phase<pg8::EpiRes<false, true, true>, pg8::StaticOrder, true, true, 2>(F.lds + RING_OFF, g, S, E); }
        else { pg8::Gemm g{A3, (const bf16*)(ws + WS_WMO), MTOK, DM, DM};
            pg8::EpiRes<false, true> E{F.in[0], X1, (float*)(ws + WS_PART), DM};
            pg8::gemm_phase<pg8::EpiRes<false, true>, pg8::StaticOrder, true, true>(F.lds + RING_OFF, g, S, E); }
    } SEAM(4);
    if (TS_ON && 5 == TS_LO) ts0 = __builtin_amdgcn_s_memrealtime(); if (IN(5)) REP(5) { if (Q8_UP_MASK & 1) rstd_phase(F, (float*)(ws + WS_RS), X1, (unsigned char*)(ws + WS_XQ), (float*)(ws + WS_RS) + 24576); else rstd_phase(F, (float*)(ws + WS_RS)); } SEAM(5);
    if (TS_ON && 6 == TS_LO) ts0 = __builtin_amdgcn_s_memrealtime(); if (IN(6)) REP(6) {
        pg8::StaticOrder S; S.init(MTOK, DFF, F.G, (int)blockIdx.x);
        if (Q8_UP_MASK & 1) { pg8::Gemm g{(const bf16*)(ws + WS_XQ), (const bf16*)(ws + WS_WUPQ0), MTOK, DFF, DM};
            pg8::EpiQ8<2> E{BIG, DFF, (const float*)(ws + CTL_CMAX), (const float*)(ws + WS_RS) + 24576};
            pg8::gemm_phase<pg8::EpiQ8<2>, pg8::StaticOrder, true, true, 2>(F.lds + RING_OFF, g, S, E); }
        else { pg8::Gemm g{X1, (const bf16*)(ws + WS_WUP0), MTOK, DFF, DM};
            pg8::EpiBf16<2, true> E{BIG, DFF, (const float*)(ws + WS_RS)};
            pg8::gemm_phase<pg8::EpiBf16<2, true>, pg8::StaticOrder, true, true>(F.lds + RING_OFF, g, S, E); }
    } SEAM(6);
    if (TS_ON && 7 == TS_LO) ts0 = __builtin_amdgcn_s_memrealtime(); if (IN(7)) REP(7) {
        pg8::Gemm g{BIG, (const bf16*)(ws + WS_WDN0), MTOK, DM, DFF}; pg8::StaticOrder S; S.init(MTOK, DM, F.G, (int)blockIdx.x);
        pg8::EpiRes<true, true> E{X1, X2, (float*)(ws + WS_PART), DM, 1.f, Q8_KVQ ? nullptr : (unsigned char*)(ws + WS_HR)};
        pg8::gemm_phase<pg8::EpiRes<true, true>, pg8::StaticOrder, true, true>(F.lds + RING_OFF, g, S, E);
    } SEAM(7);
    if (TS_ON && 8 == TS_LO) ts0 = __builtin_amdgcn_s_memrealtime(); if (IN(8)) REP(8) { if (Q8_KVQ) rstd_phase(F, (float*)(ws + WS_RS) + 8192, X2, (unsigned char*)(ws + WS_XQ), (float*)(ws + WS_RS) + 24576); else rstd_phase(F, (float*)(ws + WS_RS) + 8192); } SEAM(8);
    if (TS_ON && 9 == TS_LO) ts0 = __builtin_amdgcn_s_memrealtime(); if (IN(9)) REP(9) {
        pg8::StaticOrder S; S.init(MTOK, NKVQ, F.G, (int)blockIdx.x);
        if (Q8_KVQ) { pg8::Gemm g{(const bf16*)(ws + WS_XQ), (const bf16*)(ws + WS_WKVQ8), MTOK, NKVQ, DM};
            pg8::EpiQ8<0> E{BIG, NKVQ, (const float*)(ws + CTL_CMAX) + 32768, (const float*)(ws + WS_RS) + 24576};
            pg8::gemm_phase<pg8::EpiQ8<0>, pg8::StaticOrder, true, true, 2>(F.lds + RING_OFF, g, S, E); }
        else { pg8::Gemm g{(const bf16*)(ws + WS_HR), (const bf16*)(ws + WS_WKVQ), MTOK, NKVQ, DM};
            pg8::EpiBf16<0, true> E{BIG, NKVQ, (const float*)(ws + WS_RS) + 8192, 1.f / 256.f};
            pg8::gemm_phase<pg8::EpiBf16<0, true>, pg8::StaticOrder, true, true, 1>(F.lds + RING_OFF, g, S, E); }
        gates2_phase(F);
    } SEAM(9);
    if (TS_ON && 10 == TS_LO) ts0 = __builtin_amdgcn_s_memrealtime(); if (IN(10)) REP(10) { nsa_prep_phase(F); } SEAM(10);
    if (TS_ON && 11 == TS_LO) ts0 = __builtin_amdgcn_s_memrealtime();
    if (TS_ON && 12 == TS_LO) ts0 = __builtin_amdgcn_s_memrealtime(); if (IN(12)) REP(12) { nsa_attn_phase(F); } SEAM(12);
    if (TS_ON && 13 == TS_LO) ts0 = __builtin_amdgcn_s_memrealtime(); if (IN(13)) REP(13) {
        pg8::Gemm g{A3, (const bf16*)(ws + WS_WNO), MTOK, DM, DM}; pg8::StaticOrder S; S.init(MTOK, DM, F.G, (int)blockIdx.x);
        pg8::EpiRes<true, true> E{X2, X3, (float*)(ws + WS_PART), DM, 1.f / 16384.f};
        pg8::gemm_phase<pg8::EpiRes<true, true>, pg8::StaticOrder, true, true, 1>(F.lds + RING_OFF, g, S, E);
    } SEAM(13);
    if (TS_ON && 14 == TS_LO) ts0 = __builtin_amdgcn_s_memrealtime(); if (IN(14)) REP(14) { if (Q8_UP_MASK & 2) rstd_phase(F, (float*)(ws + WS_RS) + 16384, X3, (unsigned char*)(ws + WS_XQ), (float*)(ws + WS_RS) + 24576); else rstd_phase(F, (float*)(ws + WS_RS) + 16384); } SEAM(14);
    if (TS_ON && 15 == TS_LO) ts0 = __builtin_amdgcn_s_memrealtime(); if (IN(15)) REP(15) {
        pg8::StaticOrder S; S.init(MTOK, DFF, F.G, (int)blockIdx.x);
        if (Q8_UP_MASK & 2) { pg8::Gemm g{(const bf16*)(ws + WS_XQ), (const bf16*)(ws + WS_WUPQ1), MTOK, DFF, DM};
            pg8::EpiQ8<2> E{BIG, DFF, (const float*)(ws + CTL_CMAX) + 16384, (const float*)(ws + WS_RS) + 24576};
            pg8::gemm_phase<pg8::EpiQ8<2>, pg8::StaticOrder, true, true, 2>(F.lds + RING_OFF, g, S, E); }
        else { pg8::Gemm g{X3, (const bf16*)(ws + WS_WUP1), MTOK, DFF, DM};
            pg8::EpiBf16<2, true> E{BIG, DFF, (const float*)(ws + WS_RS) + 16384};
            pg8::gemm_phase<pg8::EpiBf16<2, true>, pg8::StaticOrder, true, true>(F.lds + RING_OFF, g, S, E); }
    } SEAM(15);
    if (TS_ON && 16 == TS_LO) ts0 = __builtin_amdgcn_s_memrealtime(); if (IN(16)) REP(16) {
        pg8::Gemm g{BIG, (const bf16*)(ws + WS_WDN1), MTOK, DM, DFF}; pg8::StaticOrder S; S.init(MTOK, DM, F.G, (int)blockIdx.x);
        pg8::EpiRes<true, false> E{X3, F.out, nullptr, DM};
        pg8::gemm_phase<pg8::EpiRes<true, false>, pg8::StaticOrder, true, true>(F.lds + RING_OFF, g, S, E);
    }
#if TS_ON
    if (TS_HI == 16) ts1 = __builtin_amdgcn_s_memrealtime();
    xcd_barrier(bar);
    if (blockIdx.x == 0 && F.tid == 0) F.out[0] = (float)(ts1 - ts0) * 0.01f;
#endif
#undef IN
#undef SEAM
}

extern "C" void kernel_launch(void* const* d_in, const int* in_sizes, int n_in, void* d_out, int out_size, void* d_ws, size_t ws_size, hipStream_t stream) {
    static int grid = 0;
    if (grid == 0) {
        if (n_in != 18 || in_sizes[0] != MTOK * DM || out_size != MTOK * DM || ws_size < WS_END) { fprintf(stderr, "kernel_launch: unexpected shapes (n_in %d, in0 %d, out %d, ws %zu); nothing launched\n", n_in, n_in > 0 ? in_sizes[0] : -1, out_size, ws_size); grid = -1; return; }
        int dev = 0, cus = 0, per_cu = 0;
        if (hipGetDevice(&dev) != hipSuccess || hipDeviceGetAttribute(&cus, hipDeviceAttributeMultiprocessorCount, dev) != hipSuccess) { grid = -1; return; }
        if (hipFuncSetAttribute((const void*)skel_fwd, hipFuncAttributeMaxDynamicSharedMemorySize, LDS_BYTES) != hipSuccess) { fprintf(stderr, "kernel_launch: hipFuncSetAttribute failed\n"); grid = -1; return; }
        if (hipOccupancyMaxActiveBlocksPerMultiprocessor(&per_cu, (const void*)skel_fwd, NWAVES * 64, LDS_BYTES) != hipSuccess || per_cu < 1) fprintf(stderr, "kernel_launch: occupancy query reports %d\n", per_cu);
        (void)hipGetLastError();
        grid = cus;
    }
    if (grid < 0) return;
    if (hipMemsetAsync((char*)d_ws + WS_CTL, 0, CTL_ZERO_BYTES, stream) != hipSuccess) return;
    Args a{};
    for (int i = 0; i < 18; ++i) a.in[i] = (const float*)d_in[i];
    a.out = (float*)d_out; a.ws = (unsigned char*)d_ws;
#if MK_PER_PHASE
    for (int p = 0; p < N_PHASES; ++p) { a.ph_lo = p; a.ph_hi = p + 1; hipLaunchKernelGGL(skel_fwd, dim3(grid), dim3(NWAVES * 64), LDS_BYTES, stream, a); }
#else
    a.ph_lo = 0; a.ph_hi = N_PHASES; hipLaunchKernelGGL(skel_fwd, dim3(grid), dim3(NWAVES * 64), LDS_BYTES, stream, a);
#endif
}
```

```cpp
#include <hip/hip_runtime.h>
#include <hip/hip_bf16.h>
#include <cstdio>
#include <cstdint>
#include <cmath>
namespace pg8 {
#define PG8_LAS __attribute__((address_space(3)))
typedef unsigned short bf16_t;
typedef short bf16x8 __attribute__((ext_vector_type(8)));
typedef float f32x4 __attribute__((ext_vector_type(4)));
typedef unsigned u32x4 __attribute__((ext_vector_type(4)));
typedef int v8i32_t __attribute__((ext_vector_type(8)));
typedef int v4i32_t __attribute__((ext_vector_type(4)));
constexpr int BM = 256, BK = 64, HALF = 128, HTB = HALF * BK * 2  , STAGE_BYTES = 8 * HTB, NXCD = 8, WGM = 8;

__host__ __device__ __forceinline__ int lds_byte(int r, int c) { const int st = (r >> 4) * 2 + (c >> 5), rr = r & 15, cc = c & 31, ob = rr * 64 + cc * 2; return st * 1024 + (ob ^ (((ob >> 9) & 1) << 5)); }
__host__ __device__ __forceinline__ void stage_rc(int b, int& R, int& C) { const int st = b / 1024, sb = b % 1024, swz = sb ^ (((sb >> 9) & 1) << 5); R = (st >> 1) * 16 + swz / 64; C = (st & 1) * 32 + (swz % 64) / 2; }
__host__ __device__ __forceinline__ int perm32(int rho) { const int n = rho >> 4, i = rho & 15; return 8 * (i >> 2) + 4 * n + (i & 3); }

struct Unit { int pm, pn; };
struct Gemm { const bf16_t* A; const bf16_t* Bt; int M, N, K; };

struct StaticOrder {
    int nM, nN, nwg, G, c;
    __host__ __device__ void init(int M, int N, int G_, int c_) { nM = M / BM; nN = N / BM; nwg = nM * nN; G = G_; c = c_; }
    __host__ __device__ bool next(int i, Unit& u) const {
        const long L = (long)i * G + c; if (L >= nwg) return false;
        int wgid = (int)L; { const int q = nwg / NXCD, r = nwg % NXCD, xcd = wgid % NXCD, off = wgid / NXCD; wgid = (xcd < r ? xcd * (q + 1) : r * (q + 1) + (xcd - r) * q) + off; }
        const int nig = WGM * nN, gid = wgid / nig, fm = gid * WGM, gsz = (nM - fm) < WGM ? (nM - fm) : WGM;
        u.pm = fm + ((wgid % nig) % gsz); u.pn = (wgid % nig) / gsz; return true;
    }
    __device__ __forceinline__ void a_ready(const Unit&) const {}
    __device__ __forceinline__ void done(const Unit&) const {}
};

typedef float f32x2c __attribute__((ext_vector_type(2))); typedef __bf16 bf16x2c __attribute__((ext_vector_type(2)));
__device__ __forceinline__ unsigned cvt_pk_bf16(float lo, float hi) { f32x2c v = {lo, hi}; bf16x2c b = __builtin_convertvector(v, bf16x2c); return __builtin_bit_cast(unsigned, b); }
template <int ACT  , bool SCALED = false> struct EpiBf16 {
    static constexpr bool PERM = true, AFTER_DRAIN = false;
    bf16_t* O; int ldc; const float* rstd; float osc = 1.f;
    __device__ __forceinline__ void operator()(const f32x4 (&acc)[2][2][4][2], const Unit& u, int wr, int wc, int fr, int fq) const {
        const int row0 = u.pm * BM + wr * 64 + fr, col0 = u.pn * BM + wc * 32 + 8 * fq;
#pragma unroll
        for (int ai = 0; ai < 2; ++ai)
#pragma unroll
            for (int m = 0; m < 4; ++m) { const int row = row0 + ai * HALF + m * 16; bf16_t* rowp = O + (size_t)row * ldc + col0;
                const float rs = (SCALED ? rstd[row] : 1.f) * osc;
#pragma unroll
                for (int bj = 0; bj < 2; ++bj) { f32x4 v0 = acc[ai][bj][m][0], v1 = acc[ai][bj][m][1];
                    v0 = v0 * rs; v1 = v1 * rs;
                    if (ACT == 2) {
#pragma unroll
                        for (int e = 0; e < 4; ++e) { const float a = fmaxf(v0[e], 0.f), b = fmaxf(v1[e], 0.f); v0[e] = a * a; v1[e] = b * b; } }
                    u32x4 w; w.x = cvt_pk_bf16(v0[0], v0[1]); w.y = cvt_pk_bf16(v0[2], v0[3]); w.z = cvt_pk_bf16(v1[0], v1[1]); w.w = cvt_pk_bf16(v1[2], v1[3]);
                    *(u32x4*)(rowp + bj * HALF) = w; } }
    }
};
template <bool BASE_BF16, bool OUT_BF16, bool Q8 = false> struct EpiRes {
    static constexpr bool PERM = true, AFTER_DRAIN = false;
    const void* base; void* out; float* part; int ldc; float osc = 1.f; unsigned char* o8 = nullptr; const float* ra = nullptr; const float* cmax = nullptr;
    __device__ __forceinline__ void operator()(const f32x4 (&acc)[2][2][4][2], const Unit& u, int wr, int wc, int fr, int fq) const {
        const int col0 = u.pn * BM + wc * 32 + 8 * fq;
        f32x4 cs[2][2];
        if (Q8) {
#pragma unroll
            for (int bj = 0; bj < 2; ++bj) { cs[bj][0] = *(const f32x4*)(cmax + col0 + bj * HALF) * (1.f / 127.f); cs[bj][1] = *(const f32x4*)(cmax + col0 + bj * HALF + 4) * (1.f / 127.f); } }
#pragma unroll
        for (int ai = 0; ai < 2; ++ai)
#pragma unroll
            for (int m = 0; m < 4; ++m) { const int row = u.pm * BM + ai * HALF + wr * 64 + m * 16 + fr; const size_t off = (size_t)row * ldc + col0; float s = 0.f; float rr = 0.f; if (Q8) rr = ra[row];
#pragma unroll
                for (int bj = 0; bj < 2; ++bj) { f32x4 b0, b1;
                    if (BASE_BF16) { const u32x4 w = *(const u32x4*)((const bf16_t*)base + off + bj * HALF);
                        b0 = (f32x4){__uint_as_float(w.x << 16), __uint_as_float(w.x & 0xffff0000u), __uint_as_float(w.y << 16), __uint_as_float(w.y & 0xffff0000u)};
                        b1 = (f32x4){__uint_as_float(w.z << 16), __uint_as_float(w.z & 0xffff0000u), __uint_as_float(w.w << 16), __uint_as_float(w.w & 0xffff0000u)}; }
                    else { b0 = *(const f32x4*)((const float*)base + off + bj * HALF); b1 = *(const f32x4*)((const float*)base + off + bj * HALF + 4); }
                    f32x4 o0, o1;
                    if (Q8) { const v4i32_t i0 = __builtin_bit_cast(v4i32_t, acc[ai][bj][m][0]), i1 = __builtin_bit_cast(v4i32_t, acc[ai][bj][m][1]);
#pragma unroll
                        for (int e = 0; e < 4; ++e) { o0[e] = b0[e] + (float)i0[e] * rr * cs[bj][0][e]; o1[e] = b1[e] + (float)i1[e] * rr * cs[bj][1][e]; } }
                    else { o0 = b0 + acc[ai][bj][m][0] * osc; o1 = b1 + acc[ai][bj][m][1] * osc; }
                    if (o8) { typedef int i32x2 __attribute__((ext_vector_type(2))); i32x2 q; q.x = __builtin_amdgcn_cvt_pk_fp8_f32(o0[0], o0[1], 0, false); q.x = __builtin_amdgcn_cvt_pk_fp8_f32(o0[2], o0[3], q.x, true);
                        q.y = __builtin_amdgcn_cvt_pk_fp8_f32(o1[0], o1[1], 0, false); q.y = __builtin_amdgcn_cvt_pk_fp8_f32(o1[2], o1[3], q.y, true); *(i32x2*)(o8 + off + bj * HALF) = q; }
                    s += ((o0[0] * o0[0] + o0[1] * o0[1]) + (o0[2] * o0[2] + o0[3] * o0[3])) + ((o1[0] * o1[0] + o1[1] * o1[1]) + (o1[2] * o1[2] + o1[3] * o1[3]));
                    if (OUT_BF16) { u32x4 w; w.x = cvt_pk_bf16(o0[0], o0[1]); w.y = cvt_pk_bf16(o0[2], o0[3]); w.z = cvt_pk_bf16(o1[0], o1[1]); w.w = cvt_pk_bf16(o1[2], o1[3]); *(u32x4*)((bf16_t*)out + off + bj * HALF) = w; }
                    else { *(f32x4*)((float*)out + off + bj * HALF) = o0; *(f32x4*)((float*)out + off + bj * HALF + 4) = o1; } }
                if (part) { s += __shfl_xor(s, 16); s += __shfl_xor(s, 32); if (fq == 0) part[(size_t)row * 64 + u.pn * 4 + wc] = s; } }
    }
};
template <int ACT> struct EpiQ8 {
    static constexpr bool PERM = true, AFTER_DRAIN = false;
    bf16_t* O; int ldc; const float* cmax; const float* ra;
    __device__ __forceinline__ void operator()(const f32x4 (&acc)[2][2][4][2], const Unit& u, int wr, int wc, int fr, int fq) const {
        const int row0 = u.pm * BM + wr * 64 + fr, col0 = u.pn * BM + wc * 32 + 8 * fq;
        f32x4 cs[2][2];
#pragma unroll
        for (int bj = 0; bj < 2; ++bj) { cs[bj][0] = *(const f32x4*)(cmax + col0 + bj * HALF) * (1.f / 127.f); cs[bj][1] = *(const f32x4*)(cmax + col0 + bj * HALF + 4) * (1.f / 127.f); }
#pragma unroll
        for (int ai = 0; ai < 2; ++ai)
#pragma unroll
            for (int m = 0; m < 4; ++m) { const int row = row0 + ai * HALF + m * 16; bf16_t* rowp = O + (size_t)row * ldc + col0; const float rr = ra[row];
#pragma unroll
                for (int bj = 0; bj < 2; ++bj) { const v4i32_t i0 = __builtin_bit_cast(v4i32_t, acc[ai][bj][m][0]), i1 = __builtin_bit_cast(v4i32_t, acc[ai][bj][m][1]); f32x4 v0, v1;
#pragma unroll
                    for (int e = 0; e < 4; ++e) { float a = (float)i0[e] * rr * cs[bj][0][e], b = (float)i1[e] * rr * cs[bj][1][e]; if (ACT == 2) { a = fmaxf(a, 0.f); b = fmaxf(b, 0.f); a *= a; b *= b; } v0[e] = a; v1[e] = b; }
                    u32x4 w; w.x = cvt_pk_bf16(v0[0], v0[1]); w.y = cvt_pk_bf16(v0[2], v0[3]); w.z = cvt_pk_bf16(v1[0], v1[1]); w.w = cvt_pk_bf16(v1[2], v1[3]);
                    *(u32x4*)(rowp + bj * HALF) = w; } }
    }
};
template <class Epi, class Sched, bool ALIGN_EPI = false, bool SP2 = false, int QM = 0>
__device__ __forceinline__ void gemm_phase(PG8_LAS unsigned char* lds, const Gemm g, const Sched& S, const Epi& E) {
    const int tid = threadIdx.x, wid = __builtin_amdgcn_readfirstlane(tid >> 6), lane = tid & 63, wr = wid >> 2, wc = wid & 3, fr = lane & 15, fq = lane >> 4;
    constexpr bool F8 = QM == 1, I8 = QM == 2;
    constexpr int ES = QM ? 1 : 2;
    const int K = g.K, nt = K / (QM ? 2 * BK : BK);
    unsigned voffA[2], voffB[2];
#pragma unroll
    for (int i = 0; i < 2; ++i) { int R, C; stage_rc(tid * 16 + i * 8192, R, C); const int Rb = Epi::PERM ? ((R & ~31) + perm32(R & 31)) : R;
        voffA[i] = (unsigned)(R * K * ES + C * 2); voffB[i] = (unsigned)(Rb * K * ES + C * 2); }
    const size_t kstep = (size_t)(BK * 2);
    const size_t hstep = (size_t)HALF * K * ES;
    const size_t tstep = 2 * hstep;
    const unsigned ldsw = (unsigned)wid * 1024u;
    const int aoff = lds_byte(wr * 64 + fr, F8 ? fq * 16 : fq * 8), boff = lds_byte(wc * 32 + fr, F8 ? fq * 16 : fq * 8);
#define PG8_SA(b, h) (((b) * 2 + (h)) * HTB)
#define PG8_SB(b, h) ((4 + (b) * 2 + (h)) * HTB)
#define PG8_STAGE(bufoff, gbase, voff) do { _Pragma("unroll") for (int _i = 0; _i < 2; ++_i) \
        __builtin_amdgcn_global_load_lds((const unsigned*)((const char*)(gbase) + (voff)[_i]), (PG8_LAS unsigned*)(lds + (bufoff) + ldsw + _i * 8192), 16, 0, 0); } while (0)
#define PG8_LDA(dst, b, h) do { if constexpr (F8) { _Pragma("unroll") for (int m = 0; m < 4; ++m) dst##8[m] = *(const PG8_LAS v8i32_t*)(lds + PG8_SA(b, h) + aoff + m * 2048); } \
        else { _Pragma("unroll") for (int m = 0; m < 4; ++m) _Pragma("unroll") for (int k = 0; k < 2; ++k) dst[m][k] = *(const PG8_LAS bf16x8*)(lds + PG8_SA(b, h) + aoff + m * 2048 + k * 1024); } } while (0)
#define PG8_LDB(dst, b, h) do { if constexpr (F8) { _Pragma("unroll") for (int n = 0; n < 2; ++n) dst##8[n] = *(const PG8_LAS v8i32_t*)(lds + PG8_SB(b, h) + boff + n * 2048); } \
        else { _Pragma("unroll") for (int n = 0; n < 2; ++n) _Pragma("unroll") for (int k = 0; k < 2; ++k) dst[n][k] = *(const PG8_LAS bf16x8*)(lds + PG8_SB(b, h) + boff + n * 2048 + k * 1024); } } while (0)
#define PG8_MMA(ai, bj, At, Bt) do { __builtin_amdgcn_s_setprio(1); _Pragma("unroll") for (int m = 0; m < 4; ++m) _Pragma("unroll") for (int n = 0; n < 2; ++n) { \
        if constexpr (F8) asm volatile("v_mfma_scale_f32_16x16x128_f8f6f4 %0, %1, %2, %0, %3, %3 op_sel_hi:[0,0,0]" : "+v"(acc[ai][bj][m][n]) : "v"(Bt##8[n]), "v"(At##8[m]), "v"(scl8));   \
        else if constexpr (I8) { _Pragma("unroll") for (int k = 0; k < 2; ++k) acc[ai][bj][m][n] = __builtin_bit_cast(f32x4, __builtin_amdgcn_mfma_i32_16x16x64_i8(__builtin_bit_cast(v4i32_t, Bt[n][k]), __builtin_bit_cast(v4i32_t, At[m][k]), __builtin_bit_cast(v4i32_t, acc[ai][bj][m][n]), 0, 0, 0)); } \
        else { _Pragma("unroll") for (int k = 0; k < 2; ++k) acc[ai][bj][m][n] = __builtin_amdgcn_mfma_f32_16x16x32_bf16(Bt[n][k], At[m][k], acc[ai][bj][m][n], 0, 0, 0); } } \
        __builtin_amdgcn_s_setprio(0); } while (0)
#define PG8_WAIT_V(n) asm volatile("s_waitcnt vmcnt(" #n ")" ::: "memory")
#define PG8_WAIT_L(n) asm volatile("s_waitcnt lgkmcnt(" #n ")" ::: "memory")
#define PG8_BAR __builtin_amdgcn_s_barrier()
#define PG8_SCHED __builtin_amdgcn_sched_barrier(0)
    Unit cur, nxt; int ui = 0;
    if (!S.next(0, cur)) return;
    f32x4 acc[2][2][4][2];
#pragma unroll
    for (int a = 0; a < 2; ++a)
#pragma unroll
        for (int b = 0; b < 2; ++b)
#pragma unroll
            for (int m = 0; m < 4; ++m)
#pragma unroll
                for (int n = 0; n < 2; ++n) acc[a][b][m][n] = (f32x4){0.f, 0.f, 0.f, 0.f};
    bf16x8 At[4][2], B0[2][2], B1[2][2]; v8i32_t At8[4], B08[2], B18[2];
    int scl8 = 0x7F7F7F7F; asm volatile("" : "+v"(scl8));
    const char* cA = (const char*)g.A + (size_t)cur.pm * tstep; const char* cB = (const char*)g.Bt + (size_t)cur.pn * tstep;
    S.a_ready(cur);
    if constexpr (SP2) {
        PG8_STAGE(PG8_SB(0, 0), cB, voffB); PG8_STAGE(PG8_SB(0, 1), cB + hstep, voffB); PG8_STAGE(PG8_SA(0, 0), cA, voffA); PG8_STAGE(PG8_SA(0, 1), cA + hstep, voffA);
        if (wr == 1) PG8_BAR;
        PG8_WAIT_V(2); PG8_BAR;
        PG8_STAGE(PG8_SB(1, 0), cB + kstep, voffB); PG8_STAGE(PG8_SA(1, 0), cA + kstep, voffA); PG8_STAGE(PG8_SB(1, 1), cB + hstep + kstep, voffB);
        PG8_WAIT_V(6); PG8_BAR;
    } else {
        PG8_STAGE(PG8_SB(0, 0), cB, voffB); PG8_STAGE(PG8_SA(0, 0), cA, voffA); PG8_STAGE(PG8_SB(0, 1), cB + hstep, voffB); PG8_STAGE(PG8_SA(0, 1), cA + hstep, voffA);
        if (wr == 1) PG8_BAR;
        PG8_WAIT_V(4); PG8_BAR;
        PG8_STAGE(PG8_SB(1, 0), cB + kstep, voffB); PG8_STAGE(PG8_SA(1, 0), cA + kstep, voffA); PG8_STAGE(PG8_SB(1, 1), cB + hstep + kstep, voffB);
        PG8_WAIT_V(6); PG8_BAR;
    }
    for (;;) {
        const bool has_next = S.next(ui + 1, nxt);
        const char* nA = has_next ? (const char*)g.A + (size_t)nxt.pm * tstep : cA; const char* nB = has_next ? (const char*)g.Bt + (size_t)nxt.pn * tstep : cB;
        for (int t = 0; t < nt; t += 2) {
            const bool last = (t == nt - 2);
            const char* a1 = cA + (size_t)(t + 1) * kstep;
            const char* a2 = last ? nA : cA + (size_t)(t + 2) * kstep; const char* b2 = last ? nB : cB + (size_t)(t + 2) * kstep;
            const char* a3 = a2 + kstep; const char* b3 = b2 + kstep;
            if (last && has_next) S.a_ready(nxt);
            if constexpr (SP2) {
            PG8_LDB(B0, 0, 0); PG8_LDB(B1, 0, 1); PG8_SCHED; PG8_LDA(At, 0, 0); PG8_STAGE(PG8_SA(1, 1), a1 + hstep, voffA);
            PG8_WAIT_V(8); PG8_WAIT_L(0); PG8_BAR; PG8_MMA(0, 0, At, B0); PG8_MMA(0, 1, At, B1); PG8_BAR; PG8_SCHED;
            PG8_LDA(At, 0, 1); PG8_STAGE(PG8_SB(0, 0), b2, voffB); PG8_STAGE(PG8_SB(0, 1), b2 + hstep, voffB); PG8_STAGE(PG8_SA(0, 0), a2, voffA);
            PG8_WAIT_V(8); PG8_WAIT_L(0); PG8_BAR; PG8_MMA(1, 0, At, B0); PG8_MMA(1, 1, At, B1); PG8_BAR; PG8_SCHED;
            PG8_LDB(B0, 1, 0); PG8_LDB(B1, 1, 1); PG8_SCHED; PG8_LDA(At, 1, 0); PG8_STAGE(PG8_SA(0, 1), a2 + hstep, voffA);
            PG8_WAIT_V(8); PG8_WAIT_L(0); PG8_BAR; PG8_MMA(0, 0, At, B0); PG8_MMA(0, 1, At, B1); PG8_BAR; PG8_SCHED;
            PG8_LDA(At, 1, 1); PG8_STAGE(PG8_SB(1, 0), b3, voffB); PG8_STAGE(PG8_SB(1, 1), b3 + hstep, voffB); PG8_STAGE(PG8_SA(1, 0), a3, voffA);
            PG8_WAIT_V(8); PG8_WAIT_L(0); PG8_BAR; PG8_MMA(1, 0, At, B0); PG8_MMA(1, 1, At, B1); PG8_BAR; PG8_SCHED;
            } else {
            PG8_LDB(B0, 0, 0); PG8_SCHED; PG8_LDA(At, 0, 0); PG8_STAGE(PG8_SA(1, 1), a1 + hstep, voffA);
            PG8_WAIT_L(8); PG8_BAR; PG8_WAIT_L(0); PG8_MMA(0, 0, At, B0); PG8_BAR; PG8_SCHED;
            PG8_LDB(B1, 0, 1); PG8_STAGE(PG8_SB(0, 0), b2, voffB);
            PG8_BAR; PG8_WAIT_L(0); PG8_MMA(0, 1, At, B1); PG8_BAR;
            PG8_LDA(At, 0, 1); PG8_STAGE(PG8_SA(0, 0), a2, voffA);
            PG8_BAR; PG8_WAIT_L(0); PG8_MMA(1, 0, At, B0); PG8_BAR; PG8_SCHED;
            PG8_STAGE(PG8_SB(0, 1), b2 + hstep, voffB);
            PG8_WAIT_V(6); PG8_BAR; PG8_MMA(1, 1, At, B1); PG8_BAR;
            PG8_LDB(B0, 1, 0); PG8_SCHED; PG8_LDA(At, 1, 0); PG8_STAGE(PG8_SA(0, 1), a2 + hstep, voffA);
            PG8_WAIT_L(8); PG8_BAR; PG8_WAIT_L(0); PG8_MMA(0, 0, At, B0); PG8_BAR; PG8_SCHED;
            PG8_LDB(B1, 1, 1); PG8_STAGE(PG8_SB(1, 0), b3, voffB);
            PG8_BAR; PG8_WAIT_L(0); PG8_MMA(0, 1, At, B1); PG8_BAR;
            PG8_LDA(At, 1, 1); PG8_STAGE(PG8_SA(1, 0), a3, voffA);
            PG8_BAR; PG8_WAIT_L(0); PG8_MMA(1, 0, At, B0); PG8_BAR; PG8_SCHED;
            PG8_STAGE(PG8_SB(1, 1), b3 + hstep, voffB);
            PG8_WAIT_V(6); PG8_BAR; PG8_MMA(1, 1, At, B1); PG8_BAR;
            }
        }
        if constexpr (F8) { asm volatile("s_nop 15\n\ts_nop 15" ::: "memory"); PG8_SCHED; }
        if constexpr (ALIGN_EPI) { if (wr == 0) PG8_BAR; }
        if constexpr (!Epi::AFTER_DRAIN) { E(acc, cur, wr, wc, fr, fq); S.done(cur); }
        if (!has_next) break;
#pragma unroll
        for (int a = 0; a < 2; ++a)
#pragma unroll
            for (int b = 0; b < 2; ++b)
#pragma unroll
                for (int m = 0; m < 4; ++m)
#pragma unroll
                    for (int n = 0; n < 2; ++n) acc[a][b][m][n] = (f32x4){0.f, 0.f, 0.f, 0.f};
        cur = nxt; cA = nA; cB = nB; ++ui;
        if constexpr (ALIGN_EPI) { if (wr == 1) PG8_BAR; }
    }
    PG8_WAIT_V(0);
    if constexpr (!ALIGN_EPI) { if (wr == 0) PG8_BAR; }
    PG8_BAR;
    if constexpr (Epi::AFTER_DRAIN) { E.fused(acc, cur, wr, wc, fr, fq, lds, wid, lane); S.done(cur); }
#undef PG8_SA
#undef PG8_SB
#undef PG8_STAGE
#undef PG8_LDA
#undef PG8_LDB
#undef PG8_MMA
#undef PG8_WAIT_V
#undef PG8_WAIT_L
#undef PG8_BAR
#undef PG8_SCHED
}
}
#define GAS __attribute__((address_space(1)))
#define LAS __attribute__((address_space(3)))
typedef unsigned short bf16;
typedef unsigned v4u __attribute__((ext_vector_type(4)));
typedef float f32x4 __attribute__((ext_vector_type(4)));
typedef short bf16x8 __attribute__((ext_vector_type(8)));
typedef GAS unsigned gu32;
typedef GAS unsigned long long gu64;
#define RLX_AGENT __ATOMIC_RELAXED, __HIP_MEMORY_SCOPE_AGENT
#define LDS_WAIT() asm volatile("s_waitcnt lgkmcnt(0)" ::: "memory")
#define VM_WAIT() asm volatile("s_waitcnt vmcnt(0)" ::: "memory")
__device__ __forceinline__ unsigned long long rt() { return __builtin_amdgcn_s_memrealtime(); }

#define XB_TMO      128
#define XB_XCNT(j)  (256  + 64 * (j))
#define XB_XSUB(j)  (1280 + 64 * (j))
#define XB_XGEN(j)  (2304 + 64 * (j))
#define XB_TOP      3328
#define XB_TOPGEN   3392
#define XCD_BAR_WORDS 3456
#define XB_SPIN_CAP (1u << 18)

__device__ __forceinline__ unsigned xb_ld(unsigned* p)              { return __hip_atomic_load(p, __ATOMIC_RELAXED, __HIP_MEMORY_SCOPE_AGENT); }
__device__ __forceinline__ unsigned xb_add(unsigned* p, unsigned v) { return __hip_atomic_fetch_add(p, v, __ATOMIC_RELAXED, __HIP_MEMORY_SCOPE_AGENT); }
__device__ __forceinline__ unsigned xb_xcc_id() { return (unsigned)__builtin_amdgcn_s_getreg((3 << 11) | 20) & 0xFu; }
#define XB_SPIN(cond, bar) do { unsigned _sp = 0; while (cond) { __builtin_amdgcn_s_sleep(1); \
    if ((++_sp & 255u) == 0u) { if (xb_ld(&(bar)[XB_TMO])) break; if (_sp > XB_SPIN_CAP) { atomicAdd(&(bar)[XB_TMO], 1u); break; } } } } while (0)

struct XcdBarrier {
    unsigned* bar; unsigned x;
    volatile LAS unsigned* st;
};

__device__ __forceinline__ XcdBarrier xcd_barrier_post(unsigned* bar, volatile LAS unsigned* st) {
    XcdBarrier b; b.bar = bar; b.x = xb_xcc_id(); b.st = st;
    if (threadIdx.x == 0) (void)xb_add(&bar[XB_XCNT(b.x)], 1u);
    return b;
}
__device__ __forceinline__ void xcd_barrier_complete(unsigned* bar, unsigned x, unsigned& nloc, unsigned& nx) {
    const unsigned G = gridDim.x * gridDim.y * gridDim.z;
    unsigned sum, cnt, mine, sp = 0u;
    for (;;) {
        sum = 0u; cnt = 0u; mine = 0u;
#pragma unroll
        for (unsigned j = 0; j < 16; ++j) { const unsigned c = xb_ld(&bar[XB_XCNT(j)]); sum += c; cnt += (c > 0u) ? 1u : 0u; mine = (j == x) ? c : mine; }
        if (sum == G) break;
        __builtin_amdgcn_s_sleep(1);
        if ((++sp & 255u) == 0u) { if (xb_ld(&bar[XB_TMO])) break; if (sp > XB_SPIN_CAP) { atomicAdd(&bar[XB_TMO], 1u); break; } }
    }
    nloc = mine > 0u ? mine : 1u; nx = cnt > 0u ? cnt : 1u;
}

__device__ __forceinline__ void xcd_barrier(const XcdBarrier& b) {
    asm volatile("s_waitcnt vmcnt(0)" ::: "memory");
    __syncthreads();
    if (threadIdx.x == 0) {
        unsigned* bar = b.bar;
        __builtin_amdgcn_s_waitcnt(0);
        unsigned nloc = b.st[0], nx = b.st[1];
        if (nloc == 0u) { xcd_barrier_complete(bar, b.x, nloc, nx); b.st[0] = nloc; b.st[1] = nx; }
        const unsigned old = xb_add(&bar[XB_XSUB(b.x)], 1u);
        const unsigned gen = old / nloc;
        if (old + 1u == (gen + 1u) * nloc) {
            __builtin_amdgcn_fence(__ATOMIC_RELEASE, "agent");
            asm volatile("s_waitcnt vmcnt(0)" ::: "memory");
            const unsigned og = xb_add(&bar[XB_TOP], 1u);
            const unsigned tg = og / nx;
            if (og + 1u == (tg + 1u) * nx) xb_add(&bar[XB_TOPGEN], 1u);
            else XB_SPIN(xb_ld(&bar[XB_TOPGEN]) == tg, bar);
            __builtin_amdgcn_fence(__ATOMIC_ACQUIRE, "agent");
            xb_add(&bar[XB_XGEN(b.x)], 1u);
            asm volatile("s_waitcnt vmcnt(0)" ::: "memory");
        } else {
            XB_SPIN(xb_ld(&bar[XB_XGEN(b.x)]) == gen, bar);
            __builtin_amdgcn_fence(__ATOMIC_ACQUIRE, "agent");
            asm volatile("s_waitcnt vmcnt(0)" ::: "memory");
        }
    }
    __syncthreads();
}

constexpr int NWAVES = 8;
#ifndef MK_PER_PHASE
#define MK_PER_PHASE 0
#endif
constexpr int N_PHASES = 17;
constexpr int BATCH = 2, SEQ = 4096, DM = 4096, MTOK = BATCH * SEQ, DFF = 16384;
constexpr int MH = 8, MDK = 256, MDV = 512, M_MAIN = 12288, M_IN = 12304;
constexpr int NKVQ = 7168, NQG = 4192, KVW = 3072;
constexpr float EPS = 1e-6f;
#ifndef Q8_UP_MASK
#define Q8_STRIPS 1
#define Q8_WIN_O 1
#define Q8_KVQ 1
#define Q8_WMO 1
#define Q8_UP_MASK 3
#endif
constexpr float ATT_SCALE = 0.08838834764831845f;

constexpr size_t MiB = 1u << 20;
constexpr size_t WS_CTL = 0, CTL_CMAX = 65536  , CTL_ZERO_BYTES = 65536 + 4 * 16384 * 4;
constexpr size_t WS_WG1 = 1 * MiB, WS_WG2 = 2 * MiB, WS_W2C = 3 * MiB, WS_POSB = 3 * MiB + 512 * 1024, WS_POSP = 3 * MiB + 640 * 1024;
constexpr size_t WS_LI = 4 * MiB, WS_LF = 4 * MiB + 512 * 1024, WS_GT = 5 * MiB, WS_HC = 8 * MiB, WS_KC = 12 * MiB, WS_VC = 12 * MiB + 512 * 1024, WS_SELM = 13 * MiB;
constexpr size_t WS_WIN = 16 * MiB, WS_WMO = 112 * MiB, WS_WUP0 = 144 * MiB, WS_WDN0 = 272 * MiB, WS_WKVQ = 400 * MiB, WS_W1C = 456 * MiB, WS_WNO = 464 * MiB, WS_WUP1 = 496 * MiB, WS_WDN1 = 624 * MiB;
constexpr size_t WS_XB = 752 * MiB, WS_A3 = 816 * MiB, WS_HR = 880 * MiB, WS_X1 = 944 * MiB, WS_X2 = 1008 * MiB, WS_BIG = 1200 * MiB, WS_AOF = 1328 * MiB, WS_WUPQ0 = 1456 * MiB, WS_WUPQ1 = 1520 * MiB  , WS_XQ = 1584 * MiB  , WS_WKVQ8 = 1616 * MiB  , WS_WMOQ = 1644 * MiB  , WS_WINQ = 1660 * MiB  , WS_END = 1676 * MiB;
constexpr int CW_BAR = 4096;
constexpr int CW_QHEAD = 16384;
constexpr size_t WS_PART = 13 * MiB, WS_RS = 15 * MiB;

constexpr int RING_OFF = 0, RING_BYTES = 147456;
constexpr int LDSCTL_OFF = RING_BYTES, MISC_OFF = LDSCTL_OFF + 320;
constexpr int LDS_BYTES = 159744;
static_assert(MISC_OFF + 128 <= LDS_BYTES, "LDS map");

typedef float f32x16 __attribute__((ext_vector_type(16)));
typedef short s16x4 __attribute__((ext_vector_type(4)));
typedef float f32x2v __attribute__((ext_vector_type(2)));

struct Frame {
    LAS unsigned char* lds;
    volatile LAS unsigned* MISC;
    gu32* ctl;
    int tid, lane, wave, G;
    const float* in[18]; float* out; unsigned char* ws;
};

__device__ __forceinline__ float wave_sum(float v) {
#pragma unroll
    for (int o = 1; o < 64; o <<= 1) v += __shfl_xor(v, o);
    return v;
}
typedef float f32x2_t __attribute__((ext_vector_type(2))); typedef __bf16 bf16x2_t __attribute__((ext_vector_type(2)));
__device__ __forceinline__ unsigned pk2(float lo, float hi) { f32x2_t v = {lo, hi}; bf16x2_t b = __builtin_convertvector(v, bf16x2_t); return __builtin_bit_cast(unsigned, b); }
__device__ __forceinline__ float bf_lo(unsigned w) { return __uint_as_float(w << 16); }
__device__ __forceinline__ float bf_hi(unsigned w) { return __uint_as_float(w & 0xffff0000u); }
__device__ __forceinline__ float bf1(unsigned short h) { return __uint_as_float(((unsigned)h) << 16); }
__device__ __forceinline__ unsigned short f2bf1(float f) { return (unsigned short)(pk2(f, 0.f) & 0xffffu); }
__device__ __forceinline__ f32x4 mfma16(bf16x8 a, bf16x8 b, f32x4 c) { return __builtin_amdgcn_mfma_f32_16x16x32_bf16(a, b, c, 0, 0, 0); }
typedef short v4i16_t __attribute__((ext_vector_type(4)));
__device__ __forceinline__ s16x4 tr16(const LAS unsigned char* p) { return __builtin_bit_cast(s16x4, __builtin_amdgcn_ds_read_tr16_b64_v4i16((LAS v4i16_t*)p)); }
__device__ __forceinline__ bf16x8 cat8(s16x4 lo, s16x4 hi) { return (bf16x8){lo[0], lo[1], lo[2], lo[3], hi[0], hi[1], hi[2], hi[3]}; }

__device__ __forceinline__ void tr_item(const float* W, int K, int ldw, int col0, int ncols, const float* gain, float cscale, int cs_lo, int cs_hi, bf16* WT, int row_off, LAS float* scr, int item, int lane) {
    const int nblk = (ncols + 31) / 32, kb = item / nblk, nb = item % nblk, k0 = 64 * kb, n0 = 32 * nb;
    const int nn = n0 + (lane & 31); const bool nok = nn < ncols; const float cs = (nn >= cs_lo && nn < cs_hi) ? cscale : 1.f;
#pragma unroll 8
    for (int i = 0; i < 32; ++i) { const int kk = 2 * i + (lane >> 5);
        float v = nok ? W[(size_t)(k0 + kk) * ldw + col0 + nn] : 0.f;
        if (gain) v *= gain[k0 + kk];
        scr[kk * 33 + (lane & 31)] = v * cs; }
    LDS_WAIT(); asm volatile("" ::: "memory");
    const int c = lane & 7;
#pragma unroll
    for (int j = 0; j < 4; ++j) { const int n = (lane >> 3) + 8 * j; const LAS float* s = scr + (8 * c) * 33 + n;
        v4u o; o.x = pk2(s[0 * 33], s[1 * 33]); o.y = pk2(s[2 * 33], s[3 * 33]); o.z = pk2(s[4 * 33], s[5 * 33]); o.w = pk2(s[6 * 33], s[7 * 33]);
        if (n0 + n < ncols) *(GAS v4u*)(WT + (size_t)(row_off + n0 + n) * K + k0 + 8 * c) = o; }
    LDS_WAIT(); asm volatile("" ::: "memory");
}
struct CvJob { const float* W; const float* gain; bf16* WT; int K, ldw, col0, ncols, row_off, cs_lo, cs_hi, r, f8; float cscale, osc; unsigned* cmax; };
__device__ __forceinline__ void cv_load(const CvJob& J, f32x4 (&v)[16], float (&gk)[16], int lane) {
    const int nblk = J.ncols >> 6, kb = J.r / nblk, nb = J.r - kb * nblk, k0 = 64 * kb, n0 = 64 * nb;
    const float* src = J.W + (size_t)(k0 + (lane >> 4)) * J.ldw + J.col0 + n0 + 4 * (lane & 15);
    const float* gp = J.gain ? J.gain : J.W;
    const float gmul = J.gain ? 1.f : 0.f, gadd = J.gain ? 0.f : 1.f;
#pragma unroll
    for (int i = 0; i < 16; ++i) { const float g = gp[k0 + 4 * i + (lane >> 4)]; gk[i] = fmaf(g, gmul, gadd); }
#pragma unroll
    for (int i = 0; i < 16; ++i) v[i] = __builtin_nontemporal_load((const GAS f32x4*)(src + (size_t)(4 * i) * J.ldw));
}
__device__ __forceinline__ void cv_store(const CvJob& J, f32x4 (&v)[16], const float (&gkv)[16], LAS unsigned char* scr, int lane) {
    const int nblk = J.ncols >> 6, kb = J.r / nblk, nb = J.r - kb * nblk, k0 = 64 * kb, n0 = 64 * nb;
    const int c = lane & 15, kr = lane >> 4;
    const float cs = ((n0 >= J.cs_lo && n0 < J.cs_hi) ? J.cscale : 1.f) * J.osc;
    f32x4 cm = {0.f, 0.f, 0.f, 0.f};
#pragma unroll
    for (int i = 0; i < 16; ++i) { const float gk = gkv[i] * cs; const f32x4 x = v[i] * gk; cm = __builtin_elementwise_max(cm, __builtin_elementwise_abs(x));
        typedef unsigned u32x2_t __attribute__((ext_vector_type(2)));
        u32x2_t w; w.x = pk2(x.x, x.y); w.y = pk2(x.z, x.w);
        *(LAS u32x2_t*)(scr + (4 * i + kr) * 136 + c * 8) = w; }
    if (J.cmax) {
#pragma unroll
        for (int e = 0; e < 4; ++e) { float m_ = cm[e]; m_ = fmaxf(m_, __shfl_xor(m_, 16)); m_ = fmaxf(m_, __shfl_xor(m_, 32)); if (kr == 0) atomicMax(J.cmax + n0 + 4 * c + e, __float_as_uint(m_)); } }
    LDS_WAIT(); asm volatile("" ::: "memory");
    const int g = lane >> 4, i16 = lane & 15, j = i16 >> 2, q = i16 & 3;
#pragma unroll
    for (int it = 0; it < 8; ++it) { const int nbk = it >> 1, kb8 = (it & 1) * 4 + g;
        const LAS unsigned char* a = scr + (kb8 * 8 + j) * 136 + (nbk * 16 + 4 * q) * 2;
        const bf16x8 o = cat8(tr16(a), tr16(a + 4 * 136));
        if (J.f8) { const v4u w = __builtin_bit_cast(v4u, o); typedef int i32x2 __attribute__((ext_vector_type(2))); i32x2 q;
            q.x = __builtin_amdgcn_cvt_pk_fp8_f32(bf_lo(w.x), bf_hi(w.x), 0, false); q.x = __builtin_amdgcn_cvt_pk_fp8_f32(bf_lo(w.y), bf_hi(w.y), q.x, true);
            q.y = __builtin_amdgcn_cvt_pk_fp8_f32(bf_lo(w.z), bf_hi(w.z), 0, false); q.y = __builtin_amdgcn_cvt_pk_fp8_f32(bf_lo(w.w), bf_hi(w.w), q.y, true);
            *(GAS i32x2*)((unsigned char*)J.WT + (size_t)(J.row_off + n0 + nbk * 16 + i16) * J.K + k0 + kb8 * 8) = q; }
        else __builtin_nontemporal_store(o, (GAS bf16x8*)(J.WT + (size_t)(J.row_off + n0 + nbk * 16 + i16) * J.K + k0 + kb8 * 8)); }
    LDS_WAIT(); asm volatile("" ::: "memory");
}
__device__ __forceinline__ unsigned q8_pack4(float a, float b, float c, float d, float sc) {
    const float M = 12582912.f;
    const unsigned ya = __float_as_uint(fmaf(a, sc, M)), yb = __float_as_uint(fmaf(b, sc, M)), yc = __float_as_uint(fmaf(c, sc, M)), yd = __float_as_uint(fmaf(d, sc, M));
    return __builtin_amdgcn_perm(yb, ya, 0x0c0c0400u) | __builtin_amdgcn_perm(yd, yc, 0x04000c0cu);
}
__device__ __forceinline__ void rownorm_row(const float* xrow, bf16* orow, int lane, unsigned char* qrow = nullptr, float* ra = nullptr) {
    const GAS f32x4* xr = (const GAS f32x4*)xrow + lane;
    f32x4 v[16]; float s = 0.f; f32x4 am4 = {0.f, 0.f, 0.f, 0.f};
#pragma unroll
    for (int j = 0; j < 16; ++j) { v[j] = xr[64 * j]; s += (v[j].x * v[j].x + v[j].y * v[j].y) + (v[j].z * v[j].z + v[j].w * v[j].w); am4 = __builtin_elementwise_max(am4, __builtin_elementwise_abs(v[j])); }
    const float rstd = 1.f / sqrtf(wave_sum(s) * (1.f / DM) + EPS);
    GAS unsigned long long* o8 = (GAS unsigned long long*)orow + lane;
#pragma unroll
    for (int j = 0; j < 16; ++j) o8[64 * j] = (unsigned long long)pk2(v[j].x * rstd, v[j].y * rstd) | ((unsigned long long)pk2(v[j].z * rstd, v[j].w * rstd) << 32);
    if (qrow) {
        float am = fmaxf(fmaxf(am4.x, am4.y), fmaxf(am4.z, am4.w));
#pragma unroll
        for (int o = 1; o < 64; o <<= 1) am = fmaxf(am, __shfl_xor(am, o));
        const float sc = am > 0.f ? 127.f / am : 0.f;
        GAS unsigned* q4 = (GAS unsigned*)qrow + lane;
#pragma unroll
        for (int j = 0; j < 16; ++j) q4[64 * j] = q8_pack4(v[j].x, v[j].y, v[j].z, v[j].w, sc);
        if (lane == 0) *ra = am * rstd * (1.f / 127.f); }
}
__device__ __forceinline__ void rownorm_phase(Frame& F, const float* src, bf16* dst, unsigned char* q8 = nullptr, float* ra = nullptr) {
    const int gw = blockIdx.x * NWAVES + F.wave, NGW = F.G * NWAVES;
    for (int m = gw; m < MTOK; m += NGW) rownorm_row(src + (size_t)m * DM, dst + (size_t)m * DM, F.lane, q8 ? q8 + (size_t)m * DM : nullptr, ra ? ra + m : nullptr);
}

constexpr int WIN_BF = Q8_WIN_O ? 8192 : M_MAIN;
constexpr int CW_0 = 64 * (WIN_BF / 64), CW_2 = Q8_STRIPS ? 0 : 64 * 64, CW_3 = Q8_STRIPS ? 0 : 64 * 256, CW_4 = 256 * 64, CW_5 = Q8_STRIPS ? 0 : 64 * 48, CW_6 = Q8_STRIPS ? 0 : 64 * 64, CW_8 = 64 * 8, CW_9 = 64 * 8, CW_10 = 16, CW_11 = 16, CW_12 = 64 * 64, CW_13 = Q8_STRIPS ? 0 : 64 * 256, CW_14 = 256 * 64;
constexpr int CW_SCAN_SHARE = 10 * 1024;
constexpr int CW_EARLY = CW_0, CW_TOTAL = CW_0 + CW_2 + CW_3 + CW_4 + CW_5 + CW_6 + CW_8 + CW_9 + CW_10 + CW_11 + CW_12 + CW_13 + CW_14;
__device__ __forceinline__ CvJob cv_decode(Frame& F, int it) {
    unsigned char* ws = F.ws; CvJob J; J.gain = nullptr; J.row_off = 0; J.cs_lo = 0; J.cs_hi = 0; J.cscale = 1.f; J.col0 = 0; J.f8 = 0; J.osc = 1.f; J.cmax = nullptr; int r = it;
    if (r < CW_0) { J.W = F.in[3]; J.K = 4096; J.ldw = M_IN; J.ncols = WIN_BF; J.gain = F.in[1]; J.cscale = 0.0625f; J.cs_lo = 2048; J.cs_hi = 4096; J.WT = (bf16*)(ws + WS_WIN); }
    else if ((r -= CW_0) < CW_2) { J.W = F.in[6]; J.K = 4096; J.ldw = 4096; J.ncols = 4096; J.gain = F.in[5]; J.WT = (bf16*)(ws + WS_WMO); if (Q8_WMO) J.cmax = (unsigned*)(ws + CTL_CMAX) + 49152; }
    else if ((r -= CW_2) < CW_3) { J.W = F.in[16]; J.K = 4096; J.ldw = DFF; J.ncols = DFF; J.gain = F.in[2]; J.WT = (bf16*)(ws + WS_WUP0); if (Q8_UP_MASK & 1) J.cmax = (unsigned*)(ws + CTL_CMAX); }
    else if ((r -= CW_3) < CW_4) { J.W = F.in[17]; J.K = DFF; J.ldw = 4096; J.ncols = 4096; J.WT = (bf16*)(ws + WS_WDN0); }
    else if ((r -= CW_4) < CW_5) { J.W = F.in[8]; J.K = 4096; J.ldw = KVW; J.ncols = KVW; J.gain = F.in[7]; J.WT = (bf16*)(ws + WS_WKVQ); if (Q8_KVQ) J.cmax = (unsigned*)(ws + CTL_CMAX) + 32768; else { J.f8 = 1; J.osc = 256.f; } }
    else if ((r -= CW_5) < CW_6) { J.W = F.in[13]; J.K = 4096; J.ldw = NQG; J.ncols = 4096; J.gain = F.in[1] + 4096; J.WT = (bf16*)(ws + WS_WKVQ); J.row_off = KVW; if (Q8_KVQ) J.cmax = (unsigned*)(ws + CTL_CMAX) + 32768 + KVW; else { J.f8 = 1; J.osc = 256.f; } }
    else if ((r -= CW_6) < CW_8) { J.W = F.in[11]; J.K = 4096; J.ldw = 512; J.ncols = 512; J.WT = (bf16*)(ws + WS_W1C); }
    else if ((r -= CW_8) < CW_9) { J.W = F.in[11] + (size_t)4096 * 512; J.K = 4096; J.ldw = 512; J.ncols = 512; J.WT = (bf16*)(ws + WS_W1C) + (size_t)512 * 4096; }
    else if ((r -= CW_9) < CW_10) { J.W = F.in[12]; J.K = 512; J.ldw = 128; J.ncols = 128; J.WT = (bf16*)(ws + WS_W2C); }
    else if ((r -= CW_10) < CW_11) { J.W = F.in[12] + (size_t)512 * 128; J.K = 512; J.ldw = 128; J.ncols = 128; J.WT = (bf16*)(ws + WS_W2C) + (size_t)128 * 512; }
    else if ((r -= CW_11) < CW_12) { J.W = F.in[15]; J.K = 4096; J.ldw = 4096; J.ncols = 4096; J.WT = (bf16*)(ws + WS_WNO); J.f8 = 1; J.osc = 256.f; }
    else if ((r -= CW_12) < CW_13) { J.W = F.in[16] + (size_t)4096 * DFF; J.K = 4096; J.ldw = DFF; J.ncols = DFF; J.gain = F.in[2] + 4096; J.WT = (bf16*)(ws + WS_WUP1); if (Q8_UP_MASK & 2) J.cmax = (unsigned*)(ws + CTL_CMAX) + 16384; }
    else { r -= CW_13; J.W = F.in[17] + (size_t)DFF * 4096; J.K = DFF; J.ldw = 4096; J.ncols = 4096; J.WT = (bf16*)(ws + WS_WDN1); }
    J.r = r; return J;
}
__device__ __forceinline__ void convert_wide(Frame& F, int lo, int hi, int worker, int nworkers) {
    LAS unsigned char* scr = F.lds + RING_OFF + F.wave * 16384;
    int it = lo + worker; if (it >= hi) return;
    f32x4 va[16], vb[16]; float ga[16], gb[16]; CvJob ja = cv_decode(F, it), jb = ja;
    cv_load(ja, va, ga, F.lane);
    for (;;) {
        const int itb = it + nworkers; const bool hb = itb < hi;
        if (hb) { jb = cv_decode(F, itb); cv_load(jb, vb, gb, F.lane); }
        cv_store(ja, va, ga, scr, F.lane);
        if (!hb) break;
        const int ita = itb + nworkers; const bool ha = ita < hi;
        if (ha) { ja = cv_decode(F, ita); cv_load(ja, va, ga, F.lane); }
        cv_store(jb, vb, gb, scr, F.lane);
        if (!ha) break;
        it = ita;
    }
}
struct CvQ { gu32* head; int lo, hi, cur, end; };
__device__ __forceinline__ int cvq_next(CvQ& Q, int lane) {
    if (Q.cur == Q.end) { unsigned v = 0u; if (lane == 0) v = __hip_atomic_fetch_add(Q.head, 8u, RLX_AGENT);
        Q.cur = Q.lo + __builtin_amdgcn_readfirstlane((int)v); Q.end = Q.cur + 8 < Q.hi ? Q.cur + 8 : Q.hi; if (Q.cur >= Q.hi) { Q.cur = Q.end = Q.hi; return Q.hi; } }
    return Q.cur++;
}
__device__ __forceinline__ void convert_queue(Frame& F, int lo, int hi, gu32* head) {
    LAS unsigned char* scr = F.lds + RING_OFF + F.wave * 16384;
    CvQ Q{head, lo, hi, 0, 0};
    int it = cvq_next(Q, F.lane); if (it >= hi) return;
    f32x4 va[16], vb[16]; float ga[16], gb[16]; CvJob ja = cv_decode(F, it), jb = ja;
    cv_load(ja, va, ga, F.lane);
    for (;;) {
        const int itb = cvq_next(Q, F.lane); const bool hb = itb < hi;
        if (hb) { jb = cv_decode(F, itb); cv_load(jb, vb, gb, F.lane); }
        cv_store(ja, va, ga, scr, F.lane);
        if (!hb) break;
        const int ita = cvq_next(Q, F.lane); const bool ha = ita < hi;
        if (ha) { ja = cv_decode(F, ita); cv_load(ja, va, ga, F.lane); }
        cv_store(jb, vb, gb, scr, F.lane);
        if (!ha) break;
    }
}
__device__ __forceinline__ void convert_narrow(Frame& F, int lo, int hi, int worker, int nworkers) {
    LAS float* scr = (LAS float*)(F.lds + RING_OFF + F.wave * 16384);
    for (int it = lo + worker; it < hi; it += nworkers) {
        if (it < 64) tr_item(F.in[3], 4096, M_IN, M_MAIN, 16, F.in[1], 1.f, 0, 0, (bf16*)(F.ws + WS_WG1), 0, scr, it, F.lane);
        else tr_item(F.in[13], 4096, NQG, 4096, 96, F.in[1] + 4096, 1.f, 0, 0, (bf16*)(F.ws + WS_WG2), 0, scr, it - 64, F.lane);
    }
}
__device__ __forceinline__ void p0_prologue(Frame& F) {
    const int gw = blockIdx.x * NWAVES + F.wave, NGW = F.G * NWAVES;
    unsigned char* ws = F.ws;
    { float* pp = (float*)(ws + WS_POSP);
      for (int task = gw; task < 512; task += NGW) { const int j = task >> 8, nbk = (task >> 5) & 7, ch = task & 31, n = nbk * 64 + F.lane;
          const float* pos = F.in[10] + (size_t)j * 4096 + ch * 128; const float* w1 = F.in[11] + ((size_t)j * 4096 + ch * 128) * 512 + n;
          float a0 = 0.f, a1 = 0.f, a2 = 0.f, a3 = 0.f;
#pragma unroll 4
          for (int kk = 0; kk < 128; kk += 4) { a0 += pos[kk] * w1[(size_t)kk * 512]; a1 += pos[kk + 1] * w1[(size_t)(kk + 1) * 512]; a2 += pos[kk + 2] * w1[(size_t)(kk + 2) * 512]; a3 += pos[kk + 3] * w1[(size_t)(kk + 3) * 512]; }
          pp[ch * 1024 + j * 512 + n] = (a0 + a1) + (a2 + a3); } }
    convert_wide(F, 0, CW_EARLY, gw, NGW); convert_narrow(F, 0, 64, gw, NGW);
    rownorm_phase(F, F.in[0], (bf16*)(ws + WS_XB), Q8_WIN_O ? (unsigned char*)(ws + WS_XQ) : nullptr, Q8_WIN_O ? (float*)(ws + WS_RS) + 24576 : nullptr);
}

__device__ __forceinline__ float quant_row(const bf16* src, unsigned char* dst, float sc, int lane) {
    v4u w[8]; float am = 0.f;
#pragma unroll
    for (int i = 0; i < 8; ++i) { w[i] = *(const v4u*)(src + (i * 64 + lane) * 8);
        am = fmaxf(fmaxf(fmaxf(am, fmaxf(fabsf(bf_lo(w[i].x)), fabsf(bf_hi(w[i].x)))), fmaxf(fabsf(bf_lo(w[i].y)), fabsf(bf_hi(w[i].y)))), fmaxf(fmaxf(fabsf(bf_lo(w[i].z)), fabsf(bf_hi(w[i].z))), fmaxf(fabsf(bf_lo(w[i].w)), fabsf(bf_hi(w[i].w))))); }
    float step = 0.f;
    if (sc <= 0.f) {
#pragma unroll
        for (int o = 1; o < 64; o <<= 1) am = fmaxf(am, __shfl_xor(am, o));
        sc = am > 0.f ? 127.f / am : 0.f; step = am * (1.f / 127.f); }
#pragma unroll
    for (int i = 0; i < 8; ++i) { typedef unsigned u32x2_t __attribute__((ext_vector_type(2))); u32x2_t o;
        o.x = q8_pack4(bf_lo(w[i].x), bf_hi(w[i].x), bf_lo(w[i].y), bf_hi(w[i].y), sc); o.y = q8_pack4(bf_lo(w[i].z), bf_hi(w[i].z), bf_lo(w[i].w), bf_hi(w[i].w), sc);
        *(u32x2_t*)(dst + (i * 64 + lane) * 8) = o; }
    return step;
}
__device__ __forceinline__ void wquant_phase(Frame& F, const bf16* W, const float* cmax, unsigned char* WQ, int N) {
    const int gw = blockIdx.x * NWAVES + F.wave, NGW = F.G * NWAVES;
    for (int n = gw; n < N; n += NGW) { const float m_ = cmax[n]; (void)quant_row(W + (size_t)n * DM, WQ + (size_t)n * DM, m_ > 0.f ? 127.f / m_ : 1e-30f, F.lane); }
}
__device__ __forceinline__ void rstd_phase(Frame& F, float* rs, const bf16* X = nullptr, unsigned char* XQ = nullptr, float* ra = nullptr) {
    const int gw = blockIdx.x * NWAVES + F.wave, NGW = F.G * NWAVES; const float* part = (const float*)(F.ws + WS_PART);
    for (int row = gw; row < MTOK; row += NGW) { const float t = wave_sum(part[(size_t)row * 64 + F.lane]); const float r_ = 1.f / sqrtf(t * (1.f / DM) + EPS); if (F.lane == 0) rs[row] = r_;
        if (X) { const float st = quant_row(X + (size_t)row * DM, XQ + (size_t)row * DM, 0.f, F.lane); if (F.lane == 0) ra[row] = st * r_; } }
}
template <int NT, class AP>
__device__ __forceinline__ void mini_gemm16(f32x4 (&acc)[NT], const AP& ap, const bf16* Bt, int ldb, int K, int lane, int kstart = 0) {
    const int r16 = lane & 15, kq = lane >> 4;
#pragma unroll
    for (int n = 0; n < NT; ++n) acc[n] = (f32x4){0.f, 0.f, 0.f, 0.f};
    const bf16* brow = Bt + (size_t)r16 * ldb + kq * 8;
#pragma unroll 8
    for (int kk = 0; kk < K; kk += 32) { const int k0 = (kk + kstart) & (K - 1);
        const bf16x8 a = *(const bf16x8*)ap(r16, k0 + kq * 8);
#pragma unroll
        for (int n = 0; n < NT; ++n) { const bf16x8 b = *(const bf16x8*)(brow + (size_t)n * 16 * ldb + k0); acc[n] = mfma16(a, b, acc[n]); }
    }
}
struct RowMajorA { const bf16* A; int lda; __device__ __forceinline__ const bf16* operator()(int r16, int k) const { return A + (size_t)r16 * lda + k; } };

template <int NT, class AP>
__device__ __forceinline__ void mini_gemm16_splitk(f32x4& out, const AP& ap, const bf16* Bt, int ldb, int K, LAS float* red, int wid, int lane) {
    const int r16 = lane & 15, kq = lane >> 4, kc = K >> 3;
    f32x4 acc[NT];
#pragma unroll
    for (int n = 0; n < NT; ++n) acc[n] = (f32x4){0.f, 0.f, 0.f, 0.f};
    const bf16* brow = Bt + (size_t)r16 * ldb + kq * 8;
#pragma unroll 4
    for (int k0 = wid * kc; k0 < (wid + 1) * kc; k0 += 32) {
        const bf16x8 a = *(const bf16x8*)ap(r16, k0 + kq * 8);
#pragma unroll
        for (int n = 0; n < NT; ++n) { const bf16x8 b = *(const bf16x8*)(brow + (size_t)n * 16 * ldb + k0); acc[n] = mfma16(a, b, acc[n]); }
    }
#pragma unroll
    for (int n = 0; n < NT; ++n) *(LAS f32x4*)(red + ((wid * NT + n) * 64 + lane) * 4) = acc[n];
    __syncthreads();
    out = (f32x4){0.f, 0.f, 0.f, 0.f};
    if (wid < NT) {
#pragma unroll
        for (int w = 0; w < 8; ++w) out = out + *(const LAS f32x4*)(red + ((w * NT + wid) * 64 + lane) * 4); }
    __syncthreads();
}
template <int NT>
__device__ __forceinline__ void mini_gemm32_splitk(f32x4& out0, f32x4& out1, const bf16* A0, const bf16* A1, int lda, const bf16* Bt, int ldb, int K, LAS float* red, int wid, int lane) {
    const int r16 = lane & 15, kq = lane >> 4, kc = K >> 3;
    f32x4 acc0[NT], acc1[NT];
#pragma unroll
    for (int n = 0; n < NT; ++n) { acc0[n] = (f32x4){0.f, 0.f, 0.f, 0.f}; acc1[n] = (f32x4){0.f, 0.f, 0.f, 0.f}; }
    const bf16* a0 = A0 + (size_t)r16 * lda + kq * 16; const bf16* a1 = A1 + (size_t)r16 * lda + kq * 16; const bf16* brow = Bt + (size_t)r16 * ldb + kq * 16;
#pragma unroll 1
    for (int k0 = wid * kc; k0 < (wid + 1) * kc; k0 += 128) {
        bf16x8 fa0[4], fa1[4], fb[4][NT];
#pragma unroll
        for (int s4 = 0; s4 < 4; ++s4) { const int off = k0 + (s4 >> 1) * 64 + (s4 & 1) * 8; fa0[s4] = *(const bf16x8*)(a0 + off); fa1[s4] = *(const bf16x8*)(a1 + off);
#pragma unroll
            for (int n = 0; n < NT; ++n) fb[s4][n] = *(const bf16x8*)(brow + (size_t)n * 16 * ldb + off); }
        __builtin_amdgcn_sched_barrier(0);
#pragma unroll
        for (int s4 = 0; s4 < 4; ++s4)
#pragma unroll
            for (int n = 0; n < NT; ++n) { acc0[n] = mfma16(fa0[s4], fb[s4][n], acc0[n]); acc1[n] = mfma16(fa1[s4], fb[s4][n], acc1[n]); }
        __builtin_amdgcn_sched_barrier(0);
    }
#pragma unroll
    for (int n = 0; n < NT; ++n) { *(LAS f32x4*)(red + ((wid * NT + n) * 64 + lane) * 4) = acc0[n]; *(LAS f32x4*)(red + 8 * NT * 256 + ((wid * NT + n) * 64 + lane) * 4) = acc1[n]; }
    __syncthreads();
    out0 = (f32x4){0.f, 0.f, 0.f, 0.f}; out1 = (f32x4){0.f, 0.f, 0.f, 0.f};
    if (wid < NT) {
#pragma unroll
        for (int w = 0; w < 8; ++w) { out0 = out0 + *(const LAS f32x4*)(red + ((w * NT + wid) * 64 + lane) * 4); out1 = out1 + *(const LAS f32x4*)(red + 8 * NT * 256 + ((w * NT + wid) * 64 + lane) * 4); } }
    __syncthreads();
}
__device__ __forceinline__ void gates1_phase(Frame& F) {
    const int r16 = F.lane & 15, kq = F.lane >> 4;
    const bf16* XB = (const bf16*)(F.ws + WS_XB); const bf16* Wg = (const bf16*)(F.ws + WS_WG1);
    float* LI = (float*)(F.ws + WS_LI); float* LF = (float*)(F.ws + WS_LF);
    const float bias = F.in[4][r16];
    for (int rt0 = blockIdx.x; rt0 < MTOK / 16; rt0 += 2 * F.G) { const int rt1 = rt0 + F.G; const bool two = rt1 < MTOK / 16;
        f32x4 acc2[2];
        mini_gemm32_splitk<1>(acc2[0], acc2[1], XB + (size_t)rt0 * 16 * DM, XB + (size_t)(two ? rt1 : rt0) * 16 * DM, DM, Wg, DM, DM, (LAS float*)(F.lds + RING_OFF), F.wave, F.lane);
        if (F.wave == 0) {
#pragma unroll
            for (int h = 0; h < 2; ++h) { if (h == 1 && !two) break; const int rt = h ? rt1 : rt0;
#pragma unroll
                for (int i = 0; i < 4; ++i) { const int row = rt * 16 + 4 * kq + i, b = row >> 12, t = row & 4095;
                    float g = acc2[h][i] + bias; g = 15.f * tanhf(g * (1.f / 15.f));
                    if (r16 < 8) LI[(size_t)(b * 8 + r16) * SEQ + t] = g;
                    else LF[(size_t)(b * 8 + (r16 - 8)) * SEQ + t] = fminf(g, 0.f) - log1pf(__expf(-fabsf(g))); } } }
    }
}
__device__ __forceinline__ void gates2_phase(Frame& F) {
    const int r16 = F.lane & 15, kq = F.lane >> 4;
    const bf16* XB = (const bf16*)(F.ws + WS_X2); const bf16* Wg = (const bf16*)(F.ws + WS_WG2); float* GT = (float*)(F.ws + WS_GT);
    const bool half = F.G == 256; const int wk = half ? (int)blockIdx.x - 128 : (int)blockIdx.x, nwk = half ? 128 : F.G;
    if (wk >= 0)
    for (int rt0 = wk; rt0 < MTOK / 16; rt0 += 2 * nwk) { const int rt1 = rt0 + nwk; const bool two = rt1 < MTOK / 16;
        f32x4 acc2[2];
        mini_gemm32_splitk<6>(acc2[0], acc2[1], XB + (size_t)rt0 * 16 * DM, XB + (size_t)(two ? rt1 : rt0) * 16 * DM, DM, Wg, DM, DM, (LAS float*)(F.lds + RING_OFF), F.wave, F.lane);
        if (F.wave < 6) {
#pragma unroll
            for (int h = 0; h < 2; ++h) { if (h == 1 && !two) break; const int rt = h ? rt1 : rt0;
#pragma unroll
                for (int i = 0; i < 4; ++i) { const int row = rt * 16 + 4 * kq + i; const float rs = ((const float*)(F.ws + WS_RS))[8192 + row];
                    GT[(size_t)row * 96 + F.wave * 16 + r16] = 1.f / (1.f + __expf(-acc2[h][i] * rs)); } } }
    }
}

#define QS_BAR() do { asm volatile("s_waitcnt lgkmcnt(0)" ::: "memory"); __builtin_amdgcn_s_barrier(); asm volatile("" ::: "memory"); } while (0)
#define QS_SB() __builtin_amdgcn_sched_barrier(0)
constexpr int QS_RS = 4112, QS_NSTRIPS = 512 + 512 + 96 + 128 + 128;
struct QsJob { const float* W; const float* gain; unsigned char* WQ; float* cmax; int ldw, n0; };
__device__ __forceinline__ QsJob qs_decode(Frame& F, int s_) {
    unsigned char* ws = F.ws; QsJob J; float* cm = (float*)(ws + CTL_CMAX); int s = s_;
    if (s < 512) { J.W = F.in[16]; J.ldw = DFF; J.gain = F.in[2]; J.WQ = ws + WS_WUPQ0; J.cmax = cm; }
    else if ((s -= 512) < 512) { J.W = F.in[16] + (size_t)4096 * DFF; J.ldw = DFF; J.gain = F.in[2] + 4096; J.WQ = ws + WS_WUPQ1; J.cmax = cm + 16384; }
    else if ((s -= 512) < 96) { J.W = F.in[8]; J.ldw = KVW; J.gain = F.in[7]; J.WQ = ws + WS_WKVQ8; J.cmax = cm + 32768; }
    else if ((s -= 96) < 128) { J.W = F.in[13]; J.ldw = NQG; J.gain = F.in[1] + 4096; J.WQ = ws + WS_WKVQ8 + (size_t)KVW * 4096; J.cmax = cm + 32768 + KVW; }
    else if ((s -= 128) < 128) { J.W = F.in[6]; J.ldw = 4096; J.gain = F.in[5]; J.WQ = ws + WS_WMOQ; J.cmax = cm + 49152; }
    else { s -= 128; J.W = F.in[3] + 8192; J.ldw = M_IN; J.gain = F.in[1]; J.WQ = ws + WS_WINQ; J.cmax = cm + 53248; }
    J.n0 = 32 * s; return J;
}
__device__ __forceinline__ void qs_load(const QsJob& J, int q, f32x4 (&v)[8], f32x2_t (&g)[4], int tid) {
    const int seg = tid & 7, kp = tid >> 3;
    unsigned off_w = (unsigned)(2 * kp * J.ldw + 4 * seg) * 4u, off_g = (unsigned)kp * 8u;
    asm volatile("" : "+v"(off_w), "+v"(off_g));
    const char* wb = (const char*)(J.W + J.n0); const char* gb = (const char*)J.gain;
#pragma unroll
    for (int i = 0; i < 4; ++i) g[i] = *(const f32x2_t*)(gb + (size_t)((q * 4 + i) * 128) * 4 + off_g);
#pragma unroll
    for (int i = 0; i < 4; ++i) { const char* p = wb + (size_t)((q * 4 + i) * 128) * (size_t)J.ldw * 4;
        v[2 * i] = __builtin_nontemporal_load((const GAS f32x4*)(p + off_w)); v[2 * i + 1] = __builtin_nontemporal_load((const GAS f32x4*)(p + (size_t)J.ldw * 4 + off_w)); }
}
__device__ __forceinline__ void qs_put(const f32x4 (&v)[8], const f32x2_t (&g)[4], int q, f32x4& cm, LAS unsigned char* lds, int tid) {
    const int seg = tid & 7, kp = tid >> 3;
    unsigned lb = (unsigned)((4 * seg) * QS_RS + 4 * kp); asm volatile("" : "+v"(lb));
#pragma unroll
    for (int i = 0; i < 4; ++i) { const f32x4 x0 = v[2 * i] * g[i].x, x1 = v[2 * i + 1] * g[i].y;
        cm = __builtin_elementwise_max(cm, __builtin_elementwise_max(__builtin_elementwise_abs(x0), __builtin_elementwise_abs(x1)));
        LAS unsigned char* b = lds + lb + (q * 4 + i) * 256;
        *(LAS unsigned*)(b) = pk2(x0.x, x1.x); *(LAS unsigned*)(b + QS_RS) = pk2(x0.y, x1.y); *(LAS unsigned*)(b + 2 * QS_RS) = pk2(x0.z, x1.z); *(LAS unsigned*)(b + 3 * QS_RS) = pk2(x0.w, x1.w); }
}
__device__ __forceinline__ void qs_park(const f32x4 (&v)[8], const f32x2_t (&g)[4], int q, f32x4& cm, unsigned (&park)[16][4]) {
#pragma unroll
    for (int i = 0; i < 4; ++i) { const f32x4 x0 = v[2 * i] * g[i].x, x1 = v[2 * i + 1] * g[i].y;
        cm = __builtin_elementwise_max(cm, __builtin_elementwise_max(__builtin_elementwise_abs(x0), __builtin_elementwise_abs(x1)));
        unsigned p0 = pk2(x0.x, x1.x), p1 = pk2(x0.y, x1.y), p2 = pk2(x0.z, x1.z), p3 = pk2(x0.w, x1.w);
        asm volatile("" : "+v"(p0), "+v"(p1), "+v"(p2), "+v"(p3));
        park[(q - 4) * 4 + i][0] = p0; park[(q - 4) * 4 + i][1] = p1; park[(q - 4) * 4 + i][2] = p2; park[(q - 4) * 4 + i][3] = p3; }
}
__device__ __forceinline__ void qs_flush(const QsJob& J, LAS unsigned char* lds, const float (&sc4)[4], int half, int wave, unsigned l16, unsigned l8) {
#pragma unroll
    for (int rr = 0; rr < 4; ++rr) { const int n = wave + 8 * rr; unsigned char* dst = J.WQ + (size_t)(J.n0 + n) * 4096 + half * 2048;
#pragma unroll
        for (int i = 0; i < 4; ++i) { const v4u w = *(const LAS v4u*)(lds + n * QS_RS + l16 + i * 1024);
            typedef unsigned u32x2_t __attribute__((ext_vector_type(2))); u32x2_t o;
            o.x = q8_pack4(bf_lo(w.x), bf_hi(w.x), bf_lo(w.y), bf_hi(w.y), sc4[rr]); o.y = q8_pack4(bf_lo(w.z), bf_hi(w.z), bf_lo(w.w), bf_hi(w.w), sc4[rr]);
            *(u32x2_t*)(dst + l8 + i * 512) = o; } }
}
__device__ __forceinline__ void convert_strips(Frame& F, int cw, int ncw, int lo = 0, int hi = QS_NSTRIPS) {
    LAS unsigned char* lds = F.lds + RING_OFF; LAS float* wm = (LAS float*)(lds + 32 * QS_RS);
    const int tid = F.tid, lane = F.lane, wave = F.wave;
    QS_BAR();
    int s = lo + cw; if (s >= hi) return;
    f32x4 A[8], B[8]; f32x2_t gA[4], gB[4];
    unsigned l16 = (unsigned)lane * 16u, l8 = (unsigned)lane * 8u; asm volatile("" : "+v"(l16), "+v"(l8));
    QsJob J = qs_decode(F, s); qs_load(J, 0, A, gA, tid); qs_load(J, 1, B, gB, tid);
    for (;;) {
        f32x4 cm = {0.f, 0.f, 0.f, 0.f}; unsigned park[16][4];
#pragma unroll 1
        for (int qq = 0; qq < 2; ++qq) {
            qs_put(A, gA, 2 * qq, cm, lds, tid); QS_SB(); qs_load(J, 2 * qq + 2, A, gA, tid); QS_SB();
            qs_put(B, gB, 2 * qq + 1, cm, lds, tid); QS_SB(); qs_load(J, 2 * qq + 3, B, gB, tid); QS_SB(); }
        qs_park(A, gA, 4, cm, park); QS_SB(); qs_load(J, 6, A, gA, tid); QS_SB();
        qs_park(B, gB, 5, cm, park); QS_SB(); qs_load(J, 7, B, gB, tid); QS_SB();
        const int sn = s + ncw; const bool more = sn < hi; QsJob Jn = J; if (more) Jn = qs_decode(F, sn);
        qs_park(A, gA, 6, cm, park); QS_SB(); if (more) qs_load(Jn, 0, A, gA, tid); QS_SB();
        qs_park(B, gB, 7, cm, park); QS_SB();
#pragma unroll
        for (int e = 0; e < 4; ++e) { float m_ = cm[e]; m_ = fmaxf(m_, __shfl_xor(m_, 8)); m_ = fmaxf(m_, __shfl_xor(m_, 16)); m_ = fmaxf(m_, __shfl_xor(m_, 32)); cm[e] = m_; }
        if (lane < 8) *(LAS f32x4*)(wm + wave * 32 + 4 * lane) = cm;
        QS_BAR();
        float sc4[4];
#pragma unroll
        for (int rr = 0; rr < 4; ++rr) { const int n = wave + 8 * rr; float m_ = 0.f;
#pragma unroll
            for (int w8 = 0; w8 < 8; ++w8) m_ = fmaxf(m_, wm[w8 * 32 + n]);
            sc4[rr] = m_ > 0.f ? 127.f / m_ : 0.f;
            if (lane == 0) J.cmax[J.n0 + n] = m_; }
        qs_flush(J, lds, sc4, 0, wave, l16, l8);
        QS_BAR();
        { const int seg = tid & 7, kp = tid >> 3; unsigned lb = (unsigned)((4 * seg) * QS_RS + 4 * kp); asm volatile("" : "+v"(lb));
#pragma unroll
          for (int d = 0; d < 16; ++d) { LAS unsigned char* b = lds + lb + d * 256;
              *(LAS unsigned*)(b) = park[d][0]; *(LAS unsigned*)(b + QS_RS) = park[d][1]; *(LAS unsigned*)(b + 2 * QS_RS) = park[d][2]; *(LAS unsigned*)(b + 3 * QS_RS) = park[d][3]; } }
        QS_SB(); if (more) qs_load(Jn, 1, B, gB, tid); QS_SB();
        QS_BAR();
        qs_flush(J, lds, sc4, 1, wave, l16, l8);
        QS_BAR();
        if (!more) break;
        s = sn; J = Jn;
    }
}

#define ML_BAR() do { asm volatile("s_waitcnt lgkmcnt(0)" ::: "memory"); __builtin_amdgcn_s_barrier(); asm volatile("" ::: "memory"); } while (0)
constexpr int ML_QS = 528, ML_VS = 144, ML_PS = 144;
constexpr int ML_Q = 0, ML_K = ML_Q + 64 * ML_QS, ML_V = ML_K + 64 * ML_QS, ML_VW = ML_V + 64 * ML_VS, ML_P = ML_VW + 64 * ML_VS, ML_CT = ML_P + 64 * ML_PS, ML_SC = ML_CT + 64 * ML_QS, ML_H = ML_SC + 4096;
static_assert(ML_H + 64 * ML_VS <= RING_BYTES, "mlstm LDS");
struct MlPref { bf16x8 q[4], k[4], v; float li, lf; };
struct MlK { LAS unsigned char* L; const bf16* QKVO; bf16* HR; const float* LI; const float* LF; size_t rowb; int bh, hd, e0, tid, lane, wid; };
__device__ __forceinline__ void ml_load(MlPref& P, const MlK& K, int c) {
    const int qr_ = K.tid >> 3, qc_ = K.tid & 7;
    const bf16* base = K.QKVO + (K.rowb + (size_t)c * 64 + qr_) * M_MAIN;
#pragma unroll
    for (int i = 0; i < 4; ++i) { P.q[i] = *(const bf16x8*)(base + K.hd * 256 + (qc_ + 8 * i) * 8); P.k[i] = *(const bf16x8*)(base + 2048 + K.hd * 256 + (qc_ + 8 * i) * 8); }
    P.v = *(const bf16x8*)(base + 4096 + K.hd * 512 + K.e0 + qc_ * 8);
    P.li = K.LI[(size_t)K.bh * SEQ + c * 64 + K.lane]; P.lf = K.LF[(size_t)K.bh * SEQ + c * 64 + K.lane];
}
__device__ __forceinline__ void ml_chunk(MlPref& P, f32x4 (&CT)[2][4], float& m_state, const MlK& K, int c) {
    LAS unsigned char* L = K.L;
    LAS float* sc_a = (LAS float*)(L + ML_SC); LAS float* sc_M = sc_a + 64; LAS float* sc_b = sc_a + 128; LAS float* sc_w = sc_a + 192;
    LAS float* sc_rs = sc_a + 256; LAS float* sc_qn = sc_a + 512; LAS float* sc_nv = sc_a + 576;
    const int tid = K.tid, lane = K.lane, wid = K.wid, r16 = lane & 15, kq = lane >> 4;
    const int tt = wid >> 1, sp = wid & 1, ep = wid & 1, qr_ = tid >> 3, qc_ = tid & 7;
    float bsum = P.lf;
#pragma unroll
    for (int o = 1; o < 64; o <<= 1) { const float t_ = __shfl_up(bsum, o); if (lane >= o) bsum += t_; }
    const float a_s = P.li - bsum;
    float pm = a_s;
#pragma unroll
    for (int o = 1; o < 64; o <<= 1) { const float t_ = __shfl_up(pm, o); if (lane >= o) pm = fmaxf(pm, t_); }
    const float Mt = fmaxf(m_state, pm);
    const float M63 = __uint_as_float(__builtin_amdgcn_readlane(__float_as_uint(Mt), 63)), b63 = __uint_as_float(__builtin_amdgcn_readlane(__float_as_uint(bsum), 63));
    const float w_s = __expf(a_s - M63), decay = __expf(m_state - M63);
    if (wid == 0) { sc_a[lane] = a_s; sc_M[lane] = Mt; sc_b[lane] = bsum; sc_w[lane] = w_s; }
#pragma unroll
    for (int i = 0; i < 4; ++i) { *(LAS bf16x8*)(L + ML_Q + qr_ * ML_QS + (qc_ + 8 * i) * 16) = P.q[i]; *(LAS bf16x8*)(L + ML_K + qr_ * ML_QS + (qc_ + 8 * i) * 16) = P.k[i]; }
    { *(LAS bf16x8*)(L + ML_V + qr_ * ML_VS + qc_ * 16) = P.v;
        const float wv = __shfl(w_s, 8 * wid + (lane >> 3)); const v4u raw = __builtin_bit_cast(v4u, P.v); v4u o;
        o.x = pk2(bf_lo(raw.x) * wv, bf_hi(raw.x) * wv); o.y = pk2(bf_lo(raw.y) * wv, bf_hi(raw.y) * wv); o.z = pk2(bf_lo(raw.z) * wv, bf_hi(raw.z) * wv); o.w = pk2(bf_lo(raw.w) * wv, bf_hi(raw.w) * wv);
        *(LAS v4u*)(L + ML_VW + qr_ * ML_VS + qc_ * 16) = o; }
    ml_load(P, K, c + 2 < 64 ? c + 2 : 63);
    ML_BAR();
    f32x4 sacc0 = {0.f, 0.f, 0.f, 0.f}, sacc1 = sacc0, iacc0 = sacc0, iacc1 = sacc0;
    { const LAS unsigned char* qrow = L + ML_Q + (tt * 16 + r16) * ML_QS + kq * 16;
      const LAS unsigned char* krow = L + ML_K + (sp * 32 + r16) * ML_QS + kq * 16;
      const LAS unsigned char* crow_ = L + ML_CT + (ep * 32 + r16) * ML_QS + kq * 16;
#pragma unroll 2
      for (int k0 = 0; k0 < 8; ++k0) { const bf16x8 a = *(const LAS bf16x8*)(qrow + k0 * 64);
          const bf16x8 b0 = *(const LAS bf16x8*)(krow + k0 * 64), b1 = *(const LAS bf16x8*)(krow + 16 * ML_QS + k0 * 64);
          const bf16x8 bc0 = *(const LAS bf16x8*)(crow_ + k0 * 64), bc1 = *(const LAS bf16x8*)(crow_ + 16 * ML_QS + k0 * 64);
          sacc0 = mfma16(b0, a, sacc0); sacc1 = mfma16(b1, a, sacc1); iacc0 = mfma16(bc0, a, iacc0); iacc1 = mfma16(bc1, a, iacc1); } }
    const int tl = tt * 16 + r16;
    const float Mt_t = sc_M[tl];
#pragma unroll
    for (int st2 = 0; st2 < 2; ++st2) { const int s0 = (2 * sp + st2) * 16 + 4 * kq; const f32x4 a4 = *(const LAS f32x4*)(sc_a + s0); const f32x4 sv = st2 ? sacc1 : sacc0;
        float pv4[4]; float rsum = 0.f;
#pragma unroll
        for (int i = 0; i < 4; ++i) { pv4[i] = (s0 + i <= tl) ? sv[i] * __expf(a4[i] - Mt_t) : 0.f; rsum += pv4[i]; }
        rsum += __shfl_xor(rsum, 16); rsum += __shfl_xor(rsum, 32);
        if (kq == 0) sc_rs[(2 * sp + st2) * 64 + tl] = rsum;
        typedef unsigned u32x2_t __attribute__((ext_vector_type(2)));
        u32x2_t w; w.x = pk2(pv4[0], pv4[1]); w.y = pk2(pv4[2], pv4[3]);
        *(LAS u32x2_t*)(L + ML_P + tl * ML_PS + s0 * 2) = w; }
    { const int t = tid >> 3, part = tid & 7; float qn = 0.f;
      const LAS v4u* qp = (const LAS v4u*)(L + ML_Q + t * ML_QS + part * 64); const LAS f32x4* np_ = (const LAS f32x4*)(sc_nv + part * 32);
#pragma unroll
      for (int j = 0; j < 4; ++j) { const v4u w = qp[j]; const f32x4 n0 = np_[2 * j], n1 = np_[2 * j + 1];
          qn += (bf_lo(w.x) * n0[0] + bf_hi(w.x) * n0[1]) + (bf_lo(w.y) * n0[2] + bf_hi(w.y) * n0[3]) + (bf_lo(w.z) * n1[0] + bf_hi(w.z) * n1[1]) + (bf_lo(w.w) * n1[2] + bf_hi(w.w) * n1[3]); }
      qn += __shfl_xor(qn, 1); qn += __shfl_xor(qn, 2); qn += __shfl_xor(qn, 4);
      if (part == 0) sc_qn[t] = qn; }
    ML_BAR();
    { f32x4 xacc[2] = {{0.f, 0.f, 0.f, 0.f}, {0.f, 0.f, 0.f, 0.f}}; const int j = r16 >> 2, q = r16 & 3;
#pragma unroll
      for (int ks = 0; ks < 2; ++ks) { const bf16x8 pf = *(const LAS bf16x8*)(L + ML_P + tl * ML_PS + (ks * 32 + kq * 8) * 2);
#pragma unroll
          for (int e2 = 0; e2 < 2; ++e2) { const LAS unsigned char* va = L + ML_V + (ks * 32 + 8 * kq + j) * ML_VS + ((2 * ep + e2) * 16 + 4 * q) * 2;
              xacc[e2] = mfma16(cat8(tr16(va), tr16(va + 4 * ML_VS)), pf, xacc[e2]); } }
      const float bb_t = sc_b[tl], winter = __expf(m_state - Mt_t);
      const float den = winter * sc_qn[tl] + ((sc_rs[tl] + sc_rs[64 + tl]) + (sc_rs[128 + tl] + sc_rs[192 + tl]));
      const float rdd = 1.f / fmaxf(fabsf(den), __expf(-(bb_t + Mt_t)));
#pragma unroll
      for (int e2 = 0; e2 < 2; ++e2) { const f32x4 ia = e2 ? iacc1 : iacc0; float hv[4];
#pragma unroll
          for (int i = 0; i < 4; ++i) hv[i] = (winter * ia[i] + xacc[e2][i]) * rdd;
          typedef unsigned u32x2_t __attribute__((ext_vector_type(2)));
          u32x2_t w; w.x = pk2(hv[0], hv[1]); w.y = pk2(hv[2], hv[3]);
          *(LAS u32x2_t*)(L + ML_H + tl * ML_VS + ((2 * ep + e2) * 16 + 4 * kq) * 2) = w; } }
    { const int j = r16 >> 2, q = r16 & 3; bf16x8 af[2][2];
#pragma unroll
      for (int e2 = 0; e2 < 2; ++e2)
#pragma unroll
          for (int ks = 0; ks < 2; ++ks) { const LAS unsigned char* va = L + ML_VW + (ks * 32 + 8 * kq + j) * ML_VS + ((2 * ep + e2) * 16 + 4 * q) * 2; af[e2][ks] = cat8(tr16(va), tr16(va + 4 * ML_VS)); }
#pragma unroll
      for (int jt = 0; jt < 4; ++jt) { const int dt = 4 * (wid >> 1) + jt; bf16x8 bfr[2];
#pragma unroll
          for (int ks = 0; ks < 2; ++ks) { const LAS unsigned char* ka = L + ML_K + (ks * 32 + 8 * kq + j) * ML_QS + (dt * 16 + 4 * q) * 2; bfr[ks] = cat8(tr16(ka), tr16(ka + 4 * ML_QS)); }
#pragma unroll
          for (int e2 = 0; e2 < 2; ++e2) { f32x4 acc = CT[e2][jt] * decay;
              acc = mfma16(bfr[0], af[e2][0], acc); acc = mfma16(bfr[1], af[e2][1], acc);
              CT[e2][jt] = acc;
              typedef unsigned u32x2_t __attribute__((ext_vector_type(2)));
              u32x2_t w; w.x = pk2(acc[0], acc[1]); w.y = pk2(acc[2], acc[3]);
              *(LAS u32x2_t*)(L + ML_CT + ((2 * ep + e2) * 16 + r16) * ML_QS + (dt * 16 + 4 * kq) * 2) = w; } } }
    if (tid < 256) { float nv = sc_nv[tid] * decay;
#pragma unroll
        for (int s = 0; s < 64; ++s) nv += __uint_as_float(__builtin_amdgcn_readlane(__float_as_uint(w_s), s)) * bf1(*(const LAS unsigned short*)(L + ML_K + s * ML_QS + tid * 2));
        sc_nv[tid] = nv; }
    m_state = b63 + M63;
    ML_BAR();
    *(bf16x8*)(K.HR + (K.rowb + (size_t)c * 64 + qr_) * DM + K.hd * 512 + K.e0 + qc_ * 8) = *(const LAS bf16x8*)(L + ML_H + qr_ * ML_VS + qc_ * 16);
}
__device__ __forceinline__ void mlstm_phase(Frame& F, int worker, int nworkers) {
    LAS unsigned char* L = F.lds + RING_OFF;
    LAS float* sc_nv = (LAS float*)(L + ML_SC) + 576;
    for (int unit = worker; unit < 128; unit += nworkers) {
        const int bh = unit >> 3, sl = unit & 7, b = bh >> 3;
        MlK K; K.L = L; K.QKVO = (const bf16*)(F.ws + WS_BIG); K.HR = (bf16*)(F.ws + WS_HR); K.LI = (const float*)(F.ws + WS_LI); K.LF = (const float*)(F.ws + WS_LF);
        K.rowb = (size_t)b * SEQ; K.bh = bh; K.hd = bh & 7; K.e0 = sl * 64; K.tid = F.tid; K.lane = F.lane; K.wid = F.wave;
        f32x4 CT[2][4];
#pragma unroll
        for (int a = 0; a < 2; ++a)
#pragma unroll
            for (int j = 0; j < 4; ++j) CT[a][j] = (f32x4){0.f, 0.f, 0.f, 0.f};
        float m_state = 0.f;
        if (F.tid < 256) sc_nv[F.tid] = 0.f;
        for (int i = F.tid; i < 64 * ML_QS / 4; i += NWAVES * 64) ((LAS unsigned*)(L + ML_CT))[i] = 0u;
        MlPref P0, P1;
        ml_load(P0, K, 0); ml_load(P1, K, 1);
        __syncthreads();
        for (int c = 0; c < 64; c += 2) { ml_chunk(P0, CT, m_state, K, c); ml_chunk(P1, CT, m_state, K, c + 1); }
    }
}

__device__ __forceinline__ void gating_phase(Frame& F) {
    const int gw = blockIdx.x * NWAVES + F.wave, NGW = F.G * NWAVES, lane = F.lane;
    const bf16* HR = (const bf16*)(F.ws + WS_HR); const bf16* QKVO = (const bf16*)(F.ws + WS_BIG); bf16* A3 = (bf16*)(F.ws + WS_A3);
    float* ra = (float*)(F.ws + WS_RS) + 24576;
    for (int row = gw; row < MTOK; row += NGW) {
        unsigned pk[8][4]; float am = 0.f;
#pragma unroll
        for (int hd = 0; hd < 8; ++hd) {
            const v4u hv = *(const v4u*)(HR + (size_t)row * DM + hd * 512 + lane * 8);
            const v4u ov = *(const v4u*)(QKVO + (size_t)row * M_MAIN + 8192 + hd * 512 + lane * 8);
            float h[8] = {bf_lo(hv.x), bf_hi(hv.x), bf_lo(hv.y), bf_hi(hv.y), bf_lo(hv.z), bf_hi(hv.z), bf_lo(hv.w), bf_hi(hv.w)};
            float o[8] = {bf_lo(ov.x), bf_hi(ov.x), bf_lo(ov.y), bf_hi(ov.y), bf_lo(ov.z), bf_hi(ov.z), bf_lo(ov.w), bf_hi(ov.w)};
            float ss = 0.f;
#pragma unroll
            for (int e = 0; e < 8; ++e) ss += h[e] * h[e];
            const float rstd = 1.f / sqrtf(wave_sum(ss) * (1.f / 512.f) + EPS);
            float r[8];
#pragma unroll
            for (int e = 0; e < 8; ++e) { r[e] = h[e] * rstd / (1.f + __expf(-o[e])); am = fmaxf(am, fabsf(r[e])); }
#pragma unroll
            for (int j = 0; j < 4; ++j) pk[hd][j] = pk2(r[2 * j], r[2 * j + 1]);
            if (!Q8_WMO) { v4u w; w.x = pk[hd][0]; w.y = pk[hd][1]; w.z = pk[hd][2]; w.w = pk[hd][3]; *(v4u*)(A3 + (size_t)row * DM + hd * 512 + lane * 8) = w; }
        }
        if (Q8_WMO) {
#pragma unroll
            for (int o = 1; o < 64; o <<= 1) am = fmaxf(am, __shfl_xor(am, o));
            const float sc = am > 0.f ? 127.f / am : 0.f;
#pragma unroll
            for (int hd = 0; hd < 8; ++hd) { typedef unsigned u32x2_t __attribute__((ext_vector_type(2))); u32x2_t o;
                o.x = q8_pack4(bf_lo(pk[hd][0]), bf_hi(pk[hd][0]), bf_lo(pk[hd][1]), bf_hi(pk[hd][1]), sc); o.y = q8_pack4(bf_lo(pk[hd][2]), bf_hi(pk[hd][2]), bf_lo(pk[hd][3]), bf_hi(pk[hd][3]), sc);
                *(u32x2_t*)((unsigned char*)A3 + (size_t)row * DM + hd * 512 + lane * 8) = o; }
            if (lane == 0) ra[row] = am * (1.f / 127.f); }
    }
}

__device__ __forceinline__ float gelu_tanh(float v) { const float u = 0.7978845608028654f * (v + 0.044715f * v * v * v); return 0.5f * v * (1.f + tanhf(u)); }
struct CmpA { const bf16* KVQ; int j, rt; __device__ __forceinline__ const bf16* operator()(int r16, int k) const {
    const int row = rt * 16 + r16, bg = row >> 8; int c = row & 255; c = c > 254 ? 254 : c; const int b = bg >> 2, g = bg & 3;
    return KVQ + ((size_t)b * SEQ + 16 * c + (k >> 7)) * NKVQ + j * 512 + g * 128 + (k & 127); } };
__device__ __forceinline__ void nsa_prep_phase(Frame& F) {
    const int gw = blockIdx.x * NWAVES + F.wave, NGW = F.G * NWAVES, lane = F.lane, r16 = lane & 15, kq = lane >> 4;
    bf16* KVQ = (bf16*)(F.ws + WS_BIG);
    { const int v = lane >> 3, br = v >> 2, g = v & 3, d0 = (lane & 7) * 16;
      float gn[16];
#pragma unroll
      for (int e = 0; e < 16; ++e) gn[e] = F.in[9][(br + 1) * 128 + d0 + e] * F.in[14][(br + 1) * 128 + d0 + e] * ATT_SCALE;
      for (int row = gw; row < MTOK; row += NGW) {
          bf16* p = KVQ + (size_t)row * NKVQ + (2 + 2 * br) * 512 + g * 128 + d0;
          const v4u a = *(const v4u*)p, c = *(const v4u*)(p + 8);
          float x[16] = {bf_lo(a.x), bf_hi(a.x), bf_lo(a.y), bf_hi(a.y), bf_lo(a.z), bf_hi(a.z), bf_lo(a.w), bf_hi(a.w), bf_lo(c.x), bf_hi(c.x), bf_lo(c.y), bf_hi(c.y), bf_lo(c.z), bf_hi(c.z), bf_lo(c.w), bf_hi(c.w)};
          float ss = 0.f;
#pragma unroll
          for (int e = 0; e < 16; ++e) ss += x[e] * x[e];
          ss += __shfl_xor(ss, 1); ss += __shfl_xor(ss, 2); ss += __shfl_xor(ss, 4);
          const float rstd = 1.f / sqrtf(ss * (1.f / 128.f) + EPS);
#pragma unroll
          for (int e = 0; e < 16; ++e) x[e] *= rstd * gn[e];
          v4u o0, o1; o0.x = pk2(x[0], x[1]); o0.y = pk2(x[2], x[3]); o0.z = pk2(x[4], x[5]); o0.w = pk2(x[6], x[7]); o1.x = pk2(x[8], x[9]); o1.y = pk2(x[10], x[11]); o1.z = pk2(x[12], x[13]); o1.w = pk2(x[14], x[15]);
          *(v4u*)p = o0; *(v4u*)(p + 8) = o1; } }
    { const bf16* W1C = (const bf16*)(F.ws + WS_W1C); const bf16* W2C = (const bf16*)(F.ws + WS_W2C); const float* posb = (const float*)(F.ws + WS_POSB);
      bf16* KC = (bf16*)(F.ws + WS_KC); bf16* VC = (bf16*)(F.ws + WS_VC);
      LAS unsigned char* As = F.lds + RING_OFF;
      LAS unsigned char* Hs = F.lds + RING_OFF; LAS float* ps = (LAS float*)(F.lds + RING_OFF + 16 * 8208);
      const int wid = F.wave;
      for (int task = blockIdx.x; task < 256; task += F.G) { const int j = (task & 7) >> 2, rt = (task & 3) * 32 + (task >> 3);
          { f32x4 acc[4]; CmpA ap{KVQ, j, rt};
            { const int l16 = F.tid & 15, ch = F.tid >> 4; v4u tmp[16];
#pragma unroll
              for (int p = 0; p < 16; ++p) tmp[p] = *(const v4u*)(ap(p, ch * 128 + l16 * 8));
#pragma unroll
              for (int p = 0; p < 16; ++p) *(LAS v4u*)(As + p * 8208 + (ch * 128 + l16 * 8) * 2) = tmp[p]; }
            __syncthreads();
#pragma unroll
            for (int n = 0; n < 4; ++n) acc[n] = (f32x4){0.f, 0.f, 0.f, 0.f};
#pragma unroll
            for (int hf = 0; hf < 2; ++hf) { const bf16* brow = W1C + ((size_t)j * 512 + hf * 256 + wid * 32 + r16) * 4096 + kq * 16; LAS unsigned char* arow = As + r16 * 8208 + kq * 32;
              bf16x8 b0[8][2], b1[8][2];
#pragma unroll
              for (int s8 = 0; s8 < 8; ++s8)
#pragma unroll
                  for (int n = 0; n < 2; ++n) b0[s8][n] = *(const bf16x8*)(brow + (size_t)n * 16 * 4096 + (s8 >> 1) * 64 + (s8 & 1) * 8);
#pragma unroll 1
              for (int kb = 0; kb < 16; kb += 2) {
#pragma unroll
                  for (int s8 = 0; s8 < 8; ++s8)
#pragma unroll
                      for (int n = 0; n < 2; ++n) b1[s8][n] = *(const bf16x8*)(brow + (size_t)n * 16 * 4096 + (kb + 1) * 256 + (s8 >> 1) * 64 + (s8 & 1) * 8);
                  __builtin_amdgcn_sched_barrier(0);
#pragma unroll
                  for (int s8 = 0; s8 < 8; ++s8) { const bf16x8 a = *(const LAS bf16x8*)(arow + (kb * 256 + (s8 >> 1) * 64 + (s8 & 1) * 8) * 2);
#pragma unroll
                      for (int n = 0; n < 2; ++n) acc[hf * 2 + n] = mfma16(a, b0[s8][n], acc[hf * 2 + n]); }
                  __builtin_amdgcn_sched_barrier(0);
                  if (kb + 2 < 16) {
#pragma unroll
                      for (int s8 = 0; s8 < 8; ++s8)
#pragma unroll
                          for (int n = 0; n < 2; ++n) b0[s8][n] = *(const bf16x8*)(brow + (size_t)n * 16 * 4096 + (kb + 2) * 256 + (s8 >> 1) * 64 + (s8 & 1) * 8); }
                  __builtin_amdgcn_sched_barrier(0);
#pragma unroll
                  for (int s8 = 0; s8 < 8; ++s8) { const bf16x8 a = *(const LAS bf16x8*)(arow + ((kb + 1) * 256 + (s8 >> 1) * 64 + (s8 & 1) * 8) * 2);
#pragma unroll
                      for (int n = 0; n < 2; ++n) acc[hf * 2 + n] = mfma16(a, b1[s8][n], acc[hf * 2 + n]); }
                  __builtin_amdgcn_sched_barrier(0); } }
            __syncthreads();
#pragma unroll
            for (int n = 0; n < 4; ++n) { const int col = (n >> 1) * 256 + wid * 32 + (n & 1) * 16 + r16; const float pb = posb[j * 512 + col];
#pragma unroll
                for (int i = 0; i < 4; ++i) *(LAS unsigned short*)(Hs + (4 * kq + i) * 1040 + col * 2) = f2bf1(gelu_tanh(acc[n][i] + pb)); } }
          __syncthreads();
          f32x4 o = {0.f, 0.f, 0.f, 0.f};
          { const bf16* brow = W2C + ((size_t)j * 128 + wid * 16 + r16) * 512 + kq * 8;
#pragma unroll 4
            for (int k0 = 0; k0 < 512; k0 += 32) o = mfma16(*(const LAS bf16x8*)(Hs + r16 * 1040 + (k0 + kq * 8) * 2), *(const bf16x8*)(brow + k0), o); }
          const int col = wid * 16 + r16;
          if (j == 0) {
#pragma unroll
              for (int i = 0; i < 4; ++i) { float ss = o[i] * o[i]; ss += __shfl_xor(ss, 1); ss += __shfl_xor(ss, 2); ss += __shfl_xor(ss, 4); ss += __shfl_xor(ss, 8);
                  if (r16 == 0) ps[wid * 16 + 4 * kq + i] = ss; } }
          __syncthreads();
          const float gsc = (j == 0) ? F.in[9][col] * F.in[14][col] * ATT_SCALE : 1.f;
#pragma unroll
          for (int i = 0; i < 4; ++i) { const int row = rt * 16 + 4 * kq + i; float v = o[i];
              if (j == 0) { float ss = 0.f;
#pragma unroll
                  for (int w = 0; w < 8; ++w) ss += ps[w * 16 + 4 * kq + i];
                  v *= gsc / sqrtf(ss * (1.f / 128.f) + EPS); }
              if ((row & 255) == 255) v = 0.f;
              (j == 0 ? KC : VC)[(size_t)row * 128 + col] = f2bf1(v); }
          __syncthreads(); } }
}
__device__ __forceinline__ void nsa_cmp2_phase(Frame& F) {
    const int gw = blockIdx.x * NWAVES + F.wave, NGW = F.G * NWAVES, lane = F.lane, r16 = lane & 15, kq = lane >> 4;
    const bf16* HC = (const bf16*)(F.ws + WS_HC); const bf16* W2C = (const bf16*)(F.ws + WS_W2C); bf16* KC = (bf16*)(F.ws + WS_KC); bf16* VC = (bf16*)(F.ws + WS_VC);
    for (int task = gw; task < 256; task += NGW) { const int j = task >> 7, rt = task & 127;
        f32x4 acc[8]; RowMajorA ap{HC + ((size_t)j * 2048 + rt * 16) * 512, 512};
        mini_gemm16<8>(acc, ap, W2C + (size_t)j * 128 * 512, 512, 512, lane);
#pragma unroll
        for (int i = 0; i < 4; ++i) { const int row = rt * 16 + 4 * kq + i; const bool pad = (row & 255) == 255;
            float sc = 1.f;
            if (j == 0) { float ss = 0.f;
#pragma unroll
                for (int n = 0; n < 8; ++n) ss += acc[n][i] * acc[n][i];
                ss += __shfl_xor(ss, 1); ss += __shfl_xor(ss, 2); ss += __shfl_xor(ss, 4); ss += __shfl_xor(ss, 8);
                sc = ATT_SCALE / sqrtf(ss * (1.f / 128.f) + EPS); }
#pragma unroll
            for (int n = 0; n < 8; ++n) { const int col = n * 16 + r16; float v = acc[n][i] * sc;
                if (j == 0) v *= F.in[9][col] * F.in[14][col];
                if (pad) v = 0.f;
                (j == 0 ? KC : VC)[(size_t)row * 128 + col] = f2bf1(v); } } }
}

namespace nsa {
constexpr int D = 128, KVBLK = 64, SHM_K = 16384, SHM_V = 16384;
constexpr int O_V = 0, O_K = SHM_V, BUF1 = SHM_V + SHM_K  , O_WS = 2 * BUF1, O_PB = O_WS + NWAVES * 64 * 4, O_SELM = O_PB + 32 * 65 * 4, O_OT = ((O_SELM + 32 * 8 + 1023) / 1024) * 1024  , O_END = O_OT + 32 * 2048;
static_assert(O_END <= RING_BYTES, "nsa LDS");
constexpr float THR2 = 11.0f;
#define KSWZ(row, colB) ((row) * 256 + ((colB) ^ (((row) & 7) << 4)))
#define SBAR() __builtin_amdgcn_sched_barrier(0)
__device__ __forceinline__ int v_st(int k, int c) { const int kk = (k & ~0xC) | ((k & 4) << 1) | ((k & 8) >> 1); return ((kk >> 3) * 4 + (c >> 5)) * 512 + ((kk & 7) * 32 + (c & 31)) * 2; }
__device__ __forceinline__ int v_rd_base(int lane) { return ((lane & 3) << 3) | (((lane >> 2) & 3) << 6) | (((lane >> 4) & 1) << 5) | (((lane >> 5) & 1) << 8); }
constexpr int v_rd_off(int d0, int ks, int half) { return d0 * 512 + ks * 4096 + half * 2048; }
__device__ __forceinline__ int crow(int r, int hi) { return (r & 3) + 8 * (r >> 2) + 4 * hi; }
__device__ __forceinline__ void mask_tile(f32x16& p0, f32x16& p1, int dq, unsigned W) {
    const float NEG = -__builtin_inff();
#pragma unroll
    for (int r = 0; r < 16; ++r) { const int c = (r & 3) + 8 * (r >> 2);
        if ((unsigned)(dq - c) >= W) p0[r] = NEG;
        if ((unsigned)(dq - c - 32) >= W) p1[r] = NEG; }
}
__device__ __forceinline__ float rowmax32(const f32x16& p0, const f32x16& p1) {
    float pmax = p0[0];
#pragma unroll
    for (int r = 1; r < 16; ++r) pmax = fmaxf(pmax, p0[r]);
#pragma unroll
    for (int r = 0; r < 16; ++r) pmax = fmaxf(pmax, p1[r]);
    auto rr = __builtin_amdgcn_permlane32_swap(__float_as_uint(pmax), __float_as_uint(pmax), false, false);
    return fmaxf(__uint_as_float(rr[0]), __uint_as_float(rr[1]));
}
__device__ __forceinline__ float rowsum32(const f32x16& p0, const f32x16& p1) {
    float ps = 0.f;
#pragma unroll
    for (int r = 0; r < 16; ++r) ps += p0[r];
#pragma unroll
    for (int r = 0; r < 16; ++r) ps += p1[r];
    auto rr = __builtin_amdgcn_permlane32_swap(__float_as_uint(ps), __float_as_uint(ps), false, false);
    return __uint_as_float(rr[0]) + __uint_as_float(rr[1]);
}
__device__ __forceinline__ void partialSM(f32x16& p0, f32x16& p1, float& m_reg, float& alpha, float c2) {
    const float pmax = rowmax32(p0, p1); float mn;
    if (__builtin_expect(__all((pmax - m_reg) * c2 <= THR2), 1)) { mn = m_reg; alpha = 1.f; }
    else { mn = fmaxf(m_reg, pmax); alpha = __builtin_amdgcn_exp2f((m_reg - mn) * c2); m_reg = mn; }
    const float mnL = -mn * c2;
#pragma unroll
    for (int r = 0; r < 16; ++r) p0[r] = fmaf(p0[r], c2, mnL);
#pragma unroll
    for (int r = 0; r < 16; ++r) p1[r] = fmaf(p1[r], c2, mnL);
#pragma unroll
    for (int r = 0; r < 16; ++r) p0[r] = __builtin_amdgcn_exp2f(p0[r]);
}
__device__ __forceinline__ void packP(const f32x16& p0, const f32x16& p1, bf16x8& pa0, bf16x8& pa1, bf16x8& pa2, bf16x8& pa3) {
#define PK4(P, B_, OUT) do { unsigned a0 = pk2(P[B_+0], P[B_+1]), a1 = pk2(P[B_+2], P[B_+3]);                          \
        unsigned b0 = pk2(P[B_+4], P[B_+5]), b1 = pk2(P[B_+6], P[B_+7]);                                             \
        auto r0 = __builtin_amdgcn_permlane32_swap(a0, b0, false, false); auto r1 = __builtin_amdgcn_permlane32_swap(a1, b1, false, false); \
        u32x4_t w = {r0[0], r1[0], r0[1], r1[1]}; OUT = __builtin_bit_cast(bf16x8, w); } while (0)
    typedef unsigned u32x4_t __attribute__((ext_vector_type(4)));
    PK4(p0, 0, pa0); PK4(p0, 8, pa1); PK4(p1, 0, pa2); PK4(p1, 8, pa3);
#undef PK4
}
__device__ __forceinline__ void finishSM(f32x16& p0, f32x16& p1, float alpha, float& l_reg, bf16x8& pa0, bf16x8& pa1, bf16x8& pa2, bf16x8& pa3) {
#pragma unroll
    for (int r = 0; r < 16; ++r) p1[r] = __builtin_amdgcn_exp2f(p1[r]);
    l_reg = l_reg * alpha + rowsum32(p0, p1);
    packP(p0, p1, pa0, pa1, pa2, pa3);
}
__device__ __forceinline__ void qkt(f32x16& p0, f32x16& p1, const char* K_lds, int r32, int hi, const bf16x8* qr, float cinit) {
#pragma unroll
    for (int r = 0; r < 16; ++r) { p0[r] = cinit; p1[r] = cinit; }
    const char* kb[4];
#pragma unroll
    for (int dd = 0; dd < 4; ++dd) kb[dd] = K_lds + KSWZ(r32, (dd * 16 + hi * 8) * 2);
#pragma unroll
    for (int d0 = 0; d0 < 8; ++d0) { const char* a = kb[d0 & 3] + (d0 >> 2) * 128;
        const bf16x8 b0 = *reinterpret_cast<const bf16x8*>(a);
        const bf16x8 b1 = *reinterpret_cast<const bf16x8*>(a + 32 * 256);
        p0 = __builtin_amdgcn_mfma_f32_32x32x16_bf16(b0, qr[d0], p0, 0, 0, 0);
        p1 = __builtin_amdgcn_mfma_f32_32x32x16_bf16(b1, qr[d0], p1, 0, 0, 0); }
}
__device__ __forceinline__ void pv_tile(f32x16* o, int vb0, bf16x8 pa0, bf16x8 pa1, bf16x8 pa2, bf16x8 pa3) {
#define TRRD(dst, off) asm volatile("ds_read_b64_tr_b16 %0, %1 offset:%2" : "=&v"(dst) : "v"(vb0), "i"(off) : "memory")
#define PV_D0(d0) do { s16x4 l0, l1, l2, l3, h0, h1, h2, h3; constexpr int b_ = v_rd_off(d0, 0, 0); \
        TRRD(l0, b_); TRRD(h0, b_ + 2048); TRRD(l1, b_ + 4096); TRRD(h1, b_ + 6144); TRRD(l2, b_ + 8192); TRRD(h2, b_ + 10240); TRRD(l3, b_ + 12288); TRRD(h3, b_ + 14336); \
        asm volatile("s_waitcnt lgkmcnt(0)" ::: "memory"); SBAR();   \
        o[d0] = __builtin_amdgcn_mfma_f32_32x32x16_bf16(pa0, (bf16x8){l0[0], l0[1], l0[2], l0[3], h0[0], h0[1], h0[2], h0[3]}, o[d0], 0, 0, 0);   \
        o[d0] = __builtin_amdgcn_mfma_f32_32x32x16_bf16(pa1, (bf16x8){l1[0], l1[1], l1[2], l1[3], h1[0], h1[1], h1[2], h1[3]}, o[d0], 0, 0, 0);   \
        o[d0] = __builtin_amdgcn_mfma_f32_32x32x16_bf16(pa2, (bf16x8){l2[0], l2[1], l2[2], l2[3], h2[0], h2[1], h2[2], h2[3]}, o[d0], 0, 0, 0);   \
        o[d0] = __builtin_amdgcn_mfma_f32_32x32x16_bf16(pa3, (bf16x8){l3[0], l3[1], l3[2], l3[3], h3[0], h3[1], h3[2], h3[3]}, o[d0], 0, 0, 0); } while (0)
    PV_D0(0); PV_D0(1); PV_D0(2); PV_D0(3);
#undef PV_D0
#undef TRRD
}
struct Stage { bf16x8 k0, k1, v0, v1; };
__device__ __forceinline__ void stage_load(Stage& S, const bf16* Kp, const bf16* Vp, int ld, int kb, int sr, int sc, bool withV) {
    const bf16* kt = Kp + (size_t)kb * ld; const bf16* vt = Vp + (size_t)kb * ld;
    const unsigned voff = (unsigned)(sr * ld + sc);
    S.k0 = *(const bf16x8*)(kt + voff); S.k1 = *(const bf16x8*)(kt + (size_t)32 * ld + voff);
    if (withV) { S.v0 = *(const bf16x8*)(vt + voff); S.v1 = *(const bf16x8*)(vt + (size_t)32 * ld + voff); }
}
__device__ __forceinline__ void stage_write(const Stage& S, char* lds, int sr, int sc, bool withV) {
    const int kws = KSWZ(sr, sc * 2);
    *(bf16x8*)(lds + O_K + kws) = S.k0; *(bf16x8*)(lds + O_K + kws + 32 * 256) = S.k1;
    if (withV) { *(bf16x8*)(lds + O_V + v_st(sr, sc)) = S.v0; *(bf16x8*)(lds + O_V + v_st(32 + sr, sc)) = S.v1; }
}
template <int ACC>
__device__ __forceinline__ void emit(const f32x16* o, const float* fl, char* OTw, int r32, int hi) {
    int r32o = r32, hio = hi; asm volatile("" : "+v"(r32o), "+v"(hio));
    char* base = OTw + 4 * hio * 2048 + r32o * 2;
#pragma unroll
    for (int r = 0; r < 16; ++r) { const float f = fl[(r & 3) + 8 * (r >> 2) + 4 * hio]; unsigned short* p = (unsigned short*)(base + ((r & 3) + 8 * (r >> 2)) * 2048);
#pragma unroll
        for (int d0 = 0; d0 < 4; ++d0) { float v = o[d0][r] * f;
            if (ACC >= 1) v += bf1(p[d0 * 32]);
            p[d0 * 32] = f2bf1(v); } }
}
template <int MODE, int ACC>
__device__ __forceinline__ void flash_pass(char* lds, const bf16* Kp, const bf16* Vp, int ld, unsigned long long tiles, int t, int qb, unsigned long long mymask, const bf16x8* qr, float c2, float gate, char* OTw,
                                           Stage& S, const bf16* Kn, const bf16* Vn, Stage* Sn, int tid, int wid, int lane) {
    const int r32 = lane & 31, hi = lane >> 5, sr = tid >> 4, sc = (tid & 15) * 8;
    float* ws = (float*)(lds + O_WS) + wid * 64; float* li_l = ws; float* al_l = ws + 32;
    const int vb0 = (int)(uintptr_t)(lds + O_V) + v_rd_base(lane);
    f32x16 o[4] = {}; float m_reg = -1e30f, l_reg = 0.f;
    unsigned long long rem = tiles;
    int j = __builtin_ctzll(rem); rem &= rem - 1;
    __syncthreads();
    stage_write(S, lds, sr, sc, true);
    int jn = rem ? __builtin_ctzll(rem) : -1;
    if (jn >= 0) { rem &= rem - 1; stage_load(S, Kp, Vp, ld, jn * KVBLK, sr, sc, true); }
    int cur = 0;
    for (;;) {
        __syncthreads();
        int jnn = -1;
        if (jn >= 0) { stage_write(S, lds + (cur ^ 1) * BUF1, sr, sc, true); jnn = rem ? __builtin_ctzll(rem) : -1;
            if (jnn >= 0) { rem &= rem - 1; stage_load(S, Kp, Vp, ld, jnn * KVBLK, sr, sc, true); } }
        f32x16 p0, p1; float alpha; bf16x8 pa0, pa1, pa2, pa3;
        float cinit = 0.f;
        if (MODE == 1) cinit = ((mymask >> j) & 1ull) ? 0.f : -__builtin_inff();
        qkt(p0, p1, lds + cur * BUF1 + O_K, r32, hi, qr, cinit);
        if (MODE == 0) { const int tok0_ = t - r32; if (!(j * KVBLK + 63 <= tok0_ && j * KVBLK >= tok0_ - 480)) mask_tile(p0, p1, t - j * KVBLK - 4 * hi, 512u); }
        else if (j == qb) mask_tile(p0, p1, t - j * KVBLK - 4 * hi, 0x7fffffffu);
        partialSM(p0, p1, m_reg, alpha, c2);
        finishSM(p0, p1, alpha, l_reg, pa0, pa1, pa2, pa3);
        if (__any(alpha < 1.f)) { if (hi == 0) al_l[r32] = alpha; asm volatile("s_waitcnt lgkmcnt(0)" ::: "memory");
#pragma unroll
            for (int d_ = 0; d_ < 4; ++d_)
#pragma unroll
                for (int r = 0; r < 16; ++r) o[d_][r] *= al_l[crow(r, hi)]; }
        pv_tile(o, vb0 + cur * BUF1, pa0, pa1, pa2, pa3);
        if (jn < 0) break;
        j = jn; jn = jnn; cur ^= 1;
    }
    if (Sn) stage_load(*Sn, Kn, Vn, ld, 0, sr, sc, true);
    if (hi == 0) li_l[r32] = gate / l_reg; asm volatile("s_waitcnt lgkmcnt(0)" ::: "memory");
    emit<ACC>(o, li_l, OTw, r32, hi);
}

__device__ __forceinline__ void unit(Frame& F, char* lds, int b, int g, int tg) {
    const int tid = F.tid, lane = F.lane, wid = F.wave, r32 = lane & 31, hi = lane >> 5, sr = tid >> 4, sc = (tid & 15) * 8;
    const int head = g * 8 + wid, tok0 = tg * 32, t = tok0 + r32, qb = tg >> 1, bg = b * 4 + g;
    const bf16* KVQ = (const bf16*)(F.ws + WS_BIG); const float* GT = (const float*)(F.ws + WS_GT);
    const bf16* KC = (const bf16*)(F.ws + WS_KC) + (size_t)bg * 256 * 128; const bf16* VC = (const bf16*)(F.ws + WS_VC) + (size_t)bg * 256 * 128;
    const size_t rowq = (size_t)b * SEQ + t;
    float* ws = (float*)(lds + O_WS) + wid * 64; float* li_l = ws;
    unsigned* pb = (unsigned*)(lds + O_PB); unsigned* selm = (unsigned*)(lds + O_SELM);
    const int vb0 = (int)(uintptr_t)(lds + O_V) + v_rd_base(lane);
    bf16x8 qr[8]; float ss = 0.f;
#pragma unroll
    for (int d0 = 0; d0 < 8; ++d0) { qr[d0] = *(const bf16x8*)(KVQ + rowq * NKVQ + KVW + head * 128 + d0 * 16 + hi * 8);
        const v4u w = __builtin_bit_cast(v4u, qr[d0]);
        ss += (bf_lo(w.x) * bf_lo(w.x) + bf_hi(w.x) * bf_hi(w.x)) + (bf_lo(w.y) * bf_lo(w.y) + bf_hi(w.y) * bf_hi(w.y)) + (bf_lo(w.z) * bf_lo(w.z) + bf_hi(w.z) * bf_hi(w.z)) + (bf_lo(w.w) * bf_lo(w.w) + bf_hi(w.w) * bf_hi(w.w)); }
    { auto rr = __builtin_amdgcn_permlane32_swap(__float_as_uint(ss), __float_as_uint(ss), false, false); ss = __uint_as_float(rr[0]) + __uint_as_float(rr[1]); }
    const float c2 = 1.4426950408889634f / sqrtf(ss * (1.f / 128.f) + EPS);
    const float g_cmp = GT[rowq * 96 + head], g_sel = GT[rowq * 96 + 32 + head], g_win = GT[rowq * 96 + 64 + head];
    for (int i = tid; i < 32 * 65; i += NWAVES * 64) pb[i] = 0u;
    char* OTw = lds + O_OT + wid * 256;
    const int nct = (tg >> 5) + 1; const int cmax = (t - 31) >> 4;
    float m_c = -1e30f, l_c = 0.f;
    { Stage S;
      for (int kt = 0; kt < nct; ++kt) {
          stage_load(S, KC, VC, 128, kt * 64, sr, sc, false);
          __syncthreads(); stage_write(S, lds, sr, sc, false); __syncthreads();
          f32x16 p0, p1; qkt(p0, p1, lds + O_K, r32, hi, qr, 0.f);
          mask_tile(p0, p1, cmax - kt * 64 - 4 * hi, 0x7fffffffu);
          const float pmax = rowmax32(p0, p1), mn = fmaxf(m_c, pmax), al = __builtin_amdgcn_exp2f((m_c - mn) * c2), mnL = -mn * c2;
#pragma unroll
          for (int r = 0; r < 16; ++r) { p0[r] = __builtin_amdgcn_exp2f(fmaf(p0[r], c2, mnL)); p1[r] = __builtin_amdgcn_exp2f(fmaf(p1[r], c2, mnL)); }
          l_c = l_c * al + rowsum32(p0, p1); m_c = mn; }
      const float inv_l = l_c > 0.f ? 1.f / l_c : 0.f; const float mnL = -m_c * c2;
      f32x16 o[4] = {};
      for (int kt = 0; kt < nct; ++kt) {
          stage_load(S, KC, VC, 128, kt * 64, sr, sc, true);
          __syncthreads(); stage_write(S, lds, sr, sc, true); __syncthreads();
          f32x16 p0, p1; qkt(p0, p1, lds + O_K, r32, hi, qr, 0.f);
          mask_tile(p0, p1, cmax - kt * 64 - 4 * hi, 0x7fffffffu);
#pragma unroll
          for (int r = 0; r < 16; ++r) { p0[r] = __builtin_amdgcn_exp2f(fmaf(p0[r], c2, mnL)) * inv_l; p1[r] = __builtin_amdgcn_exp2f(fmaf(p1[r], c2, mnL)) * inv_l; }
#pragma unroll
          for (int rg = 0; rg < 4; ++rg) { const int j0 = 16 * kt + 2 * rg + hi;
              const float a0 = (p0[4 * rg] + p0[4 * rg + 1]) + (p0[4 * rg + 2] + 0.5f * p0[4 * rg + 3]), b0 = 0.5f * p0[4 * rg + 3];
              const float a1 = (p1[4 * rg] + p1[4 * rg + 1]) + (p1[4 * rg + 2] + 0.5f * p1[4 * rg + 3]), b1 = 0.5f * p1[4 * rg + 3];
              atomicAdd(&pb[r32 * 65 + j0], (unsigned)(a0 * 67108864.f + 0.5f)); atomicAdd(&pb[r32 * 65 + j0 + 1], (unsigned)(b0 * 67108864.f + 0.5f));
              atomicAdd(&pb[r32 * 65 + j0 + 8], (unsigned)(a1 * 67108864.f + 0.5f)); atomicAdd(&pb[r32 * 65 + j0 + 9], (unsigned)(b1 * 67108864.f + 0.5f)); }
          bf16x8 pa0, pa1, pa2, pa3; packP(p0, p1, pa0, pa1, pa2, pa3);
          pv_tile(o, vb0, pa0, pa1, pa2, pa3); }
      if (hi == 0) li_l[r32] = g_cmp; asm volatile("s_waitcnt lgkmcnt(0)" ::: "memory");
      emit<0>(o, li_l, OTw, r32, hi); }
    const int lowk_ = tok0 - 511, wj_lo = lowk_ > 0 ? lowk_ >> 6 : 0, wj_hi = ((tok0 + 31) >> 6) + 1;
    const unsigned long long wtiles = ((wj_hi >= 64) ? ~0ull : ((1ull << wj_hi) - 1ull)) & ~((1ull << wj_lo) - 1ull);
    const bf16* Kw = KVQ + (size_t)b * SEQ * NKVQ + 4 * 512 + g * 128; const bf16* Vw = KVQ + (size_t)b * SEQ * NKVQ + 5 * 512 + g * 128;
    Stage SW; stage_load(SW, Kw, Vw, NKVQ, wj_lo * KVBLK, sr, sc, true);
    __syncthreads();
#pragma unroll 1
    for (int tt = 0; tt < 4; ++tt) { const int tok = 4 * wid + tt; const bool valid = lane <= qb; const bool forced = lane == 0 || lane == qb;
        const unsigned key = forced ? 0xFFFFFFFFu : pb[tok * 65 + lane]; int rank = 0;
        for (int i = 0; i <= qb; ++i) { const unsigned ki = (unsigned)__builtin_amdgcn_readlane((int)key, i); rank += (ki > key || (ki == key && i < lane)) ? 1 : 0; }
        const unsigned long long mk = __ballot(valid && rank < 16);
        if (lane == 0) { selm[2 * tok] = (unsigned)mk; selm[2 * tok + 1] = (unsigned)(mk >> 32); } }
    __syncthreads();
    const unsigned long long mymask = (unsigned long long)selm[2 * r32] | ((unsigned long long)selm[2 * r32 + 1] << 32);
    unsigned ulo = (unsigned)mymask, uhi = (unsigned)(mymask >> 32);
#pragma unroll
    for (int o_ = 1; o_ < 32; o_ <<= 1) { ulo |= __shfl_xor(ulo, o_); uhi |= __shfl_xor(uhi, o_); }
    const unsigned long long uni = (unsigned long long)(unsigned)__builtin_amdgcn_readfirstlane((int)ulo) | ((unsigned long long)(unsigned)__builtin_amdgcn_readfirstlane((int)uhi) << 32);
    { const bf16* Ks = KVQ + (size_t)b * SEQ * NKVQ + 2 * 512 + g * 128; const bf16* Vs = KVQ + (size_t)b * SEQ * NKVQ + 3 * 512 + g * 128;
      Stage SS;
      flash_pass<0, 1>(lds, Kw, Vw, NKVQ, wtiles, t, qb, 0ull, qr, c2, g_win, OTw, SW, Ks, Vs, &SS, tid, wid, lane);
      flash_pass<1, 2>(lds, Ks, Vs, NKVQ, uni, t, qb, mymask, qr, c2, g_sel, OTw, SS, nullptr, nullptr, nullptr, tid, wid, lane); }
    __syncthreads();
    { const int tok = tid >> 4, ch = tid & 15;
      const char* src = lds + O_OT + tok * 2048 + ch * 128; unsigned char* dst = (unsigned char*)(F.ws + WS_A3) + ((size_t)b * SEQ + tok0 + tok) * DM + g * 1024 + ch * 64;
#pragma unroll
      for (int i = 0; i < 4; ++i) { const v4u w0 = *(const v4u*)(src + i * 32), w1 = *(const v4u*)(src + i * 32 + 16); v4u q; const unsigned ws_[8] = {w0.x, w0.y, w0.z, w0.w, w1.x, w1.y, w1.z, w1.w}; int qq[4];
#pragma unroll
          for (int e = 0; e < 4; ++e) { int t_ = __builtin_amdgcn_cvt_pk_fp8_f32(bf_lo(ws_[2 * e]) * 64.f, bf_hi(ws_[2 * e]) * 64.f, 0, false); qq[e] = __builtin_amdgcn_cvt_pk_fp8_f32(bf_lo(ws_[2 * e + 1]) * 64.f, bf_hi(ws_[2 * e + 1]) * 64.f, t_, true); }
          q.x = (unsigned)qq[0]; q.y = (unsigned)qq[1]; q.z = (unsigned)qq[2]; q.w = (unsigned)qq[3]; *(v4u*)(dst + i * 16) = q; } }
    __syncthreads();
}
#undef KSWZ
#undef SBAR
}
__device__ __forceinline__ void nsa_attn_phase(Frame& F) {
    for (int ui = blockIdx.x; ui < 1024; ui += F.G) { const int vw = ui & 255, rnd = ui >> 8, bg = vw & 7, s = vw >> 3;
        const int tg = rnd == 0 ? s : rnd == 1 ? 63 - s : rnd == 2 ? 64 + s : 127 - s;
        nsa::unit(F, (char*)(F.lds + RING_OFF), bg >> 2, bg & 3, tg); }
}

struct Args { const float* in[18]; float* out; unsigned char* ws; int ph_lo, ph_hi; };
__global__ void __launch_bounds__(NWAVES * 64, 2) skel_fwd(Args args) {
    extern __shared__ __attribute__((aligned(16))) unsigned char lds[];
    Frame F;
    F.lds = (LAS unsigned char*)lds;
    F.MISC = (volatile LAS unsigned*)(F.lds + MISC_OFF);
    F.tid = threadIdx.x; F.lane = F.tid & 63; F.wave = __builtin_amdgcn_readfirstlane(F.tid >> 6);
    F.G = gridDim.x;
    unsigned char* ws = args.ws; F.ws = ws; F.out = args.out;
#pragma unroll
    for (int i = 0; i < 18; ++i) F.in[i] = args.in[i];
    F.ctl = (gu32*)(ws + WS_CTL);
    for (int u = F.tid; u < (LDS_BYTES - LDSCTL_OFF) / 4; u += NWAVES * 64) ((LAS unsigned*)(F.lds + LDSCTL_OFF))[u] = 0u;
    __syncthreads();
    XcdBarrier bar; bar.bar = (unsigned*)(F.ctl + CW_BAR); bar.x = 0; bar.st = nullptr;
    if (!MK_PER_PHASE) bar = xcd_barrier_post((unsigned*)(F.ctl + CW_BAR), F.MISC + 8);
    const int lo = args.ph_lo, hi = args.ph_hi;
#ifndef PHASE_MASK
#define PHASE_MASK 0x1ffff
#endif
#define IN(k) (((PHASE_MASK >> (k)) & 1) && lo <= (k) && (k) < hi)
#ifndef DUP_MASK
#define DUP_MASK 0
#endif
#ifndef PROBE_ML
#define PROBE_ML 0
#endif
#ifndef PROBE2
#define PROBE2 0
#endif
#ifndef CW_TAIL
#define CW_TAIL 10240
#endif
#ifndef TS_ON
#define TS_ON 0
#define TS_LO 0
#define TS_HI 0
#endif
#define REP(k) for (int rep_ = 0, nrep_ = 1 + ((DUP_MASK >> (k)) & 1); rep_ < nrep_; ++rep_, (rep_ < nrep_ ? xcd_barrier(bar) : (void)0))
#define SEAM(k) do { if (IN(k) && (hi > (k) + 1)) xcd_barrier(bar); if (TS_ON && (k) == TS_HI) ts1 = __builtin_amdgcn_s_memrealtime(); } while (0)
    unsigned long long ts0 = 0, ts1 = 0;
    bf16* XB = (bf16*)(ws + WS_XB); bf16* A3 = (bf16*)(ws + WS_A3); bf16* BIG = (bf16*)(ws + WS_BIG);
    bf16* X1 = (bf16*)(ws + WS_X1); bf16* X2 = (bf16*)(ws + WS_X2); bf16* X3 = X1;

    if (TS_ON && 0 == TS_LO) ts0 = __builtin_amdgcn_s_memrealtime(); if (IN(0)) REP(0) { if (Q8_WIN_O) convert_strips(F, (int)blockIdx.x, F.G, QS_NSTRIPS, QS_NSTRIPS + 128); p0_prologue(F); } SEAM(0);
    if (TS_ON && 1 == TS_LO) ts0 = __builtin_amdgcn_s_memrealtime(); if (IN(1)) REP(1) {
        { pg8::Gemm g{XB, (const bf16*)(ws + WS_WIN), MTOK, WIN_BF, DM}; pg8::StaticOrder S; S.init(MTOK, WIN_BF, F.G, (int)blockIdx.x);
          pg8::EpiBf16<0> E{BIG, M_MAIN, nullptr};
          pg8::gemm_phase<pg8::EpiBf16<0>, pg8::StaticOrder, true, true>(F.lds + RING_OFF, g, S, E); }
        if (Q8_WIN_O) {
            pg8::Gemm g{(const bf16*)(ws + WS_XQ), (const bf16*)(ws + WS_WINQ), MTOK, M_MAIN - WIN_BF, DM}; pg8::StaticOrder S; S.init(MTOK, M_MAIN - WIN_BF, F.G, (int)blockIdx.x);
            pg8::EpiQ8<0> E{BIG + WIN_BF, M_MAIN, (const float*)(ws + CTL_CMAX) + 53248, (const float*)(ws + WS_RS) + 24576};
            pg8::gemm_phase<pg8::EpiQ8<0>, pg8::StaticOrder, true, true, 2>(F.lds + RING_OFF, g, S, E); }
        gates1_phase(F);
    } SEAM(1);
    if (TS_ON && 2 == TS_LO) ts0 = __builtin_amdgcn_s_memrealtime(); if (IN(2)) REP(2) {
        const int bid = (int)blockIdx.x;
        if (F.G == 256) {
            const int x = bid & 7, y = bid >> 3;
            if (x < 4) { mlstm_phase(F, (x * 4 + (y >> 3)) * 8 + (y & 7), 128);
                QS_BAR(); convert_wide(F, CW_TOTAL - CW_SCAN_SHARE, CW_TOTAL, (y * 4 + x) * NWAVES + F.wave, 128 * NWAVES); }
            else if (!(PROBE_ML && rep_)) { const int wk = (y * 4 + (x - 4)) * NWAVES + F.wave; convert_narrow(F, 64, 256, wk, 128 * NWAVES); if (Q8_STRIPS) convert_strips(F, (x - 4) * 32 + y, 128); convert_wide(F, CW_EARLY, CW_TOTAL - CW_SCAN_SHARE, wk, 128 * NWAVES); }
        } else {
            mlstm_phase(F, bid, F.G); if (Q8_STRIPS) convert_strips(F, bid, F.G); convert_wide(F, CW_EARLY, CW_TOTAL, bid * NWAVES + F.wave, F.G * NWAVES); convert_narrow(F, 64, 256, bid * NWAVES + F.wave, F.G * NWAVES);
        }
    } SEAM(2);
#if PROBE2 == 1
    { xcd_barrier(bar); const int bid = (int)blockIdx.x, x = bid & 7, y = bid >> 3; if (x < 4) mlstm_phase(F, (x * 4 + (y >> 3)) * 8 + (y & 7), 128); xcd_barrier(bar); }
#elif PROBE2 == 2
    { xcd_barrier(bar); const int bid = (int)blockIdx.x, x = bid & 7, y = bid >> 3; if (x >= 4) { const int wk = (y * 4 + (x - 4)) * NWAVES + F.wave; convert_wide(F, CW_EARLY, CW_TOTAL, wk, 128 * NWAVES); } xcd_barrier(bar); }
#elif PROBE2 == 4
    { xcd_barrier(bar); const int bid = (int)blockIdx.x, x = bid & 7, y = bid >> 3;
      if (x < 4) mlstm_phase(F, (x * 4 + (y >> 3)) * 8 + (y & 7), 128);
      else { const int wk = (y * 4 + (x - 4)) * NWAVES + F.wave; convert_wide(F, CW_EARLY, CW_TOTAL, wk, 128 * NWAVES); }
      xcd_barrier(bar); }
#elif PROBE2 == 3
    { xcd_barrier(bar); convert_wide(F, CW_EARLY, CW_TOTAL, blockIdx.x * NWAVES + F.wave, F.G * NWAVES); xcd_barrier(bar); }
#endif
    if (TS_ON && 3 == TS_LO) ts0 = __builtin_amdgcn_s_memrealtime(); if (IN(3)) REP(3) { gating_phase(F);
        if (Q8_WMO && !Q8_STRIPS) wquant_phase(F, (const bf16*)(ws + WS_WMO), (const float*)(ws + CTL_CMAX) + 49152, (unsigned char*)(ws + WS_WMOQ), DM);
        if ((Q8_UP_MASK & 1) && !Q8_STRIPS) wquant_phase(F, (const bf16*)(ws + WS_WUP0), (const float*)(ws + CTL_CMAX), (unsigned char*)(ws + WS_WUPQ0), DFF);
        if ((Q8_UP_MASK & 2) && !Q8_STRIPS) wquant_phase(F, (const bf16*)(ws + WS_WUP1), (const float*)(ws + CTL_CMAX) + 16384, (unsigned char*)(ws + WS_WUPQ1), DFF);
        if (Q8_KVQ && !Q8_STRIPS) wquant_phase(F, (const bf16*)(ws + WS_WKVQ), (const float*)(ws + CTL_CMAX) + 32768, (unsigned char*)(ws + WS_WKVQ8), NKVQ);
        if (blockIdx.x == 0) { const float* pp = (const float*)(ws + WS_POSP); float* posb = (float*)(ws + WS_POSB);
            for (int i = F.tid; i < 1024; i += NWAVES * 64) { float a = 0.f;
#pragma unroll 8
                for (int ch = 0; ch < 32; ++ch) a += pp[ch * 1024 + i];
                posb[i] = a; } }
    } SEAM(3);
    if (TS_ON && 4 == TS_LO) ts0 = __builtin_amdgcn_s_memrealtime(); if (IN(4)) REP(4) {
        pg8::StaticOrder S; S.init(MTOK, DM, F.G, (int)blockIdx.x);
        if (Q8_WMO) { pg8::Gemm g{A3, (const bf16*)(ws + WS_WMOQ), MTOK, DM, DM};
            pg8::EpiRes<false, true, true> E{F.in[0], X1, (float*)(ws + WS_PART), DM, 1.f, nullptr, (const float*)(ws + WS_RS) + 24576, (const float*)(ws + CTL_CMAX) + 49152};
            pg8::gemm_phase<pg8::EpiRes<false, true, true>, pg8::StaticOrder, true, true, 2>(F.lds + RING_OFF, g, S, E); }
        else { pg8::Gemm g{A3, (const bf16*)(ws + WS_WMO), MTOK, DM, DM};
            pg8::EpiRes<false, true> E{F.in[0], X1, (float*)(ws + WS_PART), DM};
            pg8::gemm_phase<pg8::EpiRes<false, true>, pg8::StaticOrder, true, true>(F.lds + RING_OFF, g, S, E); }
    } SEAM(4);
    if (TS_ON && 5 == TS_LO) ts0 = __builtin_amdgcn_s_memrealtime(); if (IN(5)) REP(5) { if (Q8_UP_MASK & 1) rstd_phase(F, (float*)(ws + WS_RS), X1, (unsigned char*)(ws + WS_XQ), (float*)(ws + WS_RS) + 24576); else rstd_phase(F, (float*)(ws + WS_RS)); } SEAM(5);
    if (TS_ON && 6 == TS_LO) ts0 = __builtin_amdgcn_s_memrealtime(); if (IN(6)) REP(6) {
        pg8::StaticOrder S; S.init(MTOK, DFF, F.G, (int)blockIdx.x);
        if (Q8_UP_MASK & 1) { pg8::Gemm g{(const bf16*)(ws + WS_XQ), (const bf16*)(ws + WS_WUPQ0), MTOK, DFF, DM};
            pg8::EpiQ8<2> E{BIG, DFF, (const float*)(ws + CTL_CMAX), (const float*)(ws + WS_RS) + 24576};
            pg8::gemm_phase<pg8::EpiQ8<2>, pg8::StaticOrder, true, true, 2>(F.lds + RING_OFF, g, S, E); }
        else { pg8::Gemm g{X1, (const bf16*)(ws + WS_WUP0), MTOK, DFF, DM};
            pg8::EpiBf16<2, true> E{BIG, DFF, (const float*)(ws + WS_RS)};
            pg8::gemm_phase<pg8::EpiBf16<2, true>, pg8::StaticOrder, true, true>(F.lds + RING_OFF, g, S, E); }
    } SEAM(6);
    if (TS_ON && 7 == TS_LO) ts0 = __builtin_amdgcn_s_memrealtime(); if (IN(7)) REP(7) {
        pg8::Gemm g{BIG, (const bf16*)(ws + WS_WDN0), MTOK, DM, DFF}; pg8::StaticOrder S; S.init(MTOK, DM, F.G, (int)blockIdx.x);
        pg8::EpiRes<true, true> E{X1, X2, (float*)(ws + WS_PART), DM, 1.f, Q8_KVQ ? nullptr : (unsigned char*)(ws + WS_HR)};
        pg8::gemm_phase<pg8::EpiRes<true, true>, pg8::StaticOrder, true, true>(F.lds + RING_OFF, g, S, E);
    } SEAM(7);
    if (TS_ON && 8 == TS_LO) ts0 = __builtin_amdgcn_s_memrealtime(); if (IN(8)) REP(8) { if (Q8_KVQ) rstd_phase(F, (float*)(ws + WS_RS) + 8192, X2, (unsigned char*)(ws + WS_XQ), (float*)(ws + WS_RS) + 24576); else rstd_phase(F, (float*)(ws + WS_RS) + 8192); } SEAM(8);
    if (TS_ON && 9 == TS_LO) ts0 = __builtin_amdgcn_s_memrealtime(); if (IN(9)) REP(9) {
        pg8::StaticOrder S; S.init(MTOK, NKVQ, F.G, (int)blockIdx.x);
        if (Q8_KVQ) { pg8::Gemm g{(const bf16*)(ws + WS_XQ), (const bf16*)(ws + WS_WKVQ8), MTOK, NKVQ, DM};
            pg8::EpiQ8<0> E{BIG, NKVQ, (const float*)(ws + CTL_CMAX) + 32768, (const float*)(ws + WS_RS) + 24576};
            pg8::gemm_phase<pg8::EpiQ8<0>, pg8::StaticOrder, true, true, 2>(F.lds + RING_OFF, g, S, E); }
        else { pg8::Gemm g{(const bf16*)(ws + WS_HR), (const bf16*)(ws + WS_WKVQ), MTOK, NKVQ, DM};
            pg8::EpiBf16<0, true> E{BIG, NKVQ, (const float*)(ws + WS_RS) + 8192, 1.f / 256.f};
            pg8::gemm_phase<pg8::EpiBf16<0, true>, pg8::StaticOrder, true, true, 1>(F.lds + RING_OFF, g, S, E); }
        gates2_phase(F);
    } SEAM(9);
    if (TS_ON && 10 == TS_LO) ts0 = __builtin_amdgcn_s_memrealtime(); if (IN(10)) REP(10) { nsa_prep_phase(F); } SEAM(10);
    if (TS_ON && 11 == TS_LO) ts0 = __builtin_amdgcn_s_memrealtime();
    if (TS_ON && 12 == TS_LO) ts0 = __builtin_amdgcn_s_memrealtime(); if (IN(12)) REP(12) { nsa_attn_phase(F); } SEAM(12);
    if (TS_ON && 13 == TS_LO) ts0 = __builtin_amdgcn_s_memrealtime(); if (IN(13)) REP(13) {
        pg8::Gemm g{A3, (const bf16*)(ws + WS_WNO), MTOK, DM, DM}; pg8::StaticOrder S; S.init(MTOK, DM, F.G, (int)blockIdx.x);
        pg8::EpiRes<true, true> E{X2, X3, (float*)(ws + WS_PART), DM, 1.f / 16384.f};
        pg8::gemm_phase<pg8::EpiRes<true, true>, pg8::StaticOrder, true, true, 1>(F.lds + RING_OFF, g, S, E);
    } SEAM(13);
    if (TS_ON && 14 == TS_LO) ts0 = __builtin_amdgcn_s_memrealtime(); if (IN(14)) REP(14) { if (Q8_UP_MASK & 2) rstd_phase(F, (float*)(ws + WS_RS) + 16384, X3, (unsigned char*)(ws + WS_XQ), (float*)(ws + WS_RS) + 24576); else rstd_phase(F, (float*)(ws + WS_RS) + 16384); } SEAM(14);
    if (TS_ON && 15 == TS_LO) ts0 = __builtin_amdgcn_s_memrealtime(); if (IN(15)) REP(15) {
        pg8::StaticOrder S; S.init(MTOK, DFF, F.G, (int)blockIdx.x);
        if (Q8_UP_MASK & 2) { pg8::Gemm g{(const bf16*)(ws + WS_XQ), (const bf16*)(ws + WS_WUPQ1), MTOK, DFF, DM};
            pg8::EpiQ8<2> E{BIG, DFF, (const float*)(ws + CTL_CMAX) + 16384, (const float*)(ws + WS_RS) + 24576};
            pg8::gemm_phase<pg8::EpiQ8<2>, pg8::StaticOrder, true, true, 2>(F.lds + RING_OFF, g, S, E); }
        else { pg8::Gemm g{X3, (const bf16*)(ws + WS_WUP1), MTOK, DFF, DM};
            pg8::EpiBf16<2, true> E{BIG, DFF, (const float*)(ws + WS_RS) + 16384};
            pg8::gemm_phase<pg8::EpiBf16<2, true>, pg8::StaticOrder, true, true>(F.lds + RING_OFF, g, S, E); }
    } SEAM(15);
    if (TS_ON && 16 == TS_LO) ts0 = __builtin_amdgcn_s_memrealtime(); if (IN(16)) REP(16) {
        pg8::Gemm g{BIG, (const bf16*)(ws + WS_WDN1), MTOK, DM, DFF}; pg8::StaticOrder S; S.init(MTOK, DM, F.G, (int)blockIdx.x);
        pg8::EpiRes<true, false> E{X3, F.out, nullptr, DM};
        pg8::gemm_phase<pg8::EpiRes<true, false>, pg8::StaticOrder, true, true>(F.lds + RING_OFF, g, S, E);
    }
#if TS_ON
    if (TS_HI == 16) ts1 = __builtin_amdgcn_s_memrealtime();
    xcd_barrier(bar);
    if (blockIdx.x == 0 && F.tid == 0) F.out[0] = (float)(ts1 - ts0) * 0.01f;
#endif
#undef IN
#undef SEAM
}

extern "C" void kernel_launch(void* const* d_in, const int* in_sizes, int n_in, void* d_out, int out_size, void* d_ws, size_t ws_size, hipStream_t stream) {
    static int grid = 0;
    if (grid == 0) {
        if (n_in != 18 || in_sizes[0] != MTOK * DM || out_size != MTOK * DM || ws_size < WS_END) { fprintf(stderr, "kernel_launch: unexpected shapes (n_in %d, in0 %d, out %d, ws %zu); nothing launched\n", n_in, n_in > 0 ? in_sizes[0] : -1, out_size, ws_size); grid = -1; return; }
        int dev = 0, cus = 0, per_cu = 0;
        if (hipGetDevice(&dev) != hipSuccess || hipDeviceGetAttribute(&cus, hipDeviceAttributeMultiprocessorCount, dev) != hipSuccess) { grid = -1; return; }
        if (hipFuncSetAttribute((const void*)skel_fwd, hipFuncAttributeMaxDynamicSharedMemorySize, LDS_BYTES) != hipSuccess) { fprintf(stderr, "kernel_launch: hipFuncSetAttribute failed\n"); grid = -1; return; }
        if (hipOccupancyMaxActiveBlocksPerMultiprocessor(&per_cu, (const void*)skel_fwd, NWAVES * 64, LDS_BYTES) != hipSuccess || per_cu < 1) fprintf(stderr, "kernel_launch: occupancy query reports %d\n", per_cu);
        (void)hipGetLastError();
        grid = cus;
    }
    if (grid < 0) return;
    if (hipMemsetAsync((char*)d_ws + WS_CTL, 0, CTL_ZERO_BYTES, stream) != hipSuccess) return;
    Args a{};
    for (int i = 0; i < 18; ++i) a.in[i] = (const float*)d_in[i];
    a.out = (float*)d_out; a.ws = (unsigned char*)d_ws;
#if MK_PER_PHASE
    for (int p = 0; p < N_PHASES; ++p) { a.ph_lo = p; a.ph_hi = p + 1; hipLaunchKernelGGL(skel_fwd, dim3(grid), dim3(NWAVES * 64), LDS_BYTES, stream, a); }
#else
    a.ph_lo = 0; a.ph_hi = N_PHASES; hipLaunchKernelGGL(skel_fwd, dim3(grid), dim3(NWAVES * 64), LDS_BYTES, stream, a);
#endif
}
```
